# Optimizing an MI355X kernel written in HIP

```python
import math, functools
import jax, jax.numpy as jnp
from jax import lax
import numpy as np

D_MODEL = 1024
BATCH = 2
SEQ = 8192
DEPTH = 2
DEC_BATCH = 128
DEC_SEQ = 1
PAST_LEN = 2048
PAGE_SIZE = 128

N_A_LAYERS = DEPTH // 2
N_B_LAYERS = DEPTH - N_A_LAYERS
CHUNK = 128
A_WIDTH = D_MODEL
A_GROUPS = 8
A_GROUP_DIM = A_WIDTH // A_GROUPS
N_HEADS = 16
HEAD_DIM = D_MODEL // N_HEADS
KV_HEADS = 4
HEADS_PER_GROUP = N_HEADS // KV_HEADS
CMP_STRIDE = 16
CMP_BLOCK = 2 * CMP_STRIDE
CMP_HIDDEN = 4 * HEAD_DIM
SLC_BLOCK = 64
N_SELECT = 16
WINDOW = 512
Q_BLOCK = 128
D_FF = ((8 * D_MODEL + 3 * 256 - 1) // (3 * 256)) * 256
ROPE_THETA = 10000.0
EPS = 1e-6
NEG_INF = -1e30
FORCE_SCORE = 1e9
TINY = 1e-30

kernel_name = 'yoco_gmlp_nsa_decoder_step'


def rms_norm(x, g):
    xf = x.astype(jnp.float32)
    y = xf * lax.rsqrt(jnp.mean(xf * xf, axis=-1, keepdims=True) + EPS)
    return (y * g.astype(jnp.float32)).astype(x.dtype)


def rope(x, pos):
    half = HEAD_DIM // 2
    inv_freq = ROPE_THETA ** (-jnp.arange(half, dtype=jnp.float32) / half)
    ang = pos.astype(jnp.float32)[:, None] * inv_freq[None, :]
    cos = jnp.cos(ang)[None, :, None, :]
    sin = jnp.sin(ang)[None, :, None, :]
    xf = x.astype(jnp.float32)
    x1, x2 = xf[..., :half], xf[..., half:]
    return jnp.concatenate([x1 * cos - x2 * sin, x2 * cos + x1 * sin], axis=-1).astype(x.dtype)


def ada_modulation(c, w_ada, b_ada):
    m = jax.nn.silu(c) @ w_ada + b_ada
    return jnp.split(m[:, None, :], 6, axis=-1)


def masked_softmax(s, mask):
    s = jnp.where(mask, s.astype(jnp.float32), NEG_INF)
    m = jnp.max(s, axis=-1, keepdims=True)
    p = jnp.where(mask, jnp.exp(s - m), 0.0)
    return p / jnp.maximum(jnp.sum(p, axis=-1, keepdims=True), TINY)


def swiglu(h, w_gu, w_down):
    g, u = jnp.split(h @ w_gu, 2, axis=-1)
    return (jax.nn.silu(g) * u) @ w_down


def chunk_token_mix(v, w_s, b_s):
    B, S = v.shape[:2]
    n_chunks = -(-S // CHUNK)
    vp = jnp.pad(v, ((0, 0), (0, n_chunks * CHUNK - S), (0, 0), (0, 0)))
    vp = vp.reshape(B, n_chunks, CHUNK, A_GROUPS, A_GROUP_DIM)
    causal = jnp.tril(jnp.ones((CHUNK, CHUNK), dtype=bool))
    ws = jnp.where(causal[None], w_s, 0.0)
    mixed = jnp.einsum('gts,bnsgd->bntgd', ws, vp) + b_s.T[None, None, :, :, None]
    return mixed.reshape(B, n_chunks * CHUNK, A_GROUPS, A_GROUP_DIM)[:, :S]


def mixer_a(h, w_in, v_gain, w_s, b_s, w_out):
    B, S = h.shape[:2]
    u, v = jnp.split(jax.nn.gelu(h @ w_in), 2, axis=-1)
    v = rms_norm(v, v_gain)
    mixed = chunk_token_mix(v.reshape(B, S, A_GROUPS, A_GROUP_DIM), w_s, b_s).reshape(B, S, A_WIDTH)
    return (u * mixed) @ w_out, v


def project_kv(x, pos, kv_gain, w_kv, k_gains):
    B, S = x.shape[:2]
    kv = (rms_norm(x, kv_gain) @ w_kv).reshape(B, S, 6, KV_HEADS, HEAD_DIM)
    k_cmp = kv[:, :, 0]
    v_cmp = kv[:, :, 1]
    k_slc = rope(rms_norm(kv[:, :, 2], k_gains[1]), pos)
    v_slc = kv[:, :, 3]
    k_win = rope(rms_norm(kv[:, :, 4], k_gains[2]), pos)
    v_win = kv[:, :, 5]
    return k_cmp, v_cmp, k_slc, v_slc, k_win, v_win


def compress(rows, pe, w1, b1, w2, b2):
    B, T = rows.shape[:2]
    n_half = T // CMP_STRIDE
    r = rows[:, :n_half * CMP_STRIDE].reshape(B, n_half, CMP_STRIDE, KV_HEADS, HEAD_DIM)
    blocks = jnp.concatenate([r[:, :-1], r[:, 1:]], axis=2) + pe[None, None, :, None, :]
    flat = blocks.transpose(0, 1, 3, 2, 4).reshape(B, n_half - 1, KV_HEADS, CMP_BLOCK * HEAD_DIM)
    return jax.nn.gelu(flat @ w1 + b1) @ w2 + b2


def to_select_blocks(rows):
    B, T = rows.shape[:2]
    ns = -(-T // SLC_BLOCK)
    r = jnp.pad(rows, ((0, 0), (0, ns * SLC_BLOCK - T), (0, 0), (0, 0)))
    return r.reshape(B, ns, SLC_BLOCK, KV_HEADS, HEAD_DIM).transpose(0, 3, 1, 2, 4)


def build_b_side(k_cmp, v_cmp, k_slc, v_slc, k_gains, cmp_pe, cmp_w1, cmp_b1, cmp_w2, cmp_b2):
    kc = rms_norm(compress(k_cmp, cmp_pe[0], cmp_w1[0], cmp_b1[0], cmp_w2[0], cmp_b2[0]), k_gains[0])
    vc = compress(v_cmp, cmp_pe[1], cmp_w1[1], cmp_b1[1], cmp_w2[1], cmp_b2[1])
    return (kc, vc, to_select_blocks(k_slc), to_select_blocks(v_slc))


def nsa_queries(h, pos, w_in, q_gain):
    B, S = h.shape[:2]
    proj = h @ w_in
    q = rms_norm(proj[..., :N_HEADS * HEAD_DIM].reshape(B, S, N_HEADS, HEAD_DIM), q_gain)
    gates = jax.nn.sigmoid(proj[..., N_HEADS * HEAD_DIM:].astype(jnp.float32))
    gates = gates.reshape(B, S, N_HEADS, 3).astype(h.dtype)
    return q, rope(q, pos), gates


def nsa_core(q, q_rot, qpos, kc, vc, ksb, vsb, kw, vw, wpos, gates):
    B, Q = q.shape[:2]
    NC = kc.shape[1]
    NS = ksb.shape[2]
    scale = HEAD_DIM ** -0.5
    qg = q.reshape(B, Q, KV_HEADS, HEADS_PER_GROUP, HEAD_DIM)
    qrg = q_rot.reshape(B, Q, KV_HEADS, HEADS_PER_GROUP, HEAD_DIM)
    cmp_start = jnp.arange(NC, dtype=jnp.int32) * CMP_STRIDE
    mask_c = (cmp_start + CMP_BLOCK - 1)[None, :] <= qpos[:, None]
    s_c = jnp.einsum('bqghd,bngd->bqghn', qg, kc) * scale
    p_c = masked_softmax(s_c, mask_c[None, :, None, None, :])
    o_c = jnp.einsum('bqghn,bngd->bqghd', p_c.astype(vc.dtype), vc)
    slc_start = jnp.arange(NS, dtype=jnp.int32) * SLC_BLOCK
    overlap = ((cmp_start[:, None] < slc_start[None, :] + SLC_BLOCK)
               & (cmp_start[:, None] + CMP_BLOCK > slc_start[None, :])).astype(jnp.float32)
    imp = jnp.einsum('bqghn,ns->bqgs', p_c, overlap)
    blk = jnp.arange(NS, dtype=jnp.int32)[None, :]
    cur = (qpos // SLC_BLOCK)[:, None]
    valid = (blk <= cur)[None, :, None, :]
    forced = ((blk == 0) | (blk == cur) | (blk == cur - 1))[None, :, None, :]
    score = jnp.where(valid & forced, FORCE_SCORE, jnp.where(valid, imp, NEG_INF))
    _, idx = lax.top_k(score, min(N_SELECT, NS))
    n_sel = idx.shape[-1]
    bi = jnp.arange(B)[:, None, None, None]
    gi = jnp.arange(KV_HEADS)[None, None, :, None]
    ks = ksb[bi, gi, idx].reshape(B, Q, KV_HEADS, n_sel * SLC_BLOCK, HEAD_DIM)
    vs = vsb[bi, gi, idx].reshape(B, Q, KV_HEADS, n_sel * SLC_BLOCK, HEAD_DIM)
    kpos = (idx[..., None] * SLC_BLOCK + jnp.arange(SLC_BLOCK, dtype=jnp.int32)).reshape(
        B, Q, KV_HEADS, n_sel * SLC_BLOCK)
    mask_s = kpos <= qpos[None, :, None, None]
    s_s = jnp.einsum('bqghd,bqgkd->bqghk', qrg, ks) * scale
    p_s = masked_softmax(s_s, mask_s[:, :, :, None, :])
    o_s = jnp.einsum('bqghk,bqgkd->bqghd', p_s.astype(vs.dtype), vs)
    dpos = qpos[:, None] - wpos[None, :]
    mask_w = (dpos >= 0) & (dpos <= WINDOW) & (wpos[None, :] >= 0)
    s_w = jnp.einsum('bqghd,bkgd->bqghk', qrg, kw) * scale
    p_w = masked_softmax(s_w, mask_w[None, :, None, None, :])
    o_w = jnp.einsum('bqghk,bkgd->bqghd', p_w.astype(vw.dtype), vw)
    g = gates.reshape(B, Q, KV_HEADS, HEADS_PER_GROUP, 3)
    o = o_c * g[..., 0:1] + o_s * g[..., 1:2] + o_w * g[..., 2:3]
    return o.reshape(B, Q, N_HEADS * HEAD_DIM)


def run_group(x, c, make_kv_side, attend, w_ada, b_ada, norm_g, a_w_in, a_v_gain, a_w_s, a_b_s,
              a_w_out, ffn_w_gu, ffn_w_down):
    a_v_rows = []
    side = None
    new_rows = None
    for layer in range(DEPTH):
        shift1, scale1, gate1, shift2, scale2, gate2 = ada_modulation(c, w_ada[layer], b_ada[layer])
        if layer == N_A_LAYERS:
            side, new_rows = make_kv_side(x)
        h = rms_norm(x, norm_g[layer, 0]) * (1.0 + scale1) + shift1
        if layer < N_A_LAYERS:
            out, v = mixer_a(h, a_w_in[layer], a_v_gain[layer], a_w_s[layer], a_b_s[layer], a_w_out[layer])
            a_v_rows.append(v)
        else:
            out = attend(h, side, layer - N_A_LAYERS)
        x = x + gate1 * out
        h = rms_norm(x, norm_g[layer, 1]) * (1.0 + scale2) + shift2
        x = x + gate2 * swiglu(h, ffn_w_gu[layer], ffn_w_down[layer])
    return x, a_v_rows, new_rows


def setup_inputs(seed: int = 0) -> dict:
    key = jax.random.key(seed)
    k = jax.random.split(key, 32)
    f32 = jnp.float32

    def nrm(i, shape, scale=1.0):
        return scale * jax.random.normal(k[i], shape, f32)

    n_pages = PAST_LEN // PAGE_SIZE
    n_used = DEC_BATCH * n_pages
    n_phys = n_used + n_used // 4
    page_table = jax.random.permutation(k[8], n_phys)[:n_used].reshape(DEC_BATCH, n_pages).astype(jnp.int32)
    win_buf = min(WINDOW, PAST_LEN)
    cache_shape = (n_phys, PAGE_SIZE, KV_HEADS, HEAD_DIM)
    win_shape = (DEC_BATCH, win_buf, KV_HEADS, HEAD_DIM)
    return {
        'x_prompt': nrm(0, (BATCH, SEQ, D_MODEL)),
        'x_sample': nrm(1, (DEC_BATCH, DEC_SEQ, D_MODEL)),
        'cache_cmp_k': nrm(2, cache_shape),
        'cache_cmp_v': nrm(3, cache_shape),
        'cache_slc_k': nrm(4, cache_shape),
        'cache_slc_v': nrm(5, cache_shape),
        'state_win_k': nrm(6, win_shape),
        'state_win_v': nrm(7, win_shape),
        'page_table': page_table,
        'c_prompt': nrm(9, (BATCH, D_MODEL)),
        'c_sample': nrm(10, (DEC_BATCH, D_MODEL)),
        'w_ada': nrm(11, (DEPTH, D_MODEL, 6 * D_MODEL), D_MODEL ** -0.5),
        'b_ada': nrm(12, (DEPTH, 6 * D_MODEL), 0.01),
        'norm_g': 1.0 + nrm(13, (DEPTH, 2, D_MODEL), 0.02),
        'a_w_in': nrm(14, (N_A_LAYERS, D_MODEL, 2 * A_WIDTH), D_MODEL ** -0.5),
        'a_v_gain': 1.0 + nrm(15, (N_A_LAYERS, A_WIDTH), 0.02),
        'a_w_s': nrm(16, (N_A_LAYERS, A_GROUPS, CHUNK, CHUNK), CHUNK ** -0.5),
        'a_b_s': 1.0 + nrm(17, (N_A_LAYERS, A_GROUPS, CHUNK), 0.02),
        'a_w_out': nrm(18, (N_A_LAYERS, A_WIDTH, D_MODEL), A_WIDTH ** -0.5),
        'b_w_in': nrm(19, (N_B_LAYERS, D_MODEL, N_HEADS * HEAD_DIM + 3 * N_HEADS), D_MODEL ** -0.5),
        'b_q_gain': 1.0 + nrm(20, (N_B_LAYERS, HEAD_DIM), 0.02),
        'b_w_out': nrm(21, (N_B_LAYERS, N_HEADS * HEAD_DIM, D_MODEL), (N_HEADS * HEAD_DIM) ** -0.5),
        'kv_gain': 1.0 + nrm(22, (D_MODEL,), 0.02),
        'w_kv': nrm(23, (D_MODEL, 6 * KV_HEADS * HEAD_DIM), D_MODEL ** -0.5),
        'k_gains': 1.0 + nrm(24, (3, HEAD_DIM), 0.02),
        'cmp_pe': nrm(25, (2, CMP_BLOCK, HEAD_DIM), 0.1),
        'cmp_w1': nrm(26, (2, CMP_BLOCK * HEAD_DIM, CMP_HIDDEN), (CMP_BLOCK * HEAD_DIM) ** -0.5),
        'cmp_b1': nrm(27, (2, CMP_HIDDEN), 0.01),
        'cmp_w2': nrm(28, (2, CMP_HIDDEN, HEAD_DIM), CMP_HIDDEN ** -0.5),
        'cmp_b2': nrm(29, (2, HEAD_DIM), 0.01),
        'ffn_w_gu': nrm(30, (DEPTH, D_MODEL, 2 * D_FF), D_MODEL ** -0.5),
        'ffn_w_down': nrm(31, (DEPTH, D_FF, D_MODEL), D_FF ** -0.5),
    }


def reference(x_prompt, x_sample, cache_cmp_k, cache_cmp_v, cache_slc_k, cache_slc_v, state_win_k,
              state_win_v, page_table, c_prompt, c_sample, w_ada, b_ada, norm_g, a_w_in, a_v_gain,
              a_w_s, a_b_s, a_w_out, b_w_in, b_q_gain, b_w_out, kv_gain, w_kv, k_gains, cmp_pe,
              cmp_w1, cmp_b1, cmp_w2, cmp_b2, ffn_w_gu, ffn_w_down):
    cmp_params = (k_gains, cmp_pe, cmp_w1, cmp_b1, cmp_w2, cmp_b2)

    pos_p = jnp.arange(SEQ, dtype=jnp.int32)

    def kv_side_prompt(xm):
        k_cmp, v_cmp, k_slc, v_slc, k_win, v_win = project_kv(xm, pos_p, kv_gain, w_kv, k_gains)
        side = build_b_side(k_cmp, v_cmp, k_slc, v_slc, *cmp_params)
        pad = ((0, 0), (WINDOW, 0), (0, 0), (0, 0))
        keep = min(WINDOW, SEQ)
        rows = (k_cmp, v_cmp, k_slc, v_slc, k_win[:, SEQ - keep:], v_win[:, SEQ - keep:])
        return side + (jnp.pad(k_win, pad), jnp.pad(v_win, pad)), rows

    def attend_prompt(h, side, j):
        kc, vc, ksb, vsb, kwp, vwp = side
        B = h.shape[0]
        nq = SEQ // Q_BLOCK
        q, q_rot, gates = nsa_queries(h, pos_p, b_w_in[j], b_q_gain[j])

        def to_blocks(t):
            return jnp.moveaxis(t.reshape(B, nq, Q_BLOCK, *t.shape[2:]), 1, 0)

        def one_block(args):
            n, qb, qrb, gb = args
            start = n * Q_BLOCK
            qpos = start + jnp.arange(Q_BLOCK, dtype=jnp.int32)
            wpos = start - WINDOW + jnp.arange(WINDOW + Q_BLOCK, dtype=jnp.int32)
            kw = lax.dynamic_slice_in_dim(kwp, start, WINDOW + Q_BLOCK, axis=1)
            vw = lax.dynamic_slice_in_dim(vwp, start, WINDOW + Q_BLOCK, axis=1)
            return nsa_core(qb, qrb, qpos, kc, vc, ksb, vsb, kw, vw, wpos, gb)

        o = lax.map(one_block, (jnp.arange(nq, dtype=jnp.int32), to_blocks(q), to_blocks(q_rot),
                                to_blocks(gates)))
        o = jnp.moveaxis(o, 0, 1).reshape(B, SEQ, N_HEADS * HEAD_DIM)
        return o @ b_w_out[j]

    y_prompt, a_rows_p, rows_p = run_group(x_prompt, c_prompt, kv_side_prompt, attend_prompt, w_ada,
                                           b_ada, norm_g, a_w_in, a_v_gain, a_w_s, a_b_s, a_w_out,
                                           ffn_w_gu, ffn_w_down)

    pos_s = PAST_LEN + jnp.arange(DEC_SEQ, dtype=jnp.int32)
    n_dec = x_sample.shape[0]
    win_buf = state_win_k.shape[1]

    def gather_past(cache):
        return cache[page_table].reshape(n_dec, PAST_LEN, KV_HEADS, HEAD_DIM)

    def kv_side_sample(xm):
        k_cmp_n, v_cmp_n, k_slc_n, v_slc_n, k_win_n, v_win_n = project_kv(xm, pos_s, kv_gain, w_kv, k_gains)
        k_cmp = jnp.concatenate([gather_past(cache_cmp_k), k_cmp_n], axis=1)
        v_cmp = jnp.concatenate([gather_past(cache_cmp_v), v_cmp_n], axis=1)
        k_slc = jnp.concatenate([gather_past(cache_slc_k), k_slc_n], axis=1)
        v_slc = jnp.concatenate([gather_past(cache_slc_v), v_slc_n], axis=1)
        side = build_b_side(k_cmp, v_cmp, k_slc, v_slc, *cmp_params)
        kw = jnp.concatenate([state_win_k, k_win_n], axis=1)
        vw = jnp.concatenate([state_win_v, v_win_n], axis=1)
        keep = min(WINDOW, PAST_LEN + DEC_SEQ)
        total = kw.shape[1]
        rows = (k_cmp_n, v_cmp_n, k_slc_n, v_slc_n, kw[:, total - keep:], vw[:, total - keep:])
        return side + (kw, vw), rows

    def attend_sample(h, side, j):
        kc, vc, ksb, vsb, kw, vw = side
        q, q_rot, gates = nsa_queries(h, pos_s, b_w_in[j], b_q_gain[j])
        wpos = PAST_LEN - win_buf + jnp.arange(win_buf + DEC_SEQ, dtype=jnp.int32)
        o = nsa_core(q, q_rot, pos_s, kc, vc, ksb, vsb, kw, vw, wpos, gates)
        return o @ b_w_out[j]

    y_sample, a_rows_s, rows_s = run_group(x_sample, c_sample, kv_side_sample, attend_sample, w_ada,
                                           b_ada, norm_g, a_w_in, a_v_gain, a_w_s, a_b_s, a_w_out,
                                           ffn_w_gu, ffn_w_down)

    last_chunk_start = ((SEQ - 1) // CHUNK) * CHUNK
    a_v_prompt = jnp.stack([v[:, last_chunk_start:] for v in a_rows_p], axis=0)
    a_v_sample = jnp.stack(a_rows_s, axis=0)
    cmp_k_prompt, cmp_v_prompt, slc_k_prompt, slc_v_prompt, win_k_prompt, win_v_prompt = rows_p
    cmp_k_sample, cmp_v_sample, slc_k_sample, slc_v_sample, win_k_sample, win_v_sample = rows_s
    return (y_prompt, y_sample, a_v_prompt, a_v_sample,
            cmp_k_prompt, cmp_v_prompt, slc_k_prompt, slc_v_prompt, win_k_prompt, win_v_prompt,
            cmp_k_sample, cmp_v_sample, slc_k_sample, slc_v_sample, win_k_sample, win_v_sample)
```

```cpp
#include <hip/hip_runtime.h>
#include <hip/hip_bf16.h>
#include <cstdio>
#include <cstdint>
#include <cmath>

#ifndef MK_PER_PHASE
#define MK_PER_PHASE 0
#endif

namespace pg8 {
#define PG8_LAS __attribute__((address_space(3)))
typedef unsigned short bf16_t;
typedef short bf16x8 __attribute__((ext_vector_type(8)));
typedef float f32x4 __attribute__((ext_vector_type(4)));
typedef unsigned u32x4 __attribute__((ext_vector_type(4)));
typedef unsigned u32x2 __attribute__((ext_vector_type(2)));
constexpr int BM = 256, BK = 64, HALF = 128, HTB = HALF * BK * 2, STAGE_BYTES = 8 * HTB, NXCD = 8, WGM = 8;

__host__ __device__ __forceinline__ int lds_byte(int r, int c) { const int st = (r >> 4) * 2 + (c >> 5), rr = r & 15, cc = c & 31, ob = rr * 64 + cc * 2; return st * 1024 + (ob ^ (((ob >> 9) & 1) << 5)); }
__host__ __device__ __forceinline__ void stage_rc(int b, int& R, int& C) { const int st = b / 1024, sb = b % 1024, swz = sb ^ (((sb >> 9) & 1) << 5); R = (st >> 1) * 16 + swz / 64; C = (st & 1) * 32 + (swz % 64) / 2; }
__host__ __device__ __forceinline__ int perm32(int rho) { const int n = rho >> 4, i = rho & 15; return 8 * (i >> 2) + 4 * n + (i & 3); }

struct Unit { int pm, pn; };
struct Gemm { const bf16_t* A; const bf16_t* Bt; int M, N, K, lda, bsplit; long boff; };

struct StaticOrder {
    int nM, nN, nwg, G, c;
    __host__ __device__ void init(int M, int N, int G_, int c_) { nM = M / BM; nN = N / BM; nwg = nM * nN; G = G_; c = c_; }
    __host__ __device__ bool next(int i, Unit& u) const {
        const long L = (long)i * G + c; if (L >= nwg) return false;
        int wgid = (int)L; { const int q = nwg / NXCD, r = nwg % NXCD, xcd = wgid % NXCD, off = wgid / NXCD; wgid = (xcd < r ? xcd * (q + 1) : r * (q + 1) + (xcd - r) * q) + off; }
        const int nig = WGM * nN, gid = wgid / nig, fm = gid * WGM, gsz = (nM - fm) < WGM ? (nM - fm) : WGM;
        u.pm = fm + ((wgid % nig) % gsz); u.pn = (wgid % nig) / gsz; return true;
    }
};

template <class Epi, bool ALIGN_EPI>
__device__ __forceinline__ void gemm_phase(PG8_LAS unsigned char* lds, const Gemm g, const StaticOrder& S, const Epi& E) {
    const int tid = threadIdx.x, wid = __builtin_amdgcn_readfirstlane(tid >> 6), lane = tid & 63, wr = wid >> 2, wc = wid & 3, fr = lane & 15, fq = lane >> 4;
    const int K = g.K, nt = K / BK, lda = g.lda;
    unsigned voffA[2], voffB[2];
#pragma unroll
    for (int i = 0; i < 2; ++i) { int R, C; stage_rc(tid * 16 + i * 8192, R, C); const int Rb = ((R & ~31) + perm32(R & 31));
        voffA[i] = (unsigned)(R * lda + C) * 2u; voffB[i] = (unsigned)(Rb * K + C) * 2u; }
    const size_t kstep = (size_t)(BK * 2);
    const size_t hstepA = (size_t)HALF * lda * 2, hstepB = (size_t)HALF * K * 2;
    const size_t tstepA = 2 * hstepA, tstepB = 2 * hstepB;
    const unsigned ldsw = (unsigned)wid * 1024u;
    const int aoff = lds_byte(wr * 64 + fr, fq * 8), boff = lds_byte(wc * 32 + fr, fq * 8);
#define PG8_SA(b, h) (((b) * 2 + (h)) * HTB)
#define PG8_SB(b, h) ((4 + (b) * 2 + (h)) * HTB)
#define PG8_STAGE(bufoff, gbase, voff) do { _Pragma("unroll") for (int _i = 0; _i < 2; ++_i) \
        __builtin_amdgcn_global_load_lds((const unsigned*)((const char*)(gbase) + (voff)[_i]), (PG8_LAS unsigned*)(lds + (bufoff) + ldsw + _i * 8192), 16, 0, 0); } while (0)
#define PG8_LDA(dst, b, h) do { _Pragma("unroll") for (int m = 0; m < 4; ++m) _Pragma("unroll") for (int k = 0; k < 2; ++k) dst[m][k] = *(const PG8_LAS bf16x8*)(lds + PG8_SA(b, h) + aoff + m * 2048 + k * 1024); } while (0)
#define PG8_LDB(dst, b, h) do { _Pragma("unroll") for (int n = 0; n < 2; ++n) _Pragma("unroll") for (int k = 0; k < 2; ++k) dst[n][k] = *(const PG8_LAS bf16x8*)(lds + PG8_SB(b, h) + boff + n * 2048 + k * 1024); } while (0)
#define PG8_MMA(ai, bj, At, Bt) do { __builtin_amdgcn_s_setprio(1); _Pragma("unroll") for (int m = 0; m < 4; ++m) _Pragma("unroll") for (int n = 0; n < 2; ++n) _Pragma("unroll") for (int k = 0; k < 2; ++k) \
        acc[ai][bj][m][n] = __builtin_amdgcn_mfma_f32_16x16x32_bf16(Bt[n][k], At[m][k], acc[ai][bj][m][n], 0, 0, 0); __builtin_amdgcn_s_setprio(0); } while (0)
#define PG8_WAIT_V(n) asm volatile("s_waitcnt vmcnt(" #n ")" ::: "memory")
#define PG8_WAIT_L(n) asm volatile("s_waitcnt lgkmcnt(" #n ")" ::: "memory")
#define PG8_BAR __builtin_amdgcn_s_barrier()
#define PG8_SCHED __builtin_amdgcn_sched_barrier(0)
    Unit cur, nxt; int ui = 0;
    if (!S.next(0, cur)) return;
    f32x4 acc[2][2][4][2];
#pragma unroll
    for (int a = 0; a < 2; ++a)
#pragma unroll
        for (int b = 0; b < 2; ++b)
#pragma unroll
            for (int m = 0; m < 4; ++m)
#pragma unroll
                for (int n = 0; n < 2; ++n) acc[a][b][m][n] = (f32x4){0.f, 0.f, 0.f, 0.f};
    bf16x8 At[4][2], B0[2][2], B1[2][2];
    const char* cA = (const char*)g.A + (size_t)cur.pm * tstepA;
    const char* cB = (const char*)g.Bt + (cur.pm >= g.bsplit ? (size_t)g.boff * 2 : (size_t)0) + (size_t)cur.pn * tstepB;
    PG8_STAGE(PG8_SB(0, 0), cB, voffB); PG8_STAGE(PG8_SB(0, 1), cB + hstepB, voffB); PG8_STAGE(PG8_SA(0, 0), cA, voffA); PG8_STAGE(PG8_SA(0, 1), cA + hstepA, voffA);
    if (wr == 1) PG8_BAR;
    PG8_WAIT_V(2); PG8_BAR;
    PG8_STAGE(PG8_SB(1, 0), cB + kstep, voffB); PG8_STAGE(PG8_SA(1, 0), cA + kstep, voffA); PG8_STAGE(PG8_SB(1, 1), cB + hstepB + kstep, voffB);
    PG8_WAIT_V(6); PG8_BAR;
    for (;;) {
        const bool has_next = S.next(ui + 1, nxt);
        const char* nA = has_next ? (const char*)g.A + (size_t)nxt.pm * tstepA : cA;
        const char* nB = has_next ? (const char*)g.Bt + (nxt.pm >= g.bsplit ? (size_t)g.boff * 2 : (size_t)0) + (size_t)nxt.pn * tstepB : cB;
        for (int t = 0; t < nt; t += 2) {
            const bool last = (t == nt - 2);
            const char* a1 = cA + (size_t)(t + 1) * kstep;
            const char* a2 = last ? nA : cA + (size_t)(t + 2) * kstep; const char* b2 = last ? nB : cB + (size_t)(t + 2) * kstep;
            const char* a3 = a2 + kstep; const char* b3 = b2 + kstep;
            PG8_LDB(B0, 0, 0); PG8_LDB(B1, 0, 1); PG8_SCHED; PG8_LDA(At, 0, 0); PG8_STAGE(PG8_SA(1, 1), a1 + hstepA, voffA);
            PG8_WAIT_V(8); PG8_WAIT_L(0); PG8_BAR; PG8_MMA(0, 0, At, B0); PG8_MMA(0, 1, At, B1); PG8_BAR; PG8_SCHED;
            PG8_LDA(At, 0, 1); PG8_STAGE(PG8_SB(0, 0), b2, voffB); PG8_STAGE(PG8_SB(0, 1), b2 + hstepB, voffB); PG8_STAGE(PG8_SA(0, 0), a2, voffA);
            PG8_WAIT_V(8); PG8_WAIT_L(0); PG8_BAR; PG8_MMA(1, 0, At, B0); PG8_MMA(1, 1, At, B1); PG8_BAR; PG8_SCHED;
            PG8_LDB(B0, 1, 0); PG8_LDB(B1, 1, 1); PG8_SCHED; PG8_LDA(At, 1, 0); PG8_STAGE(PG8_SA(0, 1), a2 + hstepA, voffA);
            PG8_WAIT_V(8); PG8_WAIT_L(0); PG8_BAR; PG8_MMA(0, 0, At, B0); PG8_MMA(0, 1, At, B1); PG8_BAR; PG8_SCHED;
            PG8_LDA(At, 1, 1); PG8_STAGE(PG8_SB(1, 0), b3, voffB); PG8_STAGE(PG8_SB(1, 1), b3 + hstepB, voffB); PG8_STAGE(PG8_SA(1, 0), a3, voffA);
            PG8_WAIT_V(8); PG8_WAIT_L(0); PG8_BAR; PG8_MMA(1, 0, At, B0); PG8_MMA(1, 1, At, B1); PG8_BAR; PG8_SCHED;
        }
        if constexpr (ALIGN_EPI) { if (wr == 0) PG8_BAR; }
        E(acc, cur, wr, wc, fr, fq);
        if (!has_next) break;
#pragma unroll
        for (int a = 0; a < 2; ++a)
#pragma unroll
            for (int b = 0; b < 2; ++b)
#pragma unroll
                for (int m = 0; m < 4; ++m)
#pragma unroll
                    for (int n = 0; n < 2; ++n) acc[a][b][m][n] = (f32x4){0.f, 0.f, 0.f, 0.f};
        cur = nxt; cA = nA; cB = nB; ++ui;
        if constexpr (ALIGN_EPI) { if (wr == 1) PG8_BAR; }
    }
    PG8_WAIT_V(0);
    if constexpr (!ALIGN_EPI) { if (wr == 0) PG8_BAR; }
    PG8_BAR;
#undef PG8_SA
#undef PG8_SB
#undef PG8_STAGE
#undef PG8_LDA
#undef PG8_LDB
#undef PG8_MMA
#undef PG8_WAIT_V
#undef PG8_WAIT_L
#undef PG8_BAR
#undef PG8_SCHED
}
}

#define GAS __attribute__((address_space(1)))
#define LAS __attribute__((address_space(3)))
typedef unsigned short bf16;
typedef unsigned v4u __attribute__((ext_vector_type(4)));
typedef unsigned v2u __attribute__((ext_vector_type(2)));
typedef float f32x4 __attribute__((ext_vector_type(4)));
typedef float f32x2 __attribute__((ext_vector_type(2)));
typedef short bf16x8 __attribute__((ext_vector_type(8)));
typedef short bf16x4 __attribute__((ext_vector_type(4)));
typedef __bf16 bf16x2_t __attribute__((ext_vector_type(2)));
typedef GAS unsigned gu32;
#define RLX_AGENT __ATOMIC_RELAXED, __HIP_MEMORY_SCOPE_AGENT
#define LDS_WAIT() asm volatile("s_waitcnt lgkmcnt(0)" ::: "memory")
#define VM_WAIT() asm volatile("s_waitcnt vmcnt(0)" ::: "memory")
__device__ __forceinline__ unsigned pk2(float lo, float hi) { f32x2 v = {lo, hi}; bf16x2_t b = __builtin_convertvector(v, bf16x2_t); return __builtin_bit_cast(unsigned, b); }
__device__ __forceinline__ float bf2f(unsigned short h) { return __builtin_bit_cast(float, (unsigned)h << 16); }
__device__ __forceinline__ float bflo(unsigned w) { return __builtin_bit_cast(float, w << 16); }
__device__ __forceinline__ float bfhi(unsigned w) { return __builtin_bit_cast(float, w & 0xffff0000u); }
__device__ __forceinline__ float fexp2(float x) { return __builtin_amdgcn_exp2f(x); }
__device__ __forceinline__ float frcp(float x) { return __builtin_amdgcn_rcpf(x); }
__device__ __forceinline__ float gelu_t(float x) { const float x2 = x * x; const float e = fexp2(x * (-2.302208198f + -0.1029432357f * x2)); return x * frcp(1.f + e); }
__device__ __forceinline__ float silu_f(float x) { return x * frcp(1.f + fexp2(-1.4426950409f * x)); }
__device__ __forceinline__ float sigmoid_f(float x) { return frcp(1.f + fexp2(-1.4426950409f * x)); }
__device__ __forceinline__ float dpp_xor1(float v) { return __builtin_bit_cast(float, __builtin_amdgcn_update_dpp(0, __builtin_bit_cast(int, v), 0xB1, 0xF, 0xF, true)); }
__device__ __forceinline__ float dpp_xor2(float v) { return __builtin_bit_cast(float, __builtin_amdgcn_update_dpp(0, __builtin_bit_cast(int, v), 0x4E, 0xF, 0xF, true)); }
__device__ __forceinline__ unsigned dpp_xor1u(unsigned v) { return (unsigned)__builtin_amdgcn_update_dpp(0, (int)v, 0xB1, 0xF, 0xF, true); }
__device__ __forceinline__ unsigned dpp_xor2u(unsigned v) { return (unsigned)__builtin_amdgcn_update_dpp(0, (int)v, 0x4E, 0xF, 0xF, true); }
__device__ __forceinline__ float wave_sum(float v) {
#pragma unroll
    for (int o = 1; o < 64; o <<= 1) v += __shfl_xor(v, o);
    return v;
}
__device__ __forceinline__ float wave_max(float v) {
#pragma unroll
    for (int o = 1; o < 64; o <<= 1) v = fmaxf(v, __shfl_xor(v, o));
    return v;
}

#define XB_TMO      128
#define XB_XCNT(j)  (256  + 64 * (j))
#define XB_XSUB(j)  (1280 + 64 * (j))
#define XB_XGEN(j)  (2304 + 64 * (j))
#define XB_TOP      3328
#define XB_TOPGEN   3392
#define XCD_BAR_WORDS 3456
#define XB_SPIN_CAP (1u << 18)

__device__ __forceinline__ unsigned xb_ld(unsigned* p)              { return __hip_atomic_load(p, __ATOMIC_RELAXED, __HIP_MEMORY_SCOPE_AGENT); }
__device__ __forceinline__ unsigned xb_add(unsigned* p, unsigned v) { return __hip_atomic_fetch_add(p, v, __ATOMIC_RELAXED, __HIP_MEMORY_SCOPE_AGENT); }
__device__ __forceinline__ unsigned xb_xcc_id() { return (unsigned)__builtin_amdgcn_s_getreg((3 << 11) | 20) & 0xFu; }
#define XB_SPIN(cond, bar) do { unsigned _sp = 0; while (cond) { __builtin_amdgcn_s_sleep(1); \
    if ((++_sp & 255u) == 0u) { if (xb_ld(&(bar)[XB_TMO])) break; if (_sp > XB_SPIN_CAP) { atomicAdd(&(bar)[XB_TMO], 1u); break; } } } } while (0)

struct XcdBarrier { unsigned* bar; unsigned x; volatile LAS unsigned* st; };

__device__ __forceinline__ XcdBarrier xcd_barrier_post(unsigned* bar, volatile LAS unsigned* st) {
    XcdBarrier b; b.bar = bar; b.x = xb_xcc_id(); b.st = st;
    if (threadIdx.x == 0) (void)xb_add(&bar[XB_XCNT(b.x)], 1u);
    return b;
}
__device__ __forceinline__ void xcd_barrier_complete(unsigned* bar, unsigned x, unsigned& nloc, unsigned& nx) {
    const unsigned G = gridDim.x * gridDim.y * gridDim.z;
    unsigned sum, cnt, mine, sp = 0u;
    for (;;) {
        sum = 0u; cnt = 0u; mine = 0u;
#pragma unroll
        for (unsigned j = 0; j < 16; ++j) { const unsigned c = xb_ld(&bar[XB_XCNT(j)]); sum += c; cnt += (c > 0u) ? 1u : 0u; mine = (j == x) ? c : mine; }
        if (sum == G) break;
        __builtin_amdgcn_s_sleep(1);
        if ((++sp & 255u) == 0u) { if (xb_ld(&bar[XB_TMO])) break; if (sp > XB_SPIN_CAP) { atomicAdd(&bar[XB_TMO], 1u); break; } }
    }
    nloc = mine > 0u ? mine : 1u; nx = cnt > 0u ? cnt : 1u;
}
__device__ __forceinline__ void xcd_barrier(const XcdBarrier& b) {
    asm volatile("s_waitcnt vmcnt(0)" ::: "memory");
    __syncthreads();
    if (threadIdx.x == 0) {
        unsigned* bar = b.bar;
        __builtin_amdgcn_s_waitcnt(0);
        unsigned nloc = b.st[0], nx = b.st[1];
        if (nloc == 0u) { xcd_barrier_complete(bar, b.x, nloc, nx); b.st[0] = nloc; b.st[1] = nx; }
        const unsigned old = xb_add(&bar[XB_XSUB(b.x)], 1u);
        const unsigned gen = old / nloc;
        if (old + 1u == (gen + 1u) * nloc) {
            __builtin_amdgcn_fence(__ATOMIC_RELEASE, "agent");
            asm volatile("s_waitcnt vmcnt(0)" ::: "memory");
            const unsigned og = xb_add(&bar[XB_TOP], 1u);
            const unsigned tg = og / nx;
            if (og + 1u == (tg + 1u) * nx) xb_add(&bar[XB_TOPGEN], 1u);
            else XB_SPIN(xb_ld(&bar[XB_TOPGEN]) == tg, bar);
            __builtin_amdgcn_fence(__ATOMIC_ACQUIRE, "agent");
            xb_add(&bar[XB_XGEN(b.x)], 1u);
            asm volatile("s_waitcnt vmcnt(0)" ::: "memory");
        } else {
            XB_SPIN(xb_ld(&bar[XB_XGEN(b.x)]) == gen, bar);
            __builtin_amdgcn_fence(__ATOMIC_ACQUIRE, "agent");
            asm volatile("s_waitcnt vmcnt(0)" ::: "memory");
        }
    }
    __syncthreads();
}

constexpr int NWAVES = 8;
constexpr int D = 1024, SEQ = 8192, NBATCH = 2, MP = NBATCH * SEQ, MS = 128, MT = MP + MS, M65 = 16640;
constexpr int DFF = 2816, NGU = 2 * DFF, NAIN = 2048, NKV = 1536, NQ = 1072, NQP = 1280;
constexpr int NBIG = NAIN + NGU + NQP + NGU;
constexpr int OFF_WIN = 0, OFF_GU0 = NAIN, OFF_Q = NAIN + NGU, OFF_GU1 = NAIN + NGU + NQP;
constexpr int NMOD = 12288;
constexpr int PAST = 2048, NPAGE = 16, PAGE = 128, WIN = 512;
constexpr int RC_SAMP = 512 * 128, RC_PROMPT = 8 * 512, RC_KV = RC_SAMP + RC_PROMPT;
constexpr float EPS = 1e-6f;
constexpr float C2 = 0.125f * 1.4426950408889634f;

constexpr size_t O_YP = 0, O_YS = 16777216, O_AVP = 16908288, O_AVS = 17170432, O_CKP = 17301504, O_CVP = 21495808, O_SKP = 25690112, O_SVP = 29884416,
                 O_WKP = 34078720, O_WVP = 34340864, O_CKS = 34603008, O_CVS = 34635776, O_SKS = 34668544, O_SVS = 34701312, O_WKS = 34734080, O_WVS = 51511296;

constexpr size_t al256(size_t x) { return (x + 255) & ~(size_t)255; }
constexpr size_t WS_CTL = 0, CTL_ZERO_BYTES = 1u << 20;
constexpr size_t WS_WADA = CTL_ZERO_BYTES;
constexpr size_t WS_WBIG = WS_WADA + (size_t)NMOD * D * 2;
constexpr size_t WS_WOUT = WS_WBIG + (size_t)NBIG * D * 2;
constexpr size_t WS_WBO = WS_WOUT + (size_t)D * D * 2;
constexpr size_t WS_WDN = WS_WBO + (size_t)D * D * 2;
constexpr size_t WS_WKV = WS_WDN + (size_t)2 * D * DFF * 2;
constexpr size_t WS_W1C = WS_WKV + (size_t)NKV * D * 2;
constexpr size_t WS_W2 = WS_W1C + (size_t)2 * 256 * 2048 * 2;
constexpr size_t WS_WSB = WS_W2 + (size_t)2 * 64 * 256 * 2;
constexpr size_t WS_ROPE = WS_WSB + (size_t)8 * 128 * 128 * 2;
constexpr size_t WS_C1 = WS_ROPE + (size_t)8192 * 64 * 4;
constexpr size_t WS_SC = WS_C1 + 2 * 256 * 4;
constexpr size_t WS_MOD = WS_SC + (size_t)256 * D * 2;
constexpr size_t WS_SH = WS_MOD + (size_t)256 * NMOD * 4;
constexpr size_t WS_BIAS = WS_SH + (size_t)4 * 256 * D * 2;
constexpr size_t WS_MUL = WS_BIAS + (size_t)256 * NBIG * 4;
constexpr size_t WS_SSQ = WS_MUL + (size_t)3 * 256 * D * 4;
constexpr size_t WS_ACTA = WS_SSQ + (size_t)5 * M65 * 16 * 4;
constexpr size_t ACT_BYTES = (size_t)M65 * D * 2;
constexpr size_t WS_AKV = WS_ACTA + ACT_BYTES;
constexpr size_t WS_U = WS_AKV + ACT_BYTES;
constexpr size_t WS_V = WS_U + ACT_BYTES;
constexpr size_t WS_UM = WS_V + ACT_BYTES;
constexpr size_t WS_QN = WS_UM + ACT_BYTES;
constexpr size_t WS_QR = WS_QN + ACT_BYTES;
constexpr size_t WS_O = WS_QR + ACT_BYTES;
constexpr size_t WS_GATES = WS_O + ACT_BYTES;
constexpr size_t WS_HID = WS_GATES + (size_t)M65 * 48 * 4;
constexpr size_t WS_KS = WS_HID + (size_t)M65 * DFF * 2;
constexpr size_t WS_KW = WS_KS + (size_t)8 * SEQ * 64 * 2;
constexpr size_t WS_VST = WS_KW + (size_t)8 * SEQ * 64 * 2;
constexpr size_t WS_VWT = WS_VST + (size_t)8 * SEQ * 64 * 2;
constexpr size_t WS_RC = WS_VWT + (size_t)8 * SEQ * 64 * 2;
constexpr size_t WS_H2 = WS_RC + (size_t)2 * RC_KV * 1024 * 2 + 4096;
constexpr size_t WS_KCP = WS_H2 + (size_t)2 * RC_KV * 256 * 2;
constexpr size_t WS_VCTP = WS_KCP + (size_t)8 * 512 * 64 * 2;
constexpr size_t WS_KCS = WS_VCTP + (size_t)8 * 512 * 64 * 2;
constexpr size_t WS_VCTS = WS_KCS + (size_t)512 * 128 * 64 * 2;
constexpr size_t WS_END = WS_VCTS + (size_t)512 * 128 * 64 * 2;
static_assert(WS_WBIG % 256 == 0 && WS_ROPE % 256 == 0 && WS_SC % 256 == 0 && WS_ACTA % 256 == 0 && WS_HID % 256 == 0 && WS_RC % 256 == 0 && WS_H2 % 256 == 0 && WS_KCP % 256 == 0, "ws alignment");
constexpr int CW_BAR = 4096;

constexpr int RING_OFF = 0, RING_BYTES = 131072;
constexpr int LDSCTL_OFF = RING_BYTES, MISC_OFF = LDSCTL_OFF + 320;
constexpr int LDS_BYTES = 147456;

struct Params {
    const float* in[32];
    float* out;
    unsigned char* ws;
    int ph_lo, ph_hi;
};

__device__ __forceinline__ int seq_of(int row) { const int s = row - MP + 2; return row < MP ? (row >> 13) : (s < 255 ? s : 255); }
__device__ __forceinline__ float rstd16(const float* p) {
    const f32x4 a = *(const f32x4*)p, b = *(const f32x4*)(p + 4), c = *(const f32x4*)(p + 8), d = *(const f32x4*)(p + 12);
    const float s = ((a.x + a.y) + (a.z + a.w)) + ((b.x + b.y) + (b.z + b.w)) + ((c.x + c.y) + (c.z + c.w)) + ((d.x + d.y) + (d.z + d.w));
    return rsqrtf(s * (1.0f / 1024.0f) + EPS);
}

using pg8::Unit;
#define EPI_ARGS const pg8::f32x4 (&acc)[2][2][4][2], const Unit& u, int wr, int wc, int fr, int fq

struct EpiMod {
    float* MOD; bf16* SH; const float* b_ada;
    __device__ __forceinline__ void operator()(EPI_ARGS) const { asm volatile("" ::: "memory");
        const int cl = wc * 32 + 8 * fq, c0 = u.pn * 256 + cl;
        const int pl = u.pn % 24, lay = u.pn / 24;
        const int np = (pl < 4) ? 2 * lay : ((pl >= 12 && pl < 16) ? 2 * lay + 1 : -1);
        const int j0 = (pl < 4 ? pl : pl - 12) * 256 + cl;
        f32x4 bv[2][2];
#pragma unroll
        for (int bj = 0; bj < 2; ++bj)
#pragma unroll
            for (int n = 0; n < 2; ++n) bv[bj][n] = *(const f32x4*)(b_ada + c0 + bj * 128 + 4 * n);
#pragma unroll
        for (int ai = 0; ai < 2; ++ai)
#pragma unroll
            for (int m = 0; m < 4; ++m) { const int row = ai * 128 + wr * 64 + m * 16 + fr;
#pragma unroll
                for (int bj = 0; bj < 2; ++bj) { const f32x4 v0 = acc[ai][bj][m][0] + bv[bj][0], v1 = acc[ai][bj][m][1] + bv[bj][1];
                    float* p = MOD + (size_t)row * NMOD + c0 + bj * 128; *(f32x4*)p = v0; *(f32x4*)(p + 4) = v1;
                    if (np >= 0) { v4u w; w.x = pk2(v0[0], v0[1]); w.y = pk2(v0[2], v0[3]); w.z = pk2(v1[0], v1[1]); w.w = pk2(v1[2], v1[3]);
                        *(v4u*)(SH + ((size_t)np * 256 + row) * D + j0 + bj * 128) = w; } } }
    }
};
struct EpiBias {
    float* BIAS;
    __device__ __forceinline__ void operator()(EPI_ARGS) const { asm volatile("" ::: "memory");
        const int lo = u.pm == 0 ? 0 : u.pm == 1 ? 8 : u.pm == 2 ? 30 : 35, hi = u.pm == 0 ? 8 : u.pm == 1 ? 30 : u.pm == 2 ? 35 : 57;
        if (u.pn < lo || u.pn >= hi) return;
        const int c0 = u.pn * 256 + wc * 32 + 8 * fq;
#pragma unroll
        for (int ai = 0; ai < 2; ++ai)
#pragma unroll
            for (int m = 0; m < 4; ++m) { const int row = ai * 128 + wr * 64 + m * 16 + fr;
#pragma unroll
                for (int bj = 0; bj < 2; ++bj) { float* p = BIAS + (size_t)row * NBIG + c0 + bj * 128; *(f32x4*)p = acc[ai][bj][m][0]; *(f32x4*)(p + 4) = acc[ai][bj][m][1]; } }
    }
};
struct EpiAin {
    const float* SSQ0; const float* BIAS; bf16* U; bf16* V; float* SSQV;
    __device__ __forceinline__ void operator()(EPI_ARGS) const { asm volatile("" ::: "memory");
        const int cl = wc * 32 + 8 * fq, c0 = u.pn * 256 + cl; const bool uni = u.pm < 64; const bool isv = u.pn >= 4;
        f32x4 bv[2][2];
        if (uni) { const float* b = BIAS + (size_t)(u.pm >> 5) * NBIG + OFF_WIN + c0;
#pragma unroll
            for (int bj = 0; bj < 2; ++bj)
#pragma unroll
                for (int n = 0; n < 2; ++n) bv[bj][n] = *(const f32x4*)(b + bj * 128 + 4 * n); }
#pragma unroll
        for (int ai = 0; ai < 2; ++ai)
#pragma unroll
            for (int m = 0; m < 4; ++m) { const int row = u.pm * 256 + ai * 128 + wr * 64 + m * 16 + fr;
                const float rs = rstd16(SSQ0 + (size_t)row * 16);
                if (!uni) { const float* b = BIAS + (size_t)seq_of(row) * NBIG + OFF_WIN + c0;
#pragma unroll
                    for (int bj = 0; bj < 2; ++bj)
#pragma unroll
                        for (int n = 0; n < 2; ++n) bv[bj][n] = *(const f32x4*)(b + bj * 128 + 4 * n); }
                float sq = 0.f;
#pragma unroll
                for (int bj = 0; bj < 2; ++bj) { f32x4 v0 = acc[ai][bj][m][0] * rs + bv[bj][0], v1 = acc[ai][bj][m][1] * rs + bv[bj][1];
#pragma unroll
                    for (int i = 0; i < 4; ++i) { v0[i] = gelu_t(v0[i]); v1[i] = gelu_t(v1[i]); sq += v0[i] * v0[i] + v1[i] * v1[i]; }
                    v4u w; w.x = pk2(v0[0], v0[1]); w.y = pk2(v0[2], v0[3]); w.z = pk2(v1[0], v1[1]); w.w = pk2(v1[2], v1[3]);
                    bf16* dst = isv ? V + (size_t)row * D + (c0 - 1024) + bj * 128 : U + (size_t)row * D + c0 + bj * 128;
                    *(v4u*)dst = w; }
                if (isv) { sq += __shfl_xor(sq, 16); sq += __shfl_xor(sq, 32); if (fq == 0) SSQV[(size_t)row * 16 + (u.pn - 4) * 4 + wc] = sq; } }
    }
};
struct EpiGU {
    const float* SSQ; const float* BIAS; int boff; bf16* HID;
    __device__ __forceinline__ void operator()(EPI_ARGS) const { asm volatile("" ::: "memory");
        const int cl = wc * 32 + 8 * fq, c0 = u.pn * 256 + cl; const bool uni = u.pm < 64;
        f32x4 bv[2][2];
        if (uni) { const float* b = BIAS + (size_t)(u.pm >> 5) * NBIG + boff + c0;
#pragma unroll
            for (int bj = 0; bj < 2; ++bj)
#pragma unroll
                for (int n = 0; n < 2; ++n) bv[bj][n] = *(const f32x4*)(b + bj * 128 + 4 * n); }
#pragma unroll
        for (int ai = 0; ai < 2; ++ai)
#pragma unroll
            for (int m = 0; m < 4; ++m) { const int row = u.pm * 256 + ai * 128 + wr * 64 + m * 16 + fr;
                const float rs = rstd16(SSQ + (size_t)row * 16);
                if (!uni) { const float* b = BIAS + (size_t)seq_of(row) * NBIG + boff + c0;
#pragma unroll
                    for (int bj = 0; bj < 2; ++bj)
#pragma unroll
                        for (int n = 0; n < 2; ++n) bv[bj][n] = *(const f32x4*)(b + bj * 128 + 4 * n); }
                float h[8];
#pragma unroll
                for (int n = 0; n < 2; ++n) { const f32x4 zg = acc[ai][0][m][n] * rs + bv[0][n], zu = acc[ai][1][m][n] * rs + bv[1][n];
#pragma unroll
                    for (int i = 0; i < 4; ++i) h[4 * n + i] = silu_f(zg[i]) * zu[i]; }
                v4u w; w.x = pk2(h[0], h[1]); w.y = pk2(h[2], h[3]); w.z = pk2(h[4], h[5]); w.w = pk2(h[6], h[7]);
                *(v4u*)(HID + (size_t)row * DFF + u.pn * 128 + cl) = w; }
    }
};
struct EpiRes {
    const float* xin_p; const float* xin_s;
    const float* MOD; int goff;
    float* out;
    const float* MUL; bf16* A1;
    const float* kvg; bf16* A2;
    float* SSQ;
    __device__ __forceinline__ void operator()(EPI_ARGS) const { asm volatile("" ::: "memory");
        const int cl = wc * 32 + 8 * fq, c0 = u.pn * 256 + cl; const bool uni = u.pm < 64;
        f32x4 gv[2][2], mv[2][2], kv[2][2];
        if (uni) { const int sq_ = u.pm >> 5;
#pragma unroll
            for (int bj = 0; bj < 2; ++bj)
#pragma unroll
                for (int n = 0; n < 2; ++n) { gv[bj][n] = *(const f32x4*)(MOD + (size_t)sq_ * NMOD + goff + c0 + bj * 128 + 4 * n);
                    if (A1) mv[bj][n] = *(const f32x4*)(MUL + (size_t)sq_ * D + c0 + bj * 128 + 4 * n); } }
        if (A2) {
#pragma unroll
            for (int bj = 0; bj < 2; ++bj)
#pragma unroll
                for (int n = 0; n < 2; ++n) kv[bj][n] = *(const f32x4*)(kvg + c0 + bj * 128 + 4 * n); }
#pragma unroll
        for (int ai = 0; ai < 2; ++ai)
#pragma unroll
            for (int m = 0; m < 4; ++m) { const int row = u.pm * 256 + ai * 128 + wr * 64 + m * 16 + fr;
                const bool real = row < MT;
                if (!uni) { const int sq_ = seq_of(row);
#pragma unroll
                    for (int bj = 0; bj < 2; ++bj)
#pragma unroll
                        for (int n = 0; n < 2; ++n) { gv[bj][n] = *(const f32x4*)(MOD + (size_t)sq_ * NMOD + goff + c0 + bj * 128 + 4 * n);
                            if (A1) mv[bj][n] = *(const f32x4*)(MUL + (size_t)sq_ * D + c0 + bj * 128 + 4 * n); } }
                const float* xr = uni ? xin_p + (size_t)row * D : xin_s + (size_t)(real ? row - MP : 0) * D;
                float sq = 0.f;
#pragma unroll
                for (int bj = 0; bj < 2; ++bj) { f32x4 x0 = *(const f32x4*)(xr + c0 + bj * 128), x1 = *(const f32x4*)(xr + c0 + bj * 128 + 4);
                    if (!real) { x0 = (f32x4){0.f, 0.f, 0.f, 0.f}; x1 = x0; }
                    x0 = x0 + gv[bj][0] * acc[ai][bj][m][0]; x1 = x1 + gv[bj][1] * acc[ai][bj][m][1];
                    if (real) { float* p = out + (size_t)row * D + c0 + bj * 128; *(f32x4*)p = x0; *(f32x4*)(p + 4) = x1; }
                    sq += (x0[0] * x0[0] + x0[1] * x0[1]) + (x0[2] * x0[2] + x0[3] * x0[3]) + (x1[0] * x1[0] + x1[1] * x1[1]) + (x1[2] * x1[2] + x1[3] * x1[3]);
                    if (A1) { const f32x4 a = x0 * mv[bj][0], b = x1 * mv[bj][1]; v4u w; w.x = pk2(a[0], a[1]); w.y = pk2(a[2], a[3]); w.z = pk2(b[0], b[1]); w.w = pk2(b[2], b[3]);
                        *(v4u*)(A1 + (size_t)row * D + c0 + bj * 128) = w; }
                    if (A2) { const f32x4 a = x0 * kv[bj][0], b = x1 * kv[bj][1]; v4u w; w.x = pk2(a[0], a[1]); w.y = pk2(a[2], a[3]); w.z = pk2(b[0], b[1]); w.w = pk2(b[2], b[3]);
                        *(v4u*)(A2 + (size_t)row * D + c0 + bj * 128) = w; } }
                if (SSQ) { sq += __shfl_xor(sq, 16); sq += __shfl_xor(sq, 32); if (fq == 0) SSQ[(size_t)row * 16 + u.pn * 4 + wc] = sq; } }
    }
};
struct EpiCmp {
    const float* C1; bf16* H2;
    __device__ __forceinline__ void operator()(EPI_ARGS) const { asm volatile("" ::: "memory");
        const int cl = wc * 32 + 8 * fq; const int kv = u.pm >= (RC_KV / 256) ? 1 : 0;
        f32x4 bv[2][2];
#pragma unroll
        for (int bj = 0; bj < 2; ++bj)
#pragma unroll
            for (int n = 0; n < 2; ++n) bv[bj][n] = *(const f32x4*)(C1 + kv * 256 + cl + bj * 128 + 4 * n);
#pragma unroll
        for (int ai = 0; ai < 2; ++ai)
#pragma unroll
            for (int m = 0; m < 4; ++m) { const size_t row = (size_t)u.pm * 256 + ai * 128 + wr * 64 + m * 16 + fr;
#pragma unroll
                for (int bj = 0; bj < 2; ++bj) { f32x4 v0 = acc[ai][bj][m][0] + bv[bj][0], v1 = acc[ai][bj][m][1] + bv[bj][1];
#pragma unroll
                    for (int i = 0; i < 4; ++i) { v0[i] = gelu_t(v0[i]); v1[i] = gelu_t(v1[i]); }
                    v4u w; w.x = pk2(v0[0], v0[1]); w.y = pk2(v0[2], v0[3]); w.z = pk2(v1[0], v1[1]); w.w = pk2(v1[2], v1[3]);
                    *(v4u*)(H2 + row * 256 + cl + bj * 128) = w; } }
    }
};
struct EpiKV {
    const float* SSQ; const float* kgains; const float* ROPE; float* out;
    bf16* RC; bf16* KS; bf16* KW; bf16* VST; bf16* VWT;
    __device__ __forceinline__ void operator()(EPI_ARGS) const { asm volatile("" ::: "memory");
        const int ty = u.pn, g = wc, d0 = 8 * fq; const bool isk = (ty == 2 || ty == 4);
        f32x4 kg[2][2];
        if (isk) {
#pragma unroll
            for (int bj = 0; bj < 2; ++bj)
#pragma unroll
                for (int n = 0; n < 2; ++n) kg[bj][n] = *(const f32x4*)(kgains + (ty == 2 ? 64 : 128) + 32 * bj + d0 + 4 * n); }
#pragma unroll
        for (int ai = 0; ai < 2; ++ai)
#pragma unroll
            for (int m = 0; m < 4; ++m) { const int row = u.pm * 256 + ai * 128 + wr * 64 + m * 16 + fr;
                const float rs = rstd16(SSQ + (size_t)row * 16);
                f32x4 v[2][2];
#pragma unroll
                for (int bj = 0; bj < 2; ++bj)
#pragma unroll
                    for (int n = 0; n < 2; ++n) v[bj][n] = acc[ai][bj][m][n] * rs;
                const bool prompt = row < MP; const int t = prompt ? (row & (SEQ - 1)) : PAST; const int b = row >> 13;
                if (isk) {
                    float sq = 0.f;
#pragma unroll
                    for (int bj = 0; bj < 2; ++bj)
#pragma unroll
                        for (int n = 0; n < 2; ++n) sq += (v[bj][n][0] * v[bj][n][0] + v[bj][n][1] * v[bj][n][1]) + (v[bj][n][2] * v[bj][n][2] + v[bj][n][3] * v[bj][n][3]);
                    sq += __shfl_xor(sq, 16); sq += __shfl_xor(sq, 32);
                    const float ri = rsqrtf(sq * (1.0f / 64.0f) + EPS);
#pragma unroll
                    for (int n = 0; n < 2; ++n) { const f32x4 cs = *(const f32x4*)(ROPE + (size_t)t * 64 + d0 + 4 * n), sn = *(const f32x4*)(ROPE + (size_t)t * 64 + 32 + d0 + 4 * n);
                        const f32x4 x1 = v[0][n] * ri * kg[0][n], x2 = v[1][n] * ri * kg[1][n];
                        v[0][n] = x1 * cs - x2 * sn; v[1][n] = x2 * cs + x1 * sn; }
                }
                float* fo = nullptr;
                if (prompt) {
                    if (ty < 4) fo = out + (ty == 0 ? O_CKP : ty == 1 ? O_CVP : ty == 2 ? O_SKP : O_SVP) + (size_t)row * 256;
                    else if (t >= SEQ - WIN) fo = out + (ty == 4 ? O_WKP : O_WVP) + ((size_t)b * WIN + (t - (SEQ - WIN))) * 256;
                } else if (row < MT) { const int s = row - MP;
                    if (ty < 4) fo = out + (ty == 0 ? O_CKS : ty == 1 ? O_CVS : ty == 2 ? O_SKS : O_SVS) + (size_t)s * 256;
                    else fo = out + (ty == 4 ? O_WKS : O_WVS) + ((size_t)s * WIN + (WIN - 1)) * 256; }
                if (fo) {
#pragma unroll
                    for (int bj = 0; bj < 2; ++bj) { float* p = fo + g * 64 + 32 * bj + d0; *(f32x4*)p = v[bj][0]; *(f32x4*)(p + 4) = v[bj][1]; } }
                if (prompt) { const int gam = b * 4 + g;
                    if (ty <= 1) { bf16* dst = RC + ((size_t)ty * RC_KV + RC_SAMP + (size_t)gam * 512 + (t >> 4)) * 1024 + (t & 15) * 64 + d0;
#pragma unroll
                        for (int bj = 0; bj < 2; ++bj) { v4u w; w.x = pk2(v[bj][0][0], v[bj][0][1]); w.y = pk2(v[bj][0][2], v[bj][0][3]); w.z = pk2(v[bj][1][0], v[bj][1][1]); w.w = pk2(v[bj][1][2], v[bj][1][3]); *(v4u*)(dst + 32 * bj) = w; }
                    } else if (isk) { bf16* dst = (ty == 2 ? KS : KW) + ((size_t)gam * SEQ + t) * 64 + d0;
#pragma unroll
                        for (int bj = 0; bj < 2; ++bj) { v4u w; w.x = pk2(v[bj][0][0], v[bj][0][1]); w.y = pk2(v[bj][0][2], v[bj][0][3]); w.z = pk2(v[bj][1][0], v[bj][1][1]); w.w = pk2(v[bj][1][2], v[bj][1][3]); *(v4u*)(dst + 32 * bj) = w; }
                    } else { bf16* dst = (ty == 3 ? VST : VWT) + ((size_t)gam * 128 + (t >> 6)) * 4096 + (t & 63);
#pragma unroll
                        for (int bj = 0; bj < 2; ++bj)
#pragma unroll
                            for (int n = 0; n < 2; ++n)
#pragma unroll
                                for (int i = 0; i < 4; ++i) dst[(32 * bj + d0 + 4 * n + i) * 64] = (bf16)(pk2(v[bj][n][i], 0.f) & 0xffffu); }
                }
            }
    }
};
struct EpiQ {
    const float* SSQ; const float* BIAS; const float* qgain; const float* ROPE; bf16* QN; bf16* QR; float* GATES;
    __device__ __forceinline__ void operator()(EPI_ARGS) const { asm volatile("" ::: "memory");
        const int cl = wc * 32 + 8 * fq, c0 = u.pn * 256 + cl, d0 = 8 * fq; const bool uni = u.pm < 64;
        f32x4 bv[2][2], qg[2][2];
        if (uni) { const float* b = BIAS + (size_t)(u.pm >> 5) * NBIG + OFF_Q + c0;
#pragma unroll
            for (int bj = 0; bj < 2; ++bj)
#pragma unroll
                for (int n = 0; n < 2; ++n) bv[bj][n] = *(const f32x4*)(b + bj * 128 + 4 * n); }
#pragma unroll
        for (int bj = 0; bj < 2; ++bj)
#pragma unroll
            for (int n = 0; n < 2; ++n) qg[bj][n] = *(const f32x4*)(qgain + 32 * bj + d0 + 4 * n);
#pragma unroll
        for (int ai = 0; ai < 2; ++ai)
#pragma unroll
            for (int m = 0; m < 4; ++m) { const int row = u.pm * 256 + ai * 128 + wr * 64 + m * 16 + fr;
                const float rs = rstd16(SSQ + (size_t)row * 16);
                if (!uni) { const float* b = BIAS + (size_t)seq_of(row) * NBIG + OFF_Q + c0;
#pragma unroll
                    for (int bj = 0; bj < 2; ++bj)
#pragma unroll
                        for (int n = 0; n < 2; ++n) bv[bj][n] = *(const f32x4*)(b + bj * 128 + 4 * n); }
                f32x4 v[2][2];
#pragma unroll
                for (int bj = 0; bj < 2; ++bj)
#pragma unroll
                    for (int n = 0; n < 2; ++n) v[bj][n] = acc[ai][bj][m][n] * rs + bv[bj][n];
                if (u.pn == 4) {
                    if (cl < 48) {
#pragma unroll
                        for (int n = 0; n < 2; ++n) { f32x4 s; for (int i = 0; i < 4; ++i) s[i] = sigmoid_f(v[0][n][i]); *(f32x4*)(GATES + (size_t)row * 48 + cl + 4 * n) = s; } }
                    continue; }
                const int t = row < MP ? (row & (SEQ - 1)) : PAST;
                float sq = 0.f;
#pragma unroll
                for (int bj = 0; bj < 2; ++bj)
#pragma unroll
                    for (int n = 0; n < 2; ++n) sq += (v[bj][n][0] * v[bj][n][0] + v[bj][n][1] * v[bj][n][1]) + (v[bj][n][2] * v[bj][n][2] + v[bj][n][3] * v[bj][n][3]);
                sq += __shfl_xor(sq, 16); sq += __shfl_xor(sq, 32);
                const float ri = rsqrtf(sq * (1.0f / 64.0f) + EPS) * C2;
                f32x4 r[2][2];
#pragma unroll
                for (int n = 0; n < 2; ++n) { const f32x4 cs = *(const f32x4*)(ROPE + (size_t)t * 64 + d0 + 4 * n), sn = *(const f32x4*)(ROPE + (size_t)t * 64 + 32 + d0 + 4 * n);
                    v[0][n] = v[0][n] * ri * qg[0][n]; v[1][n] = v[1][n] * ri * qg[1][n];
                    r[0][n] = v[0][n] * cs - v[1][n] * sn; r[1][n] = v[1][n] * cs + v[0][n] * sn; }
                const size_t o = (size_t)row * D + (u.pn * 4 + wc) * 64 + d0;
#pragma unroll
                for (int bj = 0; bj < 2; ++bj) { v4u w; w.x = pk2(v[bj][0][0], v[bj][0][1]); w.y = pk2(v[bj][0][2], v[bj][0][3]); w.z = pk2(v[bj][1][0], v[bj][1][1]); w.w = pk2(v[bj][1][2], v[bj][1][3]); *(v4u*)(QN + o + 32 * bj) = w;
                    v4u x; x.x = pk2(r[bj][0][0], r[bj][0][1]); x.y = pk2(r[bj][0][2], r[bj][0][3]); x.z = pk2(r[bj][1][0], r[bj][1][1]); x.w = pk2(r[bj][1][2], r[bj][1][3]); *(v4u*)(QR + o + 32 * bj) = x; }
            }
    }
};

#define MFMA16(a, b, c) __builtin_amdgcn_mfma_f32_16x16x32_bf16((a), (b), (c), 0, 0, 0)

__device__ __forceinline__ int wperm(int mode, int n) {
    if (mode == 1) { const int up = n >= DFF ? 1 : 0, j = n - up * DFF; return (j >> 7) * 256 + up * 128 + (j & 127); }
    if (mode == 2 || (mode == 3 && n < 1024)) { const int blk = n >> 8, g = (n >> 6) & 3, d = n & 63; return blk * 256 + 128 * (d >> 5) + 32 * g + (d & 31); }
    return n;
}
__device__ __forceinline__ void transpose_item(const float* W, int K, int N, bf16* WT, int row_off, int mode, LAS float* scr, int item, int lane) {
    const int nblk = (N + 31) >> 5, kb = item / nblk, nb = item - kb * nblk, k0 = 64 * kb, n0 = 32 * nb;
    const int nn = n0 + (lane & 31); const bool okn = nn < N;
#pragma unroll 8
    for (int i = 0; i < 32; ++i) { const int kk = 2 * i + (lane >> 5); scr[kk * 33 + (lane & 31)] = okn ? W[(size_t)(k0 + kk) * N + nn] : 0.f; }
    LDS_WAIT(); asm volatile("" ::: "memory");
    const int c = lane & 7;
#pragma unroll
    for (int j = 0; j < 4; ++j) { const int n = (lane >> 3) + 8 * j; const LAS float* s = scr + (8 * c) * 33 + n;
        v4u o; o.x = pk2(s[0 * 33], s[1 * 33]); o.y = pk2(s[2 * 33], s[3 * 33]); o.z = pk2(s[4 * 33], s[5 * 33]); o.w = pk2(s[6 * 33], s[7 * 33]);
        if (n0 + n < N) *(v4u*)(WT + (size_t)(row_off + wperm(mode, n0 + n)) * K + k0 + 8 * c) = o; }
    LDS_WAIT(); asm volatile("" ::: "memory");
}
#define TR_ITEMS(K, N) (((K) / 64) * (((N) + 31) / 32))

__device__ __forceinline__ void phase0(const Params& P, LAS unsigned char* lds, int tid, int lane, int wave) {
    unsigned char* ws = P.ws;
    const int gw = blockIdx.x * NWAVES + wave, ngw = gridDim.x * NWAVES, gtid = blockIdx.x * 512 + tid, ngt = gridDim.x * 512;
    LAS float* scr = (LAS float*)(lds + wave * 16384);
    constexpr int IT_ADA = TR_ITEMS(1024, 6144);
    for (int it = gw; it < 2 * IT_ADA; it += ngw) { const int l = it / IT_ADA, r = it - l * IT_ADA;
        transpose_item(P.in[11] + (size_t)l * 1024 * 6144, 1024, 6144, (bf16*)(ws + WS_WADA), l * 6144, 0, scr, r, lane); }
    for (int e = gtid; e < 256 * 128; e += ngt) { const int row = e >> 7, c8 = (e & 127) * 8; v4u o = {0u, 0u, 0u, 0u};
        if (row < 130) { const float* src = (row < 2 ? P.in[9] + row * 1024 : P.in[10] + (row - 2) * 1024) + c8; const f32x4 a = *(const f32x4*)src, b = *(const f32x4*)(src + 4);
            o.x = pk2(silu_f(a[0]), silu_f(a[1])); o.y = pk2(silu_f(a[2]), silu_f(a[3])); o.z = pk2(silu_f(b[0]), silu_f(b[1])); o.w = pk2(silu_f(b[2]), silu_f(b[3])); }
        *(v4u*)((bf16*)(ws + WS_SC) + (size_t)row * 1024 + c8) = o; }
    for (int e = gtid; e < SEQ * 32; e += ngt) { const int pos = e >> 5, i = e & 31; const float inv = powf(10000.0f, -(float)i / 32.0f); const float ang = (float)pos * inv; float s, c; sincosf(ang, &s, &c);
        float* R = (float*)(ws + WS_ROPE) + (size_t)pos * 64; R[i] = c; R[32 + i] = s; }
    for (int e = gtid; e < 8 * 128 * 128; e += ngt) { const int t = (e >> 7) & 127, s = e & 127; ((bf16*)(ws + WS_WSB))[e] = (bf16)(pk2(s <= t ? P.in[16][e] : 0.f, 0.f) & 0xffffu); }
    for (int e = gtid; e < (NQP - NQ) * 128; e += ngt) *(v4u*)((bf16*)(ws + WS_WBIG) + (size_t)(OFF_Q + NQ) * 1024 + (size_t)e * 8) = (v4u){0u, 0u, 0u, 0u};
    if (blockIdx.x < 16) { const int kv = blockIdx.x >> 3, cg = blockIdx.x & 7, kq = tid >> 5, c = tid & 31;
        const float* w1 = P.in[26] + (size_t)kv * 2048 * 256 + cg * 32 + c; const float* pe = P.in[25] + kv * 2048; float s = 0.f;
        for (int f = kq * 128; f < kq * 128 + 128; ++f) s += pe[f] * w1[(size_t)f * 256];
        LAS float* red = (LAS float*)(lds + 8448); red[kq * 32 + c] = s; __syncthreads();
        if (tid < 32) { float a = P.in[27][kv * 256 + cg * 32 + tid]; for (int k = 0; k < 16; ++k) a += red[k * 32 + tid]; ((float*)(ws + WS_C1))[kv * 256 + cg * 32 + tid] = a; }
        __syncthreads(); }
}
__device__ __forceinline__ void phase1_weights(const Params& P, LAS unsigned char* lds, int lane, int wave) {
    unsigned char* ws = P.ws;
    const int gw = blockIdx.x * NWAVES + wave, ngw = gridDim.x * NWAVES;
    LAS float* scr = (LAS float*)(lds + wave * 16384);
    constexpr int I0 = TR_ITEMS(1024, 2048), I1 = TR_ITEMS(1024, 5632), I2 = TR_ITEMS(1024, 1072), I3 = TR_ITEMS(1024, 1024), I4 = TR_ITEMS(2816, 1024), I5 = TR_ITEMS(1024, 1536), I6 = TR_ITEMS(2048, 256), I7 = TR_ITEMS(256, 64);
    constexpr int NIT = I0 + 2 * I1 + I2 + 2 * I3 + 2 * I4 + I5 + 2 * I6 + 2 * I7;
    bf16* WBIG = (bf16*)(ws + WS_WBIG);
    for (int it = gw; it < NIT; it += ngw) { int r = it;
        if (r < I0) { transpose_item(P.in[14], 1024, 2048, WBIG, OFF_WIN, 0, scr, r, lane); continue; } r -= I0;
        if (r < I1) { transpose_item(P.in[30], 1024, 5632, WBIG, OFF_GU0, 1, scr, r, lane); continue; } r -= I1;
        if (r < I1) { transpose_item(P.in[30] + (size_t)1024 * 5632, 1024, 5632, WBIG, OFF_GU1, 1, scr, r, lane); continue; } r -= I1;
        if (r < I2) { transpose_item(P.in[19], 1024, 1072, WBIG, OFF_Q, 3, scr, r, lane); continue; } r -= I2;
        if (r < I3) { transpose_item(P.in[18], 1024, 1024, (bf16*)(ws + WS_WOUT), 0, 0, scr, r, lane); continue; } r -= I3;
        if (r < I3) { transpose_item(P.in[21], 1024, 1024, (bf16*)(ws + WS_WBO), 0, 0, scr, r, lane); continue; } r -= I3;
        if (r < I4) { transpose_item(P.in[31], 2816, 1024, (bf16*)(ws + WS_WDN), 0, 0, scr, r, lane); continue; } r -= I4;
        if (r < I4) { transpose_item(P.in[31] + (size_t)2816 * 1024, 2816, 1024, (bf16*)(ws + WS_WDN) + (size_t)1024 * 2816, 0, 0, scr, r, lane); continue; } r -= I4;
        if (r < I5) { transpose_item(P.in[23], 1024, 1536, (bf16*)(ws + WS_WKV), 0, 2, scr, r, lane); continue; } r -= I5;
        if (r < I6) { transpose_item(P.in[26], 2048, 256, (bf16*)(ws + WS_W1C), 0, 0, scr, r, lane); continue; } r -= I6;
        if (r < I6) { transpose_item(P.in[26] + (size_t)2048 * 256, 2048, 256, (bf16*)(ws + WS_W1C) + (size_t)256 * 2048, 0, 0, scr, r, lane); continue; } r -= I6;
        if (r < I7) { transpose_item(P.in[28], 256, 64, (bf16*)(ws + WS_W2), 0, 0, scr, r, lane); continue; } r -= I7;
        transpose_item(P.in[28] + 256 * 64, 256, 64, (bf16*)(ws + WS_W2) + 64 * 256, 0, 0, scr, r, lane);
    }
}
__device__ __forceinline__ void phase2_tail(const Params& P, int tid, int lane, int wave) {
    unsigned char* ws = P.ws;
    const int gw = blockIdx.x * NWAVES + wave, ngw = gridDim.x * NWAVES, gtid = blockIdx.x * 512 + tid, ngt = gridDim.x * 512;
    const float* MOD = (const float*)(ws + WS_MOD); const float* ng = P.in[13];
    for (int e = gtid; e < 3 * 256 * 256; e += ngt) { const int np = e >> 16, sq = (e >> 8) & 255, c = (e & 255) * 4;
        const int lay = np == 0 ? 0 : 1, wh = np == 1 ? 0 : 1;
        const f32x4 g = *(const f32x4*)(ng + (lay * 2 + wh) * 1024 + c), sc = *(const f32x4*)(MOD + (size_t)sq * NMOD + lay * 6144 + (wh ? 4096 : 1024) + c);
        *(f32x4*)((float*)(ws + WS_MUL) + ((size_t)np * 256 + sq) * 1024 + c) = g * (sc + 1.0f); }
    float* SSQ0 = (float*)(ws + WS_SSQ); bf16* A0 = (bf16*)(ws + WS_ACTA);
    for (int r = gw; r < M65; r += ngw) {
        f32x4 v[4]; float s = 0.f;
        if (r < MT) { const float* x = (r < MP ? P.in[0] + (size_t)r * D : P.in[1] + (size_t)(r - MP) * D) + 4 * lane;
#pragma unroll
            for (int j = 0; j < 4; ++j) { v[j] = *(const f32x4*)(x + 256 * j); s += (v[j][0] * v[j][0] + v[j][1] * v[j][1]) + (v[j][2] * v[j][2] + v[j][3] * v[j][3]); }
        } else {
#pragma unroll
            for (int j = 0; j < 4; ++j) v[j] = (f32x4){0.f, 0.f, 0.f, 0.f}; }
        s = wave_sum(s);
        if (lane < 16) SSQ0[(size_t)r * 16 + lane] = lane == 0 ? s : 0.f;
        const int sq = seq_of(r);
#pragma unroll
        for (int j = 0; j < 4; ++j) { const int c = 4 * lane + 256 * j; const f32x4 g = *(const f32x4*)(ng + c), sc = *(const f32x4*)(MOD + (size_t)sq * NMOD + 1024 + c);
            const f32x4 a = v[j] * g * (sc + 1.0f); v2u w; w.x = pk2(a[0], a[1]); w.y = pk2(a[2], a[3]); *(v2u*)(A0 + (size_t)r * D + c) = w; }
    }
}
__device__ __forceinline__ void sample_prepass(const Params& P, int tid, int lane, int wave) {
    unsigned char* ws = P.ws;
    const int gw = blockIdx.x * NWAVES + wave, ngw = gridDim.x * NWAVES, gtid = blockIdx.x * 512 + tid, ngt = gridDim.x * 512;
    const int* pt = (const int*)P.in[8]; bf16* RC = (bf16*)(ws + WS_RC);
    for (int it = gw; it < 2 * 128 * 16; it += ngw) { const int kv = it >> 11, sq = (it >> 4) & 127, p = it & 15;
        const float* src = P.in[2 + kv] + (size_t)pt[sq * 16 + p] * (128 * 256);
#pragma unroll 4
        for (int i = 0; i < 64; ++i) { const int e = (i * 64 + lane) * 8, tok = e >> 8, g = (e >> 6) & 3, d = e & 63;
            const f32x4 a = *(const f32x4*)(src + e), b = *(const f32x4*)(src + e + 4);
            v4u w; w.x = pk2(a[0], a[1]); w.y = pk2(a[2], a[3]); w.z = pk2(b[0], b[1]); w.w = pk2(b[2], b[3]);
            *(v4u*)(RC + ((size_t)kv * RC_KV + (size_t)(sq * 4 + g) * 128 + p * 8 + (tok >> 4)) * 1024 + (tok & 15) * 64 + d) = w; } }
    for (int kv = 0; kv < 2; ++kv) { const f32x4* src = (const f32x4*)P.in[6 + kv]; f32x4* dst = (f32x4*)(P.out + (kv ? O_WVS : O_WKS));
        for (int e = gtid; e < 128 * 32704; e += ngt) { const int s = e / 32704, i = e - s * 32704; dst[(size_t)s * 32768 + i] = src[(size_t)s * 32768 + 64 + i]; } }
}

__device__ __forceinline__ void phase_tokmix(const Params& P, LAS unsigned char* lds, int tid, int lane, int wave) {
    unsigned char* ws = P.ws;
    const bf16* U = (const bf16*)(ws + WS_U); const bf16* V = (const bf16*)(ws + WS_V); bf16* UM = (bf16*)(ws + WS_UM);
    const float* SSQV = (const float*)(ws + WS_SSQ) + (size_t)1 * M65 * 16; const bf16* WSB = (const bf16*)(ws + WS_WSB);
    const float* vgain = P.in[15]; const float* bs = P.in[17];
    LAS bf16* VT = (LAS bf16*)lds;
    const int col = lane & 15, quad = lane >> 4;
    for (int item = blockIdx.x; item < 1024; item += gridDim.x) { const int chunk = item >> 3, g = item & 7, r0 = chunk * 128;
        const bool lastc = (chunk & 63) == 63;
#pragma unroll
        for (int i = 0; i < 4; ++i) { const int e = tid + 512 * i, s = e >> 4, c8 = (e & 15) * 8; const int row = r0 + s;
            const float rs = rstd16(SSQV + (size_t)row * 16);
            const v4u w = *(const v4u*)(V + (size_t)row * D + g * 128 + c8);
            const f32x4 g0 = *(const f32x4*)(vgain + g * 128 + c8), g1 = *(const f32x4*)(vgain + g * 128 + c8 + 4);
            float x[8] = {bflo(w.x) * rs * g0[0], bfhi(w.x) * rs * g0[1], bflo(w.y) * rs * g0[2], bfhi(w.y) * rs * g0[3], bflo(w.z) * rs * g1[0], bfhi(w.z) * rs * g1[1], bflo(w.w) * rs * g1[2], bfhi(w.w) * rs * g1[3]};
#pragma unroll
            for (int k = 0; k < 8; ++k) VT[(c8 + k) * 136 + s] = (bf16)(pk2(x[k], 0.f) & 0xffffu);
            if (lastc) { float* av = P.out + O_AVP + ((size_t)(chunk >> 6) * 128 + s) * D + g * 128 + c8; *(f32x4*)av = (f32x4){x[0], x[1], x[2], x[3]}; *(f32x4*)(av + 4) = (f32x4){x[4], x[5], x[6], x[7]}; } }
        __syncthreads();
        f32x4 acc[8];
#pragma unroll
        for (int ct = 0; ct < 8; ++ct) acc[ct] = (f32x4){0.f, 0.f, 0.f, 0.f};
        const int t = 16 * wave + col;
        for (int ks = 0; ks <= (wave >> 1); ++ks) {
            const bf16x8 bfr = *(const bf16x8*)(WSB + ((size_t)g * 128 + t) * 128 + 32 * ks + 8 * quad);
#pragma unroll
            for (int ct = 0; ct < 8; ++ct) { const bf16x8 afr = *(const LAS bf16x8*)(VT + (16 * ct + col) * 136 + 32 * ks + 8 * quad); acc[ct] = MFMA16(afr, bfr, acc[ct]); } }
        const float bt = bs[g * 128 + t];
#pragma unroll
        for (int ct = 0; ct < 8; ++ct) { const size_t o = (size_t)(r0 + t) * D + g * 128 + 16 * ct + 4 * quad; const v2u uw = *(const v2u*)(U + o);
            v2u w; w.x = pk2(bflo(uw.x) * (acc[ct][0] + bt), bfhi(uw.x) * (acc[ct][1] + bt)); w.y = pk2(bflo(uw.y) * (acc[ct][2] + bt), bfhi(uw.y) * (acc[ct][3] + bt)); *(v2u*)(UM + o) = w; }
        __syncthreads();
    }
    const int gw = blockIdx.x * NWAVES + wave, ngw = gridDim.x * NWAVES;
    for (int r = MP + gw; r < M65; r += ngw) {
        const float rs = rstd16(SSQV + (size_t)r * 16);
#pragma unroll
        for (int j = 0; j < 4; ++j) { const int c = 4 * lane + 256 * j, g = c >> 7; v2u w = {0u, 0u};
            if (r < MT) { const v2u vw = *(const v2u*)(V + (size_t)r * D + c), uw = *(const v2u*)(U + (size_t)r * D + c); const f32x4 gn = *(const f32x4*)(vgain + c);
                const f32x4 vn = (f32x4){bflo(vw.x), bfhi(vw.x), bflo(vw.y), bfhi(vw.y)} * rs * gn;
                *(f32x4*)(P.out + O_AVS + (size_t)(r - MP) * D + c) = vn;
                const float w00 = P.in[16][g * 16384], b0 = bs[g * 128];
                w.x = pk2(bflo(uw.x) * (w00 * vn[0] + b0), bfhi(uw.x) * (w00 * vn[1] + b0)); w.y = pk2(bflo(uw.y) * (w00 * vn[2] + b0), bfhi(uw.y) * (w00 * vn[3] + b0)); }
            *(v2u*)(UM + (size_t)r * D + c) = w; } }
}

__device__ __forceinline__ void phase_w2(const Params& P, int lane, int wave) {
    unsigned char* ws = P.ws;
    const int gw = blockIdx.x * NWAVES + wave, ngw = gridDim.x * NWAVES;
    const bf16* H2 = (const bf16*)(ws + WS_H2); const bf16* W2 = (const bf16*)(ws + WS_W2);
    const int col = lane & 15, quad = lane >> 4;
    for (int task = gw; task < 2 * RC_KV / 16; task += ngw) { const int kv = task >= RC_KV / 16 ? 1 : 0; const int R0 = (task - kv * (RC_KV / 16)) * 16;
        const bool samp = R0 < RC_SAMP; const int gam = samp ? (R0 >> 7) : ((R0 - RC_SAMP) >> 9), i0 = samp ? (R0 & 127) : ((R0 - RC_SAMP) & 511);
        const bf16* hrow = H2 + ((size_t)kv * RC_KV + R0 + col) * 256 + 8 * quad; const bf16* wrow = W2 + (size_t)kv * 64 * 256 + (size_t)col * 256 + 8 * quad;
        f32x4 acc[4];
#pragma unroll
        for (int dt = 0; dt < 4; ++dt) acc[dt] = (f32x4){0.f, 0.f, 0.f, 0.f};
#pragma unroll
        for (int ks = 0; ks < 8; ++ks) { const bf16x8 hf = *(const bf16x8*)(hrow + 32 * ks);
#pragma unroll
            for (int dt = 0; dt < 4; ++dt) { const bf16x8 wf = *(const bf16x8*)(wrow + (size_t)dt * 16 * 256 + 32 * ks);
                acc[dt] = kv ? MFMA16(hf, wf, acc[dt]) : MFMA16(wf, hf, acc[dt]); } }
        const float* b2 = P.in[29] + kv * 64;
        if (!kv) {
            float sq = 0.f; f32x4 v[4];
#pragma unroll
            for (int dt = 0; dt < 4; ++dt) { v[dt] = acc[dt] + *(const f32x4*)(b2 + 16 * dt + 4 * quad); sq += (v[dt][0] * v[dt][0] + v[dt][1] * v[dt][1]) + (v[dt][2] * v[dt][2] + v[dt][3] * v[dt][3]); }
            sq += __shfl_xor(sq, 16); sq += __shfl_xor(sq, 32);
            const float ri = rsqrtf(sq * (1.0f / 64.0f) + EPS);
            bf16* dst = (samp ? (bf16*)(ws + WS_KCS) + ((size_t)gam * 128 + i0 + col) * 64 : (bf16*)(ws + WS_KCP) + ((size_t)gam * 512 + i0 + col) * 64) + 4 * quad;
#pragma unroll
            for (int dt = 0; dt < 4; ++dt) { const f32x4 kg = *(const f32x4*)(P.in[24] + 16 * dt + 4 * quad); const f32x4 o = v[dt] * ri * kg; v2u w; w.x = pk2(o[0], o[1]); w.y = pk2(o[2], o[3]); *(v2u*)(dst + 16 * dt) = w; }
        } else {
#pragma unroll
            for (int dt = 0; dt < 4; ++dt) { const int d = 16 * dt + col; const float bb = b2[d];
                bf16* dst = samp ? (bf16*)(ws + WS_VCTS) + ((size_t)gam * 64 + d) * 128 + i0 + 4 * quad : (bf16*)(ws + WS_VCTP) + ((size_t)gam * 64 + d) * 512 + i0 + 4 * quad;
                v2u w; w.x = pk2(acc[dt][0] + bb, acc[dt][1] + bb); w.y = pk2(acc[dt][2] + bb, acc[dt][3] + bb); *(v2u*)dst = w; }
        }
    }
}


__device__ __forceinline__ void attn_cmp_select(const bf16* kc, const bf16* vct, int vpitch, bf16x8 qn0, bf16x8 qn1, int nvis, int nkt, int cur, float nref,
                                                LAS float* imps, int lane, f32x4 (&oc)[4], unsigned (&msk)[4]) {
    const int col = lane & 15, quad = lane >> 4, ql = col >> 2, hl = col & 3;
    float lsum = 0.f;
    for (int kt = 0; kt < nkt; ++kt) {
        const bf16* kp = kc + (size_t)(16 * kt + col) * 64 + 8 * quad;
        const bf16x8 a0 = *(const bf16x8*)kp, a1 = *(const bf16x8*)(kp + 32);
        f32x4 s = {nref, nref, nref, nref}; s = MFMA16(a0, qn0, s); s = MFMA16(a1, qn1, s);
#pragma unroll
        for (int r = 0; r < 4; ++r) lsum += (16 * kt + 4 * quad + r < nvis) ? fexp2(s[r]) : 0.f;
    }
    float l = lsum + __shfl_xor(lsum, 16); l += __shfl_xor(l, 32);
    const float rl = l > 0.f ? 1.0f / l : 0.f;
#pragma unroll
    for (int dt = 0; dt < 4; ++dt) oc[dt] = (f32x4){0.f, 0.f, 0.f, 0.f};
    float carry = 0.f;
    const int nkp = (nkt + 1) >> 1;
    for (int kp2 = 0; kp2 < nkp; ++kp2) {
        float pa[2][4];
#pragma unroll
        for (int a = 0; a < 2; ++a) { const int kt = 2 * kp2 + a;
            const bf16* kp = kc + (size_t)(16 * kt + col) * 64 + 8 * quad;
            const bf16x8 a0 = *(const bf16x8*)kp, a1 = *(const bf16x8*)(kp + 32);
            f32x4 s = {nref, nref, nref, nref}; s = MFMA16(a0, qn0, s); s = MFMA16(a1, qn1, s);
            float hs[4];
#pragma unroll
            for (int r = 0; r < 4; ++r) { const float p = (16 * kt + 4 * quad + r < nvis) ? fexp2(s[r]) * rl : 0.f; pa[a][r] = p; float h = p + dpp_xor1(p); h += dpp_xor2(h); hs[r] = h; }
            const float tot = (hs[0] + hs[1]) + (hs[2] + hs[3]);
            const float up = __shfl(hs[3], (lane + 48) & 63);
            const float prev = quad == 0 ? carry : up; carry = up;
            if (hl == 0) imps[ql * 128 + 4 * kt + quad] = tot + prev;
        }
        v4u pw; pw.x = pk2(pa[0][0], pa[0][1]); pw.y = pk2(pa[0][2], pa[0][3]); pw.z = pk2(pa[1][0], pa[1][1]); pw.w = pk2(pa[1][2], pa[1][3]);
        const bf16x8 pb = __builtin_bit_cast(bf16x8, pw);
#pragma unroll
        for (int dt = 0; dt < 4; ++dt) { const bf16* vp = vct + (size_t)(16 * dt + col) * vpitch + 32 * kp2 + 4 * quad;
            const v2u lo = *(const v2u*)vp, hi = *(const v2u*)(vp + 16); const v4u av = {lo.x, lo.y, hi.x, hi.y};
            oc[dt] = MFMA16(__builtin_bit_cast(bf16x8, av), pb, oc[dt]); }
    }
#pragma unroll
    for (int w = 0; w < 4; ++w) msk[w] = 0u;
    if (cur <= 15) { msk[0] = (2u << cur) - 1u; return; }
    asm volatile("s_waitcnt lgkmcnt(0)" ::: "memory");
    const int lq = hl + 4 * quad;
    unsigned key[8];
#pragma unroll
    for (int e = 0; e < 8; ++e) { const int sg = lq + 16 * e; const float v = imps[ql * 128 + sg]; key[e] = (sg >= 1 && sg <= cur - 2) ? ((__builtin_bit_cast(unsigned, v) & ~127u) | (unsigned)sg) : 0u; }
    for (int it = 0; it < 13; ++it) {
        unsigned mx = key[0];
#pragma unroll
        for (int e = 1; e < 8; ++e) mx = mx > key[e] ? mx : key[e];
        { unsigned o = dpp_xor1u(mx); mx = mx > o ? mx : o; o = dpp_xor2u(mx); mx = mx > o ? mx : o; o = (unsigned)__shfl_xor((int)mx, 16); mx = mx > o ? mx : o; o = (unsigned)__shfl_xor((int)mx, 32); mx = mx > o ? mx : o; }
        const unsigned sg = mx & 127u, bit = mx ? (1u << (sg & 31u)) : 0u, w = sg >> 5;
        msk[0] |= w == 0u ? bit : 0u; msk[1] |= w == 1u ? bit : 0u; msk[2] |= w == 2u ? bit : 0u; msk[3] |= w == 3u ? bit : 0u;
#pragma unroll
        for (int e = 0; e < 8; ++e) key[e] = key[e] == mx ? 0u : key[e];
    }
    msk[0] |= 1u;
#pragma unroll
    for (int k = 0; k < 2; ++k) { const unsigned sg = (unsigned)(cur - k), bit = 1u << (sg & 31u), w = sg >> 5;
        msk[0] |= w == 0u ? bit : 0u; msk[1] |= w == 1u ? bit : 0u; msk[2] |= w == 2u ? bit : 0u; msk[3] |= w == 3u ? bit : 0u; }
}

__device__ __forceinline__ void attn_blk(const bf16* kb, const bf16* vtb, bf16x8 q0, bf16x8 q1, float cinit, bool masked, int kpos0, int lo, int hi, int lane, f32x4 (&o)[4], float& lsum) {
    const int col = lane & 15, quad = lane >> 4;
    f32x4 p[4];
#pragma unroll
    for (int kt = 0; kt < 4; ++kt) { const bf16* kp = kb + (size_t)(16 * kt + col) * 64 + 8 * quad;
        const bf16x8 a0 = *(const bf16x8*)kp, a1 = *(const bf16x8*)(kp + 32);
        f32x4 s = {cinit, cinit, cinit, cinit}; s = MFMA16(a0, q0, s); s = MFMA16(a1, q1, s);
#pragma unroll
        for (int r = 0; r < 4; ++r) p[kt][r] = fexp2(s[r]); }
    if (masked) {
#pragma unroll
        for (int kt = 0; kt < 4; ++kt)
#pragma unroll
            for (int r = 0; r < 4; ++r) { const int kpos = kpos0 + 16 * kt + 4 * quad + r; p[kt][r] = (kpos >= lo && kpos <= hi) ? p[kt][r] : 0.f; } }
#pragma unroll
    for (int kt = 0; kt < 4; ++kt) lsum += (p[kt][0] + p[kt][1]) + (p[kt][2] + p[kt][3]);
#pragma unroll
    for (int ks = 0; ks < 2; ++ks) {
        v4u pw; pw.x = pk2(p[2 * ks][0], p[2 * ks][1]); pw.y = pk2(p[2 * ks][2], p[2 * ks][3]); pw.z = pk2(p[2 * ks + 1][0], p[2 * ks + 1][1]); pw.w = pk2(p[2 * ks + 1][2], p[2 * ks + 1][3]);
        const bf16x8 pb = __builtin_bit_cast(bf16x8, pw);
#pragma unroll
        for (int dt = 0; dt < 4; ++dt) { const bf16* vp = vtb + (size_t)(16 * dt + col) * 64 + 32 * ks + 4 * quad;
            const v2u lo2 = *(const v2u*)vp, hi2 = *(const v2u*)(vp + 16); const v4u av = {lo2.x, lo2.y, hi2.x, hi2.y};
            o[dt] = MFMA16(__builtin_bit_cast(bf16x8, av), pb, o[dt]); } }
}

struct AttnRefs { float cmp, slc, win; };

__device__ __forceinline__ void attn_prompt_tile(const Params& P, int task, const AttnRefs& rf, LAS float* imps, int lane) {
    unsigned char* ws = P.ws;
    const int gam = task & 7, pt = task >> 3, b = gam >> 2, g = gam & 3, t0 = 4 * pt;
    const int col = lane & 15, quad = lane >> 4, ql = col >> 2, hl = col & 3;
    const int tq = t0 + ql, row = b * SEQ + tq, cur = t0 >> 6;
    const size_t qoff = (size_t)row * D + (4 * g + hl) * 64 + 8 * quad;
    const bf16* QN = (const bf16*)(ws + WS_QN); const bf16* QR = (const bf16*)(ws + WS_QR);
    const bf16x8 qn0 = *(const bf16x8*)(QN + qoff), qn1 = *(const bf16x8*)(QN + qoff + 32), qr0 = *(const bf16x8*)(QR + qoff), qr1 = *(const bf16x8*)(QR + qoff + 32);
    const int nvis = tq >= 31 ? ((tq - 31) >> 4) + 1 : 0;
    const int nvmax = (t0 + 3) >= 31 ? ((t0 + 3 - 31) >> 4) + 1 : 0, nkt = (nvmax + 15) >> 4;
    f32x4 oc[4]; unsigned msk[4];
    attn_cmp_select((const bf16*)(ws + WS_KCP) + (size_t)gam * 512 * 64, (const bf16*)(ws + WS_VCTP) + (size_t)gam * 64 * 512, 512, qn0, qn1, nvis, nkt, cur, rf.cmp, imps, lane, oc, msk);
    const float* gt = (const float*)(ws + WS_GATES) + (size_t)row * 48 + (4 * g + hl) * 3;
    const float g0 = gt[0], g1 = gt[1], g2 = gt[2];
    f32x4 o[4];
#pragma unroll
    for (int dt = 0; dt < 4; ++dt) o[dt] = oc[dt] * g0;
    unsigned un[4];
#pragma unroll
    for (int w = 0; w < 4; ++w) { unsigned u = msk[w]; u |= (unsigned)__shfl_xor((int)u, 4); u |= (unsigned)__shfl_xor((int)u, 8); un[w] = (unsigned)__builtin_amdgcn_readfirstlane((int)u); }
    {   f32x4 os[4]; float ls = 0.f;
#pragma unroll
        for (int dt = 0; dt < 4; ++dt) os[dt] = (f32x4){0.f, 0.f, 0.f, 0.f};
        const bf16* KS = (const bf16*)(ws + WS_KS) + (size_t)gam * SEQ * 64; const bf16* VST = (const bf16*)(ws + WS_VST) + (size_t)gam * 128 * 4096;
#pragma unroll
        for (int w = 0; w < 4; ++w) { unsigned bits = un[w];
            while (bits) { const int sg = 32 * w + __builtin_ctz(bits); bits &= bits - 1u;
                const bool sel = (msk[w] >> (sg & 31)) & 1u;
                attn_blk(KS + (size_t)sg * 4096, VST + (size_t)sg * 4096, qr0, qr1, sel ? rf.slc : -1e30f, sg == cur, 64 * sg, 0, tq, lane, os, ls); } }
        ls += __shfl_xor(ls, 16); ls += __shfl_xor(ls, 32);
        const float sc = ls > 0.f ? g1 / ls : 0.f;
#pragma unroll
        for (int dt = 0; dt < 4; ++dt) o[dt] += os[dt] * sc; }
    {   f32x4 ow[4]; float lw = 0.f;
#pragma unroll
        for (int dt = 0; dt < 4; ++dt) ow[dt] = (f32x4){0.f, 0.f, 0.f, 0.f};
        const bf16* KW = (const bf16*)(ws + WS_KW) + (size_t)gam * SEQ * 64; const bf16* VWT = (const bf16*)(ws + WS_VWT) + (size_t)gam * 128 * 4096;
        const int wlo = (t0 >= WIN ? t0 - WIN : 0) >> 6;
        for (int wb = wlo; wb <= cur; ++wb) attn_blk(KW + (size_t)wb * 4096, VWT + (size_t)wb * 4096, qr0, qr1, rf.win, true, 64 * wb, tq - WIN, tq, lane, ow, lw);
        lw += __shfl_xor(lw, 16); lw += __shfl_xor(lw, 32);
        const float sc = lw > 0.f ? g2 / lw : 0.f;
#pragma unroll
        for (int dt = 0; dt < 4; ++dt) o[dt] += ow[dt] * sc; }
    bf16* op = (bf16*)(ws + WS_O) + (size_t)row * D + (4 * g + hl) * 64 + 4 * quad;
#pragma unroll
    for (int dt = 0; dt < 4; ++dt) { v2u w; w.x = pk2(o[dt][0], o[dt][1]); w.y = pk2(o[dt][2], o[dt][3]); *(v2u*)(op + 16 * dt) = w; }
}

struct DecState { float m[4], l[4]; float o[4][16]; };
__device__ __forceinline__ void dec_job(const float* kbase, const float* vbase, int nkeys, const float (&qf)[4][16], DecState& st, int lane) {
    const int ksub = lane >> 2, dq = lane & 3;
#pragma unroll 1
    for (int k0 = 0; k0 < nkeys; k0 += 16) { const int key = k0 + ksub; const bool ok = key < nkeys;
        const float* kp = kbase + (size_t)key * 256 + 16 * dq; const float* vp = vbase + (size_t)key * 256 + 16 * dq;
        f32x4 k4[4], v4[4];
#pragma unroll
        for (int j = 0; j < 4; ++j) { k4[j] = ok ? *(const f32x4*)(kp + 4 * j) : (f32x4){0.f, 0.f, 0.f, 0.f}; v4[j] = ok ? *(const f32x4*)(vp + 4 * j) : (f32x4){0.f, 0.f, 0.f, 0.f}; }
#pragma unroll
        for (int h = 0; h < 4; ++h) { float d = 0.f;
#pragma unroll
            for (int j = 0; j < 4; ++j) d += (k4[j][0] * qf[h][4 * j] + k4[j][1] * qf[h][4 * j + 1]) + (k4[j][2] * qf[h][4 * j + 2] + k4[j][3] * qf[h][4 * j + 3]);
            d += dpp_xor1(d); d += dpp_xor2(d);
            const float sc = ok ? d : -1e30f, mn = fmaxf(st.m[h], sc), al = fexp2(st.m[h] - mn), p = ok ? fexp2(sc - mn) : 0.f;
            st.m[h] = mn; st.l[h] = st.l[h] * al + p;
#pragma unroll
            for (int j = 0; j < 4; ++j)
#pragma unroll
                for (int i = 0; i < 4; ++i) st.o[h][4 * j + i] = st.o[h][4 * j + i] * al + p * v4[j][i]; } }
}

__device__ __forceinline__ void attn_sample_item(const Params& P, int item, const AttnRefs& rf, LAS float* L, int tid, int lane, int wave) {
    unsigned char* ws = P.ws;
    const int s = item >> 2, g = item & 3, row = MP + s;
    LAS float* ocs = L; LAS unsigned* sel = (LAS unsigned*)(L + 256); LAS float* part = L + 260; LAS float* imps = L + 260 + 8 * 4 * 66;
    const float* gates = (const float*)(ws + WS_GATES) + (size_t)row * 48 + 4 * g * 3;
    if (wave == 0) {
        const int col = lane & 15, quad = lane >> 4, ql = col >> 2, hl = col & 3;
        const size_t qoff = (size_t)row * D + (4 * g + hl) * 64 + 8 * quad; const bf16* QN = (const bf16*)(ws + WS_QN);
        const bf16x8 qn0 = *(const bf16x8*)(QN + qoff), qn1 = *(const bf16x8*)(QN + qoff + 32);
        f32x4 oc[4]; unsigned msk[4];
        attn_cmp_select((const bf16*)(ws + WS_KCS) + (size_t)item * 128 * 64, (const bf16*)(ws + WS_VCTS) + (size_t)item * 64 * 128, 128, qn0, qn1, 127, 8, 32, rf.cmp, imps, lane, oc, msk);
        const float g0 = gates[hl * 3];
        if (ql == 0) {
#pragma unroll
            for (int dt = 0; dt < 4; ++dt)
#pragma unroll
                for (int r = 0; r < 4; ++r) ocs[hl * 64 + 16 * dt + 4 * quad + r] = oc[dt][r] * g0; }
        if (lane == 0) sel[0] = msk[0];
    }
    __syncthreads();
    {
        const unsigned m0 = sel[0];
        const bool isw = wave >= 5;
        const int dq = lane & 3;
        float qf[4][16];
        const bf16* QR = (const bf16*)(ws + WS_QR) + (size_t)row * D + 4 * g * 64 + 16 * dq;
#pragma unroll
        for (int h = 0; h < 4; ++h) { const v4u a = *(const v4u*)(QR + h * 64), b = *(const v4u*)(QR + h * 64 + 8);
            qf[h][0] = bflo(a.x); qf[h][1] = bfhi(a.x); qf[h][2] = bflo(a.y); qf[h][3] = bfhi(a.y); qf[h][4] = bflo(a.z); qf[h][5] = bfhi(a.z); qf[h][6] = bflo(a.w); qf[h][7] = bfhi(a.w);
            qf[h][8] = bflo(b.x); qf[h][9] = bfhi(b.x); qf[h][10] = bflo(b.y); qf[h][11] = bfhi(b.y); qf[h][12] = bflo(b.z); qf[h][13] = bfhi(b.z); qf[h][14] = bflo(b.w); qf[h][15] = bfhi(b.w); }
        DecState st;
#pragma unroll
        for (int h = 0; h < 4; ++h) { st.m[h] = -1e30f; st.l[h] = 0.f;
#pragma unroll
            for (int i = 0; i < 16; ++i) st.o[h][i] = 0.f; }
        const int* pt = (const int*)P.in[8] + s * 16;
#pragma unroll 1
        for (int jj = 0; jj < 4; ++jj) { const float* kb; const float* vb; int nk = 64;
            if (!isw) { const int J = wave + 5 * jj; if (J > 15) break;
                if (J == 15) { kb = P.out + O_SKS + (size_t)s * 256 + g * 64; vb = P.out + O_SVS + (size_t)s * 256 + g * 64; nk = 1; }
                else { unsigned bits = m0; for (int i = 0; i < J; ++i) bits &= bits - 1u; const int sg = bits ? __builtin_ctz(bits) : 0;
                    const size_t base = ((size_t)pt[sg >> 1] * 128 + (sg & 1) * 64) * 256 + g * 64; kb = P.in[4] + base; vb = P.in[5] + base; }
            } else { const int J = (wave - 5) + 3 * jj; if (J > 8) break;
                if (J == 8) { const size_t base = ((size_t)s * WIN + (WIN - 1)) * 256 + g * 64; kb = P.out + O_WKS + base; vb = P.out + O_WVS + base; nk = 1; }
                else { const size_t base = ((size_t)s * WIN + 64 * J) * 256 + g * 64; kb = P.in[6] + base; vb = P.in[7] + base; } }
            dec_job(kb, vb, nk, qf, st, lane); }
#pragma unroll
        for (int h = 0; h < 4; ++h) { float M = st.m[h]; M = fmaxf(M, __shfl_xor(M, 4)); M = fmaxf(M, __shfl_xor(M, 8)); M = fmaxf(M, __shfl_xor(M, 16)); M = fmaxf(M, __shfl_xor(M, 32));
            const float f = fexp2(st.m[h] - M); st.m[h] = M; st.l[h] *= f;
#pragma unroll
            for (int i = 0; i < 16; ++i) st.o[h][i] *= f; }
#pragma unroll
        for (int h = 0; h < 4; ++h) { float l = st.l[h]; l += __shfl_xor(l, 4); l += __shfl_xor(l, 8); l += __shfl_xor(l, 16); l += __shfl_xor(l, 32); st.l[h] = l;
#pragma unroll
            for (int i = 0; i < 16; ++i) { float v = st.o[h][i]; v += __shfl_xor(v, 4); v += __shfl_xor(v, 8); v += __shfl_xor(v, 16); v += __shfl_xor(v, 32); st.o[h][i] = v; } }
        if (lane < 4) {
#pragma unroll
            for (int h = 0; h < 4; ++h) { LAS float* pp = part + (wave * 4 + h) * 66; if (lane == 0) { pp[0] = st.m[h]; pp[1] = st.l[h]; }
#pragma unroll
                for (int i = 0; i < 16; ++i) pp[2 + 16 * dq + i] = st.o[h][i]; } }
    }
    __syncthreads();
    if (tid < 256) { const int h = tid >> 6, d = tid & 63;
        float res = ocs[h * 64 + d];
#pragma unroll
        for (int br = 0; br < 2; ++br) { const int w0 = br ? 5 : 0, w1 = br ? 8 : 5; float M = -1e30f;
            for (int w = w0; w < w1; ++w) M = fmaxf(M, part[(w * 4 + h) * 66]);
            float Lt = 0.f, Ot = 0.f;
            for (int w = w0; w < w1; ++w) { const LAS float* pp = part + (w * 4 + h) * 66; const float f = fexp2(pp[0] - M); Lt += pp[1] * f; Ot += pp[2 + d] * f; }
            res += (Lt > 0.f ? Ot / Lt : 0.f) * gates[h * 3 + 1 + br]; }
        ((bf16*)(ws + WS_O))[(size_t)row * D + (4 * g + h) * 64 + d] = (bf16)(pk2(res, 0.f) & 0xffffu); }
    __syncthreads();
}

__device__ __forceinline__ void phase_attn(const Params& P, LAS unsigned char* lds, int tid, int lane, int wave) {
    float qg = fabsf(P.in[20][lane]), k0 = fabsf(P.in[24][lane]), k1 = fabsf(P.in[24][64 + lane]), k2 = fabsf(P.in[24][128 + lane]);
    qg = wave_max(qg); k0 = wave_max(k0); k1 = wave_max(k1); k2 = wave_max(k2);
    AttnRefs rf; rf.cmp = -8.0f * 1.4426950409f * qg * k0; rf.slc = -8.0f * 1.4426950409f * qg * k1; rf.win = -8.0f * 1.4426950409f * qg * k2;
    LAS float* L = (LAS float*)lds;
    for (int item = blockIdx.x; item < 512; item += gridDim.x) attn_sample_item(P, item, rf, L, tid, lane, wave);
    LAS float* imps = L + 260 + 8 * 4 * 66 + wave * 512;
    const int gw = blockIdx.x * NWAVES + wave, ngw = gridDim.x * NWAVES;
    for (int task = gw; task < 8 * 2048; task += ngw) attn_prompt_tile(P, task, rf, imps, lane);
    const int gtid = blockIdx.x * 512 + tid, ngt = gridDim.x * 512;
    for (int e = gtid; e < (M65 - MT) * 128; e += ngt) *(v4u*)((bf16*)(P.ws + WS_O) + (size_t)MT * D + (size_t)e * 8) = (v4u){0u, 0u, 0u, 0u};
}

constexpr int NPHASE = 15;
__global__ void __launch_bounds__(NWAVES * 64, 2) fwd(Params P) {
    extern __shared__ __attribute__((aligned(16))) unsigned char lds_raw[];
    LAS unsigned char* lds = (LAS unsigned char*)lds_raw;
    const int tid = threadIdx.x, lane = tid & 63, wave = __builtin_amdgcn_readfirstlane(tid >> 6);
    const int G = gridDim.x;
    unsigned char* ws = P.ws;
    for (int u = tid; u < (LDS_BYTES - LDSCTL_OFF) / 4; u += NWAVES * 64) ((LAS unsigned*)(lds + LDSCTL_OFF))[u] = 0u;
    __syncthreads();
    XcdBarrier bar; bar.bar = (unsigned*)(ws + WS_CTL) + CW_BAR; bar.x = 0; bar.st = nullptr;
#if !MK_PER_PHASE
    bar = xcd_barrier_post((unsigned*)(ws + WS_CTL) + CW_BAR, (volatile LAS unsigned*)(lds + MISC_OFF) + 8);
#endif
    const int lo = P.ph_lo, hi = P.ph_hi;
#ifndef PH_MASK
#define PH_MASK 0x7fff
#endif
#define EN(k) (((PH_MASK) >> (k)) & 1)
#define IN(k) (lo <= (k) && (k) < hi)
#if MK_PER_PHASE
#define GRID_BAR(k) do { } while (0)
#else
#define GRID_BAR(k) do { if ((k) + 1 < hi) xcd_barrier(bar); } while (0)
#endif
    bf16* WBIG = (bf16*)(ws + WS_WBIG); bf16* ACTA = (bf16*)(ws + WS_ACTA); float* SSQ = (float*)(ws + WS_SSQ);
    float* MOD = (float*)(ws + WS_MOD); float* BIAS = (float*)(ws + WS_BIAS); float* ROPE = (float*)(ws + WS_ROPE);
    const size_t SSQ_STRIDE = (size_t)M65 * 16;

    if (EN(0) && IN(0)) { phase0(P, lds, tid, lane, wave); GRID_BAR(0); }
    if (EN(1) && IN(1)) {
        pg8::Gemm g{(const bf16*)(ws + WS_SC), (const bf16*)(ws + WS_WADA), 256, NMOD, 1024, 1024, 1 << 30, 0}; pg8::StaticOrder S; S.init(256, NMOD, G, (int)blockIdx.x);
        EpiMod E{MOD, (bf16*)(ws + WS_SH), P.in[12]};
        pg8::gemm_phase<EpiMod, true>(lds + RING_OFF, g, S, E);
        __syncthreads();
        phase1_weights(P, lds, lane, wave);
        GRID_BAR(1); }
    if (EN(2) && IN(2)) {
        pg8::Gemm g{(const bf16*)(ws + WS_SH), WBIG, 1024, NBIG, 1024, 1024, 1 << 30, 0}; pg8::StaticOrder S; S.init(1024, NBIG, G, (int)blockIdx.x);
        EpiBias E{BIAS};
        pg8::gemm_phase<EpiBias, true>(lds + RING_OFF, g, S, E);
        phase2_tail(P, tid, lane, wave);
        sample_prepass(P, tid, lane, wave);
        GRID_BAR(2); }
#define COMMON_PHASES(layer) do { \
        const int po = layer ? 12 : 5; \
        if (EN(5) && IN(po)) { \
            pg8::Gemm g{layer ? (const bf16*)(ws + WS_O) : (const bf16*)(ws + WS_UM), layer ? (const bf16*)(ws + WS_WBO) : (const bf16*)(ws + WS_WOUT), M65, 1024, 1024, 1024, 1 << 30, 0}; \
            pg8::StaticOrder S; S.init(M65, 1024, G, (int)blockIdx.x); \
            EpiRes E{layer ? P.out : P.in[0], layer ? P.out + (size_t)MP * D : P.in[1], MOD, layer * 6144 + 2048, P.out, (const float*)(ws + WS_MUL) + (size_t)(layer ? 2 : 0) * 256 * 1024, ACTA, nullptr, nullptr, SSQ + (layer ? 4 : 2) * SSQ_STRIDE}; \
            pg8::gemm_phase<EpiRes, true>(lds + RING_OFF, g, S, E); \
            GRID_BAR(po); } \
        if (EN(6) && IN(po + 1)) { \
            const int off = layer ? OFF_GU1 : OFF_GU0; \
            pg8::Gemm g{ACTA, WBIG + (size_t)off * 1024, M65, NGU, 1024, 1024, 1 << 30, 0}; pg8::StaticOrder S; S.init(M65, NGU, G, (int)blockIdx.x); \
            EpiGU E{SSQ + (layer ? 4 : 2) * SSQ_STRIDE, BIAS, off, (bf16*)(ws + WS_HID)}; \
            pg8::gemm_phase<EpiGU, true>(lds + RING_OFF, g, S, E); \
            GRID_BAR(po + 1); } \
        if (EN(7) && IN(po + 2)) { \
            pg8::Gemm g{(const bf16*)(ws + WS_HID), (const bf16*)(ws + WS_WDN) + (size_t)layer * 1024 * DFF, M65, 1024, DFF, DFF, 1 << 30, 0}; pg8::StaticOrder S; S.init(M65, 1024, G, (int)blockIdx.x); \
            EpiRes E{P.out, P.out + (size_t)MP * D, MOD, layer * 6144 + 5120, P.out, (const float*)(ws + WS_MUL) + (size_t)256 * 1024, layer ? nullptr : ACTA, P.in[22], layer ? nullptr : (bf16*)(ws + WS_AKV), layer ? nullptr : SSQ + 3 * SSQ_STRIDE}; \
            pg8::gemm_phase<EpiRes, true>(lds + RING_OFF, g, S, E); \
            GRID_BAR(po + 2); } \
    } while (0)
            if (EN(3) && IN(3)) {
                pg8::Gemm g{ACTA, WBIG + (size_t)OFF_WIN * 1024, M65, NAIN, 1024, 1024, 1 << 30, 0}; pg8::StaticOrder S; S.init(M65, NAIN, G, (int)blockIdx.x);
                EpiAin E{SSQ, BIAS, (bf16*)(ws + WS_U), (bf16*)(ws + WS_V), SSQ + SSQ_STRIDE};
                pg8::gemm_phase<EpiAin, true>(lds + RING_OFF, g, S, E);
                GRID_BAR(3); }
            if (EN(4) && IN(4)) { phase_tokmix(P, lds, tid, lane, wave); GRID_BAR(4); }
    COMMON_PHASES(0);
            if (EN(8) && IN(8)) {
                { pg8::Gemm g{(const bf16*)(ws + WS_AKV), (const bf16*)(ws + WS_WKV), M65, NKV, 1024, 1024, 1 << 30, 0}; pg8::StaticOrder S; S.init(M65, NKV, G, (int)blockIdx.x);
                  EpiKV E{SSQ + 3 * SSQ_STRIDE, P.in[24], ROPE, P.out, (bf16*)(ws + WS_RC), (bf16*)(ws + WS_KS), (bf16*)(ws + WS_KW), (bf16*)(ws + WS_VST), (bf16*)(ws + WS_VWT)};
                  pg8::gemm_phase<EpiKV, true>(lds + RING_OFF, g, S, E); }
                { pg8::Gemm g{ACTA, WBIG + (size_t)OFF_Q * 1024, M65, NQP, 1024, 1024, 1 << 30, 0}; pg8::StaticOrder S; S.init(M65, NQP, G, (int)((blockIdx.x + 128) % G));
                  EpiQ E{SSQ + 3 * SSQ_STRIDE, BIAS, P.in[20], ROPE, (bf16*)(ws + WS_QN), (bf16*)(ws + WS_QR), (float*)(ws + WS_GATES)};
                  pg8::gemm_phase<EpiQ, true>(lds + RING_OFF, g, S, E); }
                GRID_BAR(8); }
            if (EN(9) && IN(9)) {
                pg8::Gemm g{(const bf16*)(ws + WS_RC), (const bf16*)(ws + WS_W1C), 2 * RC_KV, 256, 2048, 1024, RC_KV / 256, (long)256 * 2048}; pg8::StaticOrder S; S.init(2 * RC_KV, 256, G, (int)blockIdx.x);
                EpiCmp E{(const float*)(ws + WS_C1), (bf16*)(ws + WS_H2)};
                pg8::gemm_phase<EpiCmp, true>(lds + RING_OFF, g, S, E);
                GRID_BAR(9); }
            if (EN(10) && IN(10)) { phase_w2(P, lane, wave); GRID_BAR(10); }
            if (EN(11) && IN(11)) { phase_attn(P, lds, tid, lane, wave); GRID_BAR(11); }
    COMMON_PHASES(1);
#undef IN
#undef EN
#undef GRID_BAR
}

extern "C" void kernel_launch(void* const* d_in, const int* in_sizes, int n_in, void* d_out, int out_size, void* d_ws, size_t ws_size, hipStream_t stream) {
    static int grid = 0;
    if (grid == 0) {
        if (n_in != 32 || ws_size < WS_END) { fprintf(stderr, "kernel_launch: unexpected problem (n_in %d, ws %zu < %zu)\n", n_in, ws_size, (size_t)WS_END); grid = -1; return; }
        int dev = 0, cus = 0;
        if (hipGetDevice(&dev) != hipSuccess || hipDeviceGetAttribute(&cus, hipDeviceAttributeMultiprocessorCount, dev) != hipSuccess) { grid = -1; return; }
        if (hipFuncSetAttribute((const void*)fwd, hipFuncAttributeMaxDynamicSharedMemorySize, LDS_BYTES) != hipSuccess) { fprintf(stderr, "kernel_launch: hipFuncSetAttribute failed\n"); grid = -1; return; }
        int per_cu = 0;
        if (hipOccupancyMaxActiveBlocksPerMultiprocessor(&per_cu, (const void*)fwd, NWAVES * 64, LDS_BYTES) != hipSuccess || per_cu < 1) fprintf(stderr, "kernel_launch: occupancy query says %d\n", per_cu);
        (void)hipGetLastError();
        grid = cus;
    }
    if (grid < 0) return;
    (void)hipMemsetAsync((char*)d_ws + WS_CTL, 0, CTL_ZERO_BYTES, stream);
    Params p{};
    for (int i = 0; i < 32; ++i) p.in[i] = (const float*)d_in[i];
    p.out = (float*)d_out; p.ws = (unsigned char*)d_ws;
#if MK_PER_PHASE
    for (int k = 0; k < NPHASE; ++k) { p.ph_lo = k; p.ph_hi = k + 1; hipLaunchKernelGGL(fwd, dim3(grid), dim3(NWAVES * 64), LDS_BYTES, stream, p); }
#else
    p.ph_lo = 0; p.ph_hi = NPHASE;
    hipLaunchKernelGGL(fwd, dim3(grid), dim3(NWAVES * 64), LDS_BYTES, stream, p);
#endif
    const hipError_t le = hipPeekAtLastError();
    if (le != hipSuccess) fprintf(stderr, "kernel_launch: launch failed: %s\n", hipGetErrorName(le));
}
```

```cpp
#include <hip/hip_runtime.h>
#include <hip/hip_bf16.h>
#include <cstdio>
#include <cstdint>
#include <cmath>

#ifndef MK_PER_PHASE
#define MK_PER_PHASE 0
#endif

namespace pg8 {
#define PG8_LAS __attribute__((address_space(3)))
typedef unsigned short bf16_t;
typedef short bf16x8 __attribute__((ext_vector_type(8)));
typedef float f32x4 __attribute__((ext_vector_type(4)));
typedef unsigned u32x4 __attribute__((ext_vector_type(4)));
typedef unsigned u32x2 __attribute__((ext_vector_type(2)));
constexpr int BM = 256, BK = 64, HALF = 128, HTB = HALF * BK * 2, STAGE_BYTES = 8 * HTB, NXCD = 8, WGM = 8;

__host__ __device__ __forceinline__ int lds_byte(int r, int c) { const int st = (r >> 4) * 2 + (c >> 5), rr = r & 15, cc = c & 31, ob = rr * 64 + cc * 2; return st * 1024 + (ob ^ (((ob >> 9) & 1) << 5)); }
__host__ __device__ __forceinline__ void stage_rc(int b, int& R, int& C) { const int st = b / 1024, sb = b % 1024, swz = sb ^ (((sb >> 9) & 1) << 5); R = (st >> 1) * 16 + swz / 64; C = (st & 1) * 32 + (swz % 64) / 2; }
__host__ __device__ __forceinline__ int perm32(int rho) { const int n = rho >> 4, i = rho & 15; return 8 * (i >> 2) + 4 * n + (i & 3); }

struct Unit { int pm, pn; };
struct Gemm { const bf16_t* A; const bf16_t* Bt; int M, N, K, lda, bsplit; long boff; };

struct StaticOrder {
    int nM, nN, nwg, G, c;
    __host__ __device__ void init(int M, int N, int G_, int c_) { nM = M / BM; nN = N / BM; nwg = nM * nN; G = G_; c = c_; }
    __host__ __device__ bool next(int i, Unit& u) const {
        const long L = (long)i * G + c; if (L >= nwg) return false;
        int wgid = (int)L; { const int q = nwg / NXCD, r = nwg % NXCD, xcd = wgid % NXCD, off = wgid / NXCD; wgid = (xcd < r ? xcd * (q + 1) : r * (q + 1) + (xcd - r) * q) + off; }
        const int nig = WGM * nN, gid = wgid / nig, fm = gid * WGM, gsz = (nM - fm) < WGM ? (nM - fm) : WGM;
        u.pm = fm + ((wgid % nig) % gsz); u.pn = (wgid % nig) / gsz; return true;
    }
};

template <class Epi, bool ALIGN_EPI>
__device__ __forceinline__ void gemm_phase(PG8_LAS unsigned char* lds, const Gemm g, const StaticOrder& S, const Epi& E) {
    const int tid = threadIdx.x, wid = __builtin_amdgcn_readfirstlane(tid >> 6), lane = tid & 63, wr = wid >> 2, wc = wid & 3, fr = lane & 15, fq = lane >> 4;
    const int K = g.K, nt = K / BK, lda = g.lda;
    unsigned voffA[2], voffB[2];
#pragma unroll
    for (int i = 0; i < 2; ++i) { int R, C; stage_rc(tid * 16 + i * 8192, R, C); const int Rb = ((R & ~31) + perm32(R & 31));
        voffA[i] = (unsigned)(R * lda + C) * 2u; voffB[i] = (unsigned)(Rb * K + C) * 2u; }
    const size_t kstep = (size_t)(BK * 2);
    const size_t hstepA = (size_t)HALF * lda * 2, hstepB = (size_t)HALF * K * 2;
    const size_t tstepA = 2 * hstepA, tstepB = 2 * hstepB;
    const unsigned ldsw = (unsigned)wid * 1024u;
    const int aoff = lds_byte(wr * 64 + fr, fq * 8), boff = lds_byte(wc * 32 + fr, fq * 8);
#define PG8_SA(b, h) (((b) * 2 + (h)) * HTB)
#define PG8_SB(b, h) ((4 + (b) * 2 + (h)) * HTB)
#define PG8_STAGE(bufoff, gbase, voff) do { _Pragma("unroll") for (int _i = 0; _i < 2; ++_i) \
        __builtin_amdgcn_global_load_lds((const unsigned*)((const char*)(gbase) + (voff)[_i]), (PG8_LAS unsigned*)(lds + (bufoff) + ldsw + _i * 8192), 16, 0, 0); } while (0)
#define PG8_LDA(dst, b, h) do { _Pragma("unroll") for (int m = 0; m < 4; ++m) _Pragma("unroll") for (int k = 0; k < 2; ++k) dst[m][k] = *(const PG8_LAS bf16x8*)(lds + PG8_SA(b, h) + aoff + m * 2048 + k * 1024); } while (0)
#define PG8_LDB(dst, b, h) do { _Pragma("unroll") for (int n = 0; n < 2; ++n) _Pragma("unroll") for (int k = 0; k < 2; ++k) dst[n][k] = *(const PG8_LAS bf16x8*)(lds + PG8_SB(b, h) + boff + n * 2048 + k * 1024); } while (0)
#define PG8_MMA(ai, bj, At, Bt) do { __builtin_amdgcn_s_setprio(1); _Pragma("unroll") for (int m = 0; m < 4; ++m) _Pragma("unroll") for (int n = 0; n < 2; ++n) _Pragma("unroll") for (int k = 0; k < 2; ++k) \
        acc[ai][bj][m][n] = __builtin_amdgcn_mfma_f32_16x16x32_bf16(Bt[n][k], At[m][k], acc[ai][bj][m][n], 0, 0, 0); __builtin_amdgcn_s_setprio(0); } while (0)
#define PG8_WAIT_V(n) asm volatile("s_waitcnt vmcnt(" #n ")" ::: "memory")
#define PG8_WAIT_L(n) asm volatile("s_waitcnt lgkmcnt(" #n ")" ::: "memory")
#define PG8_BAR __builtin_amdgcn_s_barrier()
#define PG8_SCHED __builtin_amdgcn_sched_barrier(0)
    Unit cur, nxt; int ui = 0;
    if (!S.next(0, cur)) return;
    f32x4 acc[2][2][4][2];
#pragma unroll
    for (int a = 0; a < 2; ++a)
#pragma unroll
        for (int b = 0; b < 2; ++b)
#pragma unroll
            for (int m = 0; m < 4; ++m)
#pragma unroll
                for (int n = 0; n < 2; ++n) acc[a][b][m][n] = (f32x4){0.f, 0.f, 0.f, 0.f};
    bf16x8 At[4][2], B0[2][2], B1[2][2];
    const char* cA = (const char*)g.A + (size_t)cur.pm * tstepA;
    const char* cB = (const char*)g.Bt + (cur.pm >= g.bsplit ? (size_t)g.boff * 2 : (size_t)0) + (size_t)cur.pn * tstepB;
    PG8_STAGE(PG8_SB(0, 0), cB, voffB); PG8_STAGE(PG8_SB(0, 1), cB + hstepB, voffB); PG8_STAGE(PG8_SA(0, 0), cA, voffA); PG8_STAGE(PG8_SA(0, 1), cA + hstepA, voffA);
    if (wr == 1) PG8_BAR;
    PG8_WAIT_V(2); PG8_BAR;
    PG8_STAGE(PG8_SB(1, 0), cB + kstep, voffB); PG8_STAGE(PG8_SA(1, 0), cA + kstep, voffA); PG8_STAGE(PG8_SB(1, 1), cB + hstepB + kstep, voffB);
    PG8_WAIT_V(6); PG8_BAR;
    for (;;) {
        const bool has_next = S.next(ui + 1, nxt);
        const char* nA = has_next ? (const char*)g.A + (size_t)nxt.pm * tstepA : cA;
        const char* nB = has_next ? (const char*)g.Bt + (nxt.pm >= g.bsplit ? (size_t)g.boff * 2 : (size_t)0) + (size_t)nxt.pn * tstepB : cB;
        for (int t = 0; t < nt; t += 2) {
            const bool last = (t == nt - 2);
            const char* a1 = cA + (size_t)(t + 1) * kstep;
            const char* a2 = last ? nA : cA + (size_t)(t + 2) * kstep; const char* b2 = last ? nB : cB + (size_t)(t + 2) * kstep;
            const char* a3 = a2 + kstep; const char* b3 = b2 + kstep;
            PG8_LDB(B0, 0, 0); PG8_LDB(B1, 0, 1); PG8_SCHED; PG8_LDA(At, 0, 0); PG8_STAGE(PG8_SA(1, 1), a1 + hstepA, voffA);
            PG8_WAIT_V(8); PG8_WAIT_L(0); PG8_BAR; PG8_MMA(0, 0, At, B0); PG8_MMA(0, 1, At, B1); PG8_BAR; PG8_SCHED;
            PG8_LDA(At, 0, 1); PG8_STAGE(PG8_SB(0, 0), b2, voffB); PG8_STAGE(PG8_SB(0, 1), b2 + hstepB, voffB); PG8_STAGE(PG8_SA(0, 0), a2, voffA);
            PG8_WAIT_V(8); PG8_WAIT_L(0); PG8_BAR; PG8_MMA(1, 0, At, B0); PG8_MMA(1, 1, At, B1); PG8_BAR; PG8_SCHED;
            PG8_LDB(B0, 1, 0); PG8_LDB(B1, 1, 1); PG8_SCHED; PG8_LDA(At, 1, 0); PG8_STAGE(PG8_SA(0, 1), a2 + hstepA, voffA);
            PG8_WAIT_V(8); PG8_WAIT_L(0); PG8_BAR; PG8_MMA(0, 0, At, B0); PG8_MMA(0, 1, At, B1); PG8_BAR; PG8_SCHED;
            PG8_LDA(At, 1, 1); PG8_STAGE(PG8_SB(1, 0), b3, voffB); PG8_STAGE(PG8_SB(1, 1), b3 + hstepB, voffB); PG8_STAGE(PG8_SA(1, 0), a3, voffA);
            PG8_WAIT_V(8); PG8_WAIT_L(0); PG8_BAR; PG8_MMA(1, 0, At, B0); PG8_MMA(1, 1, At, B1); PG8_BAR; PG8_SCHED;
        }
        if constexpr (ALIGN_EPI) { if (wr == 0) PG8_BAR; }
        E(acc, cur, wr, wc, fr, fq);
        if (!has_next) break;
#pragma unroll
        for (int a = 0; a < 2; ++a)
#pragma unroll
            for (int b = 0; b < 2; ++b)
#pragma unroll
                for (int m = 0; m < 4; ++m)
#pragma unroll
                    for (int n = 0; n < 2; ++n) acc[a][b][m][n] = (f32x4){0.f, 0.f, 0.f, 0.f};
        cur = nxt; cA = nA; cB = nB; ++ui;
        if constexpr (ALIGN_EPI) { if (wr == 1) PG8_BAR; }
    }
    PG8_WAIT_V(0);
    if constexpr (!ALIGN_EPI) { if (wr == 0) PG8_BAR; }
    PG8_BAR;
#undef PG8_SA
#undef PG8_SB
#undef PG8_STAGE
#undef PG8_LDA
#undef PG8_LDB
#undef PG8_MMA
#undef PG8_WAIT_V
#undef PG8_WAIT_L
#undef PG8_BAR
#undef PG8_SCHED
}
}

#define GAS __attribute__((address_space(1)))
#define LAS __attribute__((address_space(3)))
typedef unsigned short bf16;
typedef unsigned v4u __attribute__((ext_vector_type(4)));
typedef unsigned v2u __attribute__((ext_vector_type(2)));
typedef float f32x4 __attribute__((ext_vector_type(4)));
typedef float f32x2 __attribute__((ext_vector_type(2)));
typedef short bf16x8 __attribute__((ext_vector_type(8)));
typedef short bf16x4 __attribute__((ext_vector_type(4)));
typedef __bf16 bf16x2_t __attribute__((ext_vector_type(2)));
typedef GAS unsigned gu32;
#define RLX_AGENT __ATOMIC_RELAXED, __HIP_MEMORY_SCOPE_AGENT
#define LDS_WAIT() asm volatile("s_waitcnt lgkmcnt(0)" ::: "memory")
#define VM_WAIT() asm volatile("s_waitcnt vmcnt(0)" ::: "memory")
__device__ __forceinline__ unsigned pk2(float lo, float hi) { f32x2 v = {lo, hi}; bf16x2_t b = __builtin_convertvector(v, bf16x2_t); return __builtin_bit_cast(unsigned, b); }
__device__ __forceinline__ float bf2f(unsigned short h) { return __builtin_bit_cast(float, (unsigned)h << 16); }
__device__ __forceinline__ float bflo(unsigned w) { return __builtin_bit_cast(float, w << 16); }
__device__ __forceinline__ float bfhi(unsigned w) { return __builtin_bit_cast(float, w & 0xffff0000u); }
__device__ __forceinline__ float fexp2(float x) { return __builtin_amdgcn_exp2f(x); }
__device__ __forceinline__ float frcp(float x) { return __builtin_amdgcn_rcpf(x); }
__device__ __forceinline__ float gelu_t(float x) { const float x2 = x * x; const float e = fexp2(x * (-2.302208198f + -0.1029432357f * x2)); return x * frcp(1.f + e); }
__device__ __forceinline__ float silu_f(float x) { return x * frcp(1.f + fexp2(-1.4426950409f * x)); }
__device__ __forceinline__ float sigmoid_f(float x) { return frcp(1.f + fexp2(-1.4426950409f * x)); }
__device__ __forceinline__ float dpp_xor1(float v) { return __builtin_bit_cast(float, __builtin_amdgcn_update_dpp(0, __builtin_bit_cast(int, v), 0xB1, 0xF, 0xF, true)); }
__device__ __forceinline__ float dpp_xor2(float v) { return __builtin_bit_cast(float, __builtin_amdgcn_update_dpp(0, __builtin_bit_cast(int, v), 0x4E, 0xF, 0xF, true)); }
__device__ __forceinline__ unsigned dpp_xor1u(unsigned v) { return (unsigned)__builtin_amdgcn_update_dpp(0, (int)v, 0xB1, 0xF, 0xF, true); }
__device__ __forceinline__ unsigned dpp_xor2u(unsigned v) { return (unsigned)__builtin_amdgcn_update_dpp(0, (int)v, 0x4E, 0xF, 0xF, true); }
__device__ __forceinline__ float wave_sum(float v) {
#pragma unroll
    for (int o = 1; o < 64; o <<= 1) v += __shfl_xor(v, o);
    return v;
}
__device__ __forceinline__ float wave_max(float v) {
#pragma unroll
    for (int o = 1; o < 64; o <<= 1) v = fmaxf(v, __shfl_xor(v, o));
    return v;
}

#define XB_TMO      128
#define XB_XCNT(j)  (256  + 64 * (j))
#define XB_XSUB(j)  (1280 + 64 * (j))
#define XB_XGEN(j)  (2304 + 64 * (j))
#define XB_TOP      3328
#define XB_TOPGEN   3392
#define XCD_BAR_WORDS 3456
#define XB_SPIN_CAP (1u << 18)

__device__ __forceinline__ unsigned xb_ld(unsigned* p)              { return __hip_atomic_load(p, __ATOMIC_RELAXED, __HIP_MEMORY_SCOPE_AGENT); }
__device__ __forceinline__ unsigned xb_add(unsigned* p, unsigned v) { return __hip_atomic_fetch_add(p, v, __ATOMIC_RELAXED, __HIP_MEMORY_SCOPE_AGENT); }
__device__ __forceinline__ unsigned xb_xcc_id() { return (unsigned)__builtin_amdgcn_s_getreg((3 << 11) | 20) & 0xFu; }
#define XB_SPIN(cond, bar) do { unsigned _sp = 0; while (cond) { __builtin_amdgcn_s_sleep(1); \
    if ((++_sp & 255u) == 0u) { if (xb_ld(&(bar)[XB_TMO])) break; if (_sp > XB_SPIN_CAP) { atomicAdd(&(bar)[XB_TMO], 1u); break; } } } } while (0)

struct XcdBarrier { unsigned* bar; unsigned x; volatile LAS unsigned* st; };

__device__ __forceinline__ XcdBarrier xcd_barrier_post(unsigned* bar, volatile LAS unsigned* st) {
    XcdBarrier b; b.bar = bar; b.x = xb_xcc_id(); b.st = st;
    if (threadIdx.x == 0) (void)xb_add(&bar[XB_XCNT(b.x)], 1u);
    return b;
}
__device__ __forceinline__ void xcd_barrier_complete(unsigned* bar, unsigned x, unsigned& nloc, unsigned& nx) {
    const unsigned G = gridDim.x * gridDim.y * gridDim.z;
    unsigned sum, cnt, mine, sp = 0u;
    for (;;) {
        sum = 0u; cnt = 0u; mine = 0u;
#pragma unroll
        for (unsigned j = 0; j < 16; ++j) { const unsigned c = xb_ld(&bar[XB_XCNT(j)]); sum += c; cnt += (c > 0u) ? 1u : 0u; mine = (j == x) ? c : mine; }
        if (sum == G) break;
        __builtin_amdgcn_s_sleep(1);
        if ((++sp & 255u) == 0u) { if (xb_ld(&bar[XB_TMO])) break; if (sp > XB_SPIN_CAP) { atomicAdd(&bar[XB_TMO], 1u); break; } }
    }
    nloc = mine > 0u ? mine : 1u; nx = cnt > 0u ? cnt : 1u;
}
__device__ __forceinline__ void xcd_barrier(const XcdBarrier& b) {
    asm volatile("s_waitcnt vmcnt(0)" ::: "memory");
    __syncthreads();
    if (threadIdx.x == 0) {
        unsigned* bar = b.bar;
        __builtin_amdgcn_s_waitcnt(0);
        unsigned nloc = b.st[0], nx = b.st[1];
        if (nloc == 0u) { xcd_barrier_complete(bar, b.x, nloc, nx); b.st[0] = nloc; b.st[1] = nx; }
        const unsigned old = xb_add(&bar[XB_XSUB(b.x)], 1u);
        const unsigned gen = old / nloc;
        if (old + 1u == (gen + 1u) * nloc) {
            __builtin_amdgcn_fence(__ATOMIC_RELEASE, "agent");
            asm volatile("s_waitcnt vmcnt(0)" ::: "memory");
            const unsigned og = xb_add(&bar[XB_TOP], 1u);
            const unsigned tg = og / nx;
            if (og + 1u == (tg + 1u) * nx) xb_add(&bar[XB_TOPGEN], 1u);
            else XB_SPIN(xb_ld(&bar[XB_TOPGEN]) == tg, bar);
            __builtin_amdgcn_fence(__ATOMIC_ACQUIRE, "agent");
            xb_add(&bar[XB_XGEN(b.x)], 1u);
            asm volatile("s_waitcnt vmcnt(0)" ::: "memory");
        } else {
            XB_SPIN(xb_ld(&bar[XB_XGEN(b.x)]) == gen, bar);
            __builtin_amdgcn_fence(__ATOMIC_ACQUIRE, "agent");
            asm volatile("s_waitcnt vmcnt(0)" ::: "memory");
        }
    }
    __syncthreads();
}

constexpr int NWAVES = 8;
constexpr int D = 1024, SEQ = 8192, NBATCH = 2, MP = NBATCH * SEQ, MS = 128, MT = MP + MS, M65 = 16640;
constexpr int DFF = 2816, NGU = 2 * DFF, NAIN = 2048, NKV = 1536, NQ = 1072, NQP = 1280;
constexpr int NBIG = NAIN + NGU + NQP + NGU;
constexpr int OFF_WIN = 0, OFF_GU0 = NAIN, OFF_Q = NAIN + NGU, OFF_GU1 = NAIN + NGU + NQP;
constexpr int NMOD = 12288;
constexpr int PAST = 2048, NPAGE = 16, PAGE = 128, WIN = 512;
constexpr int RC_SAMP = 512 * 128, RC_PROMPT = 8 * 512, RC_KV = RC_SAMP + RC_PROMPT;
constexpr float EPS = 1e-6f;
constexpr float C2 = 0.125f * 1.4426950408889634f;

constexpr size_t O_YP = 0, O_YS = 16777216, O_AVP = 16908288, O_AVS = 17170432, O_CKP = 17301504, O_CVP = 21495808, O_SKP = 25690112, O_SVP = 29884416,
                 O_WKP = 34078720, O_WVP = 34340864, O_CKS = 34603008, O_CVS = 34635776, O_SKS = 34668544, O_SVS = 34701312, O_WKS = 34734080, O_WVS = 51511296;

constexpr size_t al256(size_t x) { return (x + 255) & ~(size_t)255; }
constexpr size_t WS_CTL = 0, CTL_ZERO_BYTES = 1u << 20;
constexpr size_t WS_WADA = CTL_ZERO_BYTES;
constexpr size_t WS_WBIG = WS_WADA + (size_t)NMOD * D * 2;
constexpr size_t WS_WOUT = WS_WBIG + (size_t)NBIG * D * 2;
constexpr size_t WS_WBO = WS_WOUT + (size_t)D * D * 2;
constexpr size_t WS_WDN = WS_WBO + (size_t)D * D * 2;
constexpr size_t WS_WKV = WS_WDN + (size_t)2 * D * DFF * 2;
constexpr size_t WS_W1C = WS_WKV + (size_t)NKV * D * 2;
constexpr size_t WS_W2 = WS_W1C + (size_t)2 * 256 * 2048 * 2;
constexpr size_t WS_WSB = WS_W2 + (size_t)2 * 64 * 256 * 2;
constexpr size_t WS_ROPE = WS_WSB + (size_t)8 * 128 * 128 * 2;
constexpr size_t WS_C1 = WS_ROPE + (size_t)8192 * 64 * 4;
constexpr size_t WS_SC = WS_C1 + 2 * 256 * 4;
constexpr size_t WS_MOD = WS_SC + (size_t)256 * D * 2;
constexpr size_t WS_SH = WS_MOD + (size_t)256 * NMOD * 4;
constexpr size_t WS_BIAS = WS_SH + (size_t)4 * 256 * D * 2;
constexpr size_t WS_MUL = WS_BIAS + (size_t)256 * NBIG * 4;
constexpr size_t WS_SSQ = WS_MUL + (size_t)3 * 256 * D * 4;
constexpr size_t WS_ACTA = WS_SSQ + (size_t)5 * M65 * 16 * 4;
constexpr size_t ACT_BYTES = (size_t)M65 * D * 2;
constexpr size_t WS_AKV = WS_ACTA + ACT_BYTES;
constexpr size_t WS_U = WS_AKV + ACT_BYTES;
constexpr size_t WS_V = WS_U + ACT_BYTES;
constexpr size_t WS_UM = WS_V + ACT_BYTES;
constexpr size_t WS_QN = WS_UM + ACT_BYTES;
constexpr size_t WS_QR = WS_QN + ACT_BYTES;
constexpr size_t WS_O = WS_QR + ACT_BYTES;
constexpr size_t WS_GATES = WS_O + ACT_BYTES;
constexpr size_t WS_HID = WS_GATES + (size_t)M65 * 48 * 4;
constexpr size_t WS_KS = WS_HID + (size_t)M65 * DFF * 2;
constexpr size_t WS_KW = WS_KS + (size_t)8 * SEQ * 64 * 2;
constexpr size_t WS_VST = WS_KW + (size_t)8 * SEQ * 64 * 2;
constexpr size_t WS_VWT = WS_VST + (size_t)8 * SEQ * 64 * 2;
constexpr size_t WS_RC = WS_VWT + (size_t)8 * SEQ * 64 * 2;
constexpr size_t WS_H2 = WS_RC + (size_t)2 * RC_KV * 1024 * 2 + 4096;
constexpr size_t WS_KCP = WS_H2 + (size_t)2 * RC_KV * 256 * 2;
constexpr size_t WS_VCTP = WS_KCP + (size_t)8 * 512 * 64 * 2;
constexpr size_t WS_KCS = WS_VCTP + (size_t)8 * 512 * 64 * 2;
constexpr size_t WS_VCTS = WS_KCS + (size_t)512 * 128 * 64 * 2;
constexpr size_t WS_END = WS_VCTS + (size_t)512 * 128 * 64 * 2;
static_assert(WS_WBIG % 256 == 0 && WS_ROPE % 256 == 0 && WS_SC % 256 == 0 && WS_ACTA % 256 == 0 && WS_HID % 256 == 0 && WS_RC % 256 == 0 && WS_H2 % 256 == 0 && WS_KCP % 256 == 0, "ws alignment");
constexpr int CW_BAR = 4096;

constexpr int RING_OFF = 0, RING_BYTES = 131072;
constexpr int LDSCTL_OFF = RING_BYTES, MISC_OFF = LDSCTL_OFF + 320;
constexpr int LDS_BYTES = 163840;

struct Params {
    const float* in[32];
    float* out;
    unsigned char* ws;
    int ph_lo, ph_hi;
};

__device__ __forceinline__ int seq_of(int row) { const int s = row - MP + 2; return row < MP ? (row >> 13) : (s < 255 ? s : 255); }
__device__ __forceinline__ float rstd16(const float* p) {
    const f32x4 a = *(const f32x4*)p, b = *(const f32x4*)(p + 4), c = *(const f32x4*)(p + 8), d = *(const f32x4*)(p + 12);
    const float s = ((a.x + a.y) + (a.z + a.w)) + ((b.x + b.y) + (b.z + b.w)) + ((c.x + c.y) + (c.z + c.w)) + ((d.x + d.y) + (d.z + d.w));
    return rsqrtf(s * (1.0f / 1024.0f) + EPS);
}

using pg8::Unit;
#define EPI_ARGS const pg8::f32x4 (&acc)[2][2][4][2], const Unit& u, int wr, int wc, int fr, int fq

struct EpiMod {
    float* MOD; bf16* SH; const float* b_ada;
    __device__ __forceinline__ void operator()(EPI_ARGS) const { asm volatile("" ::: "memory");
        const int cl = wc * 32 + 8 * fq, c0 = u.pn * 256 + cl;
        const int pl = u.pn % 24, lay = u.pn / 24;
        const int np = (pl < 4) ? 2 * lay : ((pl >= 12 && pl < 16) ? 2 * lay + 1 : -1);
        const int j0 = (pl < 4 ? pl : pl - 12) * 256 + cl;
        f32x4 bv[2][2];
#pragma unroll
        for (int bj = 0; bj < 2; ++bj)
#pragma unroll
            for (int n = 0; n < 2; ++n) bv[bj][n] = *(const f32x4*)(b_ada + c0 + bj * 128 + 4 * n);
#pragma unroll
        for (int ai = 0; ai < 2; ++ai)
#pragma unroll
            for (int m = 0; m < 4; ++m) { const int row = ai * 128 + wr * 64 + m * 16 + fr;
#pragma unroll
                for (int bj = 0; bj < 2; ++bj) { const f32x4 v0 = acc[ai][bj][m][0] + bv[bj][0], v1 = acc[ai][bj][m][1] + bv[bj][1];
                    float* p = MOD + (size_t)row * NMOD + c0 + bj * 128; *(f32x4*)p = v0; *(f32x4*)(p + 4) = v1;
                    if (np >= 0) { v4u w; w.x = pk2(v0[0], v0[1]); w.y = pk2(v0[2], v0[3]); w.z = pk2(v1[0], v1[1]); w.w = pk2(v1[2], v1[3]);
                        *(v4u*)(SH + ((size_t)np * 256 + row) * D + j0 + bj * 128) = w; } } }
    }
};
struct EpiBias {
    float* BIAS;
    __device__ __forceinline__ void operator()(EPI_ARGS) const { asm volatile("" ::: "memory");
        const int lo = u.pm == 0 ? 0 : u.pm == 1 ? 8 : u.pm == 2 ? 30 : 35, hi = u.pm == 0 ? 8 : u.pm == 1 ? 30 : u.pm == 2 ? 35 : 57;
        if (u.pn < lo || u.pn >= hi) return;
        const int c0 = u.pn * 256 + wc * 32 + 8 * fq;
#pragma unroll
        for (int ai = 0; ai < 2; ++ai)
#pragma unroll
            for (int m = 0; m < 4; ++m) { const int row = ai * 128 + wr * 64 + m * 16 + fr;
#pragma unroll
                for (int bj = 0; bj < 2; ++bj) { float* p = BIAS + (size_t)row * NBIG + c0 + bj * 128; *(f32x4*)p = acc[ai][bj][m][0]; *(f32x4*)(p + 4) = acc[ai][bj][m][1]; } }
    }
};
struct EpiAin {
    const float* SSQ0; const float* BIAS; bf16* U; bf16* V; float* SSQV;
    __device__ __forceinline__ void operator()(EPI_ARGS) const { asm volatile("" ::: "memory");
        const int cl = wc * 32 + 8 * fq, c0 = u.pn * 256 + cl; const bool uni = u.pm < 64; const bool isv = u.pn >= 4;
        f32x4 bv[2][2];
        if (uni) { const float* b = BIAS + (size_t)(u.pm >> 5) * NBIG + OFF_WIN + c0;
#pragma unroll
            for (int bj = 0; bj < 2; ++bj)
#pragma unroll
                for (int n = 0; n < 2; ++n) bv[bj][n] = *(const f32x4*)(b + bj * 128 + 4 * n); }
#pragma unroll
        for (int ai = 0; ai < 2; ++ai)
#pragma unroll
            for (int m = 0; m < 4; ++m) { const int row = u.pm * 256 + ai * 128 + wr * 64 + m * 16 + fr;
                const float rs = rstd16(SSQ0 + (size_t)row * 16);
                if (!uni) { const float* b = BIAS + (size_t)seq_of(row) * NBIG + OFF_WIN + c0;
#pragma unroll
                    for (int bj = 0; bj < 2; ++bj)
#pragma unroll
                        for (int n = 0; n < 2; ++n) bv[bj][n] = *(const f32x4*)(b + bj * 128 + 4 * n); }
                float sq = 0.f;
#pragma unroll
                for (int bj = 0; bj < 2; ++bj) { f32x4 v0 = acc[ai][bj][m][0] * rs + bv[bj][0], v1 = acc[ai][bj][m][1] * rs + bv[bj][1];
#pragma unroll
                    for (int i = 0; i < 4; ++i) { v0[i] = gelu_t(v0[i]); v1[i] = gelu_t(v1[i]); sq += v0[i] * v0[i] + v1[i] * v1[i]; }
                    v4u w; w.x = pk2(v0[0], v0[1]); w.y = pk2(v0[2], v0[3]); w.z = pk2(v1[0], v1[1]); w.w = pk2(v1[2], v1[3]);
                    bf16* dst = isv ? V + (size_t)row * D + (c0 - 1024) + bj * 128 : U + (size_t)row * D + c0 + bj * 128;
                    *(v4u*)dst = w; }
                if (isv) { sq += __shfl_xor(sq, 16); sq += __shfl_xor(sq, 32); if (fq == 0) SSQV[(size_t)row * 16 + (u.pn - 4) * 4 + wc] = sq; } }
    }
};
struct EpiGU {
    const float* SSQ; const float* BIAS; int boff; bf16* HID;
    __device__ __forceinline__ void operator()(EPI_ARGS) const { asm volatile("" ::: "memory");
        const int cl = wc * 32 + 8 * fq, c0 = u.pn * 256 + cl; const bool uni = u.pm < 64;
        f32x4 bv[2][2];
        if (uni) { const float* b = BIAS + (size_t)(u.pm >> 5) * NBIG + boff + c0;
#pragma unroll
            for (int bj = 0; bj < 2; ++bj)
#pragma unroll
                for (int n = 0; n < 2; ++n) bv[bj][n] = *(const f32x4*)(b + bj * 128 + 4 * n); }
#pragma unroll
        for (int ai = 0; ai < 2; ++ai)
#pragma unroll
            for (int m = 0; m < 4; ++m) { const int row = u.pm * 256 + ai * 128 + wr * 64 + m * 16 + fr;
                const float rs = rstd16(SSQ + (size_t)row * 16);
                if (!uni) { const float* b = BIAS + (size_t)seq_of(row) * NBIG + boff + c0;
#pragma unroll
                    for (int bj = 0; bj < 2; ++bj)
#pragma unroll
                        for (int n = 0; n < 2; ++n) bv[bj][n] = *(const f32x4*)(b + bj * 128 + 4 * n); }
                float h[8];
#pragma unroll
                for (int n = 0; n < 2; ++n) { const f32x4 zg = acc[ai][0][m][n] * rs + bv[0][n], zu = acc[ai][1][m][n] * rs + bv[1][n];
#pragma unroll
                    for (int i = 0; i < 4; ++i) h[4 * n + i] = silu_f(zg[i]) * zu[i]; }
                v4u w; w.x = pk2(h[0], h[1]); w.y = pk2(h[2], h[3]); w.z = pk2(h[4], h[5]); w.w = pk2(h[6], h[7]);
                *(v4u*)(HID + (size_t)row * DFF + u.pn * 128 + cl) = w; }
    }
};
struct EpiRes {
    const float* xin_p; const float* xin_s;
    const float* MOD; int goff;
    float* out;
    const float* MUL; bf16* A1;
    const float* kvg; bf16* A2;
    float* SSQ;
    __device__ __forceinline__ void operator()(EPI_ARGS) const { asm volatile("" ::: "memory");
        const int cl = wc * 32 + 8 * fq, c0 = u.pn * 256 + cl; const bool uni = u.pm < 64;
        f32x4 gv[2][2], mv[2][2], kv[2][2];
        if (uni) { const int sq_ = u.pm >> 5;
#pragma unroll
            for (int bj = 0; bj < 2; ++bj)
#pragma unroll
                for (int n = 0; n < 2; ++n) { gv[bj][n] = *(const f32x4*)(MOD + (size_t)sq_ * NMOD + goff + c0 + bj * 128 + 4 * n);
                    if (A1) mv[bj][n] = *(const f32x4*)(MUL + (size_t)sq_ * D + c0 + bj * 128 + 4 * n); } }
        if (A2) {
#pragma unroll
            for (int bj = 0; bj < 2; ++bj)
#pragma unroll
                for (int n = 0; n < 2; ++n) kv[bj][n] = *(const f32x4*)(kvg + c0 + bj * 128 + 4 * n); }
#pragma unroll
        for (int ai = 0; ai < 2; ++ai)
#pragma unroll
            for (int m = 0; m < 4; ++m) { const int row = u.pm * 256 + ai * 128 + wr * 64 + m * 16 + fr;
                const bool real = row < MT;
                if (!uni) { const int sq_ = seq_of(row);
#pragma unroll
                    for (int bj = 0; bj < 2; ++bj)
#pragma unroll
                        for (int n = 0; n < 2; ++n) { gv[bj][n] = *(const f32x4*)(MOD + (size_t)sq_ * NMOD + goff + c0 + bj * 128 + 4 * n);
                            if (A1) mv[bj][n] = *(const f32x4*)(MUL + (size_t)sq_ * D + c0 + bj * 128 + 4 * n); } }
                const float* xr = uni ? xin_p + (size_t)row * D : xin_s + (size_t)(real ? row - MP : 0) * D;
                float sq = 0.f;
#pragma unroll
                for (int bj = 0; bj < 2; ++bj) { f32x4 x0 = *(const f32x4*)(xr + c0 + bj * 128), x1 = *(const f32x4*)(xr + c0 + bj * 128 + 4);
                    if (!real) { x0 = (f32x4){0.f, 0.f, 0.f, 0.f}; x1 = x0; }
                    x0 = x0 + gv[bj][0] * acc[ai][bj][m][0]; x1 = x1 + gv[bj][1] * acc[ai][bj][m][1];
                    if (real) { float* p = out + (size_t)row * D + c0 + bj * 128; *(f32x4*)p = x0; *(f32x4*)(p + 4) = x1; }
                    sq += (x0[0] * x0[0] + x0[1] * x0[1]) + (x0[2] * x0[2] + x0[3] * x0[3]) + (x1[0] * x1[0] + x1[1] * x1[1]) + (x1[2] * x1[2] + x1[3] * x1[3]);
                    if (A1) { const f32x4 a = x0 * mv[bj][0], b = x1 * mv[bj][1]; v4u w; w.x = pk2(a[0], a[1]); w.y = pk2(a[2], a[3]); w.z = pk2(b[0], b[1]); w.w = pk2(b[2], b[3]);
                        *(v4u*)(A1 + (size_t)row * D + c0 + bj * 128) = w; }
                    if (A2) { const f32x4 a = x0 * kv[bj][0], b = x1 * kv[bj][1]; v4u w; w.x = pk2(a[0], a[1]); w.y = pk2(a[2], a[3]); w.z = pk2(b[0], b[1]); w.w = pk2(b[2], b[3]);
                        *(v4u*)(A2 + (size_t)row * D + c0 + bj * 128) = w; } }
                if (SSQ) { sq += __shfl_xor(sq, 16); sq += __shfl_xor(sq, 32); if (fq == 0) SSQ[(size_t)row * 16 + u.pn * 4 + wc] = sq; } }
    }
};
struct EpiCmp {
    const float* C1; bf16* H2;
    __device__ __forceinline__ void operator()(EPI_ARGS) const { asm volatile("" ::: "memory");
        const int cl = wc * 32 + 8 * fq; const int kv = u.pm >= (RC_KV / 256) ? 1 : 0;
        f32x4 bv[2][2];
#pragma unroll
        for (int bj = 0; bj < 2; ++bj)
#pragma unroll
            for (int n = 0; n < 2; ++n) bv[bj][n] = *(const f32x4*)(C1 + kv * 256 + cl + bj * 128 + 4 * n);
#pragma unroll
        for (int ai = 0; ai < 2; ++ai)
#pragma unroll
            for (int m = 0; m < 4; ++m) { const size_t row = (size_t)u.pm * 256 + ai * 128 + wr * 64 + m * 16 + fr;
#pragma unroll
                for (int bj = 0; bj < 2; ++bj) { f32x4 v0 = acc[ai][bj][m][0] + bv[bj][0], v1 = acc[ai][bj][m][1] + bv[bj][1];
#pragma unroll
                    for (int i = 0; i < 4; ++i) { v0[i] = gelu_t(v0[i]); v1[i] = gelu_t(v1[i]); }
                    v4u w; w.x = pk2(v0[0], v0[1]); w.y = pk2(v0[2], v0[3]); w.z = pk2(v1[0], v1[1]); w.w = pk2(v1[2], v1[3]);
                    *(v4u*)(H2 + row * 256 + cl + bj * 128) = w; } }
    }
};
struct EpiKV {
    const float* SSQ; const float* kgains; const float* ROPE; float* out;
    bf16* RC; bf16* KS; bf16* KW; bf16* VST; bf16* VWT;
    __device__ __forceinline__ void operator()(EPI_ARGS) const { asm volatile("" ::: "memory");
        const int ty = u.pn, g = wc, d0 = 8 * fq; const bool isk = (ty == 2 || ty == 4);
        f32x4 kg[2][2];
        if (isk) {
#pragma unroll
            for (int bj = 0; bj < 2; ++bj)
#pragma unroll
                for (int n = 0; n < 2; ++n) kg[bj][n] = *(const f32x4*)(kgains + (ty == 2 ? 64 : 128) + 32 * bj + d0 + 4 * n); }
#pragma unroll
        for (int ai = 0; ai < 2; ++ai)
#pragma unroll
            for (int m = 0; m < 4; ++m) { const int row = u.pm * 256 + ai * 128 + wr * 64 + m * 16 + fr;
                const float rs = rstd16(SSQ + (size_t)row * 16);
                f32x4 v[2][2];
#pragma unroll
                for (int bj = 0; bj < 2; ++bj)
#pragma unroll
                    for (int n = 0; n < 2; ++n) v[bj][n] = acc[ai][bj][m][n] * rs;
                const bool prompt = row < MP; const int t = prompt ? (row & (SEQ - 1)) : PAST; const int b = row >> 13;
                if (isk) {
                    float sq = 0.f;
#pragma unroll
                    for (int bj = 0; bj < 2; ++bj)
#pragma unroll
                        for (int n = 0; n < 2; ++n) sq += (v[bj][n][0] * v[bj][n][0] + v[bj][n][1] * v[bj][n][1]) + (v[bj][n][2] * v[bj][n][2] + v[bj][n][3] * v[bj][n][3]);
                    sq += __shfl_xor(sq, 16); sq += __shfl_xor(sq, 32);
                    const float ri = rsqrtf(sq * (1.0f / 64.0f) + EPS);
#pragma unroll
                    for (int n = 0; n < 2; ++n) { const f32x4 cs = *(const f32x4*)(ROPE + (size_t)t * 64 + d0 + 4 * n), sn = *(const f32x4*)(ROPE + (size_t)t * 64 + 32 + d0 + 4 * n);
                        const f32x4 x1 = v[0][n] * ri * kg[0][n], x2 = v[1][n] * ri * kg[1][n];
                        v[0][n] = x1 * cs - x2 * sn; v[1][n] = x2 * cs + x1 * sn; }
                }
                float* fo = nullptr;
                if (prompt) {
                    if (ty < 4) fo = out + (ty == 0 ? O_CKP : ty == 1 ? O_CVP : ty == 2 ? O_SKP : O_SVP) + (size_t)row * 256;
                    else if (t >= SEQ - WIN) fo = out + (ty == 4 ? O_WKP : O_WVP) + ((size_t)b * WIN + (t - (SEQ - WIN))) * 256;
                } else if (row < MT) { const int s = row - MP;
                    if (ty < 4) fo = out + (ty == 0 ? O_CKS : ty == 1 ? O_CVS : ty == 2 ? O_SKS : O_SVS) + (size_t)s * 256;
                    else fo = out + (ty == 4 ? O_WKS : O_WVS) + ((size_t)s * WIN + (WIN - 1)) * 256; }
                if (fo) {
#pragma unroll
                    for (int bj = 0; bj < 2; ++bj) { float* p = fo + g * 64 + 32 * bj + d0; *(f32x4*)p = v[bj][0]; *(f32x4*)(p + 4) = v[bj][1]; } }
                if (prompt) { const int gam = b * 4 + g;
                    if (ty <= 1) { bf16* dst = RC + ((size_t)ty * RC_KV + RC_SAMP + (size_t)gam * 512 + (t >> 4)) * 1024 + (t & 15) * 64 + d0;
#pragma unroll
                        for (int bj = 0; bj < 2; ++bj) { v4u w; w.x = pk2(v[bj][0][0], v[bj][0][1]); w.y = pk2(v[bj][0][2], v[bj][0][3]); w.z = pk2(v[bj][1][0], v[bj][1][1]); w.w = pk2(v[bj][1][2], v[bj][1][3]); *(v4u*)(dst + 32 * bj) = w; }
                    } else if (isk) { bf16* dst = (ty == 2 ? KS : KW) + ((size_t)gam * SEQ + t) * 64 + d0;
#pragma unroll
                        for (int bj = 0; bj < 2; ++bj) { v4u w; w.x = pk2(v[bj][0][0], v[bj][0][1]); w.y = pk2(v[bj][0][2], v[bj][0][3]); w.z = pk2(v[bj][1][0], v[bj][1][1]); w.w = pk2(v[bj][1][2], v[bj][1][3]); *(v4u*)(dst + 32 * bj) = w; }
                    } else { const int kk_ = t & 63; bf16* dst = (ty == 3 ? VST : VWT) + ((size_t)gam * 128 + (t >> 6)) * 4096 + (32 * (kk_ >> 5) + 8 * ((kk_ & 15) >> 2) + 4 * ((kk_ >> 4) & 1) + (kk_ & 3));
#pragma unroll
                        for (int bj = 0; bj < 2; ++bj)
#pragma unroll
                            for (int n = 0; n < 2; ++n)
#pragma unroll
                                for (int i = 0; i < 4; ++i) dst[(32 * bj + d0 + 4 * n + i) * 64] = (bf16)(pk2(v[bj][n][i], 0.f) & 0xffffu); }
                }
            }
    }
};
struct EpiQ {
    const float* SSQ; const float* BIAS; const float* qgain; const float* ROPE; bf16* QN; bf16* QR; float* GATES;
    __device__ __forceinline__ void operator()(EPI_ARGS) const { asm volatile("" ::: "memory");
        const int cl = wc * 32 + 8 * fq, c0 = u.pn * 256 + cl, d0 = 8 * fq; const bool uni = u.pm < 64;
        f32x4 bv[2][2], qg[2][2];
        if (uni) { const float* b = BIAS + (size_t)(u.pm >> 5) * NBIG + OFF_Q + c0;
#pragma unroll
            for (int bj = 0; bj < 2; ++bj)
#pragma unroll
                for (int n = 0; n < 2; ++n) bv[bj][n] = *(const f32x4*)(b + bj * 128 + 4 * n); }
#pragma unroll
        for (int bj = 0; bj < 2; ++bj)
#pragma unroll
            for (int n = 0; n < 2; ++n) qg[bj][n] = *(const f32x4*)(qgain + 32 * bj + d0 + 4 * n);
#pragma unroll
        for (int ai = 0; ai < 2; ++ai)
#pragma unroll
            for (int m = 0; m < 4; ++m) { const int row = u.pm * 256 + ai * 128 + wr * 64 + m * 16 + fr;
                const float rs = rstd16(SSQ + (size_t)row * 16);
                if (!uni) { const float* b = BIAS + (size_t)seq_of(row) * NBIG + OFF_Q + c0;
#pragma unroll
                    for (int bj = 0; bj < 2; ++bj)
#pragma unroll
                        for (int n = 0; n < 2; ++n) bv[bj][n] = *(const f32x4*)(b + bj * 128 + 4 * n); }
                f32x4 v[2][2];
#pragma unroll
                for (int bj = 0; bj < 2; ++bj)
#pragma unroll
                    for (int n = 0; n < 2; ++n) v[bj][n] = acc[ai][bj][m][n] * rs + bv[bj][n];
                if (u.pn == 4) {
                    if (cl < 48) {
#pragma unroll
                        for (int n = 0; n < 2; ++n) { f32x4 s; for (int i = 0; i < 4; ++i) s[i] = sigmoid_f(v[0][n][i]); *(f32x4*)(GATES + (size_t)row * 48 + cl + 4 * n) = s; } }
                    continue; }
                const int t = row < MP ? (row & (SEQ - 1)) : PAST;
                float sq = 0.f;
#pragma unroll
                for (int bj = 0; bj < 2; ++bj)
#pragma unroll
                    for (int n = 0; n < 2; ++n) sq += (v[bj][n][0] * v[bj][n][0] + v[bj][n][1] * v[bj][n][1]) + (v[bj][n][2] * v[bj][n][2] + v[bj][n][3] * v[bj][n][3]);
                sq += __shfl_xor(sq, 16); sq += __shfl_xor(sq, 32);
                const float ri = rsqrtf(sq * (1.0f / 64.0f) + EPS) * C2;
                f32x4 r[2][2];
#pragma unroll
                for (int n = 0; n < 2; ++n) { const f32x4 cs = *(const f32x4*)(ROPE + (size_t)t * 64 + d0 + 4 * n), sn = *(const f32x4*)(ROPE + (size_t)t * 64 + 32 + d0 + 4 * n);
                    v[0][n] = v[0][n] * ri * qg[0][n]; v[1][n] = v[1][n] * ri * qg[1][n];
                    r[0][n] = v[0][n] * cs - v[1][n] * sn; r[1][n] = v[1][n] * cs + v[0][n] * sn; }
                const size_t o = (size_t)row * D + (u.pn * 4 + wc) * 64 + d0;
#pragma unroll
                for (int bj = 0; bj < 2; ++bj) { v4u w; w.x = pk2(v[bj][0][0], v[bj][0][1]); w.y = pk2(v[bj][0][2], v[bj][0][3]); w.z = pk2(v[bj][1][0], v[bj][1][1]); w.w = pk2(v[bj][1][2], v[bj][1][3]); *(v4u*)(QN + o + 32 * bj) = w;
                    v4u x; x.x = pk2(r[bj][0][0], r[bj][0][1]); x.y = pk2(r[bj][0][2], r[bj][0][3]); x.z = pk2(r[bj][1][0], r[bj][1][1]); x.w = pk2(r[bj][1][2], r[bj][1][3]); *(v4u*)(QR + o + 32 * bj) = x; }
            }
    }
};

#define MFMA16(a, b, c) __builtin_amdgcn_mfma_f32_16x16x32_bf16((a), (b), (c), 0, 0, 0)

__device__ __forceinline__ int wperm(int mode, int n) {
    if (mode == 1) { const int up = n >= DFF ? 1 : 0, j = n - up * DFF; return (j >> 7) * 256 + up * 128 + (j & 127); }
    if (mode == 2 || (mode == 3 && n < 1024)) { const int blk = n >> 8, g = (n >> 6) & 3, d = n & 63; return blk * 256 + 128 * (d >> 5) + 32 * g + (d & 31); }
    return n;
}
__device__ __forceinline__ void transpose_item(const float* W, int K, int N, bf16* WT, int row_off, int mode, LAS float* scr, int item, int lane) {
    const int nblk = (N + 31) >> 5, kb = item / nblk, nb = item - kb * nblk, k0 = 64 * kb, n0 = 32 * nb;
    const int nn = n0 + (lane & 31); const bool okn = nn < N;
#pragma unroll 8
    for (int i = 0; i < 32; ++i) { const int kk = 2 * i + (lane >> 5); scr[kk * 33 + (lane & 31)] = okn ? W[(size_t)(k0 + kk) * N + nn] : 0.f; }
    LDS_WAIT(); asm volatile("" ::: "memory");
    const int c = lane & 7;
#pragma unroll
    for (int j = 0; j < 4; ++j) { const int n = (lane >> 3) + 8 * j; const LAS float* s = scr + (8 * c) * 33 + n;
        v4u o; o.x = pk2(s[0 * 33], s[1 * 33]); o.y = pk2(s[2 * 33], s[3 * 33]); o.z = pk2(s[4 * 33], s[5 * 33]); o.w = pk2(s[6 * 33], s[7 * 33]);
        if (n0 + n < N) *(v4u*)(WT + (size_t)(row_off + wperm(mode, n0 + n)) * K + k0 + 8 * c) = o; }
    LDS_WAIT(); asm volatile("" ::: "memory");
}
#define TR_ITEMS(K, N) (((K) / 64) * (((N) + 31) / 32))

__device__ __forceinline__ void phase0(const Params& P, LAS unsigned char* lds, int tid, int lane, int wave) {
    unsigned char* ws = P.ws;
    const int gw = blockIdx.x * NWAVES + wave, ngw = gridDim.x * NWAVES, gtid = blockIdx.x * 512 + tid, ngt = gridDim.x * 512;
    LAS float* scr = (LAS float*)(lds + wave * 16384);
    constexpr int IT_ADA = TR_ITEMS(1024, 6144);
    for (int it = gw; it < 2 * IT_ADA; it += ngw) { const int l = it / IT_ADA, r = it - l * IT_ADA;
        transpose_item(P.in[11] + (size_t)l * 1024 * 6144, 1024, 6144, (bf16*)(ws + WS_WADA), l * 6144, 0, scr, r, lane); }
    for (int e = gtid; e < 256 * 128; e += ngt) { const int row = e >> 7, c8 = (e & 127) * 8; v4u o = {0u, 0u, 0u, 0u};
        if (row < 130) { const float* src = (row < 2 ? P.in[9] + row * 1024 : P.in[10] + (row - 2) * 1024) + c8; const f32x4 a = *(const f32x4*)src, b = *(const f32x4*)(src + 4);
            o.x = pk2(silu_f(a[0]), silu_f(a[1])); o.y = pk2(silu_f(a[2]), silu_f(a[3])); o.z = pk2(silu_f(b[0]), silu_f(b[1])); o.w = pk2(silu_f(b[2]), silu_f(b[3])); }
        *(v4u*)((bf16*)(ws + WS_SC) + (size_t)row * 1024 + c8) = o; }
    for (int e = gtid; e < SEQ * 32; e += ngt) { const int pos = e >> 5, i = e & 31; const float inv = powf(10000.0f, -(float)i / 32.0f); const float ang = (float)pos * inv; float s, c; sincosf(ang, &s, &c);
        float* R = (float*)(ws + WS_ROPE) + (size_t)pos * 64; R[i] = c; R[32 + i] = s; }
    for (int e = gtid; e < 8 * 128 * 128; e += ngt) { const int t = (e >> 7) & 127, s = e & 127; ((bf16*)(ws + WS_WSB))[e] = (bf16)(pk2(s <= t ? P.in[16][e] : 0.f, 0.f) & 0xffffu); }
    for (int e = gtid; e < (NQP - NQ) * 128; e += ngt) *(v4u*)((bf16*)(ws + WS_WBIG) + (size_t)(OFF_Q + NQ) * 1024 + (size_t)e * 8) = (v4u){0u, 0u, 0u, 0u};
    if (blockIdx.x < 16) { const int kv = blockIdx.x >> 3, cg = blockIdx.x & 7, kq = tid >> 5, c = tid & 31;
        const float* w1 = P.in[26] + (size_t)kv * 2048 * 256 + cg * 32 + c; const float* pe = P.in[25] + kv * 2048; float s = 0.f;
        for (int f = kq * 128; f < kq * 128 + 128; ++f) s += pe[f] * w1[(size_t)f * 256];
        LAS float* red = (LAS float*)(lds + 8448); red[kq * 32 + c] = s; __syncthreads();
        if (tid < 32) { float a = P.in[27][kv * 256 + cg * 32 + tid]; for (int k = 0; k < 16; ++k) a += red[k * 32 + tid]; ((float*)(ws + WS_C1))[kv * 256 + cg * 32 + tid] = a; }
        __syncthreads(); }
}
__device__ __forceinline__ void phase1_weights(const Params& P, LAS unsigned char* lds, int lane, int wave) {
    unsigned char* ws = P.ws;
    const int gw = blockIdx.x * NWAVES + wave, ngw = gridDim.x * NWAVES;
    LAS float* scr = (LAS float*)(lds + wave * 16384);
    constexpr int I0 = TR_ITEMS(1024, 2048), I1 = TR_ITEMS(1024, 5632), I2 = TR_ITEMS(1024, 1072), I3 = TR_ITEMS(1024, 1024), I4 = TR_ITEMS(2816, 1024), I5 = TR_ITEMS(1024, 1536), I6 = TR_ITEMS(2048, 256), I7 = TR_ITEMS(256, 64);
    constexpr int NIT = I0 + 2 * I1 + I2 + 2 * I3 + 2 * I4 + I5 + 2 * I6 + 2 * I7;
    bf16* WBIG = (bf16*)(ws + WS_WBIG);
    for (int it = gw; it < NIT; it += ngw) { int r = it;
        if (r < I0) { transpose_item(P.in[14], 1024, 2048, WBIG, OFF_WIN, 0, scr, r, lane); continue; } r -= I0;
        if (r < I1) { transpose_item(P.in[30], 1024, 5632, WBIG, OFF_GU0, 1, scr, r, lane); continue; } r -= I1;
        if (r < I1) { transpose_item(P.in[30] + (size_t)1024 * 5632, 1024, 5632, WBIG, OFF_GU1, 1, scr, r, lane); continue; } r -= I1;
        if (r < I2) { transpose_item(P.in[19], 1024, 1072, WBIG, OFF_Q, 3, scr, r, lane); continue; } r -= I2;
        if (r < I3) { transpose_item(P.in[18], 1024, 1024, (bf16*)(ws + WS_WOUT), 0, 0, scr, r, lane); continue; } r -= I3;
        if (r < I3) { transpose_item(P.in[21], 1024, 1024, (bf16*)(ws + WS_WBO), 0, 0, scr, r, lane); continue; } r -= I3;
        if (r < I4) { transpose_item(P.in[31], 2816, 1024, (bf16*)(ws + WS_WDN), 0, 0, scr, r, lane); continue; } r -= I4;
        if (r < I4) { transpose_item(P.in[31] + (size_t)2816 * 1024, 2816, 1024, (bf16*)(ws + WS_WDN) + (size_t)1024 * 2816, 0, 0, scr, r, lane); continue; } r -= I4;
        if (r < I5) { transpose_item(P.in[23], 1024, 1536, (bf16*)(ws + WS_WKV), 0, 2, scr, r, lane); continue; } r -= I5;
        if (r < I6) { transpose_item(P.in[26], 2048, 256, (bf16*)(ws + WS_W1C), 0, 0, scr, r, lane); continue; } r -= I6;
        if (r < I6) { transpose_item(P.in[26] + (size_t)2048 * 256, 2048, 256, (bf16*)(ws + WS_W1C) + (size_t)256 * 2048, 0, 0, scr, r, lane); continue; } r -= I6;
        if (r < I7) { transpose_item(P.in[28], 256, 64, (bf16*)(ws + WS_W2), 0, 0, scr, r, lane); continue; } r -= I7;
        transpose_item(P.in[28] + 256 * 64, 256, 64, (bf16*)(ws + WS_W2) + 64 * 256, 0, 0, scr, r, lane);
    }
}
__device__ __forceinline__ void phase2_tail(const Params& P, int tid, int lane, int wave) {
    unsigned char* ws = P.ws;
    const int gw = blockIdx.x * NWAVES + wave, ngw = gridDim.x * NWAVES, gtid = blockIdx.x * 512 + tid, ngt = gridDim.x * 512;
    const float* MOD = (const float*)(ws + WS_MOD); const float* ng = P.in[13];
    for (int e = gtid; e < 3 * 256 * 256; e += ngt) { const int np = e >> 16, sq = (e >> 8) & 255, c = (e & 255) * 4;
        const int lay = np == 0 ? 0 : 1, wh = np == 1 ? 0 : 1;
        const f32x4 g = *(const f32x4*)(ng + (lay * 2 + wh) * 1024 + c), sc = *(const f32x4*)(MOD + (size_t)sq * NMOD + lay * 6144 + (wh ? 4096 : 1024) + c);
        *(f32x4*)((float*)(ws + WS_MUL) + ((size_t)np * 256 + sq) * 1024 + c) = g * (sc + 1.0f); }
    float* SSQ0 = (float*)(ws + WS_SSQ); bf16* A0 = (bf16*)(ws + WS_ACTA);
    for (int r = gw; r < M65; r += ngw) {
        f32x4 v[4]; float s = 0.f;
        if (r < MT) { const float* x = (r < MP ? P.in[0] + (size_t)r * D : P.in[1] + (size_t)(r - MP) * D) + 4 * lane;
#pragma unroll
            for (int j = 0; j < 4; ++j) { v[j] = *(const f32x4*)(x + 256 * j); s += (v[j][0] * v[j][0] + v[j][1] * v[j][1]) + (v[j][2] * v[j][2] + v[j][3] * v[j][3]); }
        } else {
#pragma unroll
            for (int j = 0; j < 4; ++j) v[j] = (f32x4){0.f, 0.f, 0.f, 0.f}; }
        s = wave_sum(s);
        if (lane < 16) SSQ0[(size_t)r * 16 + lane] = lane == 0 ? s : 0.f;
        const int sq = seq_of(r);
#pragma unroll
        for (int j = 0; j < 4; ++j) { const int c = 4 * lane + 256 * j; const f32x4 g = *(const f32x4*)(ng + c), sc = *(const f32x4*)(MOD + (size_t)sq * NMOD + 1024 + c);
            const f32x4 a = v[j] * g * (sc + 1.0f); v2u w; w.x = pk2(a[0], a[1]); w.y = pk2(a[2], a[3]); *(v2u*)(A0 + (size_t)r * D + c) = w; }
    }
}
__device__ __forceinline__ void sample_prepass(const Params& P, int tid, int lane, int wave) {
    unsigned char* ws = P.ws;
    const int gw = blockIdx.x * NWAVES + wave, ngw = gridDim.x * NWAVES;
    const int* pt = (const int*)P.in[8]; bf16* RC = (bf16*)(ws + WS_RC);
    for (int it = gw; it < 2 * 128 * 16 * 4; it += ngw) { const int kv = it >> 13, sq = (it >> 6) & 127, p = (it >> 2) & 15, qtr = it & 3;
        const float* src = P.in[2 + kv] + (size_t)pt[sq * 16 + p] * (128 * 256) + qtr * 8192;
#pragma unroll
        for (int i0 = 0; i0 < 16; i0 += 8) { f32x4 a[8], b[8];
#pragma unroll
            for (int i = 0; i < 8; ++i) { const int e = ((i0 + i) * 64 + lane) * 8; a[i] = __builtin_nontemporal_load((const f32x4*)(src + e)); b[i] = __builtin_nontemporal_load((const f32x4*)(src + e + 4)); }
#pragma unroll
            for (int i = 0; i < 8; ++i) { const int e = ((i0 + i) * 64 + lane) * 8, tok = qtr * 32 + (e >> 8), g = (e >> 6) & 3, d = e & 63;
                v4u w; w.x = pk2(a[i][0], a[i][1]); w.y = pk2(a[i][2], a[i][3]); w.z = pk2(b[i][0], b[i][1]); w.w = pk2(b[i][2], b[i][3]);
                *(v4u*)(RC + ((size_t)kv * RC_KV + (size_t)(sq * 4 + g) * 128 + p * 8 + (tok >> 4)) * 1024 + (tok & 15) * 64 + d) = w; } } }
    for (int it = gw; it < 2 * 128 * 64; it += ngw) { const int kv = it >> 13, s = (it >> 6) & 127, c = it & 63;
        const f32x4* src = (const f32x4*)P.in[6 + kv] + (size_t)s * 32768 + 64; f32x4* dst = (f32x4*)(P.out + (kv ? O_WVS : O_WKS)) + (size_t)s * 32768;
        f32x4 v[8];
#pragma unroll
        for (int i = 0; i < 8; ++i) { const int e = c * 512 + i * 64 + lane; if (e < 32704) v[i] = __builtin_nontemporal_load(src + e); }
#pragma unroll
        for (int i = 0; i < 8; ++i) { const int e = c * 512 + i * 64 + lane; if (e < 32704) __builtin_nontemporal_store(v[i], dst + e); } }
}

__device__ __forceinline__ void phase_tokmix(const Params& P, LAS unsigned char* lds, int tid, int lane, int wave) {
    unsigned char* ws = P.ws;
    const bf16* U = (const bf16*)(ws + WS_U); const bf16* V = (const bf16*)(ws + WS_V); bf16* UM = (bf16*)(ws + WS_UM);
    const float* SSQV = (const float*)(ws + WS_SSQ) + (size_t)1 * M65 * 16; const bf16* WSB = (const bf16*)(ws + WS_WSB);
    const float* vgain = P.in[15]; const float* bs = P.in[17];
    LAS bf16* VT = (LAS bf16*)lds;
    const int col = lane & 15, quad = lane >> 4;
    for (int item = blockIdx.x; item < 1024; item += gridDim.x) { const int chunk = item >> 3, g = item & 7, r0 = chunk * 128;
        const bool lastc = (chunk & 63) == 63;
#pragma unroll
        for (int i = 0; i < 4; ++i) { const int e = tid + 512 * i, s = e >> 4, c8 = (e & 15) * 8; const int row = r0 + s;
            const float rs = rstd16(SSQV + (size_t)row * 16);
            const v4u w = *(const v4u*)(V + (size_t)row * D + g * 128 + c8);
            const f32x4 g0 = *(const f32x4*)(vgain + g * 128 + c8), g1 = *(const f32x4*)(vgain + g * 128 + c8 + 4);
            float x[8] = {bflo(w.x) * rs * g0[0], bfhi(w.x) * rs * g0[1], bflo(w.y) * rs * g0[2], bfhi(w.y) * rs * g0[3], bflo(w.z) * rs * g1[0], bfhi(w.z) * rs * g1[1], bflo(w.w) * rs * g1[2], bfhi(w.w) * rs * g1[3]};
#pragma unroll
            for (int k = 0; k < 8; ++k) VT[(c8 + k) * 136 + s] = (bf16)(pk2(x[k], 0.f) & 0xffffu);
            if (lastc) { float* av = P.out + O_AVP + ((size_t)(chunk >> 6) * 128 + s) * D + g * 128 + c8; *(f32x4*)av = (f32x4){x[0], x[1], x[2], x[3]}; *(f32x4*)(av + 4) = (f32x4){x[4], x[5], x[6], x[7]}; } }
        __syncthreads();
        f32x4 acc[8];
#pragma unroll
        for (int ct = 0; ct < 8; ++ct) acc[ct] = (f32x4){0.f, 0.f, 0.f, 0.f};
        const int t = 16 * wave + col;
        for (int ks = 0; ks <= (wave >> 1); ++ks) {
            const bf16x8 bfr = *(const bf16x8*)(WSB + ((size_t)g * 128 + t) * 128 + 32 * ks + 8 * quad);
#pragma unroll
            for (int ct = 0; ct < 8; ++ct) { const bf16x8 afr = *(const LAS bf16x8*)(VT + (16 * ct + col) * 136 + 32 * ks + 8 * quad); acc[ct] = MFMA16(afr, bfr, acc[ct]); } }
        const float bt = bs[g * 128 + t];
#pragma unroll
        for (int ct = 0; ct < 8; ++ct) { const size_t o = (size_t)(r0 + t) * D + g * 128 + 16 * ct + 4 * quad; const v2u uw = *(const v2u*)(U + o);
            v2u w; w.x = pk2(bflo(uw.x) * (acc[ct][0] + bt), bfhi(uw.x) * (acc[ct][1] + bt)); w.y = pk2(bflo(uw.y) * (acc[ct][2] + bt), bfhi(uw.y) * (acc[ct][3] + bt)); *(v2u*)(UM + o) = w; }
        __syncthreads();
    }
    const int gw = blockIdx.x * NWAVES + wave, ngw = gridDim.x * NWAVES;
    for (int r = MP + gw; r < M65; r += ngw) {
        const float rs = rstd16(SSQV + (size_t)r * 16);
#pragma unroll
        for (int j = 0; j < 4; ++j) { const int c = 4 * lane + 256 * j, g = c >> 7; v2u w = {0u, 0u};
            if (r < MT) { const v2u vw = *(const v2u*)(V + (size_t)r * D + c), uw = *(const v2u*)(U + (size_t)r * D + c); const f32x4 gn = *(const f32x4*)(vgain + c);
                const f32x4 vn = (f32x4){bflo(vw.x), bfhi(vw.x), bflo(vw.y), bfhi(vw.y)} * rs * gn;
                *(f32x4*)(P.out + O_AVS + (size_t)(r - MP) * D + c) = vn;
                const float w00 = P.in[16][g * 16384], b0 = bs[g * 128];
                w.x = pk2(bflo(uw.x) * (w00 * vn[0] + b0), bfhi(uw.x) * (w00 * vn[1] + b0)); w.y = pk2(bflo(uw.y) * (w00 * vn[2] + b0), bfhi(uw.y) * (w00 * vn[3] + b0)); }
            *(v2u*)(UM + (size_t)r * D + c) = w; } }
}

__device__ __forceinline__ void phase_w2(const Params& P, int lane, int wave) {
    unsigned char* ws = P.ws;
    const int gw = blockIdx.x * NWAVES + wave, ngw = gridDim.x * NWAVES;
    const bf16* H2 = (const bf16*)(ws + WS_H2); const bf16* W2 = (const bf16*)(ws + WS_W2);
    const int col = lane & 15, quad = lane >> 4;
    for (int task = gw; task < 2 * RC_KV / 16; task += ngw) { const int kv = task >= RC_KV / 16 ? 1 : 0; const int R0 = (task - kv * (RC_KV / 16)) * 16;
        const bool samp = R0 < RC_SAMP; const int gam = samp ? (R0 >> 7) : ((R0 - RC_SAMP) >> 9), i0 = samp ? (R0 & 127) : ((R0 - RC_SAMP) & 511);
        const bf16* hrow = H2 + ((size_t)kv * RC_KV + R0 + col) * 256 + 8 * quad; const bf16* wrow = W2 + (size_t)kv * 64 * 256 + (size_t)col * 256 + 8 * quad;
        f32x4 acc[4];
#pragma unroll
        for (int dt = 0; dt < 4; ++dt) acc[dt] = (f32x4){0.f, 0.f, 0.f, 0.f};
#pragma unroll
        for (int ks = 0; ks < 8; ++ks) { const bf16x8 hf = *(const bf16x8*)(hrow + 32 * ks);
#pragma unroll
            for (int dt = 0; dt < 4; ++dt) { const bf16x8 wf = *(const bf16x8*)(wrow + (size_t)dt * 16 * 256 + 32 * ks);
                acc[dt] = kv ? MFMA16(hf, wf, acc[dt]) : MFMA16(wf, hf, acc[dt]); } }
        const float* b2 = P.in[29] + kv * 64;
        if (!kv) {
            float sq = 0.f; f32x4 v[4];
#pragma unroll
            for (int dt = 0; dt < 4; ++dt) { v[dt] = acc[dt] + *(const f32x4*)(b2 + 16 * dt + 4 * quad); sq += (v[dt][0] * v[dt][0] + v[dt][1] * v[dt][1]) + (v[dt][2] * v[dt][2] + v[dt][3] * v[dt][3]); }
            sq += __shfl_xor(sq, 16); sq += __shfl_xor(sq, 32);
            const float ri = rsqrtf(sq * (1.0f / 64.0f) + EPS);
            bf16* dst = (samp ? (bf16*)(ws + WS_KCS) + ((size_t)gam * 128 + i0 + col) * 64 : (bf16*)(ws + WS_KCP) + ((size_t)gam * 512 + i0 + col) * 64) + 4 * quad;
#pragma unroll
            for (int dt = 0; dt < 4; ++dt) { const f32x4 kg = *(const f32x4*)(P.in[24] + 16 * dt + 4 * quad); const f32x4 o = v[dt] * ri * kg; v2u w; w.x = pk2(o[0], o[1]); w.y = pk2(o[2], o[3]); *(v2u*)(dst + 16 * dt) = w; }
        } else {
#pragma unroll
            for (int dt = 0; dt < 4; ++dt) { const int d = 16 * dt + col; const float bb = b2[d];
                const int ip = (i0 & ~63) + 32 * ((i0 >> 5) & 1) + 8 * quad + 4 * ((i0 >> 4) & 1);
                bf16* dst = samp ? (bf16*)(ws + WS_VCTS) + ((size_t)gam * 64 + d) * 128 + ip : (bf16*)(ws + WS_VCTP) + ((size_t)gam * 64 + d) * 512 + ip;
                v2u w; w.x = pk2(acc[dt][0] + bb, acc[dt][1] + bb); w.y = pk2(acc[dt][2] + bb, acc[dt][3] + bb); *(v2u*)dst = w; }
        }
    }
}

#ifndef ATT_REP_P
#define ATT_REP_P 1
#endif
#ifndef ATT_REP_S
#define ATT_REP_S 1
#endif

__device__ __forceinline__ void load_k8(const bf16* kb, int lane, bf16x8 (&kf)[8]) {
    const int col = lane & 15, quad = lane >> 4;
#pragma unroll
    for (int kt = 0; kt < 4; ++kt) { const bf16* kp = kb + (size_t)(16 * kt + col) * 64 + 8 * quad; kf[2 * kt] = *(const bf16x8*)kp; kf[2 * kt + 1] = *(const bf16x8*)(kp + 32); }
}
__device__ __forceinline__ void load_vt8(const bf16* vtb, int pitch, int lane, bf16x8 (&vf)[8]) {
    const int col = lane & 15, quad = lane >> 4;
#pragma unroll
    for (int dt = 0; dt < 4; ++dt)
#pragma unroll
        for (int ks = 0; ks < 2; ++ks) vf[2 * dt + ks] = *(const bf16x8*)(vtb + (size_t)(16 * dt + col) * pitch + 32 * ks + 8 * quad);
}
__device__ __forceinline__ void attn_cmp_select(const bf16* kc, const bf16* vct, int vpitch, bf16x8 qn0, bf16x8 qn1, int nvis, int nkt, int cur, float nref,
                                                LAS float* imps, int lane, f32x4 (&oc)[4], unsigned (&msk)[4]) {
    const int col = lane & 15, quad = lane >> 4, ql = col >> 2, hl = col & 3;
    const int nb = (nkt + 3) >> 2;
    float lsum = 0.f;
    {   bf16x8 kfA[8], kfB[8];
        if (nb > 0) load_k8(kc, lane, kfA);
        for (int blk = 0; blk < nb; ++blk) {
            if (blk + 1 < nb) load_k8(kc + (size_t)(blk + 1) * 4096, lane, kfB);
#pragma unroll
            for (int kt = 0; kt < 4; ++kt) { f32x4 s = {nref, nref, nref, nref}; s = MFMA16(kfA[2 * kt], qn0, s); s = MFMA16(kfA[2 * kt + 1], qn1, s);
#pragma unroll
                for (int r = 0; r < 4; ++r) lsum += (64 * blk + 16 * kt + 4 * quad + r < nvis) ? fexp2(s[r]) : 0.f; }
#pragma unroll
            for (int i = 0; i < 8; ++i) kfA[i] = kfB[i];
        } }
    float l = lsum + __shfl_xor(lsum, 16); l += __shfl_xor(l, 32);
    const float rl = l > 0.f ? 1.0f / l : 0.f;
#pragma unroll
    for (int dt = 0; dt < 4; ++dt) oc[dt] = (f32x4){0.f, 0.f, 0.f, 0.f};
    float carry = 0.f;
    {   bf16x8 kfA[8], kfB[8], vfA[8];
        if (nb > 0) load_k8(kc, lane, kfA);
        for (int blk = 0; blk < nb; ++blk) {
            load_vt8(vct + blk * 64, vpitch, lane, vfA);
            if (blk + 1 < nb) load_k8(kc + (size_t)(blk + 1) * 4096, lane, kfB);
            float pa[4][4];
#pragma unroll
            for (int kt = 0; kt < 4; ++kt) { f32x4 s = {nref, nref, nref, nref}; s = MFMA16(kfA[2 * kt], qn0, s); s = MFMA16(kfA[2 * kt + 1], qn1, s);
                float hs[4];
#pragma unroll
                for (int r = 0; r < 4; ++r) { const float p = (64 * blk + 16 * kt + 4 * quad + r < nvis) ? fexp2(s[r]) * rl : 0.f; pa[kt][r] = p; float h = p + dpp_xor1(p); h += dpp_xor2(h); hs[r] = h; }
                const float tot = (hs[0] + hs[1]) + (hs[2] + hs[3]);
                const float up = __shfl(hs[3], (lane + 48) & 63);
                const float prev = quad == 0 ? carry : up; carry = up;
                if (hl == 0) imps[ql * 128 + 16 * blk + 4 * kt + quad] = tot + prev; }
#pragma unroll
            for (int ks = 0; ks < 2; ++ks) { v4u pw; pw.x = pk2(pa[2 * ks][0], pa[2 * ks][1]); pw.y = pk2(pa[2 * ks][2], pa[2 * ks][3]); pw.z = pk2(pa[2 * ks + 1][0], pa[2 * ks + 1][1]); pw.w = pk2(pa[2 * ks + 1][2], pa[2 * ks + 1][3]);
                const bf16x8 pb = __builtin_bit_cast(bf16x8, pw);
#pragma unroll
                for (int dt = 0; dt < 4; ++dt) oc[dt] = MFMA16(vfA[2 * dt + ks], pb, oc[dt]); }
#pragma unroll
            for (int i = 0; i < 8; ++i) kfA[i] = kfB[i];
        } }
#pragma unroll
    for (int w = 0; w < 4; ++w) msk[w] = 0u;
    if (cur <= 15) { msk[0] = (2u << cur) - 1u; return; }
    asm volatile("s_waitcnt lgkmcnt(0)" ::: "memory");
    const int lq = hl + 4 * quad;
    unsigned key[8];
#pragma unroll
    for (int e = 0; e < 8; ++e) { const int sg = lq + 16 * e; const float v = imps[ql * 128 + sg]; key[e] = (sg >= 1 && sg <= cur - 2) ? ((__builtin_bit_cast(unsigned, v) & ~127u) | (unsigned)sg) : 0u; }
    for (int it = 0; it < 13; ++it) {
        unsigned mx = key[0];
#pragma unroll
        for (int e = 1; e < 8; ++e) mx = mx > key[e] ? mx : key[e];
        { unsigned o = dpp_xor1u(mx); mx = mx > o ? mx : o; o = dpp_xor2u(mx); mx = mx > o ? mx : o; o = (unsigned)__shfl_xor((int)mx, 16); mx = mx > o ? mx : o; o = (unsigned)__shfl_xor((int)mx, 32); mx = mx > o ? mx : o; }
        const unsigned sg = mx & 127u, bit = mx ? (1u << (sg & 31u)) : 0u, w = sg >> 5;
        msk[0] |= w == 0u ? bit : 0u; msk[1] |= w == 1u ? bit : 0u; msk[2] |= w == 2u ? bit : 0u; msk[3] |= w == 3u ? bit : 0u;
#pragma unroll
        for (int e = 0; e < 8; ++e) key[e] = key[e] == mx ? 0u : key[e];
    }
    msk[0] |= 1u;
#pragma unroll
    for (int k = 0; k < 2; ++k) { const unsigned sg = (unsigned)(cur - k), bit = 1u << (sg & 31u), w = sg >> 5;
        msk[0] |= w == 0u ? bit : 0u; msk[1] |= w == 1u ? bit : 0u; msk[2] |= w == 2u ? bit : 0u; msk[3] |= w == 3u ? bit : 0u; }
}

__device__ __forceinline__ void tile_step(const bf16x8 (&kf)[8], const bf16x8 (&vf)[8], bf16x8 q0, bf16x8 q1, float cinit, bool masked, int kpos0, int lo, int hi, int lane, f32x4 (&o)[4], float& lsum) {
    const int quad = lane >> 4;
    f32x4 p[4];
#pragma unroll
    for (int kt = 0; kt < 4; ++kt) { f32x4 s = {cinit, cinit, cinit, cinit}; s = MFMA16(kf[2 * kt], q0, s); s = MFMA16(kf[2 * kt + 1], q1, s);
#pragma unroll
        for (int r = 0; r < 4; ++r) p[kt][r] = fexp2(s[r]); }
    if (masked) {
#pragma unroll
        for (int kt = 0; kt < 4; ++kt)
#pragma unroll
            for (int r = 0; r < 4; ++r) { const int kpos = kpos0 + 16 * kt + 4 * quad + r; p[kt][r] = (kpos >= lo && kpos <= hi) ? p[kt][r] : 0.f; } }
#pragma unroll
    for (int kt = 0; kt < 4; ++kt) lsum += (p[kt][0] + p[kt][1]) + (p[kt][2] + p[kt][3]);
#pragma unroll
    for (int ks = 0; ks < 2; ++ks) {
        v4u pw; pw.x = pk2(p[2 * ks][0], p[2 * ks][1]); pw.y = pk2(p[2 * ks][2], p[2 * ks][3]); pw.z = pk2(p[2 * ks + 1][0], p[2 * ks + 1][1]); pw.w = pk2(p[2 * ks + 1][2], p[2 * ks + 1][3]);
        const bf16x8 pb = __builtin_bit_cast(bf16x8, pw);
#pragma unroll
        for (int dt = 0; dt < 4; ++dt) o[dt] = MFMA16(vf[2 * dt + ks], pb, o[dt]); }
}

struct AttnRefs { float cmp, slc, win; };

constexpr int AT_RING = 0, AT_SLOT = 16384;
constexpr int AT_UNI = 3 * AT_SLOT, AT_LIST = AT_UNI + 256, AT_END0 = AT_LIST + 256;
static_assert(AT_END0 <= RING_BYTES, "attention LDS map");
constexpr int AT_IMPS = RING_BYTES + 1024;
static_assert(AT_IMPS + 8 * 2048 <= LDS_BYTES, "attention LDS map (imps)");

template <int BR>
__device__ __forceinline__ void attn_branch(const bf16* Kb, const bf16* Vb, LAS unsigned char* lds, int t0, int tb, int tq, int cur, float ref, float gate,
                                            const unsigned (&msk)[4], const unsigned (&un)[4], bf16x8 q0, bf16x8 q1, int w, int lane, f32x4 (&o_fin)[4]) {
    const int col = lane & 15, quad = lane >> 4;
    const LAS unsigned* UNI = (const LAS unsigned*)(lds + AT_UNI); const LAS unsigned char* LIST = lds + AT_LIST;
    int nblk, wlo = 0;
    if (BR == 0) nblk = __builtin_amdgcn_readfirstlane((int)UNI[36]);
    else { wlo = (t0 >= WIN ? t0 - WIN : 0) >> 6; nblk = cur - wlo + 1; }
    const size_t foff = (size_t)(16 * (w >> 1) + col) * 64 + 32 * (w & 1) + 8 * quad;
#define AT_BLK(j) (BR == 0 ? __builtin_amdgcn_readfirstlane((int)LIST[(j)]) : wlo + (j))
#define AT_DMA(j) do { const int sg_ = AT_BLK(j); LAS unsigned char* sl_ = lds + AT_RING + ((j) % 3) * AT_SLOT + w * 1024; \
        __builtin_amdgcn_global_load_lds((const unsigned*)(Kb + (size_t)sg_ * 4096 + foff), (LAS unsigned*)sl_, 16, 0, 0); \
        __builtin_amdgcn_global_load_lds((const unsigned*)(Vb + (size_t)sg_ * 4096 + foff), (LAS unsigned*)(sl_ + 8192), 16, 0, 0); } while (0)
    f32x4 o[4]; float ls = 0.f;
#pragma unroll
    for (int dt = 0; dt < 4; ++dt) o[dt] = (f32x4){0.f, 0.f, 0.f, 0.f};
    asm volatile("s_waitcnt vmcnt(0)" ::: "memory");
    __builtin_amdgcn_s_barrier();
    asm volatile("" ::: "memory");
    if (nblk > 0) AT_DMA(0);
    if (nblk > 1) AT_DMA(1);
    for (int j = 0; j < nblk; ++j) {
        if (j + 1 < nblk) asm volatile("s_waitcnt vmcnt(2)" ::: "memory"); else asm volatile("s_waitcnt vmcnt(0)" ::: "memory");
        __builtin_amdgcn_s_barrier();
        asm volatile("" ::: "memory");
        if (j + 2 < nblk) AT_DMA(j + 2);
        const int sg = AT_BLK(j);
        bool need, masked;
        if (BR == 0) { const int sw = sg >> 5; const unsigned wd = sw == 0 ? un[0] : sw == 1 ? un[1] : sw == 2 ? un[2] : un[3]; need = (wd >> (sg & 31)) & 1u; masked = sg == cur; }
        else { need = (64 * sg + 63 >= tb - WIN) && (64 * sg <= tb + 3); masked = (64 * sg + 63 > tb) || (64 * sg < tb + 3 - WIN); }
        if (need) {
            const LAS unsigned char* sl = lds + AT_RING + (j % 3) * AT_SLOT + lane * 16;
            bf16x8 kf[8], vf[8];
#pragma unroll
            for (int f = 0; f < 8; ++f) { kf[f] = *(const LAS bf16x8*)(sl + f * 1024); vf[f] = *(const LAS bf16x8*)(sl + 8192 + f * 1024); }
            float cinit = ref;
            if (BR == 0) { const int sw = sg >> 5; const unsigned mw = sw == 0 ? msk[0] : sw == 1 ? msk[1] : sw == 2 ? msk[2] : msk[3]; cinit = ((mw >> (sg & 31)) & 1u) ? ref : -1e30f; }
            tile_step(kf, vf, q0, q1, cinit, masked, 64 * sg, BR == 0 ? 0 : tq - WIN, tq, lane, o, ls);
        }
    }
#undef AT_BLK
#undef AT_DMA
    ls += __shfl_xor(ls, 16); ls += __shfl_xor(ls, 32);
    const float sc = ls > 0.f ? gate / ls : 0.f;
#pragma unroll
    for (int dt = 0; dt < 4; ++dt) o_fin[dt] += o[dt] * sc;
}

__device__ __forceinline__ void attn_prompt_unit(const Params& P, int unit, const AttnRefs& rf, LAS unsigned char* lds, int lane, int wave) {
    unsigned char* ws = P.ws;
    const int w = wave;
    const int gam = unit & 7, pt32 = unit >> 3, b = gam >> 2, g = gam & 3, t0 = 32 * pt32, cur = t0 >> 6;
    const int col = lane & 15, quad = lane >> 4, ql = col >> 2, hl = col & 3;
    LAS unsigned* UNI = (LAS unsigned*)(lds + AT_UNI);
    LAS unsigned char* LIST = lds + AT_LIST;
    LAS float* imps = (LAS float*)(lds + AT_IMPS) + wave * 512;
    const bf16* QN = (const bf16*)(ws + WS_QN); const bf16* QR = (const bf16*)(ws + WS_QR);
    const int tb = t0 + 4 * w, tq = tb + ql, row = b * SEQ + tq;
    const size_t qoff = (size_t)row * D + (4 * g + hl) * 64 + 8 * quad;
    const bf16x8 qn0 = *(const bf16x8*)(QN + qoff), qn1 = *(const bf16x8*)(QN + qoff + 32);
    const int nvis = tq >= 31 ? ((tq - 31) >> 4) + 1 : 0;
    const int nvmax = (tb + 3) >= 31 ? ((tb + 3 - 31) >> 4) + 1 : 0, nkt = (nvmax + 15) >> 4;
    f32x4 o[4]; unsigned msk[4];
    attn_cmp_select((const bf16*)(ws + WS_KCP) + (size_t)gam * 512 * 64, (const bf16*)(ws + WS_VCTP) + (size_t)gam * 64 * 512, 512, qn0, qn1, nvis, nkt, cur, rf.cmp, imps, lane, o, msk);
    const float* gt = (const float*)(ws + WS_GATES) + (size_t)row * 48 + (4 * g + hl) * 3;
    const float g0 = gt[0], g1 = gt[1], g2 = gt[2];
#pragma unroll
    for (int dt = 0; dt < 4; ++dt) o[dt] = o[dt] * g0;
    unsigned un[4];
#pragma unroll
    for (int k = 0; k < 4; ++k) { unsigned u = msk[k]; u |= (unsigned)__shfl_xor((int)u, 4); u |= (unsigned)__shfl_xor((int)u, 8); un[k] = (unsigned)__builtin_amdgcn_readfirstlane((int)u); }
    if (lane == 0) *(LAS v4u*)(UNI + w * 4) = (v4u){un[0], un[1], un[2], un[3]};
    __syncthreads();
    if (w == 0) {
        unsigned u[4];
#pragma unroll
        for (int k = 0; k < 4; ++k) { unsigned x = 0u;
#pragma unroll
            for (int t = 0; t < 8; ++t) x |= UNI[4 * t + k];
            u[k] = (unsigned)__builtin_amdgcn_readfirstlane((int)x); }
        const unsigned below = (1u << (lane & 31)) - 1u;
        { const unsigned wd = lane < 32 ? u[0] : u[1]; const int base = lane < 32 ? 0 : __builtin_popcount(u[0]);
          if ((wd >> (lane & 31)) & 1u) LIST[base + __builtin_popcount(wd & below)] = (unsigned char)lane; }
        { const unsigned wd = lane < 32 ? u[2] : u[3]; const int base = __builtin_popcount(u[0]) + __builtin_popcount(u[1]) + (lane < 32 ? 0 : __builtin_popcount(u[2]));
          if ((wd >> (lane & 31)) & 1u) LIST[base + __builtin_popcount(wd & below)] = (unsigned char)(64 + lane); }
        if (lane == 0) UNI[36] = (unsigned)(__builtin_popcount(u[0]) + __builtin_popcount(u[1]) + __builtin_popcount(u[2]) + __builtin_popcount(u[3]));
    }
    __syncthreads();
    const bf16x8 qr0 = *(const bf16x8*)(QR + qoff), qr1 = *(const bf16x8*)(QR + qoff + 32);
    attn_branch<0>((const bf16*)(ws + WS_KS) + (size_t)gam * SEQ * 64, (const bf16*)(ws + WS_VST) + (size_t)gam * 128 * 4096, lds, t0, tb, tq, cur, rf.slc, g1, msk, un, qr0, qr1, w, lane, o);
    attn_branch<1>((const bf16*)(ws + WS_KW) + (size_t)gam * SEQ * 64, (const bf16*)(ws + WS_VWT) + (size_t)gam * 128 * 4096, lds, t0, tb, tq, cur, rf.win, g2, msk, un, qr0, qr1, w, lane, o);
    bf16* op = (bf16*)(ws + WS_O) + (size_t)row * D + (4 * g + hl) * 64 + 4 * quad;
#pragma unroll
    for (int dt = 0; dt < 4; ++dt) { v2u wv; wv.x = pk2(o[dt][0], o[dt][1]); wv.y = pk2(o[dt][2], o[dt][3]); *(v2u*)(op + 16 * dt) = wv; }
    __syncthreads();
}

struct DecState { float m[4], l[4]; float o[4][16]; };
__device__ __forceinline__ void dec_job(const float* kbase, const float* vbase, int nkeys, const float (&qf)[4][16], DecState& st, int lane) {
    const int ksub = lane >> 2, dq = lane & 3;
#pragma unroll 1
    for (int k0 = 0; k0 < nkeys; k0 += 16) { const int key = k0 + ksub; const bool ok = key < nkeys;
        const float* kp = kbase + (size_t)key * 256 + 16 * dq; const float* vp = vbase + (size_t)key * 256 + 16 * dq;
        f32x4 k4[4], v4[4];
#pragma unroll
        for (int j = 0; j < 4; ++j) { k4[j] = ok ? *(const f32x4*)(kp + 4 * j) : (f32x4){0.f, 0.f, 0.f, 0.f}; v4[j] = ok ? *(const f32x4*)(vp + 4 * j) : (f32x4){0.f, 0.f, 0.f, 0.f}; }
#pragma unroll
        for (int h = 0; h < 4; ++h) { float d = 0.f;
#pragma unroll
            for (int j = 0; j < 4; ++j) d += (k4[j][0] * qf[h][4 * j] + k4[j][1] * qf[h][4 * j + 1]) + (k4[j][2] * qf[h][4 * j + 2] + k4[j][3] * qf[h][4 * j + 3]);
            d += dpp_xor1(d); d += dpp_xor2(d);
            const float sc = ok ? d : -1e30f, mn = fmaxf(st.m[h], sc), al = fexp2(st.m[h] - mn), p = ok ? fexp2(sc - mn) : 0.f;
            st.m[h] = mn; st.l[h] = st.l[h] * al + p;
#pragma unroll
            for (int j = 0; j < 4; ++j)
#pragma unroll
                for (int i = 0; i < 4; ++i) st.o[h][4 * j + i] = st.o[h][4 * j + i] * al + p * v4[j][i]; } }
}

__device__ __forceinline__ void attn_sample_item(const Params& P, int item, const AttnRefs& rf, LAS float* L, int tid, int lane, int wave) {
    unsigned char* ws = P.ws;
    const int s = item >> 2, g = item & 3, row = MP + s;
    LAS float* ocs = L; LAS unsigned* sel = (LAS unsigned*)(L + 256); LAS float* part = L + 260; LAS float* imps = L + 260 + 8 * 4 * 66;
    const float* gates = (const float*)(ws + WS_GATES) + (size_t)row * 48 + 4 * g * 3;
    if (wave == 0) {
        const int col = lane & 15, quad = lane >> 4, ql = col >> 2, hl = col & 3;
        const size_t qoff = (size_t)row * D + (4 * g + hl) * 64 + 8 * quad; const bf16* QN = (const bf16*)(ws + WS_QN);
        const bf16x8 qn0 = *(const bf16x8*)(QN + qoff), qn1 = *(const bf16x8*)(QN + qoff + 32);
        f32x4 oc[4]; unsigned msk[4];
        attn_cmp_select((const bf16*)(ws + WS_KCS) + (size_t)item * 128 * 64, (const bf16*)(ws + WS_VCTS) + (size_t)item * 64 * 128, 128, qn0, qn1, 127, 8, 32, rf.cmp, imps, lane, oc, msk);
        const float g0 = gates[hl * 3];
        if (ql == 0) {
#pragma unroll
            for (int dt = 0; dt < 4; ++dt)
#pragma unroll
                for (int r = 0; r < 4; ++r) ocs[hl * 64 + 16 * dt + 4 * quad + r] = oc[dt][r] * g0; }
        if (lane == 0) sel[0] = msk[0];
    }
    __syncthreads();
    {
        const unsigned m0 = sel[0];
        const bool isw = wave >= 5;
        const int dq = lane & 3;
        float qf[4][16];
        const bf16* QR = (const bf16*)(ws + WS_QR) + (size_t)row * D + 4 * g * 64 + 16 * dq;
#pragma unroll
        for (int h = 0; h < 4; ++h) { const v4u a = *(const v4u*)(QR + h * 64), b = *(const v4u*)(QR + h * 64 + 8);
            qf[h][0] = bflo(a.x); qf[h][1] = bfhi(a.x); qf[h][2] = bflo(a.y); qf[h][3] = bfhi(a.y); qf[h][4] = bflo(a.z); qf[h][5] = bfhi(a.z); qf[h][6] = bflo(a.w); qf[h][7] = bfhi(a.w);
            qf[h][8] = bflo(b.x); qf[h][9] = bfhi(b.x); qf[h][10] = bflo(b.y); qf[h][11] = bfhi(b.y); qf[h][12] = bflo(b.z); qf[h][13] = bfhi(b.z); qf[h][14] = bflo(b.w); qf[h][15] = bfhi(b.w); }
        DecState st;
#pragma unroll
        for (int h = 0; h < 4; ++h) { st.m[h] = -1e30f; st.l[h] = 0.f;
#pragma unroll
            for (int i = 0; i < 16; ++i) st.o[h][i] = 0.f; }
        const int* pt = (const int*)P.in[8] + s * 16;
#pragma unroll 1
        for (int jj = 0; jj < 4; ++jj) { const float* kb; const float* vb; int nk = 64;
            if (!isw) { const int J = wave + 5 * jj; if (J > 15) break;
                if (J == 15) { kb = P.out + O_SKS + (size_t)s * 256 + g * 64; vb = P.out + O_SVS + (size_t)s * 256 + g * 64; nk = 1; }
                else { unsigned bits = m0; for (int i = 0; i < J; ++i) bits &= bits - 1u; const int sg = bits ? __builtin_ctz(bits) : 0;
                    const size_t base = ((size_t)pt[sg >> 1] * 128 + (sg & 1) * 64) * 256 + g * 64; kb = P.in[4] + base; vb = P.in[5] + base; }
            } else { const int J = (wave - 5) + 3 * jj; if (J > 8) break;
                if (J == 8) { const size_t base = ((size_t)s * WIN + (WIN - 1)) * 256 + g * 64; kb = P.out + O_WKS + base; vb = P.out + O_WVS + base; nk = 1; }
                else { const size_t base = ((size_t)s * WIN + 64 * J) * 256 + g * 64; kb = P.in[6] + base; vb = P.in[7] + base; } }
            dec_job(kb, vb, nk, qf, st, lane); }
#pragma unroll
        for (int h = 0; h < 4; ++h) { float M = st.m[h]; M = fmaxf(M, __shfl_xor(M, 4)); M = fmaxf(M, __shfl_xor(M, 8)); M = fmaxf(M, __shfl_xor(M, 16)); M = fmaxf(M, __shfl_xor(M, 32));
            const float f = fexp2(st.m[h] - M); st.m[h] = M; st.l[h] *= f;
#pragma unroll
            for (int i = 0; i < 16; ++i) st.o[h][i] *= f; }
#pragma unroll
        for (int h = 0; h < 4; ++h) { float l = st.l[h]; l += __shfl_xor(l, 4); l += __shfl_xor(l, 8); l += __shfl_xor(l, 16); l += __shfl_xor(l, 32); st.l[h] = l;
#pragma unroll
            for (int i = 0; i < 16; ++i) { float v = st.o[h][i]; v += __shfl_xor(v, 4); v += __shfl_xor(v, 8); v += __shfl_xor(v, 16); v += __shfl_xor(v, 32); st.o[h][i] = v; } }
        if (lane < 4) {
#pragma unroll
            for (int h = 0; h < 4; ++h) { LAS float* pp = part + (wave * 4 + h) * 66; if (lane == 0) { pp[0] = st.m[h]; pp[1] = st.l[h]; }
#pragma unroll
                for (int i = 0; i < 16; ++i) pp[2 + 16 * dq + i] = st.o[h][i]; } }
    }
    __syncthreads();
    if (tid < 256) { const int h = tid >> 6, d = tid & 63;
        float res = ocs[h * 64 + d];
#pragma unroll
        for (int br = 0; br < 2; ++br) { const int w0 = br ? 5 : 0, w1 = br ? 8 : 5; float M = -1e30f;
            for (int w = w0; w < w1; ++w) M = fmaxf(M, part[(w * 4 + h) * 66]);
            float Lt = 0.f, Ot = 0.f;
            for (int w = w0; w < w1; ++w) { const LAS float* pp = part + (w * 4 + h) * 66; const float f = fexp2(pp[0] - M); Lt += pp[1] * f; Ot += pp[2 + d] * f; }
            res += (Lt > 0.f ? Ot / Lt : 0.f) * gates[h * 3 + 1 + br]; }
        ((bf16*)(ws + WS_O))[(size_t)row * D + (4 * g + h) * 64 + d] = (bf16)(pk2(res, 0.f) & 0xffffu); }
    __syncthreads();
}

__device__ __forceinline__ void phase_attn(const Params& P, LAS unsigned char* lds, int tid, int lane, int wave) {
    float qg = fabsf(P.in[20][lane]), k0 = fabsf(P.in[24][lane]), k1 = fabsf(P.in[24][64 + lane]), k2 = fabsf(P.in[24][128 + lane]);
    qg = wave_max(qg); k0 = wave_max(k0); k1 = wave_max(k1); k2 = wave_max(k2);
    AttnRefs rf; rf.cmp = -8.0f * 1.4426950409f * qg * k0; rf.slc = -8.0f * 1.4426950409f * qg * k1; rf.win = -8.0f * 1.4426950409f * qg * k2;
    LAS float* L = (LAS float*)lds;
    for (int item = blockIdx.x; item < 512 * ATT_REP_S; item += gridDim.x) attn_sample_item(P, item & 511, rf, L, tid, lane, wave);
    __syncthreads();
    {
        for (int k = 0; k < 8 * ATT_REP_P; ++k) { const int kk = k & 7; const int u0 = blockIdx.x + gridDim.x * kk;
            const int gam = u0 & 7, p0 = u0 >> 3; const int pt32 = (kk & 1) ? (32 * kk + 31 - (p0 & 31)) : p0;
            attn_prompt_unit(P, pt32 * 8 + gam, rf, lds, lane, wave); } }
    const int gtid = blockIdx.x * 512 + tid, ngt = gridDim.x * 512;
    for (int e = gtid; e < (M65 - MT) * 128; e += ngt) *(v4u*)((bf16*)(P.ws + WS_O) + (size_t)MT * D + (size_t)e * 8) = (v4u){0u, 0u, 0u, 0u};
}

constexpr int NPHASE = 15;
__global__ void __launch_bounds__(NWAVES * 64, 2) fwd(Params P) {
    extern __shared__ __attribute__((aligned(16))) unsigned char lds_raw[];
    LAS unsigned char* lds = (LAS unsigned char*)lds_raw;
    const int tid = threadIdx.x, lane = tid & 63, wave = __builtin_amdgcn_readfirstlane(tid >> 6);
    const int G = gridDim.x;
    unsigned char* ws = P.ws;
    for (int u = tid; u < (LDS_BYTES - LDSCTL_OFF) / 4; u += NWAVES * 64) ((LAS unsigned*)(lds + LDSCTL_OFF))[u] = 0u;
    __syncthreads();
    XcdBarrier bar; bar.bar = (unsigned*)(ws + WS_CTL) + CW_BAR; bar.x = 0; bar.st = nullptr;
#if !MK_PER_PHASE
    bar = xcd_barrier_post((unsigned*)(ws + WS_CTL) + CW_BAR, (volatile LAS unsigned*)(lds + MISC_OFF) + 8);
#endif
    const int lo = P.ph_lo, hi = P.ph_hi;
#ifndef PH_MASK
#define PH_MASK 0x7fff
#endif
#define EN(k) (((PH_MASK) >> (k)) & 1)
#ifndef REP_MASK
#define REP_MASK 0
#endif
#define REPS(k) ((((REP_MASK) >> (k)) & 1) + 1)
#define IN(k) (lo <= (k) && (k) < hi)
#if MK_PER_PHASE
#define GRID_BAR(k) do { } while (0)
#else
#define GRID_BAR(k) do { if ((k) + 1 < hi) xcd_barrier(bar); } while (0)
#endif
    bf16* WBIG = (bf16*)(ws + WS_WBIG); bf16* ACTA = (bf16*)(ws + WS_ACTA); float* SSQ = (float*)(ws + WS_SSQ);
    float* MOD = (float*)(ws + WS_MOD); float* BIAS = (float*)(ws + WS_BIAS); float* ROPE = (float*)(ws + WS_ROPE);
    const size_t SSQ_STRIDE = (size_t)M65 * 16;

    if (EN(0) && IN(0)) { for (int rep_ = 0; rep_ < REPS(0); ++rep_) phase0(P, lds, tid, lane, wave); GRID_BAR(0); }
    if (EN(1) && IN(1)) {
        pg8::Gemm g{(const bf16*)(ws + WS_SC), (const bf16*)(ws + WS_WADA), 256, NMOD, 1024, 1024, 1 << 30, 0}; pg8::StaticOrder S; S.init(256, NMOD, G, (int)blockIdx.x);
        EpiMod E{MOD, (bf16*)(ws + WS_SH), P.in[12]};
        pg8::gemm_phase<EpiMod, true>(lds + RING_OFF, g, S, E);
        __syncthreads();
        for (int rep_ = 0; rep_ < REPS(18); ++rep_) phase1_weights(P, lds, lane, wave);
        GRID_BAR(1); }
    if (EN(2) && IN(2)) {
        pg8::Gemm g{(const bf16*)(ws + WS_SH), WBIG, 1024, NBIG, 1024, 1024, 1 << 30, 0}; pg8::StaticOrder S; S.init(1024, NBIG, G, (int)blockIdx.x);
        EpiBias E{BIAS};
        for (int rep_ = 0; rep_ < REPS(2); ++rep_) pg8::gemm_phase<EpiBias, true>(lds + RING_OFF, g, S, E);
        for (int rep_ = 0; rep_ < REPS(15); ++rep_) phase2_tail(P, tid, lane, wave);
        for (int rep_ = 0; rep_ < REPS(16); ++rep_) sample_prepass(P, tid, lane, wave);
        GRID_BAR(2); }
#define COMMON_PHASES(layer) do { \
        const int po = layer ? 12 : 5; \
        if (EN(5) && IN(po)) { \
            pg8::Gemm g{layer ? (const bf16*)(ws + WS_O) : (const bf16*)(ws + WS_UM), layer ? (const bf16*)(ws + WS_WBO) : (const bf16*)(ws + WS_WOUT), M65, 1024, 1024, 1024, 1 << 30, 0}; \
            pg8::StaticOrder S; S.init(M65, 1024, G, (int)blockIdx.x); \
            EpiRes E{layer ? P.out : P.in[0], layer ? P.out + (size_t)MP * D : P.in[1], MOD, layer * 6144 + 2048, P.out, (const float*)(ws + WS_MUL) + (size_t)(layer ? 2 : 0) * 256 * 1024, ACTA, nullptr, nullptr, SSQ + (layer ? 4 : 2) * SSQ_STRIDE}; \
            for (int rep_ = 0; rep_ < (layer ? 1 : REPS(5)); ++rep_) pg8::gemm_phase<EpiRes, true>(lds + RING_OFF, g, S, E); \
            GRID_BAR(po); } \
        if (EN(6) && IN(po + 1)) { \
            const int off = layer ? OFF_GU1 : OFF_GU0; \
            pg8::Gemm g{ACTA, WBIG + (size_t)off * 1024, M65, NGU, 1024, 1024, 1 << 30, 0}; pg8::StaticOrder S; S.init(M65, NGU, G, (int)blockIdx.x); \
            EpiGU E{SSQ + (layer ? 4 : 2) * SSQ_STRIDE, BIAS, off, (bf16*)(ws + WS_HID)}; \
            for (int rep_ = 0; rep_ < (layer ? 1 : REPS(6)); ++rep_) pg8::gemm_phase<EpiGU, true>(lds + RING_OFF, g, S, E); \
            GRID_BAR(po + 1); } \
        if (EN(7) && IN(po + 2)) { \
            pg8::Gemm g{(const bf16*)(ws + WS_HID), (const bf16*)(ws + WS_WDN) + (size_t)layer * 1024 * DFF, M65, 1024, DFF, DFF, 1 << 30, 0}; pg8::StaticOrder S; S.init(M65, 1024, G, (int)blockIdx.x); \
            EpiRes E{P.out, P.out + (size_t)MP * D, MOD, layer * 6144 + 5120, P.out, (const float*)(ws + WS_MUL) + (size_t)256 * 1024, layer ? nullptr : ACTA, P.in[22], layer ? nullptr : (bf16*)(ws + WS_AKV), layer ? nullptr : SSQ + 3 * SSQ_STRIDE}; \
            pg8::gemm_phase<EpiRes, true>(lds + RING_OFF, g, S, E); \
            GRID_BAR(po + 2); } \
    } while (0)
            if (EN(3) && IN(3)) {
                pg8::Gemm g{ACTA, WBIG + (size_t)OFF_WIN * 1024, M65, NAIN, 1024, 1024, 1 << 30, 0}; pg8::StaticOrder S; S.init(M65, NAIN, G, (int)blockIdx.x);
                EpiAin E{SSQ, BIAS, (bf16*)(ws + WS_U), (bf16*)(ws + WS_V), SSQ + SSQ_STRIDE};
                for (int rep_ = 0; rep_ < REPS(3); ++rep_) pg8::gemm_phase<EpiAin, true>(lds + RING_OFF, g, S, E);
                GRID_BAR(3); }
            if (EN(4) && IN(4)) { for (int rep_ = 0; rep_ < REPS(4); ++rep_) phase_tokmix(P, lds, tid, lane, wave); GRID_BAR(4); }
    COMMON_PHASES(0);
            if (EN(8) && IN(8)) {
                { pg8::Gemm g{(const bf16*)(ws + WS_AKV), (const bf16*)(ws + WS_WKV), M65, NKV, 1024, 1024, 1 << 30, 0}; pg8::StaticOrder S; S.init(M65, NKV, G, (int)blockIdx.x);
                  EpiKV E{SSQ + 3 * SSQ_STRIDE, P.in[24], ROPE, P.out, (bf16*)(ws + WS_RC), (bf16*)(ws + WS_KS), (bf16*)(ws + WS_KW), (bf16*)(ws + WS_VST), (bf16*)(ws + WS_VWT)};
                  for (int rep_ = 0; rep_ < REPS(8); ++rep_) pg8::gemm_phase<EpiKV, true>(lds + RING_OFF, g, S, E); }
                { pg8::Gemm g{ACTA, WBIG + (size_t)OFF_Q * 1024, M65, NQP, 1024, 1024, 1 << 30, 0}; pg8::StaticOrder S; S.init(M65, NQP, G, (int)((blockIdx.x + 128) % G));
                  EpiQ E{SSQ + 3 * SSQ_STRIDE, BIAS, P.in[20], ROPE, (bf16*)(ws + WS_QN), (bf16*)(ws + WS_QR), (float*)(ws + WS_GATES)};
                  for (int rep_ = 0; rep_ < REPS(17); ++rep_) pg8::gemm_phase<EpiQ, true>(lds + RING_OFF, g, S, E); }
                GRID_BAR(8); }
            if (EN(9) && IN(9)) {
                pg8::Gemm g{(const bf16*)(ws + WS_RC), (const bf16*)(ws + WS_W1C), 2 * RC_KV, 256, 2048, 1024, RC_KV / 256, (long)256 * 2048}; pg8::StaticOrder S; S.init(2 * RC_KV, 256, G, (int)blockIdx.x);
                EpiCmp E{(const float*)(ws + WS_C1), (bf16*)(ws + WS_H2)};
                for (int rep_ = 0; rep_ < REPS(9); ++rep_) pg8::gemm_phase<EpiCmp, true>(lds + RING_OFF, g, S, E);
                GRID_BAR(9); }
            if (EN(10) && IN(10)) { for (int rep_ = 0; rep_ < REPS(10); ++rep_) phase_w2(P, lane, wave); GRID_BAR(10); }
            if (EN(11) && IN(11)) { for (int rep_ = 0; rep_ < REPS(11); ++rep_) phase_attn(P, lds, tid, lane, wave); GRID_BAR(11); }
    COMMON_PHASES(1);
#undef IN
#undef EN
#undef REPS
#undef GRID_BAR
}

extern "C" void kernel_launch(void* const* d_in, const int* in_sizes, int n_in, void* d_out, int out_size, void* d_ws, size_t ws_size, hipStream_t stream) {
    static int grid = 0;
    if (grid == 0) {
        if (n_in != 32 || ws_size < WS_END) { fprintf(stderr, "kernel_launch: unexpected problem (n_in %d, ws %zu < %zu)\n", n_in, ws_size, (size_t)WS_END); grid = -1; return; }
        int dev = 0, cus = 0;
        if (hipGetDevice(&dev) != hipSuccess || hipDeviceGetAttribute(&cus, hipDeviceAttributeMultiprocessorCount, dev) != hipSuccess) { grid = -1; return; }
        if (hipFuncSetAttribute((const void*)fwd, hipFuncAttributeMaxDynamicSharedMemorySize, LDS_BYTES) != hipSuccess) { fprintf(stderr, "kernel_launch: hipFuncSetAttribute failed\n"); grid = -1; return; }
        int per_cu = 0;
        if (hipOccupancyMaxActiveBlocksPerMultiprocessor(&per_cu, (const void*)fwd, NWAVES * 64, LDS_BYTES) != hipSuccess || per_cu < 1) fprintf(stderr, "kernel_launch: occupancy query says %d\n", per_cu);
        (void)hipGetLastError();
        grid = cus;
    }
    if (grid < 0) return;
    (void)hipMemsetAsync((char*)d_ws + WS_CTL, 0, CTL_ZERO_BYTES, stream);
    Params p{};
    for (int i = 0; i < 32; ++i) p.in[i] = (const float*)d_in[i];
    p.out = (float*)d_out; p.ws = (unsigned char*)d_ws;
#if MK_PER_PHASE
    for (int k = 0; k < NPHASE; ++k) { p.ph_lo = k; p.ph_hi = k + 1; hipLaunchKernelGGL(fwd, dim3(grid), dim3(NWAVES * 64), LDS_BYTES, stream, p); }
#else
    p.ph_lo = 0; p.ph_hi = NPHASE;
    hipLaunchKernelGGL(fwd, dim3(grid), dim3(NWAVES * 64), LDS_BYTES, stream, p);
#endif
    const hipError_t le = hipPeekAtLastError();
    if (le != hipSuccess) fprintf(stderr, "kernel_launch: launch failed: %s\n", hipGetErrorName(le));
}
```

```cpp
#include <hip/hip_runtime.h>
#include <hip/hip_bf16.h>
#include <cstdio>
#include <cstdint>
#include <cmath>

#ifndef MK_PER_PHASE
#define MK_PER_PHASE 0
#endif

namespace pg8 {
#define PG8_LAS __attribute__((address_space(3)))
typedef unsigned short bf16_t;
typedef short bf16x8 __attribute__((ext_vector_type(8)));
typedef float f32x4 __attribute__((ext_vector_type(4)));
typedef unsigned u32x4 __attribute__((ext_vector_type(4)));
typedef unsigned u32x2 __attribute__((ext_vector_type(2)));
constexpr int BM = 256, BK = 64, HALF = 128, HTB = HALF * BK * 2, STAGE_BYTES = 8 * HTB, NXCD = 8, WGM = 8;

__host__ __device__ __forceinline__ int lds_byte(int r, int c) { const int st = (r >> 4) * 2 + (c >> 5), rr = r & 15, cc = c & 31, ob = rr * 64 + cc * 2; return st * 1024 + (ob ^ (((ob >> 9) & 1) << 5)); }
__host__ __device__ __forceinline__ void stage_rc(int b, int& R, int& C) { const int st = b / 1024, sb = b % 1024, swz = sb ^ (((sb >> 9) & 1) << 5); R = (st >> 1) * 16 + swz / 64; C = (st & 1) * 32 + (swz % 64) / 2; }
__host__ __device__ __forceinline__ int perm32(int rho) { const int n = rho >> 4, i = rho & 15; return 8 * (i >> 2) + 4 * n + (i & 3); }

struct Unit { int pm, pn; };
struct Gemm { const bf16_t* A; const bf16_t* Bt; int M, N, K, lda, bsplit; long boff; };

struct StaticOrder {
    int nM, nN, nwg, G, c;
    __host__ __device__ void init(int M, int N, int G_, int c_) { nM = M / BM; nN = N / BM; nwg = nM * nN; G = G_; c = c_; }
    __host__ __device__ bool next(int i, Unit& u) const {
        const long L = (long)i * G + c; if (L >= nwg) return false;
        int wgid = (int)L; { const int q = nwg / NXCD, r = nwg % NXCD, xcd = wgid % NXCD, off = wgid / NXCD; wgid = (xcd < r ? xcd * (q + 1) : r * (q + 1) + (xcd - r) * q) + off; }
        const int nig = WGM * nN, gid = wgid / nig, fm = gid * WGM, gsz = (nM - fm) < WGM ? (nM - fm) : WGM;
        u.pm = fm + ((wgid % nig) % gsz); u.pn = (wgid % nig) / gsz; return true;
    }
};

template <class Epi, bool ALIGN_EPI>
__device__ __forceinline__ void gemm_phase(PG8_LAS unsigned char* lds, const Gemm g, const StaticOrder& S, const Epi& E) {
    const int tid = threadIdx.x, wid = __builtin_amdgcn_readfirstlane(tid >> 6), lane = tid & 63, wr = wid >> 2, wc = wid & 3, fr = lane & 15, fq = lane >> 4;
    const int K = g.K, nt = K / BK, lda = g.lda;
    unsigned voffA[2], voffB[2];
#pragma unroll
    for (int i = 0; i < 2; ++i) { int R, C; stage_rc(tid * 16 + i * 8192, R, C); const int Rb = ((R & ~31) + perm32(R & 31));
        voffA[i] = (unsigned)(R * lda + C) * 2u; voffB[i] = (unsigned)(Rb * K + C) * 2u; }
    const size_t kstep = (size_t)(BK * 2);
    const size_t hstepA = (size_t)HALF * lda * 2, hstepB = (size_t)HALF * K * 2;
    const size_t tstepA = 2 * hstepA, tstepB = 2 * hstepB;
    const unsigned ldsw = (unsigned)wid * 1024u;
    const int aoff = lds_byte(wr * 64 + fr, fq * 8), boff = lds_byte(wc * 32 + fr, fq * 8);
#define PG8_SA(b, h) (((b) * 2 + (h)) * HTB)
#define PG8_SB(b, h) ((4 + (b) * 2 + (h)) * HTB)
#define PG8_STAGE(bufoff, gbase, voff) do { _Pragma("unroll") for (int _i = 0; _i < 2; ++_i) \
        __builtin_amdgcn_global_load_lds((const unsigned*)((const char*)(gbase) + (voff)[_i]), (PG8_LAS unsigned*)(lds + (bufoff) + ldsw + _i * 8192), 16, 0, 0); } while (0)
#define PG8_LDA(dst, b, h) do { _Pragma("unroll") for (int m = 0; m < 4; ++m) _Pragma("unroll") for (int k = 0; k < 2; ++k) dst[m][k] = *(const PG8_LAS bf16x8*)(lds + PG8_SA(b, h) + aoff + m * 2048 + k * 1024); } while (0)
#define PG8_LDB(dst, b, h) do { _Pragma("unroll") for (int n = 0; n < 2; ++n) _Pragma("unroll") for (int k = 0; k < 2; ++k) dst[n][k] = *(const PG8_LAS bf16x8*)(lds + PG8_SB(b, h) + boff + n * 2048 + k * 1024); } while (0)
#define PG8_MMA(ai, bj, At, Bt) do { __builtin_amdgcn_s_setprio(1); _Pragma("unroll") for (int m = 0; m < 4; ++m) _Pragma("unroll") for (int n = 0; n < 2; ++n) _Pragma("unroll") for (int k = 0; k < 2; ++k) \
        acc[ai][bj][m][n] = __builtin_amdgcn_mfma_f32_16x16x32_bf16(Bt[n][k], At[m][k], acc[ai][bj][m][n], 0, 0, 0); __builtin_amdgcn_s_setprio(0); } while (0)
#define PG8_WAIT_V(n) asm volatile("s_waitcnt vmcnt(" #n ")" ::: "memory")
#define PG8_WAIT_L(n) asm volatile("s_waitcnt lgkmcnt(" #n ")" ::: "memory")
#define PG8_BAR __builtin_amdgcn_s_barrier()
#define PG8_SCHED __builtin_amdgcn_sched_barrier(0)
    Unit cur, nxt; int ui = 0;
    if (!S.next(0, cur)) return;
    f32x4 acc[2][2][4][2];
#pragma unroll
    for (int a = 0; a < 2; ++a)
#pragma unroll
        for (int b = 0; b < 2; ++b)
#pragma unroll
            for (int m = 0; m < 4; ++m)
#pragma unroll
                for (int n = 0; n < 2; ++n) acc[a][b][m][n] = (f32x4){0.f, 0.f, 0.f, 0.f};
    bf16x8 At[4][2], B0[2][2], B1[2][2];
    const char* cA = (const char*)g.A + (size_t)cur.pm * tstepA;
    const char* cB = (const char*)g.Bt + (cur.pm >= g.bsplit ? (size_t)g.boff * 2 : (size_t)0) + (size_t)cur.pn * tstepB;
    PG8_STAGE(PG8_SB(0, 0), cB, voffB); PG8_STAGE(PG8_SB(0, 1), cB + hstepB, voffB); PG8_STAGE(PG8_SA(0, 0), cA, voffA); PG8_STAGE(PG8_SA(0, 1), cA + hstepA, voffA);
    if (wr == 1) PG8_BAR;
    PG8_WAIT_V(2); PG8_BAR;
    PG8_STAGE(PG8_SB(1, 0), cB + kstep, voffB); PG8_STAGE(PG8_SA(1, 0), cA + kstep, voffA); PG8_STAGE(PG8_SB(1, 1), cB + hstepB + kstep, voffB);
    PG8_WAIT_V(6); PG8_BAR;
    for (;;) {
        const bool has_next = S.next(ui + 1, nxt);
        const char* nA = has_next ? (const char*)g.A + (size_t)nxt.pm * tstepA : cA;
        const char* nB = has_next ? (const char*)g.Bt + (nxt.pm >= g.bsplit ? (size_t)g.boff * 2 : (size_t)0) + (size_t)nxt.pn * tstepB : cB;
        for (int t = 0; t < nt; t += 2) {
            const bool last = (t == nt - 2);
            const char* a1 = cA + (size_t)(t + 1) * kstep;
            const char* a2 = last ? nA : cA + (size_t)(t + 2) * kstep; const char* b2 = last ? nB : cB + (size_t)(t + 2) * kstep;
            const char* a3 = a2 + kstep; const char* b3 = b2 + kstep;
            PG8_LDB(B0, 0, 0); PG8_LDB(B1, 0, 1); PG8_SCHED; PG8_LDA(At, 0, 0); PG8_STAGE(PG8_SA(1, 1), a1 + hstepA, voffA);
            PG8_WAIT_V(8); PG8_WAIT_L(0); PG8_BAR; PG8_MMA(0, 0, At, B0); PG8_MMA(0, 1, At, B1); PG8_BAR; PG8_SCHED;
            PG8_LDA(At, 0, 1); PG8_STAGE(PG8_SB(0, 0), b2, voffB); PG8_STAGE(PG8_SB(0, 1), b2 + hstepB, voffB); PG8_STAGE(PG8_SA(0, 0), a2, voffA);
            PG8_WAIT_V(8); PG8_WAIT_L(0); PG8_BAR; PG8_MMA(1, 0, At, B0); PG8_MMA(1, 1, At, B1); PG8_BAR; PG8_SCHED;
            PG8_LDB(B0, 1, 0); PG8_LDB(B1, 1, 1); PG8_SCHED; PG8_LDA(At, 1, 0); PG8_STAGE(PG8_SA(0, 1), a2 + hstepA, voffA);
            PG8_WAIT_V(8); PG8_WAIT_L(0); PG8_BAR; PG8_MMA(0, 0, At, B0); PG8_MMA(0, 1, At, B1); PG8_BAR; PG8_SCHED;
            PG8_LDA(At, 1, 1); PG8_STAGE(PG8_SB(1, 0), b3, voffB); PG8_STAGE(PG8_SB(1, 1), b3 + hstepB, voffB); PG8_STAGE(PG8_SA(1, 0), a3, voffA);
            PG8_WAIT_V(8); PG8_WAIT_L(0); PG8_BAR; PG8_MMA(1, 0, At, B0); PG8_MMA(1, 1, At, B1); PG8_BAR; PG8_SCHED;
        }
        if constexpr (ALIGN_EPI) { if (wr == 0) PG8_BAR; }
        E(acc, cur, wr, wc, fr, fq);
        if (!has_next) break;
#pragma unroll
        for (int a = 0; a < 2; ++a)
#pragma unroll
            for (int b = 0; b < 2; ++b)
#pragma unroll
                for (int m = 0; m < 4; ++m)
#pragma unroll
                    for (int n = 0; n < 2; ++n) acc[a][b][m][n] = (f32x4){0.f, 0.f, 0.f, 0.f};
        cur = nxt; cA = nA; cB = nB; ++ui;
        if constexpr (ALIGN_EPI) { if (wr == 1) PG8_BAR; }
    }
    PG8_WAIT_V(0);
    if constexpr (!ALIGN_EPI) { if (wr == 0) PG8_BAR; }
    PG8_BAR;
#undef PG8_SA
#undef PG8_SB
#undef PG8_STAGE
#undef PG8_LDA
#undef PG8_LDB
#undef PG8_MMA
#undef PG8_WAIT_V
#undef PG8_WAIT_L
#undef PG8_BAR
#undef PG8_SCHED
}
}

#define GAS __attribute__((address_space(1)))
#define LAS __attribute__((address_space(3)))
typedef unsigned short bf16;
typedef unsigned v4u __attribute__((ext_vector_type(4)));
typedef unsigned v2u __attribute__((ext_vector_type(2)));
typedef float f32x4 __attribute__((ext_vector_type(4)));
typedef float f32x2 __attribute__((ext_vector_type(2)));
typedef short bf16x8 __attribute__((ext_vector_type(8)));
typedef short bf16x4 __attribute__((ext_vector_type(4)));
typedef __bf16 bf16x2_t __attribute__((ext_vector_type(2)));
typedef GAS unsigned gu32;
#define RLX_AGENT __ATOMIC_RELAXED, __HIP_MEMORY_SCOPE_AGENT
#define LDS_WAIT() asm volatile("s_waitcnt lgkmcnt(0)" ::: "memory")
#define VM_WAIT() asm volatile("s_waitcnt vmcnt(0)" ::: "memory")
__device__ __forceinline__ unsigned pk2(float lo, float hi) { f32x2 v = {lo, hi}; bf16x2_t b = __builtin_convertvector(v, bf16x2_t); return __builtin_bit_cast(unsigned, b); }
__device__ __forceinline__ float bf2f(unsigned short h) { return __builtin_bit_cast(float, (unsigned)h << 16); }
__device__ __forceinline__ float bflo(unsigned w) { return __builtin_bit_cast(float, w << 16); }
__device__ __forceinline__ float bfhi(unsigned w) { return __builtin_bit_cast(float, w & 0xffff0000u); }
__device__ __forceinline__ float fexp2(float x) { return __builtin_amdgcn_exp2f(x); }
__device__ __forceinline__ float frcp(float x) { return __builtin_amdgcn_rcpf(x); }
__device__ __forceinline__ float gelu_t(float x) { const float x2 = x * x; const float e = fexp2(x * (-2.302208198f + -0.1029432357f * x2)); return x * frcp(1.f + e); }
__device__ __forceinline__ float silu_f(float x) { return x * frcp(1.f + fexp2(-1.4426950409f * x)); }
__device__ __forceinline__ float sigmoid_f(float x) { return frcp(1.f + fexp2(-1.4426950409f * x)); }
__device__ __forceinline__ float dpp_xor1(float v) { return __builtin_bit_cast(float, __builtin_amdgcn_update_dpp(0, __builtin_bit_cast(int, v), 0xB1, 0xF, 0xF, true)); }
__device__ __forceinline__ float dpp_xor2(float v) { return __builtin_bit_cast(float, __builtin_amdgcn_update_dpp(0, __builtin_bit_cast(int, v), 0x4E, 0xF, 0xF, true)); }
__device__ __forceinline__ unsigned dpp_xor1u(unsigned v) { return (unsigned)__builtin_amdgcn_update_dpp(0, (int)v, 0xB1, 0xF, 0xF, true); }
__device__ __forceinline__ unsigned dpp_xor2u(unsigned v) { return (unsigned)__builtin_amdgcn_update_dpp(0, (int)v, 0x4E, 0xF, 0xF, true); }
__device__ __forceinline__ float wave_sum(float v) {
#pragma unroll
    for (int o = 1; o < 64; o <<= 1) v += __shfl_xor(v, o);
    return v;
}
__device__ __forceinline__ float wave_max(float v) {
#pragma unroll
    for (int o = 1; o < 64; o <<= 1) v = fmaxf(v, __shfl_xor(v, o));
    return v;
}

#define XB_TMO      128
#define XB_XCNT(j)  (256  + 64 * (j))
#define XB_XSUB(j)  (1280 + 64 * (j))
#define XB_XGEN(j)  (2304 + 64 * (j))
#define XB_TOP      3328
#define XB_TOPGEN   3392
#define XCD_BAR_WORDS 3456
#define XB_SPIN_CAP (1u << 18)

__device__ __forceinline__ unsigned xb_ld(unsigned* p)              { return __hip_atomic_load(p, __ATOMIC_RELAXED, __HIP_MEMORY_SCOPE_AGENT); }
__device__ __forceinline__ unsigned xb_add(unsigned* p, unsigned v) { return __hip_atomic_fetch_add(p, v, __ATOMIC_RELAXED, __HIP_MEMORY_SCOPE_AGENT); }
__device__ __forceinline__ unsigned xb_xcc_id() { return (unsigned)__builtin_amdgcn_s_getreg((3 << 11) | 20) & 0xFu; }
#define XB_SPIN(cond, bar) do { unsigned _sp = 0; while (cond) { __builtin_amdgcn_s_sleep(1); \
    if ((++_sp & 255u) == 0u) { if (xb_ld(&(bar)[XB_TMO])) break; if (_sp > XB_SPIN_CAP) { atomicAdd(&(bar)[XB_TMO], 1u); break; } } } } while (0)

struct XcdBarrier { unsigned* bar; unsigned x; volatile LAS unsigned* st; };

__device__ __forceinline__ XcdBarrier xcd_barrier_post(unsigned* bar, volatile LAS unsigned* st) {
    XcdBarrier b; b.bar = bar; b.x = xb_xcc_id(); b.st = st;
    if (threadIdx.x == 0) (void)xb_add(&bar[XB_XCNT(b.x)], 1u);
    return b;
}
__device__ __forceinline__ void xcd_barrier_complete(unsigned* bar, unsigned x, unsigned& nloc, unsigned& nx) {
    const unsigned G = gridDim.x * gridDim.y * gridDim.z;
    unsigned sum, cnt, mine, sp = 0u;
    for (;;) {
        sum = 0u; cnt = 0u; mine = 0u;
#pragma unroll
        for (unsigned j = 0; j < 16; ++j) { const unsigned c = xb_ld(&bar[XB_XCNT(j)]); sum += c; cnt += (c > 0u) ? 1u : 0u; mine = (j == x) ? c : mine; }
        if (sum == G) break;
        __builtin_amdgcn_s_sleep(1);
        if ((++sp & 255u) == 0u) { if (xb_ld(&bar[XB_TMO])) break; if (sp > XB_SPIN_CAP) { atomicAdd(&bar[XB_TMO], 1u); break; } }
    }
    nloc = mine > 0u ? mine : 1u; nx = cnt > 0u ? cnt : 1u;
}
__device__ __forceinline__ void xcd_barrier(const XcdBarrier& b) {
    asm volatile("s_waitcnt vmcnt(0)" ::: "memory");
    __syncthreads();
    if (threadIdx.x == 0) {
        unsigned* bar = b.bar;
        __builtin_amdgcn_s_waitcnt(0);
        unsigned nloc = b.st[0], nx = b.st[1];
        if (nloc == 0u) { xcd_barrier_complete(bar, b.x, nloc, nx); b.st[0] = nloc; b.st[1] = nx; }
        const unsigned old = xb_add(&bar[XB_XSUB(b.x)], 1u);
        const unsigned gen = old / nloc;
        if (old + 1u == (gen + 1u) * nloc) {
            __builtin_amdgcn_fence(__ATOMIC_RELEASE, "agent");
            asm volatile("s_waitcnt vmcnt(0)" ::: "memory");
            const unsigned og = xb_add(&bar[XB_TOP], 1u);
            const unsigned tg = og / nx;
            if (og + 1u == (tg + 1u) * nx) xb_add(&bar[XB_TOPGEN], 1u);
            else XB_SPIN(xb_ld(&bar[XB_TOPGEN]) == tg, bar);
            __builtin_amdgcn_fence(__ATOMIC_ACQUIRE, "agent");
            xb_add(&bar[XB_XGEN(b.x)], 1u);
            asm volatile("s_waitcnt vmcnt(0)" ::: "memory");
        } else {
            XB_SPIN(xb_ld(&bar[XB_XGEN(b.x)]) == gen, bar);
            __builtin_amdgcn_fence(__ATOMIC_ACQUIRE, "agent");
            asm volatile("s_waitcnt vmcnt(0)" ::: "memory");
        }
    }
    __syncthreads();
}

constexpr int NWAVES = 8;
constexpr int D = 1024, SEQ = 8192, NBATCH = 2, MP = NBATCH * SEQ, MS = 128, MT = MP + MS, M65 = 16640;
constexpr int DFF = 2816, NGU = 2 * DFF, NAIN = 2048, NKV = 1536, NQ = 1072, NQP = 1280;
constexpr int NBIG = NAIN + NGU + NQP + NGU;
constexpr int OFF_WIN = 0, OFF_GU0 = NAIN, OFF_Q = NAIN + NGU, OFF_GU1 = NAIN + NGU + NQP;
constexpr int NMOD = 12288;
constexpr int PAST = 2048, NPAGE = 16, PAGE = 128, WIN = 512;
constexpr int RC_SAMP = 512 * 128, RC_PROMPT = 8 * 512, RC_KV = RC_SAMP + RC_PROMPT;
constexpr float EPS = 1e-6f;
constexpr float C2 = 0.125f * 1.4426950408889634f;

constexpr size_t O_YP = 0, O_YS = 16777216, O_AVP = 16908288, O_AVS = 17170432, O_CKP = 17301504, O_CVP = 21495808, O_SKP = 25690112, O_SVP = 29884416,
                 O_WKP = 34078720, O_WVP = 34340864, O_CKS = 34603008, O_CVS = 34635776, O_SKS = 34668544, O_SVS = 34701312, O_WKS = 34734080, O_WVS = 51511296;

constexpr size_t al256(size_t x) { return (x + 255) & ~(size_t)255; }
constexpr size_t WS_CTL = 0, CTL_ZERO_BYTES = 1u << 20;
constexpr size_t WS_WADA = CTL_ZERO_BYTES;
constexpr size_t WS_WBIG = WS_WADA + (size_t)NMOD * D * 2;
constexpr size_t WS_WOUT = WS_WBIG + (size_t)NBIG * D * 2;
constexpr size_t WS_WBO = WS_WOUT + (size_t)D * D * 2;
constexpr size_t WS_WDN = WS_WBO + (size_t)D * D * 2;
constexpr size_t WS_WKV = WS_WDN + (size_t)2 * D * DFF * 2;
constexpr size_t WS_W1C = WS_WKV + (size_t)NKV * D * 2;
constexpr size_t WS_W2 = WS_W1C + (size_t)2 * 256 * 2048 * 2;
constexpr size_t WS_WSB = WS_W2 + (size_t)2 * 64 * 256 * 2;
constexpr size_t WS_ROPE = WS_WSB + (size_t)8 * 128 * 128 * 2;
constexpr size_t WS_C1 = WS_ROPE + (size_t)8192 * 64 * 4;
constexpr size_t WS_SC = WS_C1 + 2 * 256 * 4;
constexpr size_t WS_MOD = WS_SC + (size_t)256 * D * 2;
constexpr size_t WS_SH = WS_MOD + (size_t)256 * NMOD * 4;
constexpr size_t WS_BIAS = WS_SH + (size_t)4 * 256 * D * 2;
constexpr size_t WS_MUL = WS_BIAS + (size_t)256 * NBIG * 4;
constexpr size_t WS_SSQ = WS_MUL + (size_t)3 * 256 * D * 4;
constexpr size_t WS_ACTA = WS_SSQ + (size_t)5 * M65 * 16 * 4;
constexpr size_t ACT_BYTES = (size_t)M65 * D * 2;
constexpr size_t WS_AKV = WS_ACTA + ACT_BYTES;
constexpr size_t WS_U = WS_AKV + ACT_BYTES;
constexpr size_t WS_V = WS_U + ACT_BYTES;
constexpr size_t WS_UM = WS_V + ACT_BYTES;
constexpr size_t WS_QN = WS_UM + ACT_BYTES;
constexpr size_t WS_QR = WS_QN + ACT_BYTES;
constexpr size_t WS_O = WS_QR + ACT_BYTES;
constexpr size_t WS_GATES = WS_O + ACT_BYTES;
constexpr size_t WS_HID = WS_GATES + (size_t)M65 * 48 * 4;
constexpr size_t WS_KS = WS_HID + (size_t)M65 * DFF * 2;
constexpr size_t WS_KW = WS_KS + (size_t)8 * SEQ * 64 * 2;
constexpr size_t WS_VST = WS_KW + (size_t)8 * SEQ * 64 * 2;
constexpr size_t WS_VWT = WS_VST + (size_t)8 * SEQ * 64 * 2;
constexpr size_t WS_RC = WS_VWT + (size_t)8 * SEQ * 64 * 2;
constexpr size_t WS_H2 = WS_RC + (size_t)2 * RC_KV * 1024 * 2 + 4096;
constexpr size_t WS_KCP = WS_H2 + (size_t)2 * RC_KV * 256 * 2;
constexpr size_t WS_VCTP = WS_KCP + (size_t)8 * 512 * 64 * 2;
constexpr size_t WS_KCS = WS_VCTP + (size_t)8 * 512 * 64 * 2;
constexpr size_t WS_VCTS = WS_KCS + (size_t)512 * 128 * 64 * 2;
constexpr size_t WS_END = WS_VCTS + (size_t)512 * 128 * 64 * 2;
static_assert(WS_WBIG % 256 == 0 && WS_ROPE % 256 == 0 && WS_SC % 256 == 0 && WS_ACTA % 256 == 0 && WS_HID % 256 == 0 && WS_RC % 256 == 0 && WS_H2 % 256 == 0 && WS_KCP % 256 == 0, "ws alignment");
constexpr int CW_BAR = 4096;

constexpr int RING_OFF = 0, RING_BYTES = 131072;
constexpr int LDSCTL_OFF = RING_BYTES, MISC_OFF = LDSCTL_OFF + 320;
constexpr int LDS_BYTES = 163840;

struct Params {
    const float* in[32];
    float* out;
    unsigned char* ws;
    int ph_lo, ph_hi;
};

__device__ __forceinline__ int seq_of(int row) { const int s = row - MP + 2; return row < MP ? (row >> 13) : (s < 255 ? s : 255); }
__device__ __forceinline__ float rstd16(const float* p) {
    const f32x4 a = *(const f32x4*)p, b = *(const f32x4*)(p + 4), c = *(const f32x4*)(p + 8), d = *(const f32x4*)(p + 12);
    const float s = ((a.x + a.y) + (a.z + a.w)) + ((b.x + b.y) + (b.z + b.w)) + ((c.x + c.y) + (c.z + c.w)) + ((d.x + d.y) + (d.z + d.w));
    return rsqrtf(s * (1.0f / 1024.0f) + EPS);
}

using pg8::Unit;
#define EPI_ARGS const pg8::f32x4 (&acc)[2][2][4][2], const Unit& u, int wr, int wc, int fr, int fq

struct EpiMod {
    float* MOD; bf16* SH; const float* b_ada;
    __device__ __forceinline__ void operator()(EPI_ARGS) const { asm volatile("" ::: "memory");
        const int cl = wc * 32 + 8 * fq, c0 = u.pn * 256 + cl;
        const int pl = u.pn % 24, lay = u.pn / 24;
        const int np = (pl < 4) ? 2 * lay : ((pl >= 12 && pl < 16) ? 2 * lay + 1 : -1);
        const int j0 = (pl < 4 ? pl : pl - 12) * 256 + cl;
        f32x4 bv[2][2];
#pragma unroll
        for (int bj = 0; bj < 2; ++bj)
#pragma unroll
            for (int n = 0; n < 2; ++n) bv[bj][n] = *(const f32x4*)(b_ada + c0 + bj * 128 + 4 * n);
#pragma unroll
        for (int ai = 0; ai < 2; ++ai)
#pragma unroll
            for (int m = 0; m < 4; ++m) { const int row = ai * 128 + wr * 64 + m * 16 + fr;
#pragma unroll
                for (int bj = 0; bj < 2; ++bj) { const f32x4 v0 = acc[ai][bj][m][0] + bv[bj][0], v1 = acc[ai][bj][m][1] + bv[bj][1];
                    float* p = MOD + (size_t)row * NMOD + c0 + bj * 128; *(f32x4*)p = v0; *(f32x4*)(p + 4) = v1;
                    if (np >= 0) { v4u w; w.x = pk2(v0[0], v0[1]); w.y = pk2(v0[2], v0[3]); w.z = pk2(v1[0], v1[1]); w.w = pk2(v1[2], v1[3]);
                        *(v4u*)(SH + ((size_t)np * 256 + row) * D + j0 + bj * 128) = w; } } }
    }
};
struct EpiBias {
    float* BIAS;
    __device__ __forceinline__ void operator()(EPI_ARGS) const { asm volatile("" ::: "memory");
        const int lo = u.pm == 0 ? 0 : u.pm == 1 ? 8 : u.pm == 2 ? 30 : 35, hi = u.pm == 0 ? 8 : u.pm == 1 ? 30 : u.pm == 2 ? 35 : 57;
        if (u.pn < lo || u.pn >= hi) return;
        const int c0 = u.pn * 256 + wc * 32 + 8 * fq;
#pragma unroll
        for (int ai = 0; ai < 2; ++ai)
#pragma unroll
            for (int m = 0; m < 4; ++m) { const int row = ai * 128 + wr * 64 + m * 16 + fr;
#pragma unroll
                for (int bj = 0; bj < 2; ++bj) { float* p = BIAS + (size_t)row * NBIG + c0 + bj * 128; *(f32x4*)p = acc[ai][bj][m][0]; *(f32x4*)(p + 4) = acc[ai][bj][m][1]; } }
    }
};
struct EpiAin {
    const float* SSQ0; const float* BIAS; bf16* U; bf16* V; float* SSQV;
    __device__ __forceinline__ void operator()(EPI_ARGS) const { asm volatile("" ::: "memory");
        const int cl = wc * 32 + 8 * fq, c0 = u.pn * 256 + cl; const bool uni = u.pm < 64; const bool isv = u.pn >= 4;
        f32x4 bv[2][2];
        if (uni) { const float* b = BIAS + (size_t)(u.pm >> 5) * NBIG + OFF_WIN + c0;
#pragma unroll
            for (int bj = 0; bj < 2; ++bj)
#pragma unroll
                for (int n = 0; n < 2; ++n) bv[bj][n] = *(const f32x4*)(b + bj * 128 + 4 * n); }
#pragma unroll
        for (int ai = 0; ai < 2; ++ai)
#pragma unroll
            for (int m = 0; m < 4; ++m) { const int row = u.pm * 256 + ai * 128 + wr * 64 + m * 16 + fr;
                const float rs = rstd16(SSQ0 + (size_t)row * 16);
                if (!uni) { const float* b = BIAS + (size_t)seq_of(row) * NBIG + OFF_WIN + c0;
#pragma unroll
                    for (int bj = 0; bj < 2; ++bj)
#pragma unroll
                        for (int n = 0; n < 2; ++n) bv[bj][n] = *(const f32x4*)(b + bj * 128 + 4 * n); }
                float sq = 0.f;
#pragma unroll
                for (int bj = 0; bj < 2; ++bj) { f32x4 v0 = acc[ai][bj][m][0] * rs + bv[bj][0], v1 = acc[ai][bj][m][1] * rs + bv[bj][1];
#pragma unroll
                    for (int i = 0; i < 4; ++i) { v0[i] = gelu_t(v0[i]); v1[i] = gelu_t(v1[i]); sq += v0[i] * v0[i] + v1[i] * v1[i]; }
                    v4u w; w.x = pk2(v0[0], v0[1]); w.y = pk2(v0[2], v0[3]); w.z = pk2(v1[0], v1[1]); w.w = pk2(v1[2], v1[3]);
                    bf16* dst = isv ? V + (size_t)row * D + (c0 - 1024) + bj * 128 : U + (size_t)row * D + c0 + bj * 128;
                    *(v4u*)dst = w; }
                if (isv) { sq += __shfl_xor(sq, 16); sq += __shfl_xor(sq, 32); if (fq == 0) SSQV[(size_t)row * 16 + (u.pn - 4) * 4 + wc] = sq; } }
    }
};
struct EpiGU {
    const float* SSQ; const float* BIAS; int boff; bf16* HID;
    __device__ __forceinline__ void operator()(EPI_ARGS) const { asm volatile("" ::: "memory");
        const int cl = wc * 32 + 8 * fq, c0 = u.pn * 256 + cl; const bool uni = u.pm < 64;
        f32x4 bv[2][2];
        if (uni) { const float* b = BIAS + (size_t)(u.pm >> 5) * NBIG + boff + c0;
#pragma unroll
            for (int bj = 0; bj < 2; ++bj)
#pragma unroll
                for (int n = 0; n < 2; ++n) bv[bj][n] = *(const f32x4*)(b + bj * 128 + 4 * n); }
#pragma unroll
        for (int ai = 0; ai < 2; ++ai)
#pragma unroll
            for (int m = 0; m < 4; ++m) { const int row = u.pm * 256 + ai * 128 + wr * 64 + m * 16 + fr;
                const float rs = rstd16(SSQ + (size_t)row * 16);
                if (!uni) { const float* b = BIAS + (size_t)seq_of(row) * NBIG + boff + c0;
#pragma unroll
                    for (int bj = 0; bj < 2; ++bj)
#pragma unroll
                        for (int n = 0; n < 2; ++n) bv[bj][n] = *(const f32x4*)(b + bj * 128 + 4 * n); }
                float h[8];
#pragma unroll
                for (int n = 0; n < 2; ++n) { const f32x4 zg = acc[ai][0][m][n] * rs + bv[0][n], zu = acc[ai][1][m][n] * rs + bv[1][n];
#pragma unroll
                    for (int i = 0; i < 4; ++i) h[4 * n + i] = silu_f(zg[i]) * zu[i]; }
                v4u w; w.x = pk2(h[0], h[1]); w.y = pk2(h[2], h[3]); w.z = pk2(h[4], h[5]); w.w = pk2(h[6], h[7]);
                *(v4u*)(HID + (size_t)row * DFF + u.pn * 128 + cl) = w; }
    }
};
struct EpiRes {
    const float* xin_p; const float* xin_s;
    const float* MOD; int goff;
    float* out;
    const float* MUL; bf16* A1;
    const float* kvg; bf16* A2;
    float* SSQ;
    __device__ __forceinline__ void operator()(EPI_ARGS) const { asm volatile("" ::: "memory");
        const int cl = wc * 32 + 8 * fq, c0 = u.pn * 256 + cl; const bool uni = u.pm < 64;
        f32x4 gv[2][2], mv[2][2], kv[2][2];
        if (uni) { const int sq_ = u.pm >> 5;
#pragma unroll
            for (int bj = 0; bj < 2; ++bj)
#pragma unroll
                for (int n = 0; n < 2; ++n) { gv[bj][n] = *(const f32x4*)(MOD + (size_t)sq_ * NMOD + goff + c0 + bj * 128 + 4 * n);
                    if (A1) mv[bj][n] = *(const f32x4*)(MUL + (size_t)sq_ * D + c0 + bj * 128 + 4 * n); } }
        if (A2) {
#pragma unroll
            for (int bj = 0; bj < 2; ++bj)
#pragma unroll
                for (int n = 0; n < 2; ++n) kv[bj][n] = *(const f32x4*)(kvg + c0 + bj * 128 + 4 * n); }
#pragma unroll
        for (int ai = 0; ai < 2; ++ai)
#pragma unroll
            for (int m = 0; m < 4; ++m) { const int row = u.pm * 256 + ai * 128 + wr * 64 + m * 16 + fr;
                const bool real = row < MT;
                if (!uni) { const int sq_ = seq_of(row);
#pragma unroll
                    for (int bj = 0; bj < 2; ++bj)
#pragma unroll
                        for (int n = 0; n < 2; ++n) { gv[bj][n] = *(const f32x4*)(MOD + (size_t)sq_ * NMOD + goff + c0 + bj * 128 + 4 * n);
                            if (A1) mv[bj][n] = *(const f32x4*)(MUL + (size_t)sq_ * D + c0 + bj * 128 + 4 * n); } }
                const float* xr = uni ? xin_p + (size_t)row * D : xin_s + (size_t)(real ? row - MP : 0) * D;
                float sq = 0.f;
#pragma unroll
                for (int bj = 0; bj < 2; ++bj) { f32x4 x0 = *(const f32x4*)(xr + c0 + bj * 128), x1 = *(const f32x4*)(xr + c0 + bj * 128 + 4);
                    if (!real) { x0 = (f32x4){0.f, 0.f, 0.f, 0.f}; x1 = x0; }
                    x0 = x0 + gv[bj][0] * acc[ai][bj][m][0]; x1 = x1 + gv[bj][1] * acc[ai][bj][m][1];
                    if (real) { float* p = out + (size_t)row * D + c0 + bj * 128; *(f32x4*)p = x0; *(f32x4*)(p + 4) = x1; }
                    sq += (x0[0] * x0[0] + x0[1] * x0[1]) + (x0[2] * x0[2] + x0[3] * x0[3]) + (x1[0] * x1[0] + x1[1] * x1[1]) + (x1[2] * x1[2] + x1[3] * x1[3]);
                    if (A1) { const f32x4 a = x0 * mv[bj][0], b = x1 * mv[bj][1]; v4u w; w.x = pk2(a[0], a[1]); w.y = pk2(a[2], a[3]); w.z = pk2(b[0], b[1]); w.w = pk2(b[2], b[3]);
                        *(v4u*)(A1 + (size_t)row * D + c0 + bj * 128) = w; }
                    if (A2) { const f32x4 a = x0 * kv[bj][0], b = x1 * kv[bj][1]; v4u w; w.x = pk2(a[0], a[1]); w.y = pk2(a[2], a[3]); w.z = pk2(b[0], b[1]); w.w = pk2(b[2], b[3]);
                        *(v4u*)(A2 + (size_t)row * D + c0 + bj * 128) = w; } }
                if (SSQ) { sq += __shfl_xor(sq, 16); sq += __shfl_xor(sq, 32); if (fq == 0) SSQ[(size_t)row * 16 + u.pn * 4 + wc] = sq; } }
    }
};
struct EpiCmp {
    const float* C1; bf16* H2;
    __device__ __forceinline__ void operator()(EPI_ARGS) const { asm volatile("" ::: "memory");
        const int cl = wc * 32 + 8 * fq; const int kv = u.pm >= (RC_KV / 256) ? 1 : 0;
        f32x4 bv[2][2];
#pragma unroll
        for (int bj = 0; bj < 2; ++bj)
#pragma unroll
            for (int n = 0; n < 2; ++n) bv[bj][n] = *(const f32x4*)(C1 + kv * 256 + cl + bj * 128 + 4 * n);
#pragma unroll
        for (int ai = 0; ai < 2; ++ai)
#pragma unroll
            for (int m = 0; m < 4; ++m) { const size_t row = (size_t)u.pm * 256 + ai * 128 + wr * 64 + m * 16 + fr;
#pragma unroll
                for (int bj = 0; bj < 2; ++bj) { f32x4 v0 = acc[ai][bj][m][0] + bv[bj][0], v1 = acc[ai][bj][m][1] + bv[bj][1];
#pragma unroll
                    for (int i = 0; i < 4; ++i) { v0[i] = gelu_t(v0[i]); v1[i] = gelu_t(v1[i]); }
                    v4u w; w.x = pk2(v0[0], v0[1]); w.y = pk2(v0[2], v0[3]); w.z = pk2(v1[0], v1[1]); w.w = pk2(v1[2], v1[3]);
                    *(v4u*)(H2 + row * 256 + cl + bj * 128) = w; } }
    }
};
struct EpiKV {
    const float* SSQ; const float* kgains; const float* ROPE; float* out;
    bf16* RC; bf16* KS; bf16* KW; bf16* VST; bf16* VWT;
    __device__ __forceinline__ void operator()(EPI_ARGS) const { asm volatile("" ::: "memory");
        const int ty = u.pn, g = wc, d0 = 8 * fq; const bool isk = (ty == 2 || ty == 4);
        f32x4 kg[2][2];
        if (isk) {
#pragma unroll
            for (int bj = 0; bj < 2; ++bj)
#pragma unroll
                for (int n = 0; n < 2; ++n) kg[bj][n] = *(const f32x4*)(kgains + (ty == 2 ? 64 : 128) + 32 * bj + d0 + 4 * n); }
#pragma unroll
        for (int ai = 0; ai < 2; ++ai)
#pragma unroll
            for (int m = 0; m < 4; ++m) { const int row = u.pm * 256 + ai * 128 + wr * 64 + m * 16 + fr;
                const float rs = rstd16(SSQ + (size_t)row * 16);
                f32x4 v[2][2];
#pragma unroll
                for (int bj = 0; bj < 2; ++bj)
#pragma unroll
                    for (int n = 0; n < 2; ++n) v[bj][n] = acc[ai][bj][m][n] * rs;
                const bool prompt = row < MP; const int t = prompt ? (row & (SEQ - 1)) : PAST; const int b = row >> 13;
                if (isk) {
                    float sq = 0.f;
#pragma unroll
                    for (int bj = 0; bj < 2; ++bj)
#pragma unroll
                        for (int n = 0; n < 2; ++n) sq += (v[bj][n][0] * v[bj][n][0] + v[bj][n][1] * v[bj][n][1]) + (v[bj][n][2] * v[bj][n][2] + v[bj][n][3] * v[bj][n][3]);
                    sq += __shfl_xor(sq, 16); sq += __shfl_xor(sq, 32);
                    const float ri = rsqrtf(sq * (1.0f / 64.0f) + EPS);
#pragma unroll
                    for (int n = 0; n < 2; ++n) { const f32x4 cs = *(const f32x4*)(ROPE + (size_t)t * 64 + d0 + 4 * n), sn = *(const f32x4*)(ROPE + (size_t)t * 64 + 32 + d0 + 4 * n);
                        const f32x4 x1 = v[0][n] * ri * kg[0][n], x2 = v[1][n] * ri * kg[1][n];
                        v[0][n] = x1 * cs - x2 * sn; v[1][n] = x2 * cs + x1 * sn; }
                }
                float* fo = nullptr;
                if (prompt) {
                    if (ty < 4) fo = out + (ty == 0 ? O_CKP : ty == 1 ? O_CVP : ty == 2 ? O_SKP : O_SVP) + (size_t)row * 256;
                    else if (t >= SEQ - WIN) fo = out + (ty == 4 ? O_WKP : O_WVP) + ((size_t)b * WIN + (t - (SEQ - WIN))) * 256;
                } else if (row < MT) { const int s = row - MP;
                    if (ty < 4) fo = out + (ty == 0 ? O_CKS : ty == 1 ? O_CVS : ty == 2 ? O_SKS : O_SVS) + (size_t)s * 256;
                    else fo = out + (ty == 4 ? O_WKS : O_WVS) + ((size_t)s * WIN + (WIN - 1)) * 256; }
                if (fo) {
#pragma unroll
                    for (int bj = 0; bj < 2; ++bj) { float* p = fo + g * 64 + 32 * bj + d0; *(f32x4*)p = v[bj][0]; *(f32x4*)(p + 4) = v[bj][1]; } }
                if (prompt) { const int gam = b * 4 + g;
                    if (ty <= 1) { bf16* dst = RC + ((size_t)ty * RC_KV + RC_SAMP + (size_t)gam * 512 + (t >> 4)) * 1024 + (t & 15) * 64 + d0;
#pragma unroll
                        for (int bj = 0; bj < 2; ++bj) { v4u w; w.x = pk2(v[bj][0][0], v[bj][0][1]); w.y = pk2(v[bj][0][2], v[bj][0][3]); w.z = pk2(v[bj][1][0], v[bj][1][1]); w.w = pk2(v[bj][1][2], v[bj][1][3]); *(v4u*)(dst + 32 * bj) = w; }
                    } else if (isk) { bf16* dst = (ty == 2 ? KS : KW) + ((size_t)gam * SEQ + t) * 64 + d0;
#pragma unroll
                        for (int bj = 0; bj < 2; ++bj) { v4u w; w.x = pk2(v[bj][0][0], v[bj][0][1]); w.y = pk2(v[bj][0][2], v[bj][0][3]); w.z = pk2(v[bj][1][0], v[bj][1][1]); w.w = pk2(v[bj][1][2], v[bj][1][3]); *(v4u*)(dst + 32 * bj) = w; }
                    } else { const int kk_ = t & 63; bf16* dst = (ty == 3 ? VST : VWT) + ((size_t)gam * 128 + (t >> 6)) * 4096 + (32 * (kk_ >> 5) + 8 * ((kk_ & 15) >> 2) + 4 * ((kk_ >> 4) & 1) + (kk_ & 3));
#pragma unroll
                        for (int bj = 0; bj < 2; ++bj)
#pragma unroll
                            for (int n = 0; n < 2; ++n)
#pragma unroll
                                for (int i = 0; i < 4; ++i) dst[(32 * bj + d0 + 4 * n + i) * 64] = (bf16)(pk2(v[bj][n][i], 0.f) & 0xffffu); }
                }
            }
    }
};
struct EpiQ {
    const float* SSQ; const float* BIAS; const float* qgain; const float* ROPE; bf16* QN; bf16* QR; float* GATES;
    __device__ __forceinline__ void operator()(EPI_ARGS) const { asm volatile("" ::: "memory");
        const int cl = wc * 32 + 8 * fq, c0 = u.pn * 256 + cl, d0 = 8 * fq; const bool uni = u.pm < 64;
        f32x4 bv[2][2], qg[2][2];
        if (uni) { const float* b = BIAS + (size_t)(u.pm >> 5) * NBIG + OFF_Q + c0;
#pragma unroll
            for (int bj = 0; bj < 2; ++bj)
#pragma unroll
                for (int n = 0; n < 2; ++n) bv[bj][n] = *(const f32x4*)(b + bj * 128 + 4 * n); }
#pragma unroll
        for (int bj = 0; bj < 2; ++bj)
#pragma unroll
            for (int n = 0; n < 2; ++n) qg[bj][n] = *(const f32x4*)(qgain + 32 * bj + d0 + 4 * n);
#pragma unroll
        for (int ai = 0; ai < 2; ++ai)
#pragma unroll
            for (int m = 0; m < 4; ++m) { const int row = u.pm * 256 + ai * 128 + wr * 64 + m * 16 + fr;
                const float rs = rstd16(SSQ + (size_t)row * 16);
                if (!uni) { const float* b = BIAS + (size_t)seq_of(row) * NBIG + OFF_Q + c0;
#pragma unroll
                    for (int bj = 0; bj < 2; ++bj)
#pragma unroll
                        for (int n = 0; n < 2; ++n) bv[bj][n] = *(const f32x4*)(b + bj * 128 + 4 * n); }
                f32x4 v[2][2];
#pragma unroll
                for (int bj = 0; bj < 2; ++bj)
#pragma unroll
                    for (int n = 0; n < 2; ++n) v[bj][n] = acc[ai][bj][m][n] * rs + bv[bj][n];
                if (u.pn == 4) {
                    if (cl < 48) {
#pragma unroll
                        for (int n = 0; n < 2; ++n) { f32x4 s; for (int i = 0; i < 4; ++i) s[i] = sigmoid_f(v[0][n][i]); *(f32x4*)(GATES + (size_t)row * 48 + cl + 4 * n) = s; } }
                    continue; }
                const int t = row < MP ? (row & (SEQ - 1)) : PAST;
                float sq = 0.f;
#pragma unroll
                for (int bj = 0; bj < 2; ++bj)
#pragma unroll
                    for (int n = 0; n < 2; ++n) sq += (v[bj][n][0] * v[bj][n][0] + v[bj][n][1] * v[bj][n][1]) + (v[bj][n][2] * v[bj][n][2] + v[bj][n][3] * v[bj][n][3]);
                sq += __shfl_xor(sq, 16); sq += __shfl_xor(sq, 32);
                const float ri = rsqrtf(sq * (1.0f / 64.0f) + EPS) * C2;
                f32x4 r[2][2];
#pragma unroll
                for (int n = 0; n < 2; ++n) { const f32x4 cs = *(const f32x4*)(ROPE + (size_t)t * 64 + d0 + 4 * n), sn = *(const f32x4*)(ROPE + (size_t)t * 64 + 32 + d0 + 4 * n);
                    v[0][n] = v[0][n] * ri * qg[0][n]; v[1][n] = v[1][n] * ri * qg[1][n];
                    r[0][n] = v[0][n] * cs - v[1][n] * sn; r[1][n] = v[1][n] * cs + v[0][n] * sn; }
                const size_t o = (size_t)row * D + (u.pn * 4 + wc) * 64 + d0;
#pragma unroll
                for (int bj = 0; bj < 2; ++bj) { v4u w; w.x = pk2(v[bj][0][0], v[bj][0][1]); w.y = pk2(v[bj][0][2], v[bj][0][3]); w.z = pk2(v[bj][1][0], v[bj][1][1]); w.w = pk2(v[bj][1][2], v[bj][1][3]); *(v4u*)(QN + o + 32 * bj) = w;
                    v4u x; x.x = pk2(r[bj][0][0], r[bj][0][1]); x.y = pk2(r[bj][0][2], r[bj][0][3]); x.z = pk2(r[bj][1][0], r[bj][1][1]); x.w = pk2(r[bj][1][2], r[bj][1][3]); *(v4u*)(QR + o + 32 * bj) = x; }
            }
    }
};

#define MFMA16(a, b, c) __builtin_amdgcn_mfma_f32_16x16x32_bf16((a), (b), (c), 0, 0, 0)

__device__ __forceinline__ int wperm(int mode, int n) {
    if (mode == 1) { const int up = n >= DFF ? 1 : 0, j = n - up * DFF; return (j >> 7) * 256 + up * 128 + (j & 127); }
    if (mode == 2 || (mode == 3 && n < 1024)) { const int blk = n >> 8, g = (n >> 6) & 3, d = n & 63; return blk * 256 + 128 * (d >> 5) + 32 * g + (d & 31); }
    return n;
}
__device__ __forceinline__ void transpose_item(const float* W, int K, int N, bf16* WT, int row_off, int mode, LAS float* scr, int item, int lane) {
    const int nblk = (N + 31) >> 5, kb = item / nblk, nb = item - kb * nblk, k0 = 64 * kb, n0 = 32 * nb;
    const int nn = n0 + (lane & 31); const bool okn = nn < N;
#pragma unroll 8
    for (int i = 0; i < 32; ++i) { const int kk = 2 * i + (lane >> 5); scr[kk * 33 + (lane & 31)] = okn ? W[(size_t)(k0 + kk) * N + nn] : 0.f; }
    LDS_WAIT(); asm volatile("" ::: "memory");
    const int c = lane & 7;
#pragma unroll
    for (int j = 0; j < 4; ++j) { const int n = (lane >> 3) + 8 * j; const LAS float* s = scr + (8 * c) * 33 + n;
        v4u o; o.x = pk2(s[0 * 33], s[1 * 33]); o.y = pk2(s[2 * 33], s[3 * 33]); o.z = pk2(s[4 * 33], s[5 * 33]); o.w = pk2(s[6 * 33], s[7 * 33]);
        if (n0 + n < N) *(v4u*)(WT + (size_t)(row_off + wperm(mode, n0 + n)) * K + k0 + 8 * c) = o; }
    LDS_WAIT(); asm volatile("" ::: "memory");
}
#define TR_ITEMS(K, N) (((K) / 64) * (((N) + 31) / 32))

__device__ __forceinline__ void phase0(const Params& P, LAS unsigned char* lds, int tid, int lane, int wave) {
    unsigned char* ws = P.ws;
    const int gw = blockIdx.x * NWAVES + wave, ngw = gridDim.x * NWAVES, gtid = blockIdx.x * 512 + tid, ngt = gridDim.x * 512;
    LAS float* scr = (LAS float*)(lds + wave * 16384);
    constexpr int IT_ADA = TR_ITEMS(1024, 6144);
    for (int it = gw; it < 2 * IT_ADA; it += ngw) { const int l = it / IT_ADA, r = it - l * IT_ADA;
        transpose_item(P.in[11] + (size_t)l * 1024 * 6144, 1024, 6144, (bf16*)(ws + WS_WADA), l * 6144, 0, scr, r, lane); }
    for (int e = gtid; e < 256 * 128; e += ngt) { const int row = e >> 7, c8 = (e & 127) * 8; v4u o = {0u, 0u, 0u, 0u};
        if (row < 130) { const float* src = (row < 2 ? P.in[9] + row * 1024 : P.in[10] + (row - 2) * 1024) + c8; const f32x4 a = *(const f32x4*)src, b = *(const f32x4*)(src + 4);
            o.x = pk2(silu_f(a[0]), silu_f(a[1])); o.y = pk2(silu_f(a[2]), silu_f(a[3])); o.z = pk2(silu_f(b[0]), silu_f(b[1])); o.w = pk2(silu_f(b[2]), silu_f(b[3])); }
        *(v4u*)((bf16*)(ws + WS_SC) + (size_t)row * 1024 + c8) = o; }
    for (int e = gtid; e < SEQ * 32; e += ngt) { const int pos = e >> 5, i = e & 31; const float inv = powf(10000.0f, -(float)i / 32.0f); const float ang = (float)pos * inv; float s, c; sincosf(ang, &s, &c);
        float* R = (float*)(ws + WS_ROPE) + (size_t)pos * 64; R[i] = c; R[32 + i] = s; }
    for (int e = gtid; e < 8 * 128 * 128; e += ngt) { const int t = (e >> 7) & 127, s = e & 127; ((bf16*)(ws + WS_WSB))[e] = (bf16)(pk2(s <= t ? P.in[16][e] : 0.f, 0.f) & 0xffffu); }
    for (int e = gtid; e < (NQP - NQ) * 128; e += ngt) *(v4u*)((bf16*)(ws + WS_WBIG) + (size_t)(OFF_Q + NQ) * 1024 + (size_t)e * 8) = (v4u){0u, 0u, 0u, 0u};
    if (blockIdx.x < 16) { const int kv = blockIdx.x >> 3, cg = blockIdx.x & 7, kq = tid >> 5, c = tid & 31;
        const float* w1 = P.in[26] + (size_t)kv * 2048 * 256 + cg * 32 + c; const float* pe = P.in[25] + kv * 2048; float s = 0.f;
        for (int f = kq * 128; f < kq * 128 + 128; ++f) s += pe[f] * w1[(size_t)f * 256];
        LAS float* red = (LAS float*)(lds + 8448); red[kq * 32 + c] = s; __syncthreads();
        if (tid < 32) { float a = P.in[27][kv * 256 + cg * 32 + tid]; for (int k = 0; k < 16; ++k) a += red[k * 32 + tid]; ((float*)(ws + WS_C1))[kv * 256 + cg * 32 + tid] = a; }
        __syncthreads(); }
}
__device__ __forceinline__ void phase1_weights(const Params& P, LAS unsigned char* lds, int lane, int wave) {
    unsigned char* ws = P.ws;
    const int gw = blockIdx.x * NWAVES + wave, ngw = gridDim.x * NWAVES;
    LAS float* scr = (LAS float*)(lds + wave * 16384);
    constexpr int I0 = TR_ITEMS(1024, 2048), I1 = TR_ITEMS(1024, 5632), I2 = TR_ITEMS(1024, 1072), I3 = TR_ITEMS(1024, 1024), I4 = TR_ITEMS(2816, 1024), I5 = TR_ITEMS(1024, 1536), I6 = TR_ITEMS(2048, 256), I7 = TR_ITEMS(256, 64);
    constexpr int NIT = I0 + 2 * I1 + I2 + 2 * I3 + 2 * I4 + I5 + 2 * I6 + 2 * I7;
    bf16* WBIG = (bf16*)(ws + WS_WBIG);
    for (int it = gw; it < NIT; it += ngw) { int r = it;
        if (r < I0) { transpose_item(P.in[14], 1024, 2048, WBIG, OFF_WIN, 0, scr, r, lane); continue; } r -= I0;
        if (r < I1) { transpose_item(P.in[30], 1024, 5632, WBIG, OFF_GU0, 1, scr, r, lane); continue; } r -= I1;
        if (r < I1) { transpose_item(P.in[30] + (size_t)1024 * 5632, 1024, 5632, WBIG, OFF_GU1, 1, scr, r, lane); continue; } r -= I1;
        if (r < I2) { transpose_item(P.in[19], 1024, 1072, WBIG, OFF_Q, 3, scr, r, lane); continue; } r -= I2;
        if (r < I3) { transpose_item(P.in[18], 1024, 1024, (bf16*)(ws + WS_WOUT), 0, 0, scr, r, lane); continue; } r -= I3;
        if (r < I3) { transpose_item(P.in[21], 1024, 1024, (bf16*)(ws + WS_WBO), 0, 0, scr, r, lane); continue; } r -= I3;
        if (r < I4) { transpose_item(P.in[31], 2816, 1024, (bf16*)(ws + WS_WDN), 0, 0, scr, r, lane); continue; } r -= I4;
        if (r < I4) { transpose_item(P.in[31] + (size_t)2816 * 1024, 2816, 1024, (bf16*)(ws + WS_WDN) + (size_t)1024 * 2816, 0, 0, scr, r, lane); continue; } r -= I4;
        if (r < I5) { transpose_item(P.in[23], 1024, 1536, (bf16*)(ws + WS_WKV), 0, 2, scr, r, lane); continue; } r -= I5;
        if (r < I6) { transpose_item(P.in[26], 2048, 256, (bf16*)(ws + WS_W1C), 0, 0, scr, r, lane); continue; } r -= I6;
        if (r < I6) { transpose_item(P.in[26] + (size_t)2048 * 256, 2048, 256, (bf16*)(ws + WS_W1C) + (size_t)256 * 2048, 0, 0, scr, r, lane); continue; } r -= I6;
        if (r < I7) { transpose_item(P.in[28], 256, 64, (bf16*)(ws + WS_W2), 0, 0, scr, r, lane); continue; } r -= I7;
        transpose_item(P.in[28] + 256 * 64, 256, 64, (bf16*)(ws + WS_W2) + 64 * 256, 0, 0, scr, r, lane);
    }
}
__device__ __forceinline__ void phase2_tail(const Params& P, int tid, int lane, int wave) {
    unsigned char* ws = P.ws;
    const int gw = blockIdx.x * NWAVES + wave, ngw = gridDim.x * NWAVES, gtid = blockIdx.x * 512 + tid, ngt = gridDim.x * 512;
    const float* MOD = (const float*)(ws + WS_MOD); const float* ng = P.in[13];
    for (int e = gtid; e < 3 * 256 * 256; e += ngt) { const int np = e >> 16, sq = (e >> 8) & 255, c = (e & 255) * 4;
        const int lay = np == 0 ? 0 : 1, wh = np == 1 ? 0 : 1;
        const f32x4 g = *(const f32x4*)(ng + (lay * 2 + wh) * 1024 + c), sc = *(const f32x4*)(MOD + (size_t)sq * NMOD + lay * 6144 + (wh ? 4096 : 1024) + c);
        *(f32x4*)((float*)(ws + WS_MUL) + ((size_t)np * 256 + sq) * 1024 + c) = g * (sc + 1.0f); }
    float* SSQ0 = (float*)(ws + WS_SSQ); bf16* A0 = (bf16*)(ws + WS_ACTA);
    for (int r = gw; r < M65; r += ngw) {
        f32x4 v[4]; float s = 0.f;
        if (r < MT) { const float* x = (r < MP ? P.in[0] + (size_t)r * D : P.in[1] + (size_t)(r - MP) * D) + 4 * lane;
#pragma unroll
            for (int j = 0; j < 4; ++j) { v[j] = *(const f32x4*)(x + 256 * j); s += (v[j][0] * v[j][0] + v[j][1] * v[j][1]) + (v[j][2] * v[j][2] + v[j][3] * v[j][3]); }
        } else {
#pragma unroll
            for (int j = 0; j < 4; ++j) v[j] = (f32x4){0.f, 0.f, 0.f, 0.f}; }
        s = wave_sum(s);
        if (lane < 16) SSQ0[(size_t)r * 16 + lane] = lane == 0 ? s : 0.f;
        const int sq = seq_of(r);
#pragma unroll
        for (int j = 0; j < 4; ++j) { const int c = 4 * lane + 256 * j; const f32x4 g = *(const f32x4*)(ng + c), sc = *(const f32x4*)(MOD + (size_t)sq * NMOD + 1024 + c);
            const f32x4 a = v[j] * g * (sc + 1.0f); v2u w; w.x = pk2(a[0], a[1]); w.y = pk2(a[2], a[3]); *(v2u*)(A0 + (size_t)r * D + c) = w; }
    }
}
__device__ __forceinline__ void sample_prepass(const Params& P, int tid, int lane, int wave) {
    unsigned char* ws = P.ws;
    const int gw = blockIdx.x * NWAVES + wave, ngw = gridDim.x * NWAVES;
    const int* pt = (const int*)P.in[8]; bf16* RC = (bf16*)(ws + WS_RC);
    for (int it = gw; it < 2 * 128 * 16 * 4; it += ngw) { const int kv = it >> 13, sq = (it >> 6) & 127, p = (it >> 2) & 15, qtr = it & 3;
        const float* src = P.in[2 + kv] + (size_t)pt[sq * 16 + p] * (128 * 256) + qtr * 8192;
#pragma unroll
        for (int i0 = 0; i0 < 16; i0 += 8) { f32x4 a[8], b[8];
#pragma unroll
            for (int i = 0; i < 8; ++i) { const int e = ((i0 + i) * 64 + lane) * 8; a[i] = __builtin_nontemporal_load((const f32x4*)(src + e)); b[i] = __builtin_nontemporal_load((const f32x4*)(src + e + 4)); }
#pragma unroll
            for (int i = 0; i < 8; ++i) { const int e = ((i0 + i) * 64 + lane) * 8, tok = qtr * 32 + (e >> 8), g = (e >> 6) & 3, d = e & 63;
                v4u w; w.x = pk2(a[i][0], a[i][1]); w.y = pk2(a[i][2], a[i][3]); w.z = pk2(b[i][0], b[i][1]); w.w = pk2(b[i][2], b[i][3]);
                *(v4u*)(RC + ((size_t)kv * RC_KV + (size_t)(sq * 4 + g) * 128 + p * 8 + (tok >> 4)) * 1024 + (tok & 15) * 64 + d) = w; } } }
    for (int it = gw; it < 2 * 128 * 64; it += ngw) { const int kv = it >> 13, s = (it >> 6) & 127, c = it & 63;
        const f32x4* src = (const f32x4*)P.in[6 + kv] + (size_t)s * 32768 + 64; f32x4* dst = (f32x4*)(P.out + (kv ? O_WVS : O_WKS)) + (size_t)s * 32768;
        f32x4 v[8];
#pragma unroll
        for (int i = 0; i < 8; ++i) { const int e = c * 512 + i * 64 + lane; if (e < 32704) v[i] = __builtin_nontemporal_load(src + e); }
#pragma unroll
        for (int i = 0; i < 8; ++i) { const int e = c * 512 + i * 64 + lane; if (e < 32704) __builtin_nontemporal_store(v[i], dst + e); } }
}

__device__ __forceinline__ void skinny_core(const bf16* Arows  , int lda, int K, const bf16* Bt64  , LAS float* RED, int tid, int lane, int wave, float& s0, float& s1) {
    const int col = lane & 15, quad = lane >> 4;
    const int kw = K >> 3;
    const bf16* ap = Arows + (size_t)col * lda + wave * kw + 8 * quad;
    const bf16* bp = Bt64 + (size_t)col * K + wave * kw + 8 * quad;
    f32x4 acc[4];
#pragma unroll
    for (int ct = 0; ct < 4; ++ct) acc[ct] = (f32x4){0.f, 0.f, 0.f, 0.f};
#pragma unroll 4
    for (int k0 = 0; k0 < kw; k0 += 32) { const bf16x8 af = *(const bf16x8*)(ap + k0);
#pragma unroll
        for (int ct = 0; ct < 4; ++ct) { const bf16x8 bf = *(const bf16x8*)(bp + (size_t)ct * 16 * K + k0); acc[ct] = MFMA16(af, bf, acc[ct]); } }
#pragma unroll
    for (int ct = 0; ct < 4; ++ct)
#pragma unroll
        for (int r = 0; r < 4; ++r) RED[((wave * 4 + ct) * 4 + r) * 64 + lane] = acc[ct][r];
    __syncthreads();
    const int r16 = tid >> 5, c2 = (tid & 31) * 2;
    const int base = ((c2 >> 4) * 4 + (r16 & 3)) * 64 + (c2 & 15) + 16 * (r16 >> 2);
    s0 = 0.f; s1 = 0.f;
#pragma unroll
    for (int wv = 0; wv < 8; ++wv) { s0 += RED[wv * 1024 + base]; s1 += RED[wv * 1024 + base + 1]; }
    __syncthreads();
}
__device__ __forceinline__ float half_wave_sum(float v) { v += __shfl_xor(v, 1); v += __shfl_xor(v, 2); v += __shfl_xor(v, 4); v += __shfl_xor(v, 8); v += __shfl_xor(v, 16); return v; }
__device__ __forceinline__ void skinny_res(const bf16* A, int lda, int K, const bf16* Bt, const EpiRes& E, LAS unsigned char* lds, int tid, int lane, int wave) {
    for (int task = blockIdx.x; task < 8 * 16; task += gridDim.x) { const int rt = task >> 4, cg = task & 15;
        float s0, s1;
        skinny_core(A + (size_t)(MP + 16 * rt) * lda, lda, K, Bt + (size_t)(64 * cg) * K, (LAS float*)lds, tid, lane, wave, s0, s1);
        const int srow = 16 * rt + (tid >> 5), row = MP + srow, sq = 2 + srow, c = 64 * cg + (tid & 31) * 2;
        const f32x2 xi = *(const f32x2*)(E.xin_s + (size_t)srow * D + c), gt = *(const f32x2*)(E.MOD + (size_t)sq * NMOD + E.goff + c);
        const float x0 = xi[0] + gt[0] * s0, x1 = xi[1] + gt[1] * s1;
        *(f32x2*)(E.out + (size_t)row * D + c) = (f32x2){x0, x1};
        if (E.A1) { const f32x2 m = *(const f32x2*)(E.MUL + (size_t)sq * D + c); *(unsigned*)(E.A1 + (size_t)row * D + c) = pk2(x0 * m[0], x1 * m[1]); }
        if (E.A2) { const f32x2 m = *(const f32x2*)(E.kvg + c); *(unsigned*)(E.A2 + (size_t)row * D + c) = pk2(x0 * m[0], x1 * m[1]); }
        if (E.SSQ) { const float q = half_wave_sum(x0 * x0 + x1 * x1); if ((tid & 31) == 0) E.SSQ[(size_t)row * 16 + cg] = q; }
    }
}
__device__ __forceinline__ void skinny_ain(const bf16* A, const bf16* Bt, const EpiAin& E, LAS unsigned char* lds, int tid, int lane, int wave) {
    for (int task = blockIdx.x; task < 8 * 32; task += gridDim.x) { const int rt = task >> 5, cg = task & 31;
        float s0, s1;
        skinny_core(A + (size_t)(MP + 16 * rt) * D, D, D, Bt + (size_t)(64 * cg) * D, (LAS float*)lds, tid, lane, wave, s0, s1);
        const int srow = 16 * rt + (tid >> 5), row = MP + srow, sq = 2 + srow, c = 64 * cg + (tid & 31) * 2;
        const float rs = rstd16(E.SSQ0 + (size_t)row * 16);
        const f32x2 bv = *(const f32x2*)(E.BIAS + (size_t)sq * NBIG + OFF_WIN + c);
        const float g0 = gelu_t(s0 * rs + bv[0]), g1 = gelu_t(s1 * rs + bv[1]);
        if (cg < 16) *(unsigned*)(E.U + (size_t)row * D + c) = pk2(g0, g1);
        else { *(unsigned*)(E.V + (size_t)row * D + c - 1024) = pk2(g0, g1); const float q = half_wave_sum(g0 * g0 + g1 * g1); if ((tid & 31) == 0) E.SSQV[(size_t)row * 16 + (cg - 16)] = q; }
    }
}

__device__ __forceinline__ void phase_tokmix(const Params& P, LAS unsigned char* lds, int tid, int lane, int wave) {
    unsigned char* ws = P.ws;
    const bf16* U = (const bf16*)(ws + WS_U); const bf16* V = (const bf16*)(ws + WS_V); bf16* UM = (bf16*)(ws + WS_UM);
    const float* SSQV = (const float*)(ws + WS_SSQ) + (size_t)1 * M65 * 16; const bf16* WSB = (const bf16*)(ws + WS_WSB);
    const float* vgain = P.in[15]; const float* bs = P.in[17];
    LAS bf16* VT = (LAS bf16*)lds;
    const int col = lane & 15, quad = lane >> 4;
    for (int item = blockIdx.x; item < 1024; item += gridDim.x) { const int chunk = item >> 3, g = item & 7, r0 = chunk * 128;
        const bool lastc = (chunk & 63) == 63;
#pragma unroll
        for (int i = 0; i < 4; ++i) { const int e = tid + 512 * i, s = e >> 4, c8 = (e & 15) * 8; const int row = r0 + s;
            const float rs = rstd16(SSQV + (size_t)row * 16);
            const v4u w = *(const v4u*)(V + (size_t)row * D + g * 128 + c8);
            const f32x4 g0 = *(const f32x4*)(vgain + g * 128 + c8), g1 = *(const f32x4*)(vgain + g * 128 + c8 + 4);
            float x[8] = {bflo(w.x) * rs * g0[0], bfhi(w.x) * rs * g0[1], bflo(w.y) * rs * g0[2], bfhi(w.y) * rs * g0[3], bflo(w.z) * rs * g1[0], bfhi(w.z) * rs * g1[1], bflo(w.w) * rs * g1[2], bfhi(w.w) * rs * g1[3]};
#pragma unroll
            for (int k = 0; k < 8; ++k) VT[(c8 + k) * 136 + s] = (bf16)(pk2(x[k], 0.f) & 0xffffu);
            if (lastc) { float* av = P.out + O_AVP + ((size_t)(chunk >> 6) * 128 + s) * D + g * 128 + c8; *(f32x4*)av = (f32x4){x[0], x[1], x[2], x[3]}; *(f32x4*)(av + 4) = (f32x4){x[4], x[5], x[6], x[7]}; } }
        __syncthreads();
        f32x4 acc[8];
#pragma unroll
        for (int ct = 0; ct < 8; ++ct) acc[ct] = (f32x4){0.f, 0.f, 0.f, 0.f};
        const int t = 16 * wave + col;
        for (int ks = 0; ks <= (wave >> 1); ++ks) {
            const bf16x8 bfr = *(const bf16x8*)(WSB + ((size_t)g * 128 + t) * 128 + 32 * ks + 8 * quad);
#pragma unroll
            for (int ct = 0; ct < 8; ++ct) { const bf16x8 afr = *(const LAS bf16x8*)(VT + (16 * ct + col) * 136 + 32 * ks + 8 * quad); acc[ct] = MFMA16(afr, bfr, acc[ct]); } }
        const float bt = bs[g * 128 + t];
#pragma unroll
        for (int ct = 0; ct < 8; ++ct) { const size_t o = (size_t)(r0 + t) * D + g * 128 + 16 * ct + 4 * quad; const v2u uw = *(const v2u*)(U + o);
            v2u w; w.x = pk2(bflo(uw.x) * (acc[ct][0] + bt), bfhi(uw.x) * (acc[ct][1] + bt)); w.y = pk2(bflo(uw.y) * (acc[ct][2] + bt), bfhi(uw.y) * (acc[ct][3] + bt)); *(v2u*)(UM + o) = w; }
        __syncthreads();
    }
    const int gw = blockIdx.x * NWAVES + wave, ngw = gridDim.x * NWAVES;
    for (int r = MP + gw; r < M65; r += ngw) {
        const float rs = rstd16(SSQV + (size_t)r * 16);
#pragma unroll
        for (int j = 0; j < 4; ++j) { const int c = 4 * lane + 256 * j, g = c >> 7; v2u w = {0u, 0u};
            if (r < MT) { const v2u vw = *(const v2u*)(V + (size_t)r * D + c), uw = *(const v2u*)(U + (size_t)r * D + c); const f32x4 gn = *(const f32x4*)(vgain + c);
                const f32x4 vn = (f32x4){bflo(vw.x), bfhi(vw.x), bflo(vw.y), bfhi(vw.y)} * rs * gn;
                *(f32x4*)(P.out + O_AVS + (size_t)(r - MP) * D + c) = vn;
                const float w00 = P.in[16][g * 16384], b0 = bs[g * 128];
                w.x = pk2(bflo(uw.x) * (w00 * vn[0] + b0), bfhi(uw.x) * (w00 * vn[1] + b0)); w.y = pk2(bflo(uw.y) * (w00 * vn[2] + b0), bfhi(uw.y) * (w00 * vn[3] + b0)); }
            *(v2u*)(UM + (size_t)r * D + c) = w; } }
}

__device__ __forceinline__ void phase_w2(const Params& P, int lane, int wave) {
    unsigned char* ws = P.ws;
    const int gw = blockIdx.x * NWAVES + wave, ngw = gridDim.x * NWAVES;
    const bf16* H2 = (const bf16*)(ws + WS_H2); const bf16* W2 = (const bf16*)(ws + WS_W2);
    const int col = lane & 15, quad = lane >> 4;
    for (int task = gw; task < 2 * RC_KV / 16; task += ngw) { const int kv = task >= RC_KV / 16 ? 1 : 0; const int R0 = (task - kv * (RC_KV / 16)) * 16;
        const bool samp = R0 < RC_SAMP; const int gam = samp ? (R0 >> 7) : ((R0 - RC_SAMP) >> 9), i0 = samp ? (R0 & 127) : ((R0 - RC_SAMP) & 511);
        const bf16* hrow = H2 + ((size_t)kv * RC_KV + R0 + col) * 256 + 8 * quad; const bf16* wrow = W2 + (size_t)kv * 64 * 256 + (size_t)col * 256 + 8 * quad;
        f32x4 acc[4];
#pragma unroll
        for (int dt = 0; dt < 4; ++dt) acc[dt] = (f32x4){0.f, 0.f, 0.f, 0.f};
#pragma unroll
        for (int ks = 0; ks < 8; ++ks) { const bf16x8 hf = *(const bf16x8*)(hrow + 32 * ks);
#pragma unroll
            for (int dt = 0; dt < 4; ++dt) { const bf16x8 wf = *(const bf16x8*)(wrow + (size_t)dt * 16 * 256 + 32 * ks);
                acc[dt] = kv ? MFMA16(hf, wf, acc[dt]) : MFMA16(wf, hf, acc[dt]); } }
        const float* b2 = P.in[29] + kv * 64;
        if (!kv) {
            float sq = 0.f; f32x4 v[4];
#pragma unroll
            for (int dt = 0; dt < 4; ++dt) { v[dt] = acc[dt] + *(const f32x4*)(b2 + 16 * dt + 4 * quad); sq += (v[dt][0] * v[dt][0] + v[dt][1] * v[dt][1]) + (v[dt][2] * v[dt][2] + v[dt][3] * v[dt][3]); }
            sq += __shfl_xor(sq, 16); sq += __shfl_xor(sq, 32);
            const float ri = rsqrtf(sq * (1.0f / 64.0f) + EPS);
            bf16* dst = (samp ? (bf16*)(ws + WS_KCS) + ((size_t)gam * 128 + i0 + col) * 64 : (bf16*)(ws + WS_KCP) + ((size_t)gam * 512 + i0 + col) * 64) + 4 * quad;
#pragma unroll
            for (int dt = 0; dt < 4; ++dt) { const f32x4 kg = *(const f32x4*)(P.in[24] + 16 * dt + 4 * quad); const f32x4 o = v[dt] * ri * kg; v2u w; w.x = pk2(o[0], o[1]); w.y = pk2(o[2], o[3]); *(v2u*)(dst + 16 * dt) = w; }
        } else {
#pragma unroll
            for (int dt = 0; dt < 4; ++dt) { const int d = 16 * dt + col; const float bb = b2[d];
                const int ip = (i0 & ~63) + 32 * ((i0 >> 5) & 1) + 8 * quad + 4 * ((i0 >> 4) & 1);
                bf16* dst = (samp ? (bf16*)(ws + WS_VCTS) + (size_t)gam * 2 * 4096 : (bf16*)(ws + WS_VCTP) + (size_t)gam * 8 * 4096) + (size_t)(ip >> 6) * 4096 + d * 64 + (ip & 63);
                v2u w; w.x = pk2(acc[dt][0] + bb, acc[dt][1] + bb); w.y = pk2(acc[dt][2] + bb, acc[dt][3] + bb); *(v2u*)dst = w; }
        }
    }
}

#ifndef ATT_REP_P
#define ATT_REP_P 1
#endif
#ifndef ATT_REP_S
#define ATT_REP_S 1
#endif

__device__ __forceinline__ void load_k8(const bf16* kb, int lane, bf16x8 (&kf)[8]) {
    const int col = lane & 15, quad = lane >> 4;
#pragma unroll
    for (int kt = 0; kt < 4; ++kt) { const bf16* kp = kb + (size_t)(16 * kt + col) * 64 + 8 * quad; kf[2 * kt] = *(const bf16x8*)kp; kf[2 * kt + 1] = *(const bf16x8*)(kp + 32); }
}
__device__ __forceinline__ void load_vt8(const bf16* vtb, int pitch, int lane, bf16x8 (&vf)[8]) {
    const int col = lane & 15, quad = lane >> 4;
#pragma unroll
    for (int dt = 0; dt < 4; ++dt)
#pragma unroll
        for (int ks = 0; ks < 2; ++ks) vf[2 * dt + ks] = *(const bf16x8*)(vtb + (size_t)(16 * dt + col) * pitch + 32 * ks + 8 * quad);
}
__device__ __forceinline__ void select_topk(LAS float* imps, int cur, int lane, unsigned (&msk)[4]) {
    const int col = lane & 15, quad = lane >> 4, ql = col >> 2, hl = col & 3;
#pragma unroll
    for (int w = 0; w < 4; ++w) msk[w] = 0u;
    if (cur <= 15) { msk[0] = (2u << cur) - 1u; return; }
    asm volatile("s_waitcnt lgkmcnt(0)" ::: "memory");
    const int lq = hl + 4 * quad;
    unsigned key[8];
#pragma unroll
    for (int e = 0; e < 8; ++e) { const int sg = lq + 16 * e; const float v = imps[ql * 128 + sg]; key[e] = (sg >= 1 && sg <= cur - 2) ? ((__builtin_bit_cast(unsigned, v) & ~127u) | (unsigned)sg) : 0u; }
    for (int it = 0; it < 13; ++it) {
        unsigned mx = key[0];
#pragma unroll
        for (int e = 1; e < 8; ++e) mx = mx > key[e] ? mx : key[e];
        { unsigned o = dpp_xor1u(mx); mx = mx > o ? mx : o; o = dpp_xor2u(mx); mx = mx > o ? mx : o; o = (unsigned)__shfl_xor((int)mx, 16); mx = mx > o ? mx : o; o = (unsigned)__shfl_xor((int)mx, 32); mx = mx > o ? mx : o; }
        const unsigned sg = mx & 127u, bit = mx ? (1u << (sg & 31u)) : 0u, w = sg >> 5;
        msk[0] |= w == 0u ? bit : 0u; msk[1] |= w == 1u ? bit : 0u; msk[2] |= w == 2u ? bit : 0u; msk[3] |= w == 3u ? bit : 0u;
#pragma unroll
        for (int e = 0; e < 8; ++e) key[e] = key[e] == mx ? 0u : key[e];
    }
    msk[0] |= 1u;
#pragma unroll
    for (int k = 0; k < 2; ++k) { const unsigned sg = (unsigned)(cur - k), bit = 1u << (sg & 31u), w = sg >> 5;
        msk[0] |= w == 0u ? bit : 0u; msk[1] |= w == 1u ? bit : 0u; msk[2] |= w == 2u ? bit : 0u; msk[3] |= w == 3u ? bit : 0u; }
}

__device__ __forceinline__ void attn_cmp_select(const bf16* kc, const bf16* vct, int vpitch, bf16x8 qn0, bf16x8 qn1, int nvis, int nkt, int cur, float nref,
                                                LAS float* imps, int lane, f32x4 (&oc)[4], unsigned (&msk)[4]) {
    const int col = lane & 15, quad = lane >> 4, ql = col >> 2, hl = col & 3;
    const int nb = (nkt + 3) >> 2;
    float lsum = 0.f;
    {   bf16x8 kfA[8], kfB[8];
        if (nb > 0) load_k8(kc, lane, kfA);
        for (int blk = 0; blk < nb; ++blk) {
            if (blk + 1 < nb) load_k8(kc + (size_t)(blk + 1) * 4096, lane, kfB);
#pragma unroll
            for (int kt = 0; kt < 4; ++kt) { f32x4 s = {nref, nref, nref, nref}; s = MFMA16(kfA[2 * kt], qn0, s); s = MFMA16(kfA[2 * kt + 1], qn1, s);
#pragma unroll
                for (int r = 0; r < 4; ++r) lsum += (64 * blk + 16 * kt + 4 * quad + r < nvis) ? fexp2(s[r]) : 0.f; }
#pragma unroll
            for (int i = 0; i < 8; ++i) kfA[i] = kfB[i];
        } }
    float l = lsum + __shfl_xor(lsum, 16); l += __shfl_xor(l, 32);
    const float rl = l > 0.f ? 1.0f / l : 0.f;
#pragma unroll
    for (int dt = 0; dt < 4; ++dt) oc[dt] = (f32x4){0.f, 0.f, 0.f, 0.f};
    float carry = 0.f;
    {   bf16x8 kfA[8], kfB[8], vfA[8];
        if (nb > 0) load_k8(kc, lane, kfA);
        for (int blk = 0; blk < nb; ++blk) {
            load_vt8(vct + (size_t)blk * 4096, 64, lane, vfA);
            if (blk + 1 < nb) load_k8(kc + (size_t)(blk + 1) * 4096, lane, kfB);
            float pa[4][4];
#pragma unroll
            for (int kt = 0; kt < 4; ++kt) { f32x4 s = {nref, nref, nref, nref}; s = MFMA16(kfA[2 * kt], qn0, s); s = MFMA16(kfA[2 * kt + 1], qn1, s);
                float hs[4];
#pragma unroll
                for (int r = 0; r < 4; ++r) { const float p = (64 * blk + 16 * kt + 4 * quad + r < nvis) ? fexp2(s[r]) * rl : 0.f; pa[kt][r] = p; float h = p + dpp_xor1(p); h += dpp_xor2(h); hs[r] = h; }
                const float tot = (hs[0] + hs[1]) + (hs[2] + hs[3]);
                const float up = __shfl(hs[3], (lane + 48) & 63);
                const float prev = quad == 0 ? carry : up; carry = up;
                if (hl == 0) imps[ql * 128 + 16 * blk + 4 * kt + quad] = tot + prev; }
#pragma unroll
            for (int ks = 0; ks < 2; ++ks) { v4u pw; pw.x = pk2(pa[2 * ks][0], pa[2 * ks][1]); pw.y = pk2(pa[2 * ks][2], pa[2 * ks][3]); pw.z = pk2(pa[2 * ks + 1][0], pa[2 * ks + 1][1]); pw.w = pk2(pa[2 * ks + 1][2], pa[2 * ks + 1][3]);
                const bf16x8 pb = __builtin_bit_cast(bf16x8, pw);
#pragma unroll
                for (int dt = 0; dt < 4; ++dt) oc[dt] = MFMA16(vfA[2 * dt + ks], pb, oc[dt]); }
#pragma unroll
            for (int i = 0; i < 8; ++i) kfA[i] = kfB[i];
        } }
    select_topk(imps, cur, lane, msk);
}

__device__ __forceinline__ void tile_step(const bf16x8 (&kf)[8], const bf16x8 (&vf)[8], bf16x8 q0, bf16x8 q1, float cinit, bool masked, int kpos0, int lo, int hi, int lane, f32x4 (&o)[4], float& lsum) {
    const int quad = lane >> 4;
    f32x4 p[4];
#pragma unroll
    for (int kt = 0; kt < 4; ++kt) { f32x4 s = {cinit, cinit, cinit, cinit}; s = MFMA16(kf[2 * kt], q0, s); s = MFMA16(kf[2 * kt + 1], q1, s);
#pragma unroll
        for (int r = 0; r < 4; ++r) p[kt][r] = fexp2(s[r]); }
    if (masked) {
#pragma unroll
        for (int kt = 0; kt < 4; ++kt)
#pragma unroll
            for (int r = 0; r < 4; ++r) { const int kpos = kpos0 + 16 * kt + 4 * quad + r; p[kt][r] = (kpos >= lo && kpos <= hi) ? p[kt][r] : 0.f; } }
#pragma unroll
    for (int kt = 0; kt < 4; ++kt) lsum += (p[kt][0] + p[kt][1]) + (p[kt][2] + p[kt][3]);
#pragma unroll
    for (int ks = 0; ks < 2; ++ks) {
        v4u pw; pw.x = pk2(p[2 * ks][0], p[2 * ks][1]); pw.y = pk2(p[2 * ks][2], p[2 * ks][3]); pw.z = pk2(p[2 * ks + 1][0], p[2 * ks + 1][1]); pw.w = pk2(p[2 * ks + 1][2], p[2 * ks + 1][3]);
        const bf16x8 pb = __builtin_bit_cast(bf16x8, pw);
#pragma unroll
        for (int dt = 0; dt < 4; ++dt) o[dt] = MFMA16(vf[2 * dt + ks], pb, o[dt]); }
}

struct AttnRefs { float cmp, slc, win; };

constexpr int AT_RING = 0, AT_SLOT = 16384, AT_NS = 8;
static_assert(AT_NS * AT_SLOT <= RING_BYTES, "attention ring");
constexpr int AT_IMPS = RING_BYTES + 1024;
constexpr int AT_UNI = AT_IMPS + 8 * 2048, AT_LIST = AT_UNI + 256;
static_assert(AT_LIST + 256 <= LDS_BYTES, "attention LDS map");
#define AT_WAITV(n) asm volatile("s_waitcnt vmcnt(" #n ")" ::: "memory")
#define AT_RING_WAIT2(rem) do { const int r_ = (rem); if (r_ >= 6) AT_WAITV(12); else if (r_ == 5) AT_WAITV(10); else if (r_ == 4) AT_WAITV(8); else if (r_ == 3) AT_WAITV(6); else if (r_ == 2) AT_WAITV(4); else if (r_ == 1) AT_WAITV(2); else AT_WAITV(0); } while (0)
#define AT_RING_WAIT1(rem) do { const int r_ = (rem); if (r_ >= 6) AT_WAITV(6); else if (r_ == 5) AT_WAITV(5); else if (r_ == 4) AT_WAITV(4); else if (r_ == 3) AT_WAITV(3); else if (r_ == 2) AT_WAITV(2); else if (r_ == 1) AT_WAITV(1); else AT_WAITV(0); } while (0)

template <int BR>
__device__ __forceinline__ void attn_branch(const bf16* Kb, const bf16* Vb, LAS unsigned char* lds, int t0, int tb, int tq, int cur, float ref, float gate,
                                            const unsigned (&msk)[4], const unsigned (&un)[4], const unsigned (&uu)[4], bf16x8 q0, bf16x8 q1, int w, int lane, f32x4 (&o_fin)[4]) {
    const int col = lane & 15, quad = lane >> 4;
    int nblk, wlo = 0;
    unsigned c0 = uu[0], c1 = uu[1], c2 = uu[2], c3 = uu[3], p0 = uu[0], p1 = uu[1], p2 = uu[2], p3 = uu[3];
    if (BR == 0) nblk = __builtin_popcount(c0) + __builtin_popcount(c1) + __builtin_popcount(c2) + __builtin_popcount(c3);
    else { wlo = (t0 >= WIN ? t0 - WIN : 0) >> 6; nblk = cur - wlo + 1; }
    const size_t foff = (size_t)(16 * (w >> 1) + col) * 64 + 32 * (w & 1) + 8 * quad;
#define AT_BITNEXT(a, b, c, d, out) do { if (a) { out = __builtin_ctz(a); a &= a - 1u; } else if (b) { out = 32 + __builtin_ctz(b); b &= b - 1u; } else if (c) { out = 64 + __builtin_ctz(c); c &= c - 1u; } else { out = 96 + __builtin_ctz(d); d &= d - 1u; } } while (0)
#define AT_DMA(j) do { int sg_; if (BR == 0) AT_BITNEXT(p0, p1, p2, p3, sg_); else sg_ = wlo + (j); LAS unsigned char* sl_ = lds + AT_RING + ((j) & (AT_NS - 1)) * AT_SLOT + w * 1024; \
        __builtin_amdgcn_global_load_lds((const unsigned*)(Kb + (size_t)sg_ * 4096 + foff), (LAS unsigned*)sl_, 16, 0, 0); \
        __builtin_amdgcn_global_load_lds((const unsigned*)(Vb + (size_t)sg_ * 4096 + foff), (LAS unsigned*)(sl_ + 8192), 16, 0, 0); } while (0)
    f32x4 o[4]; float ls = 0.f;
#pragma unroll
    for (int dt = 0; dt < 4; ++dt) o[dt] = (f32x4){0.f, 0.f, 0.f, 0.f};
    asm volatile("s_waitcnt vmcnt(0)" ::: "memory");
    __builtin_amdgcn_s_barrier();
    asm volatile("" ::: "memory");
    for (int j = 0; j < AT_NS - 1; ++j) if (j < nblk) AT_DMA(j);
    for (int j = 0; j < nblk; ++j) {
        AT_RING_WAIT2(nblk - 1 - j);
        __builtin_amdgcn_s_barrier();
        asm volatile("" ::: "memory");
        if (j + AT_NS - 1 < nblk) AT_DMA(j + AT_NS - 1);
        int sg; if (BR == 0) AT_BITNEXT(c0, c1, c2, c3, sg); else sg = wlo + j;
        bool need, masked;
        if (BR == 0) { const int sw = sg >> 5; const unsigned wd = sw == 0 ? un[0] : sw == 1 ? un[1] : sw == 2 ? un[2] : un[3]; need = (wd >> (sg & 31)) & 1u; masked = sg == cur; }
        else { need = (64 * sg + 63 >= tb - WIN) && (64 * sg <= tb + 3); masked = (64 * sg + 63 > tb) || (64 * sg < tb + 3 - WIN); }
        if (need) {
            const LAS unsigned char* sl = lds + AT_RING + (j & (AT_NS - 1)) * AT_SLOT + lane * 16;
            bf16x8 kf[8], vf[8];
#pragma unroll
            for (int f = 0; f < 8; ++f) { kf[f] = *(const LAS bf16x8*)(sl + f * 1024); vf[f] = *(const LAS bf16x8*)(sl + 8192 + f * 1024); }
            float cinit = ref;
            if (BR == 0) { const int sw = sg >> 5; const unsigned mw = sw == 0 ? msk[0] : sw == 1 ? msk[1] : sw == 2 ? msk[2] : msk[3]; cinit = ((mw >> (sg & 31)) & 1u) ? ref : -1e30f; }
            tile_step(kf, vf, q0, q1, cinit, masked, 64 * sg, BR == 0 ? 0 : tq - WIN, tq, lane, o, ls);
        }
    }
#undef AT_BITNEXT
#undef AT_DMA
    ls += __shfl_xor(ls, 16); ls += __shfl_xor(ls, 32);
    const float sc = ls > 0.f ? gate / ls : 0.f;
#pragma unroll
    for (int dt = 0; dt < 4; ++dt) o_fin[dt] += o[dt] * sc;
}

__device__ __forceinline__ void attn_cmp_ring(const bf16* Kb, const bf16* Vb, LAS unsigned char* lds, bf16x8 qn0, bf16x8 qn1, int nvis, int nvt, int nb, int cur, float nref,
                                              LAS float* imps, int w, int lane, f32x4 (&oc)[4], unsigned (&msk)[4]) {
    const int col = lane & 15, quad = lane >> 4, ql = col >> 2, hl = col & 3;
    const size_t foff = (size_t)(16 * (w >> 1) + col) * 64 + 32 * (w & 1) + 8 * quad;
#define CR_DMAK(j) __builtin_amdgcn_global_load_lds((const unsigned*)(Kb + (size_t)(j) * 4096 + foff), (LAS unsigned*)(lds + AT_RING + ((j) & (AT_NS - 1)) * AT_SLOT + w * 1024), 16, 0, 0)
#define CR_DMAV(j) __builtin_amdgcn_global_load_lds((const unsigned*)(Vb + (size_t)(j) * 4096 + foff), (LAS unsigned*)(lds + AT_RING + ((j) & (AT_NS - 1)) * AT_SLOT + 8192 + w * 1024), 16, 0, 0)
    float lsum = 0.f;
    asm volatile("s_waitcnt vmcnt(0)" ::: "memory"); __builtin_amdgcn_s_barrier(); asm volatile("" ::: "memory");
    for (int j = 0; j < AT_NS - 1; ++j) if (j < nb) CR_DMAK(j);
    for (int j = 0; j < nb; ++j) {
        AT_RING_WAIT1(nb - 1 - j);
        __builtin_amdgcn_s_barrier(); asm volatile("" ::: "memory");
        if (j + AT_NS - 1 < nb) CR_DMAK(j + AT_NS - 1);
        if (64 * j < nvt) {
            const LAS unsigned char* sl = lds + AT_RING + (j & (AT_NS - 1)) * AT_SLOT + lane * 16;
#pragma unroll
            for (int kt = 0; kt < 4; ++kt) { const bf16x8 k0 = *(const LAS bf16x8*)(sl + (2 * kt) * 1024), k1 = *(const LAS bf16x8*)(sl + (2 * kt + 1) * 1024);
                f32x4 s = {nref, nref, nref, nref}; s = MFMA16(k0, qn0, s); s = MFMA16(k1, qn1, s);
#pragma unroll
                for (int r = 0; r < 4; ++r) lsum += (64 * j + 16 * kt + 4 * quad + r < nvis) ? fexp2(s[r]) : 0.f; } }
    }
    float l = lsum + __shfl_xor(lsum, 16); l += __shfl_xor(l, 32);
    const float rl = l > 0.f ? 1.0f / l : 0.f;
#pragma unroll
    for (int dt = 0; dt < 4; ++dt) oc[dt] = (f32x4){0.f, 0.f, 0.f, 0.f};
    float carry = 0.f;
    asm volatile("s_waitcnt vmcnt(0)" ::: "memory"); __builtin_amdgcn_s_barrier(); asm volatile("" ::: "memory");
    for (int j = 0; j < AT_NS - 1; ++j) if (j < nb) { CR_DMAK(j); CR_DMAV(j); }
    for (int j = 0; j < nb; ++j) {
        AT_RING_WAIT2(nb - 1 - j);
        __builtin_amdgcn_s_barrier(); asm volatile("" ::: "memory");
        if (j + AT_NS - 1 < nb) { CR_DMAK(j + AT_NS - 1); CR_DMAV(j + AT_NS - 1); }
        const LAS unsigned char* sl = lds + AT_RING + (j & (AT_NS - 1)) * AT_SLOT + lane * 16;
        float pa[4][4];
#pragma unroll
        for (int kt = 0; kt < 4; ++kt) { const bf16x8 k0 = *(const LAS bf16x8*)(sl + (2 * kt) * 1024), k1 = *(const LAS bf16x8*)(sl + (2 * kt + 1) * 1024);
            f32x4 s = {nref, nref, nref, nref}; s = MFMA16(k0, qn0, s); s = MFMA16(k1, qn1, s);
            float hs[4];
#pragma unroll
            for (int r = 0; r < 4; ++r) { const float p = (64 * j + 16 * kt + 4 * quad + r < nvis) ? fexp2(s[r]) * rl : 0.f; pa[kt][r] = p; float h = p + dpp_xor1(p); h += dpp_xor2(h); hs[r] = h; }
            const float tot = (hs[0] + hs[1]) + (hs[2] + hs[3]);
            const float up = __shfl(hs[3], (lane + 48) & 63);
            const float prev = quad == 0 ? carry : up; carry = up;
            if (hl == 0) imps[ql * 128 + 16 * j + 4 * kt + quad] = tot + prev; }
#pragma unroll
        for (int ks = 0; ks < 2; ++ks) { v4u pw; pw.x = pk2(pa[2 * ks][0], pa[2 * ks][1]); pw.y = pk2(pa[2 * ks][2], pa[2 * ks][3]); pw.z = pk2(pa[2 * ks + 1][0], pa[2 * ks + 1][1]); pw.w = pk2(pa[2 * ks + 1][2], pa[2 * ks + 1][3]);
            const bf16x8 pb = __builtin_bit_cast(bf16x8, pw);
#pragma unroll
            for (int dt = 0; dt < 4; ++dt) { const bf16x8 vfr = *(const LAS bf16x8*)(sl + 8192 + (2 * dt + ks) * 1024); oc[dt] = MFMA16(vfr, pb, oc[dt]); } }
    }
#undef CR_DMAK
#undef CR_DMAV
    select_topk(imps, cur, lane, msk);
}

__device__ __forceinline__ void attn_prompt_unit(const Params& P, int unit, const AttnRefs& rf, LAS unsigned char* lds, int lane, int wave) {
    unsigned char* ws = P.ws;
    const int w = wave;
    const int gam = unit & 7, pt32 = unit >> 3, b = gam >> 2, g = gam & 3, t0 = 32 * pt32, cur = t0 >> 6;
    const int col = lane & 15, quad = lane >> 4, ql = col >> 2, hl = col & 3;
    LAS unsigned* UNI = (LAS unsigned*)(lds + AT_UNI);
    LAS float* imps = (LAS float*)(lds + AT_IMPS) + wave * 512;
    const bf16* QN = (const bf16*)(ws + WS_QN); const bf16* QR = (const bf16*)(ws + WS_QR);
    const int tb = t0 + 4 * w, tq = tb + ql, row = b * SEQ + tq;
    const size_t qoff = (size_t)row * D + (4 * g + hl) * 64 + 8 * quad;
    const bf16x8 qn0 = *(const bf16x8*)(QN + qoff), qn1 = *(const bf16x8*)(QN + qoff + 32);
    const int nvis = tq >= 31 ? ((tq - 31) >> 4) + 1 : 0;
    const int nvu = (t0 + 31) >= 31 ? ((t0 + 31 - 31) >> 4) + 1 : 0, nb = (nvu + 63) >> 6;
    f32x4 o[4]; unsigned msk[4];
    attn_cmp_ring((const bf16*)(ws + WS_KCP) + (size_t)gam * 512 * 64, (const bf16*)(ws + WS_VCTP) + (size_t)gam * 8 * 4096, lds, qn0, qn1, nvis, (tb + 3) >= 31 ? ((tb + 3 - 31) >> 4) + 1 : 0, nb, cur, rf.cmp, imps, w, lane, o, msk);
    const float* gt = (const float*)(ws + WS_GATES) + (size_t)row * 48 + (4 * g + hl) * 3;
    const float g0 = gt[0], g1 = gt[1], g2 = gt[2];
#pragma unroll
    for (int dt = 0; dt < 4; ++dt) o[dt] = o[dt] * g0;
    unsigned un[4];
#pragma unroll
    for (int k = 0; k < 4; ++k) { unsigned u = msk[k]; u |= (unsigned)__shfl_xor((int)u, 4); u |= (unsigned)__shfl_xor((int)u, 8); un[k] = (unsigned)__builtin_amdgcn_readfirstlane((int)u); }
    if (lane == 0) *(LAS v4u*)(UNI + w * 4) = (v4u){un[0], un[1], un[2], un[3]};
    __syncthreads();
    unsigned uu[4];
#pragma unroll
    for (int k = 0; k < 4; ++k) { unsigned x = 0u;
#pragma unroll
        for (int t = 0; t < 8; ++t) x |= UNI[4 * t + k];
        uu[k] = (unsigned)__builtin_amdgcn_readfirstlane((int)x); }
    const bf16x8 qr0 = *(const bf16x8*)(QR + qoff), qr1 = *(const bf16x8*)(QR + qoff + 32);
    attn_branch<0>((const bf16*)(ws + WS_KS) + (size_t)gam * SEQ * 64, (const bf16*)(ws + WS_VST) + (size_t)gam * 128 * 4096, lds, t0, tb, tq, cur, rf.slc, g1, msk, un, uu, qr0, qr1, w, lane, o);
#ifdef ATT_REP_SLC
    attn_branch<0>((const bf16*)(ws + WS_KS) + (size_t)gam * SEQ * 64, (const bf16*)(ws + WS_VST) + (size_t)gam * 128 * 4096, lds, t0, tb, tq, cur, rf.slc, 0.f, msk, un, uu, qr0, qr1, w, lane, o);
#endif
    attn_branch<1>((const bf16*)(ws + WS_KW) + (size_t)gam * SEQ * 64, (const bf16*)(ws + WS_VWT) + (size_t)gam * 128 * 4096, lds, t0, tb, tq, cur, rf.win, g2, msk, un, uu, qr0, qr1, w, lane, o);
#ifdef ATT_REP_WIN
    attn_branch<1>((const bf16*)(ws + WS_KW) + (size_t)gam * SEQ * 64, (const bf16*)(ws + WS_VWT) + (size_t)gam * 128 * 4096, lds, t0, tb, tq, cur, rf.win, 0.f, msk, un, uu, qr0, qr1, w, lane, o);
#endif
    bf16* op = (bf16*)(ws + WS_O) + (size_t)row * D + (4 * g + hl) * 64 + 4 * quad;
#pragma unroll
    for (int dt = 0; dt < 4; ++dt) { v2u wv; wv.x = pk2(o[dt][0], o[dt][1]); wv.y = pk2(o[dt][2], o[dt][3]); *(v2u*)(op + 16 * dt) = wv; }
}

struct DecState { float m[4], l[4]; float o[4][16]; };
__device__ __forceinline__ void dec_job(const float* kbase, const float* vbase, int nkeys, const float (&qf)[4][16], DecState& st, int lane) {
    const int ksub = lane >> 2, dq = lane & 3;
#pragma unroll 1
    for (int k0 = 0; k0 < nkeys; k0 += 16) { const int key = k0 + ksub; const bool ok = key < nkeys;
        const float* kp = kbase + (size_t)key * 256 + 16 * dq; const float* vp = vbase + (size_t)key * 256 + 16 * dq;
        f32x4 k4[4], v4[4];
#pragma unroll
        for (int j = 0; j < 4; ++j) { k4[j] = ok ? *(const f32x4*)(kp + 4 * j) : (f32x4){0.f, 0.f, 0.f, 0.f}; v4[j] = ok ? *(const f32x4*)(vp + 4 * j) : (f32x4){0.f, 0.f, 0.f, 0.f}; }
#pragma unroll
        for (int h = 0; h < 4; ++h) { float d = 0.f;
#pragma unroll
            for (int j = 0; j < 4; ++j) d += (k4[j][0] * qf[h][4 * j] + k4[j][1] * qf[h][4 * j + 1]) + (k4[j][2] * qf[h][4 * j + 2] + k4[j][3] * qf[h][4 * j + 3]);
            d += dpp_xor1(d); d += dpp_xor2(d);
            const float sc = ok ? d : -1e30f, mn = fmaxf(st.m[h], sc), al = fexp2(st.m[h] - mn), p = ok ? fexp2(sc - mn) : 0.f;
            st.m[h] = mn; st.l[h] = st.l[h] * al + p;
#pragma unroll
            for (int j = 0; j < 4; ++j)
#pragma unroll
                for (int i = 0; i < 4; ++i) st.o[h][4 * j + i] = st.o[h][4 * j + i] * al + p * v4[j][i]; } }
}

__device__ __forceinline__ void attn_sample_item(const Params& P, int item, const AttnRefs& rf, LAS float* L, int tid, int lane, int wave) {
    unsigned char* ws = P.ws;
    const int s = item >> 2, g = item & 3, row = MP + s;
    LAS float* ocs = L; LAS unsigned* sel = (LAS unsigned*)(L + 256); LAS float* part = L + 260; LAS float* imps = L + 260 + 8 * 4 * 66;
    const float* gates = (const float*)(ws + WS_GATES) + (size_t)row * 48 + 4 * g * 3;
    if (wave == 0) {
        const int col = lane & 15, quad = lane >> 4, ql = col >> 2, hl = col & 3;
        const size_t qoff = (size_t)row * D + (4 * g + hl) * 64 + 8 * quad; const bf16* QN = (const bf16*)(ws + WS_QN);
        const bf16x8 qn0 = *(const bf16x8*)(QN + qoff), qn1 = *(const bf16x8*)(QN + qoff + 32);
        f32x4 oc[4]; unsigned msk[4];
        attn_cmp_select((const bf16*)(ws + WS_KCS) + (size_t)item * 128 * 64, (const bf16*)(ws + WS_VCTS) + (size_t)item * 2 * 4096, 64, qn0, qn1, 127, 8, 32, rf.cmp, imps, lane, oc, msk);
        const float g0 = gates[hl * 3];
        if (ql == 0) {
#pragma unroll
            for (int dt = 0; dt < 4; ++dt)
#pragma unroll
                for (int r = 0; r < 4; ++r) ocs[hl * 64 + 16 * dt + 4 * quad + r] = oc[dt][r] * g0; }
        if (lane == 0) sel[0] = msk[0];
    }
    __syncthreads();
    {
        const unsigned m0 = sel[0];
        const bool isw = wave >= 5;
        const int dq = lane & 3;
        float qf[4][16];
        const bf16* QR = (const bf16*)(ws + WS_QR) + (size_t)row * D + 4 * g * 64 + 16 * dq;
#pragma unroll
        for (int h = 0; h < 4; ++h) { const v4u a = *(const v4u*)(QR + h * 64), b = *(const v4u*)(QR + h * 64 + 8);
            qf[h][0] = bflo(a.x); qf[h][1] = bfhi(a.x); qf[h][2] = bflo(a.y); qf[h][3] = bfhi(a.y); qf[h][4] = bflo(a.z); qf[h][5] = bfhi(a.z); qf[h][6] = bflo(a.w); qf[h][7] = bfhi(a.w);
            qf[h][8] = bflo(b.x); qf[h][9] = bfhi(b.x); qf[h][10] = bflo(b.y); qf[h][11] = bfhi(b.y); qf[h][12] = bflo(b.z); qf[h][13] = bfhi(b.z); qf[h][14] = bflo(b.w); qf[h][15] = bfhi(b.w); }
        DecState st;
#pragma unroll
        for (int h = 0; h < 4; ++h) { st.m[h] = -1e30f; st.l[h] = 0.f;
#pragma unroll
            for (int i = 0; i < 16; ++i) st.o[h][i] = 0.f; }
        const int* pt = (const int*)P.in[8] + s * 16;
#pragma unroll 1
        for (int jj = 0; jj < 4; ++jj) { const float* kb; const float* vb; int nk = 64;
            if (!isw) { const int J = wave + 5 * jj; if (J > 15) break;
                if (J == 15) { kb = P.out + O_SKS + (size_t)s * 256 + g * 64; vb = P.out + O_SVS + (size_t)s * 256 + g * 64; nk = 1; }
                else { unsigned bits = m0; for (int i = 0; i < J; ++i) bits &= bits - 1u; const int sg = bits ? __builtin_ctz(bits) : 0;
                    const size_t base = ((size_t)pt[sg >> 1] * 128 + (sg & 1) * 64) * 256 + g * 64; kb = P.in[4] + base; vb = P.in[5] + base; }
            } else { const int J = (wave - 5) + 3 * jj; if (J > 8) break;
                if (J == 8) { const size_t base = ((size_t)s * WIN + (WIN - 1)) * 256 + g * 64; kb = P.out + O_WKS + base; vb = P.out + O_WVS + base; nk = 1; }
                else { const size_t base = ((size_t)s * WIN + 64 * J) * 256 + g * 64; kb = P.in[6] + base; vb = P.in[7] + base; } }
            dec_job(kb, vb, nk, qf, st, lane); }
#pragma unroll
        for (int h = 0; h < 4; ++h) { float M = st.m[h]; M = fmaxf(M, __shfl_xor(M, 4)); M = fmaxf(M, __shfl_xor(M, 8)); M = fmaxf(M, __shfl_xor(M, 16)); M = fmaxf(M, __shfl_xor(M, 32));
            const float f = fexp2(st.m[h] - M); st.m[h] = M; st.l[h] *= f;
#pragma unroll
            for (int i = 0; i < 16; ++i) st.o[h][i] *= f; }
#pragma unroll
        for (int h = 0; h < 4; ++h) { float l = st.l[h]; l += __shfl_xor(l, 4); l += __shfl_xor(l, 8); l += __shfl_xor(l, 16); l += __shfl_xor(l, 32); st.l[h] = l;
#pragma unroll
            for (int i = 0; i < 16; ++i) { float v = st.o[h][i]; v += __shfl_xor(v, 4); v += __shfl_xor(v, 8); v += __shfl_xor(v, 16); v += __shfl_xor(v, 32); st.o[h][i] = v; } }
        if (lane < 4) {
#pragma unroll
            for (int h = 0; h < 4; ++h) { LAS float* pp = part + (wave * 4 + h) * 66; if (lane == 0) { pp[0] = st.m[h]; pp[1] = st.l[h]; }
#pragma unroll
                for (int i = 0; i < 16; ++i) pp[2 + 16 * dq + i] = st.o[h][i]; } }
    }
    __syncthreads();
    if (tid < 256) { const int h = tid >> 6, d = tid & 63;
        float res = ocs[h * 64 + d];
#pragma unroll
        for (int br = 0; br < 2; ++br) { const int w0 = br ? 5 : 0, w1 = br ? 8 : 5; float M = -1e30f;
            for (int w = w0; w < w1; ++w) M = fmaxf(M, part[(w * 4 + h) * 66]);
            float Lt = 0.f, Ot = 0.f;
            for (int w = w0; w < w1; ++w) { const LAS float* pp = part + (w * 4 + h) * 66; const float f = fexp2(pp[0] - M); Lt += pp[1] * f; Ot += pp[2 + d] * f; }
            res += (Lt > 0.f ? Ot / Lt : 0.f) * gates[h * 3 + 1 + br]; }
        ((bf16*)(ws + WS_O))[(size_t)row * D + (4 * g + h) * 64 + d] = (bf16)(pk2(res, 0.f) & 0xffffu); }
    __syncthreads();
}

__device__ __forceinline__ void phase_attn(const Params& P, LAS unsigned char* lds, int tid, int lane, int wave) {
    float qg = fabsf(P.in[20][lane]), k0 = fabsf(P.in[24][lane]), k1 = fabsf(P.in[24][64 + lane]), k2 = fabsf(P.in[24][128 + lane]);
    qg = wave_max(qg); k0 = wave_max(k0); k1 = wave_max(k1); k2 = wave_max(k2);
    AttnRefs rf; rf.cmp = -8.0f * 1.4426950409f * qg * k0; rf.slc = -8.0f * 1.4426950409f * qg * k1; rf.win = -8.0f * 1.4426950409f * qg * k2;
    LAS float* L = (LAS float*)lds;
    for (int item = blockIdx.x; item < 512 * ATT_REP_S; item += gridDim.x) attn_sample_item(P, item & 511, rf, L, tid, lane, wave);
    __syncthreads();
    {
        for (int k = 0; k < 8 * ATT_REP_P; ++k) { const int kk = k & 7; const int u0 = blockIdx.x + gridDim.x * kk;
            const int gam = u0 & 7, p0 = u0 >> 3; const int pt32 = (kk & 1) ? (32 * kk + 31 - (p0 & 31)) : p0;
            attn_prompt_unit(P, pt32 * 8 + gam, rf, lds, lane, wave); } }
    const int gtid = blockIdx.x * 512 + tid, ngt = gridDim.x * 512;
    for (int e = gtid; e < (M65 - MT) * 128; e += ngt) *(v4u*)((bf16*)(P.ws + WS_O) + (size_t)MT * D + (size_t)e * 8) = (v4u){0u, 0u, 0u, 0u};
}

constexpr int NPHASE = 15;
__global__ void __launch_bounds__(NWAVES * 64, 2) fwd(Params P) {
    extern __shared__ __attribute__((aligned(16))) unsigned char lds_raw[];
    LAS unsigned char* lds = (LAS unsigned char*)lds_raw;
    const int tid = threadIdx.x, lane = tid & 63, wave = __builtin_amdgcn_readfirstlane(tid >> 6);
    const int G = gridDim.x;
    unsigned char* ws = P.ws;
    for (int u = tid; u < (LDS_BYTES - LDSCTL_OFF) / 4; u += NWAVES * 64) ((LAS unsigned*)(lds + LDSCTL_OFF))[u] = 0u;
    __syncthreads();
    XcdBarrier bar; bar.bar = (unsigned*)(ws + WS_CTL) + CW_BAR; bar.x = 0; bar.st = nullptr;
#if !MK_PER_PHASE
    bar = xcd_barrier_post((unsigned*)(ws + WS_CTL) + CW_BAR, (volatile LAS unsigned*)(lds + MISC_OFF) + 8);
#endif
    const int lo = P.ph_lo, hi = P.ph_hi;
#ifndef PH_MASK
#define PH_MASK 0x7fff
#endif
#define EN(k) (((PH_MASK) >> (k)) & 1)
#ifndef REP_MASK
#define REP_MASK 0
#endif
#define REPS(k) ((((REP_MASK) >> (k)) & 1) + 1)
#define IN(k) (lo <= (k) && (k) < hi)
#if MK_PER_PHASE
#define GRID_BAR(k) do { } while (0)
#else
#define GRID_BAR(k) do { if ((k) + 1 < hi) xcd_barrier(bar); } while (0)
#endif
    bf16* WBIG = (bf16*)(ws + WS_WBIG); bf16* ACTA = (bf16*)(ws + WS_ACTA); float* SSQ = (float*)(ws + WS_SSQ);
    float* MOD = (float*)(ws + WS_MOD); float* BIAS = (float*)(ws + WS_BIAS); float* ROPE = (float*)(ws + WS_ROPE);
    const size_t SSQ_STRIDE = (size_t)M65 * 16;

    if (EN(0) && IN(0)) { for (int rep_ = 0; rep_ < REPS(0); ++rep_) phase0(P, lds, tid, lane, wave); GRID_BAR(0); }
    if (EN(1) && IN(1)) {
        pg8::Gemm g{(const bf16*)(ws + WS_SC), (const bf16*)(ws + WS_WADA), 256, NMOD, 1024, 1024, 1 << 30, 0}; pg8::StaticOrder S; S.init(256, NMOD, G, (int)blockIdx.x);
        EpiMod E{MOD, (bf16*)(ws + WS_SH), P.in[12]};
        pg8::gemm_phase<EpiMod, true>(lds + RING_OFF, g, S, E);
        __syncthreads();
        for (int rep_ = 0; rep_ < REPS(18); ++rep_) phase1_weights(P, lds, lane, wave);
        GRID_BAR(1); }
    if (EN(2) && IN(2)) {
        pg8::Gemm g{(const bf16*)(ws + WS_SH), WBIG, 1024, NBIG, 1024, 1024, 1 << 30, 0}; pg8::StaticOrder S; S.init(1024, NBIG, G, (int)blockIdx.x);
        EpiBias E{BIAS};
        for (int rep_ = 0; rep_ < REPS(2); ++rep_) pg8::gemm_phase<EpiBias, true>(lds + RING_OFF, g, S, E);
        for (int rep_ = 0; rep_ < REPS(15); ++rep_) phase2_tail(P, tid, lane, wave);
        for (int rep_ = 0; rep_ < REPS(16); ++rep_) sample_prepass(P, tid, lane, wave);
        GRID_BAR(2); }
#define COMMON_PHASES(layer) do { \
        const int po = layer ? 12 : 5; \
        if (EN(5) && IN(po)) { \
            pg8::Gemm g{layer ? (const bf16*)(ws + WS_O) : (const bf16*)(ws + WS_UM), layer ? (const bf16*)(ws + WS_WBO) : (const bf16*)(ws + WS_WOUT), MP, 1024, 1024, 1024, 1 << 30, 0}; \
            pg8::StaticOrder S; S.init(MP, 1024, G, (int)blockIdx.x); \
            EpiRes E{layer ? P.out : P.in[0], layer ? P.out + (size_t)MP * D : P.in[1], MOD, layer * 6144 + 2048, P.out, (const float*)(ws + WS_MUL) + (size_t)(layer ? 2 : 0) * 256 * 1024, ACTA, nullptr, nullptr, SSQ + (layer ? 4 : 2) * SSQ_STRIDE}; \
            for (int rep_ = 0; rep_ < (layer ? 1 : REPS(5)); ++rep_) pg8::gemm_phase<EpiRes, true>(lds + RING_OFF, g, S, E); \
            skinny_res(g.A, 1024, 1024, g.Bt, E, lds, tid, lane, wave); \
            GRID_BAR(po); } \
        if (EN(6) && IN(po + 1)) { \
            const int off = layer ? OFF_GU1 : OFF_GU0; \
            pg8::Gemm g{ACTA, WBIG + (size_t)off * 1024, M65, NGU, 1024, 1024, 1 << 30, 0}; pg8::StaticOrder S; S.init(M65, NGU, G, (int)blockIdx.x); \
            EpiGU E{SSQ + (layer ? 4 : 2) * SSQ_STRIDE, BIAS, off, (bf16*)(ws + WS_HID)}; \
            for (int rep_ = 0; rep_ < (layer ? 1 : REPS(6)); ++rep_) pg8::gemm_phase<EpiGU, true>(lds + RING_OFF, g, S, E); \
            GRID_BAR(po + 1); } \
        if (EN(7) && IN(po + 2)) { \
            pg8::Gemm g{(const bf16*)(ws + WS_HID), (const bf16*)(ws + WS_WDN) + (size_t)layer * 1024 * DFF, MP, 1024, DFF, DFF, 1 << 30, 0}; pg8::StaticOrder S; S.init(MP, 1024, G, (int)blockIdx.x); \
            EpiRes E{P.out, P.out + (size_t)MP * D, MOD, layer * 6144 + 5120, P.out, (const float*)(ws + WS_MUL) + (size_t)256 * 1024, layer ? nullptr : ACTA, P.in[22], layer ? nullptr : (bf16*)(ws + WS_AKV), layer ? nullptr : SSQ + 3 * SSQ_STRIDE}; \
            pg8::gemm_phase<EpiRes, true>(lds + RING_OFF, g, S, E); \
            skinny_res(g.A, DFF, DFF, g.Bt, E, lds, tid, lane, wave); \
            GRID_BAR(po + 2); } \
    } while (0)
            if (EN(3) && IN(3)) {
                pg8::Gemm g{ACTA, WBIG + (size_t)OFF_WIN * 1024, MP, NAIN, 1024, 1024, 1 << 30, 0}; pg8::StaticOrder S; S.init(MP, NAIN, G, (int)blockIdx.x);
                EpiAin E{SSQ, BIAS, (bf16*)(ws + WS_U), (bf16*)(ws + WS_V), SSQ + SSQ_STRIDE};
                for (int rep_ = 0; rep_ < REPS(3); ++rep_) pg8::gemm_phase<EpiAin, true>(lds + RING_OFF, g, S, E);
                skinny_ain(ACTA, WBIG + (size_t)OFF_WIN * 1024, E, lds, tid, lane, wave);
                GRID_BAR(3); }
            if (EN(4) && IN(4)) { for (int rep_ = 0; rep_ < REPS(4); ++rep_) phase_tokmix(P, lds, tid, lane, wave); GRID_BAR(4); }
    COMMON_PHASES(0);
            if (EN(8) && IN(8)) {
                { pg8::Gemm g{(const bf16*)(ws + WS_AKV), (const bf16*)(ws + WS_WKV), M65, NKV, 1024, 1024, 1 << 30, 0}; pg8::StaticOrder S; S.init(M65, NKV, G, (int)blockIdx.x);
                  EpiKV E{SSQ + 3 * SSQ_STRIDE, P.in[24], ROPE, P.out, (bf16*)(ws + WS_RC), (bf16*)(ws + WS_KS), (bf16*)(ws + WS_KW), (bf16*)(ws + WS_VST), (bf16*)(ws + WS_VWT)};
                  for (int rep_ = 0; rep_ < REPS(8); ++rep_) pg8::gemm_phase<EpiKV, true>(lds + RING_OFF, g, S, E); }
                { pg8::Gemm g{ACTA, WBIG + (size_t)OFF_Q * 1024, M65, NQP, 1024, 1024, 1 << 30, 0}; pg8::StaticOrder S; S.init(M65, NQP, G, (int)((blockIdx.x + 128) % G));
                  EpiQ E{SSQ + 3 * SSQ_STRIDE, BIAS, P.in[20], ROPE, (bf16*)(ws + WS_QN), (bf16*)(ws + WS_QR), (float*)(ws + WS_GATES)};
                  for (int rep_ = 0; rep_ < REPS(17); ++rep_) pg8::gemm_phase<EpiQ, true>(lds + RING_OFF, g, S, E); }
                GRID_BAR(8); }
            if (EN(9) && IN(9)) {
                pg8::Gemm g{(const bf16*)(ws + WS_RC), (const bf16*)(ws + WS_W1C), 2 * RC_KV, 256, 2048, 1024, RC_KV / 256, (long)256 * 2048}; pg8::StaticOrder S; S.init(2 * RC_KV, 256, G, (int)blockIdx.x);
                EpiCmp E{(const float*)(ws + WS_C1), (bf16*)(ws + WS_H2)};
                for (int rep_ = 0; rep_ < REPS(9); ++rep_) pg8::gemm_phase<EpiCmp, true>(lds + RING_OFF, g, S, E);
                GRID_BAR(9); }
            if (EN(10) && IN(10)) { for (int rep_ = 0; rep_ < REPS(10); ++rep_) phase_w2(P, lane, wave); GRID_BAR(10); }
            if (EN(11) && IN(11)) { for (int rep_ = 0; rep_ < REPS(11); ++rep_) phase_attn(P, lds, tid, lane, wave); GRID_BAR(11); }
    COMMON_PHASES(1);
#undef IN
#undef EN
#undef REPS
#undef GRID_BAR
}

extern "C" void kernel_launch(void* const* d_in, const int* in_sizes, int n_in, void* d_out, int out_size, void* d_ws, size_t ws_size, hipStream_t stream) {
    static int grid = 0;
    if (grid == 0) {
        if (n_in != 32 || ws_size < WS_END) { fprintf(stderr, "kernel_launch: unexpected problem (n_in %d, ws %zu < %zu)\n", n_in, ws_size, (size_t)WS_END); grid = -1; return; }
        int dev = 0, cus = 0;
        if (hipGetDevice(&dev) != hipSuccess || hipDeviceGetAttribute(&cus, hipDeviceAttributeMultiprocessorCount, dev) != hipSuccess) { grid = -1; return; }
        if (hipFuncSetAttribute((const void*)fwd, hipFuncAttributeMaxDynamicSharedMemorySize, LDS_BYTES) != hipSuccess) { fprintf(stderr, "kernel_launch: hipFuncSetAttribute failed\n"); grid = -1; return; }
        int per_cu = 0;
        if (hipOccupancyMaxActiveBlocksPerMultiprocessor(&per_cu, (const void*)fwd, NWAVES * 64, LDS_BYTES) != hipSuccess || per_cu < 1) fprintf(stderr, "kernel_launch: occupancy query says %d\n", per_cu);
        (void)hipGetLastError();
        grid = cus;
    }
    if (grid < 0) return;
    (void)hipMemsetAsync((char*)d_ws + WS_CTL, 0, CTL_ZERO_BYTES, stream);
    Params p{};
    for (int i = 0; i < 32; ++i) p.in[i] = (const float*)d_in[i];
    p.out = (float*)d_out; p.ws = (unsigned char*)d_ws;
#if MK_PER_PHASE
    for (int k = 0; k < NPHASE; ++k) { p.ph_lo = k; p.ph_hi = k + 1; hipLaunchKernelGGL(fwd, dim3(grid), dim3(NWAVES * 64), LDS_BYTES, stream, p); }
#else
    p.ph_lo = 0; p.ph_hi = NPHASE;
    hipLaunchKernelGGL(fwd, dim3(grid), dim3(NWAVES * 64), LDS_BYTES, stream, p);
#endif
    const hipError_t le = hipPeekAtLastError();
    if (le != hipSuccess) fprintf(stderr, "kernel_launch: launch failed: %s\n", hipGetErrorName(le));
}
```

```cpp
#include <hip/hip_runtime.h>
#include <hip/hip_bf16.h>
#include <cstdio>
#include <cstdint>
#include <cmath>

#ifndef MK_PER_PHASE
#define MK_PER_PHASE 0
#endif

namespace pg8 {
#define PG8_LAS __attribute__((address_space(3)))
typedef unsigned short bf16_t;
typedef short bf16x8 __attribute__((ext_vector_type(8)));
typedef float f32x4 __attribute__((ext_vector_type(4)));
typedef unsigned u32x4 __attribute__((ext_vector_type(4)));
typedef unsigned u32x2 __attribute__((ext_vector_type(2)));
constexpr int BM = 256, BK = 64, HALF = 128, HTB = HALF * BK * 2, STAGE_BYTES = 8 * HTB, NXCD = 8, WGM = 8;

__host__ __device__ __forceinline__ int lds_byte(int r, int c) { const int st = (r >> 4) * 2 + (c >> 5), rr = r & 15, cc = c & 31, ob = rr * 64 + cc * 2; return st * 1024 + (ob ^ (((ob >> 9) & 1) << 5)); }
__host__ __device__ __forceinline__ void stage_rc(int b, int& R, int& C) { const int st = b / 1024, sb = b % 1024, swz = sb ^ (((sb >> 9) & 1) << 5); R = (st >> 1) * 16 + swz / 64; C = (st & 1) * 32 + (swz % 64) / 2; }
__host__ __device__ __forceinline__ int perm32(int rho) { const int n = rho >> 4, i = rho & 15; return 8 * (i >> 2) + 4 * n + (i & 3); }

struct Unit { int pm, pn; };
struct Gemm { const bf16_t* A; const bf16_t* Bt; int M, N, K, lda, bsplit; long boff; };

struct StaticOrder {
    int nM, nN, nwg, G, c;
    __host__ __device__ void init(int M, int N, int G_, int c_) { nM = M / BM; nN = N / BM; nwg = nM * nN; G = G_; c = c_; }
    __host__ __device__ bool next(int i, Unit& u) const {
        const long L = (long)i * G + c; if (L >= nwg) return false;
        int wgid = (int)L; { const int q = nwg / NXCD, r = nwg % NXCD, xcd = wgid % NXCD, off = wgid / NXCD; wgid = (xcd < r ? xcd * (q + 1) : r * (q + 1) + (xcd - r) * q) + off; }
        const int nig = WGM * nN, gid = wgid / nig, fm = gid * WGM, gsz = (nM - fm) < WGM ? (nM - fm) : WGM;
        u.pm = fm + ((wgid % nig) % gsz); u.pn = (wgid % nig) / gsz; return true;
    }
};

template <class Epi, bool ALIGN_EPI>
__device__ __forceinline__ void gemm_phase(PG8_LAS unsigned char* lds, const Gemm g, const StaticOrder& S, const Epi& E) {
    const int tid = threadIdx.x, wid = __builtin_amdgcn_readfirstlane(tid >> 6), lane = tid & 63, wr = wid >> 2, wc = wid & 3, fr = lane & 15, fq = lane >> 4;
    const int K = g.K, nt = K / BK, lda = g.lda;
    unsigned voffA[2], voffB[2];
#pragma unroll
    for (int i = 0; i < 2; ++i) { int R, C; stage_rc(tid * 16 + i * 8192, R, C); const int Rb = ((R & ~31) + perm32(R & 31));
        voffA[i] = (unsigned)(R * lda + C) * 2u; voffB[i] = (unsigned)(Rb * K + C) * 2u; }
    const size_t kstep = (size_t)(BK * 2);
    const size_t hstepA = (size_t)HALF * lda * 2, hstepB = (size_t)HALF * K * 2;
    const size_t tstepA = 2 * hstepA, tstepB = 2 * hstepB;
    const unsigned ldsw = (unsigned)wid * 1024u;
    const int aoff = lds_byte(wr * 64 + fr, fq * 8), boff = lds_byte(wc * 32 + fr, fq * 8);
#define PG8_SA(b, h) (((b) * 2 + (h)) * HTB)
#define PG8_SB(b, h) ((4 + (b) * 2 + (h)) * HTB)
#define PG8_STAGE(bufoff, gbase, voff) do { _Pragma("unroll") for (int _i = 0; _i < 2; ++_i) \
        __builtin_amdgcn_global_load_lds((const unsigned*)((const char*)(gbase) + (voff)[_i]), (PG8_LAS unsigned*)(lds + (bufoff) + ldsw + _i * 8192), 16, 0, 0); } while (0)
#define PG8_LDA(dst, b, h) do { _Pragma("unroll") for (int m = 0; m < 4; ++m) _Pragma("unroll") for (int k = 0; k < 2; ++k) dst[m][k] = *(const PG8_LAS bf16x8*)(lds + PG8_SA(b, h) + aoff + m * 2048 + k * 1024); } while (0)
#define PG8_LDB(dst, b, h) do { _Pragma("unroll") for (int n = 0; n < 2; ++n) _Pragma("unroll") for (int k = 0; k < 2; ++k) dst[n][k] = *(const PG8_LAS bf16x8*)(lds + PG8_SB(b, h) + boff + n * 2048 + k * 1024); } while (0)
#define PG8_MMA(ai, bj, At, Bt) do { __builtin_amdgcn_s_setprio(1); _Pragma("unroll") for (int m = 0; m < 4; ++m) _Pragma("unroll") for (int n = 0; n < 2; ++n) _Pragma("unroll") for (int k = 0; k < 2; ++k) \
        acc[ai][bj][m][n] = __builtin_amdgcn_mfma_f32_16x16x32_bf16(Bt[n][k], At[m][k], acc[ai][bj][m][n], 0, 0, 0); __builtin_amdgcn_s_setprio(0); } while (0)
#define PG8_WAIT_V(n) asm volatile("s_waitcnt vmcnt(" #n ")" ::: "memory")
#define PG8_WAIT_L(n) asm volatile("s_waitcnt lgkmcnt(" #n ")" ::: "memory")
#define PG8_BAR __builtin_amdgcn_s_barrier()
#define PG8_SCHED __builtin_amdgcn_sched_barrier(0)
    Unit cur, nxt; int ui = 0;
    if (!S.next(0, cur)) return;
    f32x4 acc[2][2][4][2];
#pragma unroll
    for (int a = 0; a < 2; ++a)
#pragma unroll
        for (int b = 0; b < 2; ++b)
#pragma unroll
            for (int m = 0; m < 4; ++m)
#pragma unroll
                for (int n = 0; n < 2; ++n) acc[a][b][m][n] = (f32x4){0.f, 0.f, 0.f, 0.f};
    bf16x8 At[4][2], B0[2][2], B1[2][2];
    const char* cA = (const char*)g.A + (size_t)cur.pm * tstepA;
    const char* cB = (const char*)g.Bt + (cur.pm >= g.bsplit ? (size_t)g.boff * 2 : (size_t)0) + (size_t)cur.pn * tstepB;
    PG8_STAGE(PG8_SB(0, 0), cB, voffB); PG8_STAGE(PG8_SB(0, 1), cB + hstepB, voffB); PG8_STAGE(PG8_SA(0, 0), cA, voffA); PG8_STAGE(PG8_SA(0, 1), cA + hstepA, voffA);
    if (wr == 1) PG8_BAR;
    PG8_WAIT_V(2); PG8_BAR;
    PG8_STAGE(PG8_SB(1, 0), cB + kstep, voffB); PG8_STAGE(PG8_SA(1, 0), cA + kstep, voffA); PG8_STAGE(PG8_SB(1, 1), cB + hstepB + kstep, voffB);
    PG8_WAIT_V(6); PG8_BAR;
    for (;;) {
        const bool has_next = S.next(ui + 1, nxt);
        const char* nA = has_next ? (const char*)g.A + (size_t)nxt.pm * tstepA : cA;
        const char* nB = has_next ? (const char*)g.Bt + (nxt.pm >= g.bsplit ? (size_t)g.boff * 2 : (size_t)0) + (size_t)nxt.pn * tstepB : cB;
        for (int t = 0; t < nt; t += 2) {
            const bool last = (t == nt - 2);
            const char* a1 = cA + (size_t)(t + 1) * kstep;
            const char* a2 = last ? nA : cA + (size_t)(t + 2) * kstep; const char* b2 = last ? nB : cB + (size_t)(t + 2) * kstep;
            const char* a3 = a2 + kstep; const char* b3 = b2 + kstep;
            PG8_LDB(B0, 0, 0); PG8_LDB(B1, 0, 1); PG8_SCHED; PG8_LDA(At, 0, 0); PG8_STAGE(PG8_SA(1, 1), a1 + hstepA, voffA);
            PG8_WAIT_V(8); PG8_WAIT_L(0); PG8_BAR; PG8_MMA(0, 0, At, B0); PG8_MMA(0, 1, At, B1); PG8_BAR; PG8_SCHED;
            PG8_LDA(At, 0, 1); PG8_STAGE(PG8_SB(0, 0), b2, voffB); PG8_STAGE(PG8_SB(0, 1), b2 + hstepB, voffB); PG8_STAGE(PG8_SA(0, 0), a2, voffA);
            PG8_WAIT_V(8); PG8_WAIT_L(0); PG8_BAR; PG8_MMA(1, 0, At, B0); PG8_MMA(1, 1, At, B1); PG8_BAR; PG8_SCHED;
            PG8_LDB(B0, 1, 0); PG8_LDB(B1, 1, 1); PG8_SCHED; PG8_LDA(At, 1, 0); PG8_STAGE(PG8_SA(0, 1), a2 + hstepA, voffA);
            PG8_WAIT_V(8); PG8_WAIT_L(0); PG8_BAR; PG8_MMA(0, 0, At, B0); PG8_MMA(0, 1, At, B1); PG8_BAR; PG8_SCHED;
            PG8_LDA(At, 1, 1); PG8_STAGE(PG8_SB(1, 0), b3, voffB); PG8_STAGE(PG8_SB(1, 1), b3 + hstepB, voffB); PG8_STAGE(PG8_SA(1, 0), a3, voffA);
            PG8_WAIT_V(8); PG8_WAIT_L(0); PG8_BAR; PG8_MMA(1, 0, At, B0); PG8_MMA(1, 1, At, B1); PG8_BAR; PG8_SCHED;
        }
        if constexpr (ALIGN_EPI) { if (wr == 0) PG8_BAR; }
        E(acc, cur, wr, wc, fr, fq);
        if (!has_next) break;
#pragma unroll
        for (int a = 0; a < 2; ++a)
#pragma unroll
            for (int b = 0; b < 2; ++b)
#pragma unroll
                for (int m = 0; m < 4; ++m)
#pragma unroll
                    for (int n = 0; n < 2; ++n) acc[a][b][m][n] = (f32x4){0.f, 0.f, 0.f, 0.f};
        cur = nxt; cA = nA; cB = nB; ++ui;
        if constexpr (ALIGN_EPI) { if (wr == 1) PG8_BAR; }
    }
    PG8_WAIT_V(0);
    if constexpr (!ALIGN_EPI) { if (wr == 0) PG8_BAR; }
    PG8_BAR;
#undef PG8_SA
#undef PG8_SB
#undef PG8_STAGE
#undef PG8_LDA
#undef PG8_LDB
#undef PG8_MMA
#undef PG8_WAIT_V
#undef PG8_WAIT_L
#undef PG8_BAR
#undef PG8_SCHED
}
}

#define GAS __attribute__((address_space(1)))
#define LAS __attribute__((address_space(3)))
typedef unsigned short bf16;
typedef unsigned v4u __attribute__((ext_vector_type(4)));
typedef unsigned v2u __attribute__((ext_vector_type(2)));
typedef float f32x4 __attribute__((ext_vector_type(4)));
typedef float f32x2 __attribute__((ext_vector_type(2)));
typedef short bf16x8 __attribute__((ext_vector_type(8)));
typedef short bf16x4 __attribute__((ext_vector_type(4)));
typedef __bf16 bf16x2_t __attribute__((ext_vector_type(2)));
typedef GAS unsigned gu32;
#define RLX_AGENT __ATOMIC_RELAXED, __HIP_MEMORY_SCOPE_AGENT
#define LDS_WAIT() asm volatile("s_waitcnt lgkmcnt(0)" ::: "memory")
#define VM_WAIT() asm volatile("s_waitcnt vmcnt(0)" ::: "memory")
__device__ __forceinline__ unsigned pk2(float lo, float hi) { f32x2 v = {lo, hi}; bf16x2_t b = __builtin_convertvector(v, bf16x2_t); return __builtin_bit_cast(unsigned, b); }
__device__ __forceinline__ float bf2f(unsigned short h) { return __builtin_bit_cast(float, (unsigned)h << 16); }
__device__ __forceinline__ float bflo(unsigned w) { return __builtin_bit_cast(float, w << 16); }
__device__ __forceinline__ float bfhi(unsigned w) { return __builtin_bit_cast(float, w & 0xffff0000u); }
__device__ __forceinline__ float fexp2(float x) { return __builtin_amdgcn_exp2f(x); }
__device__ __forceinline__ float frcp(float x) { return __builtin_amdgcn_rcpf(x); }
__device__ __forceinline__ float gelu_t(float x) { const float x2 = x * x; const float e = fexp2(x * (-2.302208198f + -0.1029432357f * x2)); return x * frcp(1.f + e); }
__device__ __forceinline__ float silu_f(float x) { return x * frcp(1.f + fexp2(-1.4426950409f * x)); }
__device__ __forceinline__ float sigmoid_f(float x) { return frcp(1.f + fexp2(-1.4426950409f * x)); }
__device__ __forceinline__ float dpp_xor1(float v) { return __builtin_bit_cast(float, __builtin_amdgcn_update_dpp(0, __builtin_bit_cast(int, v), 0xB1, 0xF, 0xF, true)); }
__device__ __forceinline__ float dpp_xor2(float v) { return __builtin_bit_cast(float, __builtin_amdgcn_update_dpp(0, __builtin_bit_cast(int, v), 0x4E, 0xF, 0xF, true)); }
__device__ __forceinline__ unsigned dpp_xor1u(unsigned v) { return (unsigned)__builtin_amdgcn_update_dpp(0, (int)v, 0xB1, 0xF, 0xF, true); }
__device__ __forceinline__ unsigned dpp_xor2u(unsigned v) { return (unsigned)__builtin_amdgcn_update_dpp(0, (int)v, 0x4E, 0xF, 0xF, true); }
__device__ __forceinline__ float wave_sum(float v) {
#pragma unroll
    for (int o = 1; o < 64; o <<= 1) v += __shfl_xor(v, o);
    return v;
}
__device__ __forceinline__ float wave_max(float v) {
#pragma unroll
    for (int o = 1; o < 64; o <<= 1) v = fmaxf(v, __shfl_xor(v, o));
    return v;
}

#define XB_TMO      128
#define XB_XCNT(j)  (256  + 64 * (j))
#define XB_XSUB(j)  (1280 + 64 * (j))
#define XB_XGEN(j)  (2304 + 64 * (j))
#define XB_TOP      3328
#define XB_TOPGEN   3392
#define XCD_BAR_WORDS 3456
#define XB_SPIN_CAP (1u << 18)

__device__ __forceinline__ unsigned xb_ld(unsigned* p)              { return __hip_atomic_load(p, __ATOMIC_RELAXED, __HIP_MEMORY_SCOPE_AGENT); }
__device__ __forceinline__ unsigned xb_add(unsigned* p, unsigned v) { return __hip_atomic_fetch_add(p, v, __ATOMIC_RELAXED, __HIP_MEMORY_SCOPE_AGENT); }
__device__ __forceinline__ unsigned xb_xcc_id() { return (unsigned)__builtin_amdgcn_s_getreg((3 << 11) | 20) & 0xFu; }
#define XB_SPIN(cond, bar) do { unsigned _sp = 0; while (cond) { __builtin_amdgcn_s_sleep(1); \
    if ((++_sp & 255u) == 0u) { if (xb_ld(&(bar)[XB_TMO])) break; if (_sp > XB_SPIN_CAP) { atomicAdd(&(bar)[XB_TMO], 1u); break; } } } } while (0)

struct XcdBarrier { unsigned* bar; unsigned x; volatile LAS unsigned* st; };

__device__ __forceinline__ XcdBarrier xcd_barrier_post(unsigned* bar, volatile LAS unsigned* st) {
    XcdBarrier b; b.bar = bar; b.x = xb_xcc_id(); b.st = st;
    if (threadIdx.x == 0) (void)xb_add(&bar[XB_XCNT(b.x)], 1u);
    return b;
}
__device__ __forceinline__ void xcd_barrier_complete(unsigned* bar, unsigned x, unsigned& nloc, unsigned& nx) {
    const unsigned G = gridDim.x * gridDim.y * gridDim.z;
    unsigned sum, cnt, mine, sp = 0u;
    for (;;) {
        sum = 0u; cnt = 0u; mine = 0u;
#pragma unroll
        for (unsigned j = 0; j < 16; ++j) { const unsigned c = xb_ld(&bar[XB_XCNT(j)]); sum += c; cnt += (c > 0u) ? 1u : 0u; mine = (j == x) ? c : mine; }
        if (sum == G) break;
        __builtin_amdgcn_s_sleep(1);
        if ((++sp & 255u) == 0u) { if (xb_ld(&bar[XB_TMO])) break; if (sp > XB_SPIN_CAP) { atomicAdd(&bar[XB_TMO], 1u); break; } }
    }
    nloc = mine > 0u ? mine : 1u; nx = cnt > 0u ? cnt : 1u;
}
__device__ __forceinline__ void xcd_barrier(const XcdBarrier& b) {
    asm volatile("s_waitcnt vmcnt(0)" ::: "memory");
    __syncthreads();
    if (threadIdx.x == 0) {
        unsigned* bar = b.bar;
        __builtin_amdgcn_s_waitcnt(0);
        unsigned nloc = b.st[0], nx = b.st[1];
        if (nloc == 0u) { xcd_barrier_complete(bar, b.x, nloc, nx); b.st[0] = nloc; b.st[1] = nx; }
        const unsigned old = xb_add(&bar[XB_XSUB(b.x)], 1u);
        const unsigned gen = old / nloc;
        if (old + 1u == (gen + 1u) * nloc) {
            __builtin_amdgcn_fence(__ATOMIC_RELEASE, "agent");
            asm volatile("s_waitcnt vmcnt(0)" ::: "memory");
            const unsigned og = xb_add(&bar[XB_TOP], 1u);
            const unsigned tg = og / nx;
            if (og + 1u == (tg + 1u) * nx) xb_add(&bar[XB_TOPGEN], 1u);
            else XB_SPIN(xb_ld(&bar[XB_TOPGEN]) == tg, bar);
            __builtin_amdgcn_fence(__ATOMIC_ACQUIRE, "agent");
            xb_add(&bar[XB_XGEN(b.x)], 1u);
            asm volatile("s_waitcnt vmcnt(0)" ::: "memory");
        } else {
            XB_SPIN(xb_ld(&bar[XB_XGEN(b.x)]) == gen, bar);
            __builtin_amdgcn_fence(__ATOMIC_ACQUIRE, "agent");
            asm volatile("s_waitcnt vmcnt(0)" ::: "memory");
        }
    }
    __syncthreads();
}

constexpr int NWAVES = 8;
constexpr int D = 1024, SEQ = 8192, NBATCH = 2, MP = NBATCH * SEQ, MS = 128, MT = MP + MS, M65 = 16640;
constexpr int DFF = 2816, NGU = 2 * DFF, NAIN = 2048, NKV = 1536, NQ = 1072, NQP = 1280;
constexpr int NBIG = NAIN + NGU + NQP + NGU;
constexpr int OFF_WIN = 0, OFF_GU0 = NAIN, OFF_Q = NAIN + NGU, OFF_GU1 = NAIN + NGU + NQP;
constexpr int NMOD = 12288;
constexpr int PAST = 2048, NPAGE = 16, PAGE = 128, WIN = 512;
constexpr int RC_SAMP = 512 * 128, RC_PROMPT = 8 * 512, RC_KV = RC_SAMP + RC_PROMPT;
constexpr float EPS = 1e-6f;
constexpr float C2 = 0.125f * 1.4426950408889634f;

constexpr size_t O_YP = 0, O_YS = 16777216, O_AVP = 16908288, O_AVS = 17170432, O_CKP = 17301504, O_CVP = 21495808, O_SKP = 25690112, O_SVP = 29884416,
                 O_WKP = 34078720, O_WVP = 34340864, O_CKS = 34603008, O_CVS = 34635776, O_SKS = 34668544, O_SVS = 34701312, O_WKS = 34734080, O_WVS = 51511296;

constexpr size_t al256(size_t x) { return (x + 255) & ~(size_t)255; }
constexpr size_t WS_CTL = 0, CTL_ZERO_BYTES = 1u << 20;
constexpr size_t WS_WADA = CTL_ZERO_BYTES;
constexpr size_t WS_WBIG = WS_WADA + (size_t)NMOD * D * 2;
constexpr size_t WS_WOUT = WS_WBIG + (size_t)NBIG * D * 2;
constexpr size_t WS_WBO = WS_WOUT + (size_t)D * D * 2;
constexpr size_t WS_WDN = WS_WBO + (size_t)D * D * 2;
constexpr size_t WS_WKV = WS_WDN + (size_t)2 * D * DFF * 2;
constexpr size_t WS_W1C = WS_WKV + (size_t)NKV * D * 2;
constexpr size_t WS_W2 = WS_W1C + (size_t)2 * 256 * 2048 * 2;
constexpr size_t WS_WSB = WS_W2 + (size_t)2 * 64 * 256 * 2;
constexpr size_t WS_ROPE = WS_WSB + (size_t)8 * 128 * 128 * 2;
constexpr size_t WS_C1 = WS_ROPE + (size_t)8192 * 64 * 4;
constexpr size_t WS_SC = WS_C1 + 2 * 256 * 4;
constexpr size_t WS_MOD = WS_SC + (size_t)256 * D * 2;
constexpr size_t WS_SH = WS_MOD + (size_t)256 * NMOD * 4;
constexpr size_t WS_BIAS = WS_SH + (size_t)4 * 256 * D * 2;
constexpr size_t WS_MUL = WS_BIAS + (size_t)256 * NBIG * 4;
constexpr size_t WS_SSQ = WS_MUL + (size_t)3 * 256 * D * 4;
constexpr size_t WS_ACTA = WS_SSQ + (size_t)5 * M65 * 16 * 4;
constexpr size_t ACT_BYTES = (size_t)M65 * D * 2;
constexpr size_t WS_AKV = WS_ACTA + ACT_BYTES;
constexpr size_t WS_U = WS_AKV + ACT_BYTES;
constexpr size_t WS_V = WS_U + ACT_BYTES;
constexpr size_t WS_UM = WS_V + ACT_BYTES;
constexpr size_t WS_QN = WS_UM + ACT_BYTES;
constexpr size_t WS_QR = WS_QN + ACT_BYTES;
constexpr size_t WS_O = WS_QR + ACT_BYTES;
constexpr size_t WS_GATES = WS_O + ACT_BYTES;
constexpr size_t WS_HID = WS_GATES + (size_t)M65 * 48 * 4;
constexpr size_t WS_KS = WS_HID + (size_t)M65 * DFF * 2;
constexpr size_t WS_KW = WS_KS + (size_t)8 * SEQ * 64 * 2;
constexpr size_t WS_VST = WS_KW + (size_t)8 * SEQ * 64 * 2;
constexpr size_t WS_VWT = WS_VST + (size_t)8 * SEQ * 64 * 2;
constexpr size_t WS_RC = WS_VWT + (size_t)8 * SEQ * 64 * 2;
constexpr size_t WS_H2 = WS_RC + (size_t)2 * RC_KV * 1024 * 2 + 4096;
constexpr size_t WS_KCP = WS_H2 + (size_t)2 * RC_KV * 256 * 2;
constexpr size_t WS_VCTP = WS_KCP + (size_t)8 * 512 * 64 * 2;
constexpr size_t WS_KCS = WS_VCTP + (size_t)8 * 512 * 64 * 2;
constexpr size_t WS_VCTS = WS_KCS + (size_t)512 * 128 * 64 * 2;
constexpr size_t WS_END = WS_VCTS + (size_t)512 * 128 * 64 * 2;
static_assert(WS_WBIG % 256 == 0 && WS_ROPE % 256 == 0 && WS_SC % 256 == 0 && WS_ACTA % 256 == 0 && WS_HID % 256 == 0 && WS_RC % 256 == 0 && WS_H2 % 256 == 0 && WS_KCP % 256 == 0, "ws alignment");
constexpr int CW_BAR = 4096;

constexpr int RING_OFF = 0, RING_BYTES = 131072;
constexpr int LDSCTL_OFF = RING_BYTES, MISC_OFF = LDSCTL_OFF + 320;
constexpr int LDS_BYTES = 163840;

struct Params {
    const float* in[32];
    float* out;
    unsigned char* ws;
    int ph_lo, ph_hi;
};

__device__ __forceinline__ int seq_of(int row) { const int s = row - MP + 2; return row < MP ? (row >> 13) : (s < 255 ? s : 255); }
__device__ __forceinline__ float rstd16(const float* p) {
    const f32x4 a = *(const f32x4*)p, b = *(const f32x4*)(p + 4), c = *(const f32x4*)(p + 8), d = *(const f32x4*)(p + 12);
    const float s = ((a.x + a.y) + (a.z + a.w)) + ((b.x + b.y) + (b.z + b.w)) + ((c.x + c.y) + (c.z + c.w)) + ((d.x + d.y) + (d.z + d.w));
    return rsqrtf(s * (1.0f / 1024.0f) + EPS);
}

using pg8::Unit;
#define EPI_ARGS const pg8::f32x4 (&acc)[2][2][4][2], const Unit& u, int wr, int wc, int fr, int fq

struct EpiMod {
    float* MOD; bf16* SH; const float* b_ada;
    __device__ __forceinline__ void operator()(EPI_ARGS) const { asm volatile("" ::: "memory");
        const int cl = wc * 32 + 8 * fq, c0 = u.pn * 256 + cl;
        const int pl = u.pn % 24, lay = u.pn / 24;
        const int np = (pl < 4) ? 2 * lay : ((pl >= 12 && pl < 16) ? 2 * lay + 1 : -1);
        const int j0 = (pl < 4 ? pl : pl - 12) * 256 + cl;
        f32x4 bv[2][2];
#pragma unroll
        for (int bj = 0; bj < 2; ++bj)
#pragma unroll
            for (int n = 0; n < 2; ++n) bv[bj][n] = *(const f32x4*)(b_ada + c0 + bj * 128 + 4 * n);
#pragma unroll
        for (int ai = 0; ai < 2; ++ai)
#pragma unroll
            for (int m = 0; m < 4; ++m) { const int row = ai * 128 + wr * 64 + m * 16 + fr;
#pragma unroll
                for (int bj = 0; bj < 2; ++bj) { const f32x4 v0 = acc[ai][bj][m][0] + bv[bj][0], v1 = acc[ai][bj][m][1] + bv[bj][1];
                    float* p = MOD + (size_t)row * NMOD + c0 + bj * 128; *(f32x4*)p = v0; *(f32x4*)(p + 4) = v1;
                    if (np >= 0) { v4u w; w.x = pk2(v0[0], v0[1]); w.y = pk2(v0[2], v0[3]); w.z = pk2(v1[0], v1[1]); w.w = pk2(v1[2], v1[3]);
                        *(v4u*)(SH + ((size_t)np * 256 + row) * D + j0 + bj * 128) = w; } } }
    }
};
struct EpiBias {
    float* BIAS;
    __device__ __forceinline__ void operator()(EPI_ARGS) const { asm volatile("" ::: "memory");
        const int lo = u.pm == 0 ? 0 : u.pm == 1 ? 8 : u.pm == 2 ? 30 : 35, hi = u.pm == 0 ? 8 : u.pm == 1 ? 30 : u.pm == 2 ? 35 : 57;
        if (u.pn < lo || u.pn >= hi) return;
        const int c0 = u.pn * 256 + wc * 32 + 8 * fq;
#pragma unroll
        for (int ai = 0; ai < 2; ++ai)
#pragma unroll
            for (int m = 0; m < 4; ++m) { const int row = ai * 128 + wr * 64 + m * 16 + fr;
#pragma unroll
                for (int bj = 0; bj < 2; ++bj) { float* p = BIAS + (size_t)row * NBIG + c0 + bj * 128; *(f32x4*)p = acc[ai][bj][m][0]; *(f32x4*)(p + 4) = acc[ai][bj][m][1]; } }
    }
};
struct EpiAin {
    const float* SSQ0; const float* BIAS; bf16* U; bf16* V; float* SSQV;
    __device__ __forceinline__ void operator()(EPI_ARGS) const { asm volatile("" ::: "memory");
        const int cl = wc * 32 + 8 * fq, c0 = u.pn * 256 + cl; const bool uni = u.pm < 64; const bool isv = u.pn >= 4;
        f32x4 bv[2][2];
        if (uni) { const float* b = BIAS + (size_t)(u.pm >> 5) * NBIG + OFF_WIN + c0;
#pragma unroll
            for (int bj = 0; bj < 2; ++bj)
#pragma unroll
                for (int n = 0; n < 2; ++n) bv[bj][n] = *(const f32x4*)(b + bj * 128 + 4 * n); }
#pragma unroll
        for (int ai = 0; ai < 2; ++ai)
#pragma unroll
            for (int m = 0; m < 4; ++m) { const int row = u.pm * 256 + ai * 128 + wr * 64 + m * 16 + fr;
                const float rs = rstd16(SSQ0 + (size_t)row * 16);
                if (!uni) { const float* b = BIAS + (size_t)seq_of(row) * NBIG + OFF_WIN + c0;
#pragma unroll
                    for (int bj = 0; bj < 2; ++bj)
#pragma unroll
                        for (int n = 0; n < 2; ++n) bv[bj][n] = *(const f32x4*)(b + bj * 128 + 4 * n); }
                float sq = 0.f;
#pragma unroll
                for (int bj = 0; bj < 2; ++bj) { f32x4 v0 = acc[ai][bj][m][0] * rs + bv[bj][0], v1 = acc[ai][bj][m][1] * rs + bv[bj][1];
#pragma unroll
                    for (int i = 0; i < 4; ++i) { v0[i] = gelu_t(v0[i]); v1[i] = gelu_t(v1[i]); sq += v0[i] * v0[i] + v1[i] * v1[i]; }
                    v4u w; w.x = pk2(v0[0], v0[1]); w.y = pk2(v0[2], v0[3]); w.z = pk2(v1[0], v1[1]); w.w = pk2(v1[2], v1[3]);
                    bf16* dst = isv ? V + (size_t)row * D + (c0 - 1024) + bj * 128 : U + (size_t)row * D + c0 + bj * 128;
                    *(v4u*)dst = w; }
                if (isv) { sq += __shfl_xor(sq, 16); sq += __shfl_xor(sq, 32); if (fq == 0) SSQV[(size_t)row * 16 + (u.pn - 4) * 4 + wc] = sq; } }
    }
};
struct EpiGU {
    const float* SSQ; const float* BIAS; int boff; bf16* HID;
    __device__ __forceinline__ void operator()(EPI_ARGS) const { asm volatile("" ::: "memory");
        const int cl = wc * 32 + 8 * fq, c0 = u.pn * 256 + cl; const bool uni = u.pm < 64;
        f32x4 bv[2][2];
        if (uni) { const float* b = BIAS + (size_t)(u.pm >> 5) * NBIG + boff + c0;
#pragma unroll
            for (int bj = 0; bj < 2; ++bj)
#pragma unroll
                for (int n = 0; n < 2; ++n) bv[bj][n] = *(const f32x4*)(b + bj * 128 + 4 * n); }
#pragma unroll
        for (int ai = 0; ai < 2; ++ai)
#pragma unroll
            for (int m = 0; m < 4; ++m) { const int row = u.pm * 256 + ai * 128 + wr * 64 + m * 16 + fr;
                const float rs = rstd16(SSQ + (size_t)row * 16);
                if (!uni) { const float* b = BIAS + (size_t)seq_of(row) * NBIG + boff + c0;
#pragma unroll
                    for (int bj = 0; bj < 2; ++bj)
#pragma unroll
                        for (int n = 0; n < 2; ++n) bv[bj][n] = *(const f32x4*)(b + bj * 128 + 4 * n); }
                float h[8];
#pragma unroll
                for (int n = 0; n < 2; ++n) { const f32x4 zg = acc[ai][0][m][n] * rs + bv[0][n], zu = acc[ai][1][m][n] * rs + bv[1][n];
#pragma unroll
                    for (int i = 0; i < 4; ++i) h[4 * n + i] = silu_f(zg[i]) * zu[i]; }
                v4u w; w.x = pk2(h[0], h[1]); w.y = pk2(h[2], h[3]); w.z = pk2(h[4], h[5]); w.w = pk2(h[6], h[7]);
                *(v4u*)(HID + (size_t)row * DFF + u.pn * 128 + cl) = w; }
    }
};
struct EpiRes {
    const float* xin_p; const float* xin_s;
    const float* MOD; int goff;
    float* out;
    const float* MUL; bf16* A1;
    const float* kvg; bf16* A2;
    float* SSQ;
    __device__ __forceinline__ void operator()(EPI_ARGS) const { asm volatile("" ::: "memory");
        const int cl = wc * 32 + 8 * fq, c0 = u.pn * 256 + cl; const bool uni = u.pm < 64;
        f32x4 gv[2][2], mv[2][2], kv[2][2];
        if (uni) { const int sq_ = u.pm >> 5;
#pragma unroll
            for (int bj = 0; bj < 2; ++bj)
#pragma unroll
                for (int n = 0; n < 2; ++n) { gv[bj][n] = *(const f32x4*)(MOD + (size_t)sq_ * NMOD + goff + c0 + bj * 128 + 4 * n);
                    if (A1) mv[bj][n] = *(const f32x4*)(MUL + (size_t)sq_ * D + c0 + bj * 128 + 4 * n); } }
        if (A2) {
#pragma unroll
            for (int bj = 0; bj < 2; ++bj)
#pragma unroll
                for (int n = 0; n < 2; ++n) kv[bj][n] = *(const f32x4*)(kvg + c0 + bj * 128 + 4 * n); }
#pragma unroll
        for (int ai = 0; ai < 2; ++ai)
#pragma unroll
            for (int m = 0; m < 4; ++m) { const int row = u.pm * 256 + ai * 128 + wr * 64 + m * 16 + fr;
                const bool real = row < MT;
                if (!uni) { const int sq_ = seq_of(row);
#pragma unroll
                    for (int bj = 0; bj < 2; ++bj)
#pragma unroll
                        for (int n = 0; n < 2; ++n) { gv[bj][n] = *(const f32x4*)(MOD + (size_t)sq_ * NMOD + goff + c0 + bj * 128 + 4 * n);
                            if (A1) mv[bj][n] = *(const f32x4*)(MUL + (size_t)sq_ * D + c0 + bj * 128 + 4 * n); } }
                const float* xr = uni ? xin_p + (size_t)row * D : xin_s + (size_t)(real ? row - MP : 0) * D;
                float sq = 0.f;
#pragma unroll
                for (int bj = 0; bj < 2; ++bj) { f32x4 x0 = *(const f32x4*)(xr + c0 + bj * 128), x1 = *(const f32x4*)(xr + c0 + bj * 128 + 4);
                    if (!real) { x0 = (f32x4){0.f, 0.f, 0.f, 0.f}; x1 = x0; }
                    x0 = x0 + gv[bj][0] * acc[ai][bj][m][0]; x1 = x1 + gv[bj][1] * acc[ai][bj][m][1];
                    if (real) { float* p = out + (size_t)row * D + c0 + bj * 128; *(f32x4*)p = x0; *(f32x4*)(p + 4) = x1; }
                    sq += (x0[0] * x0[0] + x0[1] * x0[1]) + (x0[2] * x0[2] + x0[3] * x0[3]) + (x1[0] * x1[0] + x1[1] * x1[1]) + (x1[2] * x1[2] + x1[3] * x1[3]);
                    if (A1) { const f32x4 a = x0 * mv[bj][0], b = x1 * mv[bj][1]; v4u w; w.x = pk2(a[0], a[1]); w.y = pk2(a[2], a[3]); w.z = pk2(b[0], b[1]); w.w = pk2(b[2], b[3]);
                        *(v4u*)(A1 + (size_t)row * D + c0 + bj * 128) = w; }
                    if (A2) { const f32x4 a = x0 * kv[bj][0], b = x1 * kv[bj][1]; v4u w; w.x = pk2(a[0], a[1]); w.y = pk2(a[2], a[3]); w.z = pk2(b[0], b[1]); w.w = pk2(b[2], b[3]);
                        *(v4u*)(A2 + (size_t)row * D + c0 + bj * 128) = w; } }
                if (SSQ) { sq += __shfl_xor(sq, 16); sq += __shfl_xor(sq, 32); if (fq == 0) SSQ[(size_t)row * 16 + u.pn * 4 + wc] = sq; } }
    }
};
struct EpiCmp {
    const float* C1; bf16* H2;
    __device__ __forceinline__ void operator()(EPI_ARGS) const { asm volatile("" ::: "memory");
        const int cl = wc * 32 + 8 * fq; const int kv = u.pm >= (RC_KV / 256) ? 1 : 0;
        f32x4 bv[2][2];
#pragma unroll
        for (int bj = 0; bj < 2; ++bj)
#pragma unroll
            for (int n = 0; n < 2; ++n) bv[bj][n] = *(const f32x4*)(C1 + kv * 256 + cl + bj * 128 + 4 * n);
#pragma unroll
        for (int ai = 0; ai < 2; ++ai)
#pragma unroll
            for (int m = 0; m < 4; ++m) { const size_t row = (size_t)u.pm * 256 + ai * 128 + wr * 64 + m * 16 + fr;
#pragma unroll
                for (int bj = 0; bj < 2; ++bj) { f32x4 v0 = acc[ai][bj][m][0] + bv[bj][0], v1 = acc[ai][bj][m][1] + bv[bj][1];
#pragma unroll
                    for (int i = 0; i < 4; ++i) { v0[i] = gelu_t(v0[i]); v1[i] = gelu_t(v1[i]); }
                    v4u w; w.x = pk2(v0[0], v0[1]); w.y = pk2(v0[2], v0[3]); w.z = pk2(v1[0], v1[1]); w.w = pk2(v1[2], v1[3]);
                    *(v4u*)(H2 + row * 256 + cl + bj * 128) = w; } }
    }
};
struct EpiKV {
    const float* SSQ; const float* kgains; const float* ROPE; float* out;
    bf16* RC; bf16* KS; bf16* KW; bf16* VST; bf16* VWT;
    __device__ __forceinline__ void operator()(EPI_ARGS) const { asm volatile("" ::: "memory");
        const int ty = u.pn, g = wc, d0 = 8 * fq; const bool isk = (ty == 2 || ty == 4);
        f32x4 kg[2][2];
        if (isk) {
#pragma unroll
            for (int bj = 0; bj < 2; ++bj)
#pragma unroll
                for (int n = 0; n < 2; ++n) kg[bj][n] = *(const f32x4*)(kgains + (ty == 2 ? 64 : 128) + 32 * bj + d0 + 4 * n); }
#pragma unroll
        for (int ai = 0; ai < 2; ++ai)
#pragma unroll
            for (int m = 0; m < 4; ++m) { const int row = u.pm * 256 + ai * 128 + wr * 64 + m * 16 + fr;
                const float rs = rstd16(SSQ + (size_t)row * 16);
                f32x4 v[2][2];
#pragma unroll
                for (int bj = 0; bj < 2; ++bj)
#pragma unroll
                    for (int n = 0; n < 2; ++n) v[bj][n] = acc[ai][bj][m][n] * rs;
                const bool prompt = row < MP; const int t = prompt ? (row & (SEQ - 1)) : PAST; const int b = row >> 13;
                if (isk) {
                    float sq = 0.f;
#pragma unroll
                    for (int bj = 0; bj < 2; ++bj)
#pragma unroll
                        for (int n = 0; n < 2; ++n) sq += (v[bj][n][0] * v[bj][n][0] + v[bj][n][1] * v[bj][n][1]) + (v[bj][n][2] * v[bj][n][2] + v[bj][n][3] * v[bj][n][3]);
                    sq += __shfl_xor(sq, 16); sq += __shfl_xor(sq, 32);
                    const float ri = rsqrtf(sq * (1.0f / 64.0f) + EPS);
#pragma unroll
                    for (int n = 0; n < 2; ++n) { const f32x4 cs = *(const f32x4*)(ROPE + (size_t)t * 64 + d0 + 4 * n), sn = *(const f32x4*)(ROPE + (size_t)t * 64 + 32 + d0 + 4 * n);
                        const f32x4 x1 = v[0][n] * ri * kg[0][n], x2 = v[1][n] * ri * kg[1][n];
                        v[0][n] = x1 * cs - x2 * sn; v[1][n] = x2 * cs + x1 * sn; }
                }
                float* fo = nullptr;
                if (prompt) {
                    if (ty < 4) fo = out + (ty == 0 ? O_CKP : ty == 1 ? O_CVP : ty == 2 ? O_SKP : O_SVP) + (size_t)row * 256;
                    else if (t >= SEQ - WIN) fo = out + (ty == 4 ? O_WKP : O_WVP) + ((size_t)b * WIN + (t - (SEQ - WIN))) * 256;
                } else if (row < MT) { const int s = row - MP;
                    if (ty < 4) fo = out + (ty == 0 ? O_CKS : ty == 1 ? O_CVS : ty == 2 ? O_SKS : O_SVS) + (size_t)s * 256;
                    else fo = out + (ty == 4 ? O_WKS : O_WVS) + ((size_t)s * WIN + (WIN - 1)) * 256; }
                if (fo) {
#pragma unroll
                    for (int bj = 0; bj < 2; ++bj) { float* p = fo + g * 64 + 32 * bj + d0; *(f32x4*)p = v[bj][0]; *(f32x4*)(p + 4) = v[bj][1]; } }
                if (prompt) { const int gam = b * 4 + g;
                    if (ty <= 1) { bf16* dst = RC + ((size_t)ty * RC_KV + RC_SAMP + (size_t)gam * 512 + (t >> 4)) * 1024 + (t & 15) * 64 + d0;
#pragma unroll
                        for (int bj = 0; bj < 2; ++bj) { v4u w; w.x = pk2(v[bj][0][0], v[bj][0][1]); w.y = pk2(v[bj][0][2], v[bj][0][3]); w.z = pk2(v[bj][1][0], v[bj][1][1]); w.w = pk2(v[bj][1][2], v[bj][1][3]); *(v4u*)(dst + 32 * bj) = w; }
                    } else if (isk) { bf16* dst = (ty == 2 ? KS : KW) + ((size_t)gam * SEQ + t) * 64 + d0;
#pragma unroll
                        for (int bj = 0; bj < 2; ++bj) { v4u w; w.x = pk2(v[bj][0][0], v[bj][0][1]); w.y = pk2(v[bj][0][2], v[bj][0][3]); w.z = pk2(v[bj][1][0], v[bj][1][1]); w.w = pk2(v[bj][1][2], v[bj][1][3]); *(v4u*)(dst + 32 * bj) = w; }
                    } else { const int kk_ = t & 63; bf16* dst = (ty == 3 ? VST : VWT) + ((size_t)gam * 128 + (t >> 6)) * 4096 + (32 * (kk_ >> 5) + 8 * ((kk_ & 15) >> 2) + 4 * ((kk_ >> 4) & 1) + (kk_ & 3));
#pragma unroll
                        for (int bj = 0; bj < 2; ++bj)
#pragma unroll
                            for (int n = 0; n < 2; ++n)
#pragma unroll
                                for (int i = 0; i < 4; ++i) dst[(32 * bj + d0 + 4 * n + i) * 64] = (bf16)(pk2(v[bj][n][i], 0.f) & 0xffffu); }
                }
            }
    }
};
struct EpiQ {
    const float* SSQ; const float* BIAS; const float* qgain; const float* ROPE; bf16* QN; bf16* QR; float* GATES;
    __device__ __forceinline__ void operator()(EPI_ARGS) const { asm volatile("" ::: "memory");
        const int cl = wc * 32 + 8 * fq, c0 = u.pn * 256 + cl, d0 = 8 * fq; const bool uni = u.pm < 64;
        f32x4 bv[2][2], qg[2][2];
        if (uni) { const float* b = BIAS + (size_t)(u.pm >> 5) * NBIG + OFF_Q + c0;
#pragma unroll
            for (int bj = 0; bj < 2; ++bj)
#pragma unroll
                for (int n = 0; n < 2; ++n) bv[bj][n] = *(const f32x4*)(b + bj * 128 + 4 * n); }
#pragma unroll
        for (int bj = 0; bj < 2; ++bj)
#pragma unroll
            for (int n = 0; n < 2; ++n) qg[bj][n] = *(const f32x4*)(qgain + 32 * bj + d0 + 4 * n);
#pragma unroll
        for (int ai = 0; ai < 2; ++ai)
#pragma unroll
            for (int m = 0; m < 4; ++m) { const int row = u.pm * 256 + ai * 128 + wr * 64 + m * 16 + fr;
                const float rs = rstd16(SSQ + (size_t)row * 16);
                if (!uni) { const float* b = BIAS + (size_t)seq_of(row) * NBIG + OFF_Q + c0;
#pragma unroll
                    for (int bj = 0; bj < 2; ++bj)
#pragma unroll
                        for (int n = 0; n < 2; ++n) bv[bj][n] = *(const f32x4*)(b + bj * 128 + 4 * n); }
                f32x4 v[2][2];
#pragma unroll
                for (int bj = 0; bj < 2; ++bj)
#pragma unroll
                    for (int n = 0; n < 2; ++n) v[bj][n] = acc[ai][bj][m][n] * rs + bv[bj][n];
                if (u.pn == 4) {
                    if (cl < 48) {
#pragma unroll
                        for (int n = 0; n < 2; ++n) { f32x4 s; for (int i = 0; i < 4; ++i) s[i] = sigmoid_f(v[0][n][i]); *(f32x4*)(GATES + (size_t)row * 48 + cl + 4 * n) = s; } }
                    continue; }
                const int t = row < MP ? (row & (SEQ - 1)) : PAST;
                float sq = 0.f;
#pragma unroll
                for (int bj = 0; bj < 2; ++bj)
#pragma unroll
                    for (int n = 0; n < 2; ++n) sq += (v[bj][n][0] * v[bj][n][0] + v[bj][n][1] * v[bj][n][1]) + (v[bj][n][2] * v[bj][n][2] + v[bj][n][3] * v[bj][n][3]);
                sq += __shfl_xor(sq, 16); sq += __shfl_xor(sq, 32);
                const float ri = rsqrtf(sq * (1.0f / 64.0f) + EPS) * C2;
                f32x4 r[2][2];
#pragma unroll
                for (int n = 0; n < 2; ++n) { const f32x4 cs = *(const f32x4*)(ROPE + (size_t)t * 64 + d0 + 4 * n), sn = *(const f32x4*)(ROPE + (size_t)t * 64 + 32 + d0 + 4 * n);
                    v[0][n] = v[0][n] * ri * qg[0][n]; v[1][n] = v[1][n] * ri * qg[1][n];
                    r[0][n] = v[0][n] * cs - v[1][n] * sn; r[1][n] = v[1][n] * cs + v[0][n] * sn; }
                const size_t o = (size_t)row * D + (u.pn * 4 + wc) * 64 + d0;
#pragma unroll
                for (int bj = 0; bj < 2; ++bj) { v4u w; w.x = pk2(v[bj][0][0], v[bj][0][1]); w.y = pk2(v[bj][0][2], v[bj][0][3]); w.z = pk2(v[bj][1][0], v[bj][1][1]); w.w = pk2(v[bj][1][2], v[bj][1][3]); *(v4u*)(QN + o + 32 * bj) = w;
                    v4u x; x.x = pk2(r[bj][0][0], r[bj][0][1]); x.y = pk2(r[bj][0][2], r[bj][0][3]); x.z = pk2(r[bj][1][0], r[bj][1][1]); x.w = pk2(r[bj][1][2], r[bj][1][3]); *(v4u*)(QR + o + 32 * bj) = x; }
            }
    }
};

#define MFMA16(a, b, c) __builtin_amdgcn_mfma_f32_16x16x32_bf16((a), (b), (c), 0, 0, 0)

__device__ __forceinline__ int wperm(int mode, int n) {
    if (mode == 1) { const int up = n >= DFF ? 1 : 0, j = n - up * DFF; return (j >> 7) * 256 + up * 128 + (j & 127); }
    if (mode == 2 || (mode == 3 && n < 1024)) { const int blk = n >> 8, g = (n >> 6) & 3, d = n & 63; return blk * 256 + 128 * (d >> 5) + 32 * g + (d & 31); }
    return n;
}
__device__ __forceinline__ void transpose_item(const float* W, int K, int N, bf16* WT, int row_off, int mode, LAS float* scr, int item, int lane) {
    const int nblk = (N + 31) >> 5, kb = item / nblk, nb = item - kb * nblk, k0 = 64 * kb, n0 = 32 * nb;
    const int nn = n0 + (lane & 31); const bool okn = nn < N;
#pragma unroll 8
    for (int i = 0; i < 32; ++i) { const int kk = 2 * i + (lane >> 5); scr[kk * 33 + (lane & 31)] = okn ? W[(size_t)(k0 + kk) * N + nn] : 0.f; }
    LDS_WAIT(); asm volatile("" ::: "memory");
    const int c = lane & 7;
#pragma unroll
    for (int j = 0; j < 4; ++j) { const int n = (lane >> 3) + 8 * j; const LAS float* s = scr + (8 * c) * 33 + n;
        v4u o; o.x = pk2(s[0 * 33], s[1 * 33]); o.y = pk2(s[2 * 33], s[3 * 33]); o.z = pk2(s[4 * 33], s[5 * 33]); o.w = pk2(s[6 * 33], s[7 * 33]);
        if (n0 + n < N) *(v4u*)(WT + (size_t)(row_off + wperm(mode, n0 + n)) * K + k0 + 8 * c) = o; }
    LDS_WAIT(); asm volatile("" ::: "memory");
}
#define TR_ITEMS(K, N) (((K) / 64) * (((N) + 31) / 32))

__device__ __forceinline__ void phase0(const Params& P, LAS unsigned char* lds, int tid, int lane, int wave) {
    unsigned char* ws = P.ws;
    const int gw = blockIdx.x * NWAVES + wave, ngw = gridDim.x * NWAVES, gtid = blockIdx.x * 512 + tid, ngt = gridDim.x * 512;
    LAS float* scr = (LAS float*)(lds + wave * 16384);
    constexpr int IT_ADA = TR_ITEMS(1024, 6144);
    for (int it = gw; it < 2 * IT_ADA; it += ngw) { const int l = it / IT_ADA, r = it - l * IT_ADA;
        transpose_item(P.in[11] + (size_t)l * 1024 * 6144, 1024, 6144, (bf16*)(ws + WS_WADA), l * 6144, 0, scr, r, lane); }
    for (int e = gtid; e < 256 * 128; e += ngt) { const int row = e >> 7, c8 = (e & 127) * 8; v4u o = {0u, 0u, 0u, 0u};
        if (row < 130) { const float* src = (row < 2 ? P.in[9] + row * 1024 : P.in[10] + (row - 2) * 1024) + c8; const f32x4 a = *(const f32x4*)src, b = *(const f32x4*)(src + 4);
            o.x = pk2(silu_f(a[0]), silu_f(a[1])); o.y = pk2(silu_f(a[2]), silu_f(a[3])); o.z = pk2(silu_f(b[0]), silu_f(b[1])); o.w = pk2(silu_f(b[2]), silu_f(b[3])); }
        *(v4u*)((bf16*)(ws + WS_SC) + (size_t)row * 1024 + c8) = o; }
    for (int e = gtid; e < SEQ * 32; e += ngt) { const int pos = e >> 5, i = e & 31; const float inv = powf(10000.0f, -(float)i / 32.0f); const float ang = (float)pos * inv; float s, c; sincosf(ang, &s, &c);
        float* R = (float*)(ws + WS_ROPE) + (size_t)pos * 64; R[i] = c; R[32 + i] = s; }
    for (int e = gtid; e < 8 * 128 * 128; e += ngt) { const int t = (e >> 7) & 127, s = e & 127; ((bf16*)(ws + WS_WSB))[e] = (bf16)(pk2(s <= t ? P.in[16][e] : 0.f, 0.f) & 0xffffu); }
    for (int e = gtid; e < (NQP - NQ) * 128; e += ngt) *(v4u*)((bf16*)(ws + WS_WBIG) + (size_t)(OFF_Q + NQ) * 1024 + (size_t)e * 8) = (v4u){0u, 0u, 0u, 0u};
    if (blockIdx.x < 16) { const int kv = blockIdx.x >> 3, cg = blockIdx.x & 7, kq = tid >> 5, c = tid & 31;
        const float* w1 = P.in[26] + (size_t)kv * 2048 * 256 + cg * 32 + c; const float* pe = P.in[25] + kv * 2048; float s = 0.f;
        for (int f = kq * 128; f < kq * 128 + 128; ++f) s += pe[f] * w1[(size_t)f * 256];
        LAS float* red = (LAS float*)(lds + 8448); red[kq * 32 + c] = s; __syncthreads();
        if (tid < 32) { float a = P.in[27][kv * 256 + cg * 32 + tid]; for (int k = 0; k < 16; ++k) a += red[k * 32 + tid]; ((float*)(ws + WS_C1))[kv * 256 + cg * 32 + tid] = a; }
        __syncthreads(); }
}
__device__ __forceinline__ void phase1_weights(const Params& P, LAS unsigned char* lds, int lane, int wave) {
    unsigned char* ws = P.ws;
    const int gw = blockIdx.x * NWAVES + wave, ngw = gridDim.x * NWAVES;
    LAS float* scr = (LAS float*)(lds + wave * 16384);
    constexpr int I0 = TR_ITEMS(1024, 2048), I1 = TR_ITEMS(1024, 5632), I2 = TR_ITEMS(1024, 1072), I3 = TR_ITEMS(1024, 1024), I4 = TR_ITEMS(2816, 1024), I5 = TR_ITEMS(1024, 1536), I6 = TR_ITEMS(2048, 256), I7 = TR_ITEMS(256, 64);
    constexpr int NIT = I0 + 2 * I1 + I2 + 2 * I3 + 2 * I4 + I5 + 2 * I6 + 2 * I7;
    bf16* WBIG = (bf16*)(ws + WS_WBIG);
    for (int it = gw; it < NIT; it += ngw) { int r = it;
        if (r < I0) { transpose_item(P.in[14], 1024, 2048, WBIG, OFF_WIN, 0, scr, r, lane); continue; } r -= I0;
        if (r < I1) { transpose_item(P.in[30], 1024, 5632, WBIG, OFF_GU0, 1, scr, r, lane); continue; } r -= I1;
        if (r < I1) { transpose_item(P.in[30] + (size_t)1024 * 5632, 1024, 5632, WBIG, OFF_GU1, 1, scr, r, lane); continue; } r -= I1;
        if (r < I2) { transpose_item(P.in[19], 1024, 1072, WBIG, OFF_Q, 3, scr, r, lane); continue; } r -= I2;
        if (r < I3) { transpose_item(P.in[18], 1024, 1024, (bf16*)(ws + WS_WOUT), 0, 0, scr, r, lane); continue; } r -= I3;
        if (r < I3) { transpose_item(P.in[21], 1024, 1024, (bf16*)(ws + WS_WBO), 0, 0, scr, r, lane); continue; } r -= I3;
        if (r < I4) { transpose_item(P.in[31], 2816, 1024, (bf16*)(ws + WS_WDN), 0, 0, scr, r, lane); continue; } r -= I4;
        if (r < I4) { transpose_item(P.in[31] + (size_t)2816 * 1024, 2816, 1024, (bf16*)(ws + WS_WDN) + (size_t)1024 * 2816, 0, 0, scr, r, lane); continue; } r -= I4;
        if (r < I5) { transpose_item(P.in[23], 1024, 1536, (bf16*)(ws + WS_WKV), 0, 2, scr, r, lane); continue; } r -= I5;
        if (r < I6) { transpose_item(P.in[26], 2048, 256, (bf16*)(ws + WS_W1C), 0, 0, scr, r, lane); continue; } r -= I6;
        if (r < I6) { transpose_item(P.in[26] + (size_t)2048 * 256, 2048, 256, (bf16*)(ws + WS_W1C) + (size_t)256 * 2048, 0, 0, scr, r, lane); continue; } r -= I6;
        if (r < I7) { transpose_item(P.in[28], 256, 64, (bf16*)(ws + WS_W2), 0, 0, scr, r, lane); continue; } r -= I7;
        transpose_item(P.in[28] + 256 * 64, 256, 64, (bf16*)(ws + WS_W2) + 64 * 256, 0, 0, scr, r, lane);
    }
}
__device__ __forceinline__ void phase2_tail(const Params& P, int tid, int lane, int wave) {
    unsigned char* ws = P.ws;
    const int gw = blockIdx.x * NWAVES + wave, ngw = gridDim.x * NWAVES, gtid = blockIdx.x * 512 + tid, ngt = gridDim.x * 512;
    const float* MOD = (const float*)(ws + WS_MOD); const float* ng = P.in[13];
    for (int e = gtid; e < 3 * 256 * 256; e += ngt) { const int np = e >> 16, sq = (e >> 8) & 255, c = (e & 255) * 4;
        const int lay = np == 0 ? 0 : 1, wh = np == 1 ? 0 : 1;
        const f32x4 g = *(const f32x4*)(ng + (lay * 2 + wh) * 1024 + c), sc = *(const f32x4*)(MOD + (size_t)sq * NMOD + lay * 6144 + (wh ? 4096 : 1024) + c);
        *(f32x4*)((float*)(ws + WS_MUL) + ((size_t)np * 256 + sq) * 1024 + c) = g * (sc + 1.0f); }
    float* SSQ0 = (float*)(ws + WS_SSQ); bf16* A0 = (bf16*)(ws + WS_ACTA);
    for (int r = gw; r < M65; r += ngw) {
        f32x4 v[4]; float s = 0.f;
        if (r < MT) { const float* x = (r < MP ? P.in[0] + (size_t)r * D : P.in[1] + (size_t)(r - MP) * D) + 4 * lane;
#pragma unroll
            for (int j = 0; j < 4; ++j) { v[j] = *(const f32x4*)(x + 256 * j); s += (v[j][0] * v[j][0] + v[j][1] * v[j][1]) + (v[j][2] * v[j][2] + v[j][3] * v[j][3]); }
        } else {
#pragma unroll
            for (int j = 0; j < 4; ++j) v[j] = (f32x4){0.f, 0.f, 0.f, 0.f}; }
        s = wave_sum(s);
        if (lane < 16) SSQ0[(size_t)r * 16 + lane] = lane == 0 ? s : 0.f;
        const int sq = seq_of(r);
#pragma unroll
        for (int j = 0; j < 4; ++j) { const int c = 4 * lane + 256 * j; const f32x4 g = *(const f32x4*)(ng + c), sc = *(const f32x4*)(MOD + (size_t)sq * NMOD + 1024 + c);
            const f32x4 a = v[j] * g * (sc + 1.0f); v2u w; w.x = pk2(a[0], a[1]); w.y = pk2(a[2], a[3]); *(v2u*)(A0 + (size_t)r * D + c) = w; }
    }
}
__device__ __forceinline__ void sample_prepass(const Params& P, int tid, int lane, int wave) {
    unsigned char* ws = P.ws;
    const int gw = blockIdx.x * NWAVES + wave, ngw = gridDim.x * NWAVES;
    const int* pt = (const int*)P.in[8]; bf16* RC = (bf16*)(ws + WS_RC);
    for (int it = gw; it < 2 * 128 * 16 * 4; it += ngw) { const int kv = it >> 13, sq = (it >> 6) & 127, p = (it >> 2) & 15, qtr = it & 3;
        const float* src = P.in[2 + kv] + (size_t)pt[sq * 16 + p] * (128 * 256) + qtr * 8192;
#pragma unroll
        for (int i0 = 0; i0 < 16; i0 += 8) { f32x4 a[8], b[8];
#pragma unroll
            for (int i = 0; i < 8; ++i) { const int e = ((i0 + i) * 64 + lane) * 8; a[i] = __builtin_nontemporal_load((const f32x4*)(src + e)); b[i] = __builtin_nontemporal_load((const f32x4*)(src + e + 4)); }
#pragma unroll
            for (int i = 0; i < 8; ++i) { const int e = ((i0 + i) * 64 + lane) * 8, tok = qtr * 32 + (e >> 8), g = (e >> 6) & 3, d = e & 63;
                v4u w; w.x = pk2(a[i][0], a[i][1]); w.y = pk2(a[i][2], a[i][3]); w.z = pk2(b[i][0], b[i][1]); w.w = pk2(b[i][2], b[i][3]);
                *(v4u*)(RC + ((size_t)kv * RC_KV + (size_t)(sq * 4 + g) * 128 + p * 8 + (tok >> 4)) * 1024 + (tok & 15) * 64 + d) = w; } } }
    for (int it = gw; it < 2 * 128 * 64; it += ngw) { const int kv = it >> 13, s = (it >> 6) & 127, c = it & 63;
        const f32x4* src = (const f32x4*)P.in[6 + kv] + (size_t)s * 32768 + 64; f32x4* dst = (f32x4*)(P.out + (kv ? O_WVS : O_WKS)) + (size_t)s * 32768;
        f32x4 v[8];
#pragma unroll
        for (int i = 0; i < 8; ++i) { const int e = c * 512 + i * 64 + lane; if (e < 32704) v[i] = __builtin_nontemporal_load(src + e); }
#pragma unroll
        for (int i = 0; i < 8; ++i) { const int e = c * 512 + i * 64 + lane; if (e < 32704) __builtin_nontemporal_store(v[i], dst + e); } }
}

__device__ __forceinline__ void skinny_core(const bf16* Arows  , int lda, int K, const bf16* Bt64  , LAS float* RED, int tid, int lane, int wave, float& s0, float& s1) {
    const int col = lane & 15, quad = lane >> 4;
    const int kw = K >> 3;
    const bf16* ap = Arows + (size_t)col * lda + wave * kw + 8 * quad;
    const bf16* bp = Bt64 + (size_t)col * K + wave * kw + 8 * quad;
    f32x4 acc[4];
#pragma unroll
    for (int ct = 0; ct < 4; ++ct) acc[ct] = (f32x4){0.f, 0.f, 0.f, 0.f};
#pragma unroll 4
    for (int k0 = 0; k0 < kw; k0 += 32) { const bf16x8 af = *(const bf16x8*)(ap + k0);
#pragma unroll
        for (int ct = 0; ct < 4; ++ct) { const bf16x8 bf = *(const bf16x8*)(bp + (size_t)ct * 16 * K + k0); acc[ct] = MFMA16(af, bf, acc[ct]); } }
#pragma unroll
    for (int ct = 0; ct < 4; ++ct)
#pragma unroll
        for (int r = 0; r < 4; ++r) RED[((wave * 4 + ct) * 4 + r) * 64 + lane] = acc[ct][r];
    __syncthreads();
    const int r16 = tid >> 5, c2 = (tid & 31) * 2;
    const int base = ((c2 >> 4) * 4 + (r16 & 3)) * 64 + (c2 & 15) + 16 * (r16 >> 2);
    s0 = 0.f; s1 = 0.f;
#pragma unroll
    for (int wv = 0; wv < 8; ++wv) { s0 += RED[wv * 1024 + base]; s1 += RED[wv * 1024 + base + 1]; }
    __syncthreads();
}
__device__ __forceinline__ float half_wave_sum(float v) { v += __shfl_xor(v, 1); v += __shfl_xor(v, 2); v += __shfl_xor(v, 4); v += __shfl_xor(v, 8); v += __shfl_xor(v, 16); return v; }
__device__ __forceinline__ void skinny_res(const bf16* A, int lda, int K, const bf16* Bt, const EpiRes& E, LAS unsigned char* lds, int tid, int lane, int wave) {
    for (int task = blockIdx.x; task < 8 * 16; task += gridDim.x) { const int rt = task >> 4, cg = task & 15;
        float s0, s1;
        skinny_core(A + (size_t)(MP + 16 * rt) * lda, lda, K, Bt + (size_t)(64 * cg) * K, (LAS float*)lds, tid, lane, wave, s0, s1);
        const int srow = 16 * rt + (tid >> 5), row = MP + srow, sq = 2 + srow, c = 64 * cg + (tid & 31) * 2;
        const f32x2 xi = *(const f32x2*)(E.xin_s + (size_t)srow * D + c), gt = *(const f32x2*)(E.MOD + (size_t)sq * NMOD + E.goff + c);
        const float x0 = xi[0] + gt[0] * s0, x1 = xi[1] + gt[1] * s1;
        *(f32x2*)(E.out + (size_t)row * D + c) = (f32x2){x0, x1};
        if (E.A1) { const f32x2 m = *(const f32x2*)(E.MUL + (size_t)sq * D + c); *(unsigned*)(E.A1 + (size_t)row * D + c) = pk2(x0 * m[0], x1 * m[1]); }
        if (E.A2) { const f32x2 m = *(const f32x2*)(E.kvg + c); *(unsigned*)(E.A2 + (size_t)row * D + c) = pk2(x0 * m[0], x1 * m[1]); }
        if (E.SSQ) { const float q = half_wave_sum(x0 * x0 + x1 * x1); if ((tid & 31) == 0) E.SSQ[(size_t)row * 16 + cg] = q; }
    }
}
__device__ __forceinline__ void skinny_ain(const bf16* A, const bf16* Bt, const EpiAin& E, LAS unsigned char* lds, int tid, int lane, int wave) {
    for (int task = blockIdx.x; task < 8 * 32; task += gridDim.x) { const int rt = task >> 5, cg = task & 31;
        float s0, s1;
        skinny_core(A + (size_t)(MP + 16 * rt) * D, D, D, Bt + (size_t)(64 * cg) * D, (LAS float*)lds, tid, lane, wave, s0, s1);
        const int srow = 16 * rt + (tid >> 5), row = MP + srow, sq = 2 + srow, c = 64 * cg + (tid & 31) * 2;
        const float rs = rstd16(E.SSQ0 + (size_t)row * 16);
        const f32x2 bv = *(const f32x2*)(E.BIAS + (size_t)sq * NBIG + OFF_WIN + c);
        const float g0 = gelu_t(s0 * rs + bv[0]), g1 = gelu_t(s1 * rs + bv[1]);
        if (cg < 16) *(unsigned*)(E.U + (size_t)row * D + c) = pk2(g0, g1);
        else { *(unsigned*)(E.V + (size_t)row * D + c - 1024) = pk2(g0, g1); const float q = half_wave_sum(g0 * g0 + g1 * g1); if ((tid & 31) == 0) E.SSQV[(size_t)row * 16 + (cg - 16)] = q; }
    }
}

__device__ __forceinline__ void phase_tokmix(const Params& P, LAS unsigned char* lds, int tid, int lane, int wave) {
    unsigned char* ws = P.ws;
    const bf16* U = (const bf16*)(ws + WS_U); const bf16* V = (const bf16*)(ws + WS_V); bf16* UM = (bf16*)(ws + WS_UM);
    const float* SSQV = (const float*)(ws + WS_SSQ) + (size_t)1 * M65 * 16; const bf16* WSB = (const bf16*)(ws + WS_WSB);
    const float* vgain = P.in[15]; const float* bs = P.in[17];
    LAS bf16* VT = (LAS bf16*)lds;
    const int col = lane & 15, quad = lane >> 4;
    for (int item = blockIdx.x; item < 1024; item += gridDim.x) { const int chunk = item >> 3, g = item & 7, r0 = chunk * 128;
        const bool lastc = (chunk & 63) == 63;
#pragma unroll
        for (int i = 0; i < 4; ++i) { const int e = tid + 512 * i, s = e >> 4, c8 = (e & 15) * 8; const int row = r0 + s;
            const float rs = rstd16(SSQV + (size_t)row * 16);
            const v4u w = *(const v4u*)(V + (size_t)row * D + g * 128 + c8);
            const f32x4 g0 = *(const f32x4*)(vgain + g * 128 + c8), g1 = *(const f32x4*)(vgain + g * 128 + c8 + 4);
            float x[8] = {bflo(w.x) * rs * g0[0], bfhi(w.x) * rs * g0[1], bflo(w.y) * rs * g0[2], bfhi(w.y) * rs * g0[3], bflo(w.z) * rs * g1[0], bfhi(w.z) * rs * g1[1], bflo(w.w) * rs * g1[2], bfhi(w.w) * rs * g1[3]};
#pragma unroll
            for (int k = 0; k < 8; ++k) VT[(c8 + k) * 136 + s] = (bf16)(pk2(x[k], 0.f) & 0xffffu);
            if (lastc) { float* av = P.out + O_AVP + ((size_t)(chunk >> 6) * 128 + s) * D + g * 128 + c8; *(f32x4*)av = (f32x4){x[0], x[1], x[2], x[3]}; *(f32x4*)(av + 4) = (f32x4){x[4], x[5], x[6], x[7]}; } }
        __syncthreads();
        f32x4 acc[8];
#pragma unroll
        for (int ct = 0; ct < 8; ++ct) acc[ct] = (f32x4){0.f, 0.f, 0.f, 0.f};
        const int t = 16 * wave + col;
        for (int ks = 0; ks <= (wave >> 1); ++ks) {
            const bf16x8 bfr = *(const bf16x8*)(WSB + ((size_t)g * 128 + t) * 128 + 32 * ks + 8 * quad);
#pragma unroll
            for (int ct = 0; ct < 8; ++ct) { const bf16x8 afr = *(const LAS bf16x8*)(VT + (16 * ct + col) * 136 + 32 * ks + 8 * quad); acc[ct] = MFMA16(afr, bfr, acc[ct]); } }
        const float bt = bs[g * 128 + t];
#pragma unroll
        for (int ct = 0; ct < 8; ++ct) { const size_t o = (size_t)(r0 + t) * D + g * 128 + 16 * ct + 4 * quad; const v2u uw = *(const v2u*)(U + o);
            v2u w; w.x = pk2(bflo(uw.x) * (acc[ct][0] + bt), bfhi(uw.x) * (acc[ct][1] + bt)); w.y = pk2(bflo(uw.y) * (acc[ct][2] + bt), bfhi(uw.y) * (acc[ct][3] + bt)); *(v2u*)(UM + o) = w; }
        __syncthreads();
    }
    const int gw = blockIdx.x * NWAVES + wave, ngw = gridDim.x * NWAVES;
    for (int r = MP + gw; r < M65; r += ngw) {
        const float rs = rstd16(SSQV + (size_t)r * 16);
#pragma unroll
        for (int j = 0; j < 4; ++j) { const int c = 4 * lane + 256 * j, g = c >> 7; v2u w = {0u, 0u};
            if (r < MT) { const v2u vw = *(const v2u*)(V + (size_t)r * D + c), uw = *(const v2u*)(U + (size_t)r * D + c); const f32x4 gn = *(const f32x4*)(vgain + c);
                const f32x4 vn = (f32x4){bflo(vw.x), bfhi(vw.x), bflo(vw.y), bfhi(vw.y)} * rs * gn;
                *(f32x4*)(P.out + O_AVS + (size_t)(r - MP) * D + c) = vn;
                const float w00 = P.in[16][g * 16384], b0 = bs[g * 128];
                w.x = pk2(bflo(uw.x) * (w00 * vn[0] + b0), bfhi(uw.x) * (w00 * vn[1] + b0)); w.y = pk2(bflo(uw.y) * (w00 * vn[2] + b0), bfhi(uw.y) * (w00 * vn[3] + b0)); }
            *(v2u*)(UM + (size_t)r * D + c) = w; } }
}

__device__ __forceinline__ void phase_w2(const Params& P, int lane, int wave) {
    unsigned char* ws = P.ws;
    const int gw = blockIdx.x * NWAVES + wave, ngw = gridDim.x * NWAVES;
    const bf16* H2 = (const bf16*)(ws + WS_H2); const bf16* W2 = (const bf16*)(ws + WS_W2);
    const int col = lane & 15, quad = lane >> 4;
    for (int task = gw; task < 2 * RC_KV / 16; task += ngw) { const int kv = task >= RC_KV / 16 ? 1 : 0; const int R0 = (task - kv * (RC_KV / 16)) * 16;
        const bool samp = R0 < RC_SAMP; const int gam = samp ? (R0 >> 7) : ((R0 - RC_SAMP) >> 9), i0 = samp ? (R0 & 127) : ((R0 - RC_SAMP) & 511);
        const bf16* hrow = H2 + ((size_t)kv * RC_KV + R0 + col) * 256 + 8 * quad; const bf16* wrow = W2 + (size_t)kv * 64 * 256 + (size_t)col * 256 + 8 * quad;
        f32x4 acc[4];
#pragma unroll
        for (int dt = 0; dt < 4; ++dt) acc[dt] = (f32x4){0.f, 0.f, 0.f, 0.f};
#pragma unroll
        for (int ks = 0; ks < 8; ++ks) { const bf16x8 hf = *(const bf16x8*)(hrow + 32 * ks);
#pragma unroll
            for (int dt = 0; dt < 4; ++dt) { const bf16x8 wf = *(const bf16x8*)(wrow + (size_t)dt * 16 * 256 + 32 * ks);
                acc[dt] = kv ? MFMA16(hf, wf, acc[dt]) : MFMA16(wf, hf, acc[dt]); } }
        const float* b2 = P.in[29] + kv * 64;
        if (!kv) {
            float sq = 0.f; f32x4 v[4];
#pragma unroll
            for (int dt = 0; dt < 4; ++dt) { v[dt] = acc[dt] + *(const f32x4*)(b2 + 16 * dt + 4 * quad); sq += (v[dt][0] * v[dt][0] + v[dt][1] * v[dt][1]) + (v[dt][2] * v[dt][2] + v[dt][3] * v[dt][3]); }
            sq += __shfl_xor(sq, 16); sq += __shfl_xor(sq, 32);
            const float ri = rsqrtf(sq * (1.0f / 64.0f) + EPS);
            bf16* dst = (samp ? (bf16*)(ws + WS_KCS) + ((size_t)gam * 128 + i0 + col) * 64 : (bf16*)(ws + WS_KCP) + ((size_t)gam * 512 + i0 + col) * 64) + 4 * quad;
#pragma unroll
            for (int dt = 0; dt < 4; ++dt) { const f32x4 kg = *(const f32x4*)(P.in[24] + 16 * dt + 4 * quad); const f32x4 o = v[dt] * ri * kg; v2u w; w.x = pk2(o[0], o[1]); w.y = pk2(o[2], o[3]); *(v2u*)(dst + 16 * dt) = w; }
        } else {
#pragma unroll
            for (int dt = 0; dt < 4; ++dt) { const int d = 16 * dt + col; const float bb = b2[d];
                const int ip = (i0 & ~63) + 32 * ((i0 >> 5) & 1) + 8 * quad + 4 * ((i0 >> 4) & 1);
                bf16* dst = (samp ? (bf16*)(ws + WS_VCTS) + (size_t)gam * 2 * 4096 : (bf16*)(ws + WS_VCTP) + (size_t)gam * 8 * 4096) + (size_t)(ip >> 6) * 4096 + d * 64 + (ip & 63);
                v2u w; w.x = pk2(acc[dt][0] + bb, acc[dt][1] + bb); w.y = pk2(acc[dt][2] + bb, acc[dt][3] + bb); *(v2u*)dst = w; }
        }
    }
}

#ifndef ATT_REP_P
#define ATT_REP_P 1
#endif
#ifndef ATT_REP_S
#define ATT_REP_S 1
#endif

__device__ __forceinline__ void load_k8(const bf16* kb, int lane, bf16x8 (&kf)[8]) {
    const int col = lane & 15, quad = lane >> 4;
#pragma unroll
    for (int kt = 0; kt < 4; ++kt) { const bf16* kp = kb + (size_t)(16 * kt + col) * 64 + 8 * quad; kf[2 * kt] = *(const bf16x8*)kp; kf[2 * kt + 1] = *(const bf16x8*)(kp + 32); }
}
__device__ __forceinline__ void load_vt8(const bf16* vtb, int pitch, int lane, bf16x8 (&vf)[8]) {
    const int col = lane & 15, quad = lane >> 4;
#pragma unroll
    for (int dt = 0; dt < 4; ++dt)
#pragma unroll
        for (int ks = 0; ks < 2; ++ks) vf[2 * dt + ks] = *(const bf16x8*)(vtb + (size_t)(16 * dt + col) * pitch + 32 * ks + 8 * quad);
}
__device__ __forceinline__ void select_topk(LAS float* imps, int cur, int lane, unsigned (&msk)[4]) {
    const int col = lane & 15, quad = lane >> 4, ql = col >> 2, hl = col & 3;
#pragma unroll
    for (int w = 0; w < 4; ++w) msk[w] = 0u;
    if (cur <= 15) { msk[0] = (2u << cur) - 1u; return; }
    asm volatile("s_waitcnt lgkmcnt(0)" ::: "memory");
    const int lq = hl + 4 * quad;
    unsigned key[8];
#pragma unroll
    for (int e = 0; e < 8; ++e) { const int sg = lq + 16 * e; const float v = imps[ql * 128 + sg]; key[e] = (sg >= 1 && sg <= cur - 2) ? ((__builtin_bit_cast(unsigned, v) & ~127u) | (unsigned)sg) : 0u; }
    for (int it = 0; it < 13; ++it) {
        unsigned mx = key[0];
#pragma unroll
        for (int e = 1; e < 8; ++e) mx = mx > key[e] ? mx : key[e];
        { unsigned o = dpp_xor1u(mx); mx = mx > o ? mx : o; o = dpp_xor2u(mx); mx = mx > o ? mx : o; o = (unsigned)__shfl_xor((int)mx, 16); mx = mx > o ? mx : o; o = (unsigned)__shfl_xor((int)mx, 32); mx = mx > o ? mx : o; }
        const unsigned sg = mx & 127u, bit = mx ? (1u << (sg & 31u)) : 0u, w = sg >> 5;
        msk[0] |= w == 0u ? bit : 0u; msk[1] |= w == 1u ? bit : 0u; msk[2] |= w == 2u ? bit : 0u; msk[3] |= w == 3u ? bit : 0u;
#pragma unroll
        for (int e = 0; e < 8; ++e) key[e] = key[e] == mx ? 0u : key[e];
    }
    msk[0] |= 1u;
#pragma unroll
    for (int k = 0; k < 2; ++k) { const unsigned sg = (unsigned)(cur - k), bit = 1u << (sg & 31u), w = sg >> 5;
        msk[0] |= w == 0u ? bit : 0u; msk[1] |= w == 1u ? bit : 0u; msk[2] |= w == 2u ? bit : 0u; msk[3] |= w == 3u ? bit : 0u; }
}

__device__ __forceinline__ void attn_cmp_select(const bf16* kc, const bf16* vct, int vpitch, bf16x8 qn0, bf16x8 qn1, int nvis, int nkt, int cur, float nref,
                                                LAS float* imps, int lane, f32x4 (&oc)[4], unsigned (&msk)[4]) {
    const int col = lane & 15, quad = lane >> 4, ql = col >> 2, hl = col & 3;
    const int nb = (nkt + 3) >> 2;
    float lsum = 0.f;
    {   bf16x8 kfA[8], kfB[8];
        if (nb > 0) load_k8(kc, lane, kfA);
        for (int blk = 0; blk < nb; ++blk) {
            if (blk + 1 < nb) load_k8(kc + (size_t)(blk + 1) * 4096, lane, kfB);
#pragma unroll
            for (int kt = 0; kt < 4; ++kt) { f32x4 s = {nref, nref, nref, nref}; s = MFMA16(kfA[2 * kt], qn0, s); s = MFMA16(kfA[2 * kt + 1], qn1, s);
#pragma unroll
                for (int r = 0; r < 4; ++r) lsum += (64 * blk + 16 * kt + 4 * quad + r < nvis) ? fexp2(s[r]) : 0.f; }
#pragma unroll
            for (int i = 0; i < 8; ++i) kfA[i] = kfB[i];
        } }
    float l = lsum + __shfl_xor(lsum, 16); l += __shfl_xor(l, 32);
    const float rl = l > 0.f ? 1.0f / l : 0.f;
#pragma unroll
    for (int dt = 0; dt < 4; ++dt) oc[dt] = (f32x4){0.f, 0.f, 0.f, 0.f};
    float carry = 0.f;
    {   bf16x8 kfA[8], kfB[8], vfA[8];
        if (nb > 0) load_k8(kc, lane, kfA);
        for (int blk = 0; blk < nb; ++blk) {
            load_vt8(vct + (size_t)blk * 4096, 64, lane, vfA);
            if (blk + 1 < nb) load_k8(kc + (size_t)(blk + 1) * 4096, lane, kfB);
            float pa[4][4];
#pragma unroll
            for (int kt = 0; kt < 4; ++kt) { f32x4 s = {nref, nref, nref, nref}; s = MFMA16(kfA[2 * kt], qn0, s); s = MFMA16(kfA[2 * kt + 1], qn1, s);
                float hs[4];
#pragma unroll
                for (int r = 0; r < 4; ++r) { const float p = (64 * blk + 16 * kt + 4 * quad + r < nvis) ? fexp2(s[r]) * rl : 0.f; pa[kt][r] = p; float h = p + dpp_xor1(p); h += dpp_xor2(h); hs[r] = h; }
                const float tot = (hs[0] + hs[1]) + (hs[2] + hs[3]);
                const float up = __shfl(hs[3], (lane + 48) & 63);
                const float prev = quad == 0 ? carry : up; carry = up;
                if (hl == 0) imps[ql * 128 + 16 * blk + 4 * kt + quad] = tot + prev; }
#pragma unroll
            for (int ks = 0; ks < 2; ++ks) { v4u pw; pw.x = pk2(pa[2 * ks][0], pa[2 * ks][1]); pw.y = pk2(pa[2 * ks][2], pa[2 * ks][3]); pw.z = pk2(pa[2 * ks + 1][0], pa[2 * ks + 1][1]); pw.w = pk2(pa[2 * ks + 1][2], pa[2 * ks + 1][3]);
                const bf16x8 pb = __builtin_bit_cast(bf16x8, pw);
#pragma unroll
                for (int dt = 0; dt < 4; ++dt) oc[dt] = MFMA16(vfA[2 * dt + ks], pb, oc[dt]); }
#pragma unroll
            for (int i = 0; i < 8; ++i) kfA[i] = kfB[i];
        } }
    select_topk(imps, cur, lane, msk);
}

__device__ __forceinline__ void tile_step(const bf16x8 (&kf)[8], const bf16x8 (&vf)[8], bf16x8 q0, bf16x8 q1, float cinit, bool masked, int kpos0, int lo, int hi, int lane, f32x4 (&o)[4], float& lsum) {
    const int quad = lane >> 4;
    f32x4 p[4];
#pragma unroll
    for (int kt = 0; kt < 4; ++kt) { f32x4 s = {cinit, cinit, cinit, cinit}; s = MFMA16(kf[2 * kt], q0, s); s = MFMA16(kf[2 * kt + 1], q1, s);
#pragma unroll
        for (int r = 0; r < 4; ++r) p[kt][r] = fexp2(s[r]); }
    if (masked) {
#pragma unroll
        for (int kt = 0; kt < 4; ++kt)
#pragma unroll
            for (int r = 0; r < 4; ++r) { const int kpos = kpos0 + 16 * kt + 4 * quad + r; p[kt][r] = (kpos >= lo && kpos <= hi) ? p[kt][r] : 0.f; } }
#pragma unroll
    for (int kt = 0; kt < 4; ++kt) lsum += (p[kt][0] + p[kt][1]) + (p[kt][2] + p[kt][3]);
#pragma unroll
    for (int ks = 0; ks < 2; ++ks) {
        v4u pw; pw.x = pk2(p[2 * ks][0], p[2 * ks][1]); pw.y = pk2(p[2 * ks][2], p[2 * ks][3]); pw.z = pk2(p[2 * ks + 1][0], p[2 * ks + 1][1]); pw.w = pk2(p[2 * ks + 1][2], p[2 * ks + 1][3]);
        const bf16x8 pb = __builtin_bit_cast(bf16x8, pw);
#pragma unroll
        for (int dt = 0; dt < 4; ++dt) o[dt] = MFMA16(vf[2 * dt + ks], pb, o[dt]); }
}

struct AttnRefs { float cmp, slc, win; };

constexpr int AT_RING = 0, AT_SLOT = 16384, AT_NS = 4;
constexpr int AT_IMPS = AT_NS * AT_SLOT;
constexpr int AT_PARKA = AT_IMPS, AT_PARKB = AT_IMPS + 32768;
constexpr int AT_UNI = RING_BYTES + 1024;
static_assert(AT_PARKB + 32768 <= RING_BYTES && AT_UNI + 256 <= LDS_BYTES, "attention LDS map");
#define AT_WAITV(n) asm volatile("s_waitcnt vmcnt(" #n ")" ::: "memory")
#define AT_RING_WAIT2(rem) do { const int r_ = (rem); if (r_ >= 2) AT_WAITV(4); else if (r_ == 1) AT_WAITV(2); else AT_WAITV(0); } while (0)
#define AT_RING_WAIT1(rem) do { const int r_ = (rem); if (r_ >= 2) AT_WAITV(2); else if (r_ == 1) AT_WAITV(1); else AT_WAITV(0); } while (0)

struct TileQ { bf16x8 q0, q1; int nvis, nvt, tb, tq; };
__device__ __forceinline__ void pv_acc(const bf16x8 (&vf)[8], const f32x4 (&p)[4], f32x4 (&o)[4]);

__device__ __forceinline__ void cmp_p1_step(const bf16x8 (&kf)[8], const TileQ& T, float nref, int j, int lane, float& lsum) {
    const int quad = lane >> 4;
#pragma unroll
    for (int kt = 0; kt < 4; ++kt) { f32x4 s = {nref, nref, nref, nref}; s = MFMA16(kf[2 * kt], T.q0, s); s = MFMA16(kf[2 * kt + 1], T.q1, s);
#pragma unroll
        for (int r = 0; r < 4; ++r) lsum += (64 * j + 16 * kt + 4 * quad + r < T.nvis) ? fexp2(s[r]) : 0.f; }
}
__device__ __forceinline__ void cmp_p2_qk(const bf16x8 (&kf)[8], const TileQ& T, float nref, float rl, int j, int lane, float& carry, LAS float* imps, f32x4 (&pa)[4]) {
    const int col = lane & 15, quad = lane >> 4, ql = col >> 2, hl = col & 3;
#pragma unroll
    for (int kt = 0; kt < 4; ++kt) { f32x4 s = {nref, nref, nref, nref}; s = MFMA16(kf[2 * kt], T.q0, s); s = MFMA16(kf[2 * kt + 1], T.q1, s);
        float hs[4];
#pragma unroll
        for (int r = 0; r < 4; ++r) { const float p = (64 * j + 16 * kt + 4 * quad + r < T.nvis) ? fexp2(s[r]) * rl : 0.f; pa[kt][r] = p; float h = p + dpp_xor1(p); h += dpp_xor2(h); hs[r] = h; }
        const float tot = (hs[0] + hs[1]) + (hs[2] + hs[3]);
        const float up = __shfl(hs[3], (lane + 48) & 63);
        const float prev = quad == 0 ? carry : up; carry = up;
        if (hl == 0) imps[ql * 128 + 16 * j + 4 * kt + quad] = tot + prev; }
}

__device__ __forceinline__ void attn_cmp_ring2(const bf16* Kb, const bf16* Vb, LAS unsigned char* lds, const TileQ& A, const TileQ& B, int nb, int cur, float nref,
                                               LAS float* imps, int w, int lane, f32x4 (&oa)[4], f32x4 (&ob)[4], unsigned (&ma)[4], unsigned (&mb)[4]) {
    const int col = lane & 15, quad = lane >> 4;
    const size_t foff = (size_t)(16 * (w >> 1) + col) * 64 + 32 * (w & 1) + 8 * quad;
#define CR_DMAK(j) __builtin_amdgcn_global_load_lds((const unsigned*)(Kb + (size_t)(j) * 4096 + foff), (LAS unsigned*)(lds + AT_RING + ((j) & (AT_NS - 1)) * AT_SLOT + w * 1024), 16, 0, 0)
#define CR_DMAV(j) __builtin_amdgcn_global_load_lds((const unsigned*)(Vb + (size_t)(j) * 4096 + foff), (LAS unsigned*)(lds + AT_RING + ((j) & (AT_NS - 1)) * AT_SLOT + 8192 + w * 1024), 16, 0, 0)
    float lsa = 0.f, lsb = 0.f;
    asm volatile("s_waitcnt vmcnt(0)" ::: "memory"); __builtin_amdgcn_s_barrier(); asm volatile("" ::: "memory");
    for (int j = 0; j < AT_NS - 1; ++j) if (j < nb) CR_DMAK(j);
    for (int j = 0; j < nb; ++j) {
        AT_RING_WAIT1(nb - 1 - j);
        __builtin_amdgcn_s_barrier(); asm volatile("" ::: "memory");
        if (j + AT_NS - 1 < nb) CR_DMAK(j + AT_NS - 1);
        if (64 * j < B.nvt) {
            const LAS unsigned char* sl = lds + AT_RING + (j & (AT_NS - 1)) * AT_SLOT + lane * 16;
            bf16x8 kf[8];
#pragma unroll
            for (int f = 0; f < 8; ++f) kf[f] = *(const LAS bf16x8*)(sl + f * 1024);
            if (64 * j < A.nvt) cmp_p1_step(kf, A, nref, j, lane, lsa);
            cmp_p1_step(kf, B, nref, j, lane, lsb); }
    }
    lsa += __shfl_xor(lsa, 16); lsa += __shfl_xor(lsa, 32); lsb += __shfl_xor(lsb, 16); lsb += __shfl_xor(lsb, 32);
    const float rla = lsa > 0.f ? 1.0f / lsa : 0.f, rlb = lsb > 0.f ? 1.0f / lsb : 0.f;
#pragma unroll
    for (int dt = 0; dt < 4; ++dt) { oa[dt] = (f32x4){0.f, 0.f, 0.f, 0.f}; ob[dt] = (f32x4){0.f, 0.f, 0.f, 0.f}; }
    float ca = 0.f, cb = 0.f;
    asm volatile("s_waitcnt vmcnt(0)" ::: "memory"); __builtin_amdgcn_s_barrier(); asm volatile("" ::: "memory");
    for (int j = 0; j < AT_NS - 1; ++j) if (j < nb) { CR_DMAK(j); CR_DMAV(j); }
    for (int j = 0; j < nb; ++j) {
        AT_RING_WAIT2(nb - 1 - j);
        __builtin_amdgcn_s_barrier(); asm volatile("" ::: "memory");
        if (j + AT_NS - 1 < nb) { CR_DMAK(j + AT_NS - 1); CR_DMAV(j + AT_NS - 1); }
        const LAS unsigned char* sl = lds + AT_RING + (j & (AT_NS - 1)) * AT_SLOT + lane * 16;
        f32x4 pA[4], pB[4];
        {   bf16x8 kf[8];
#pragma unroll
            for (int f = 0; f < 8; ++f) kf[f] = *(const LAS bf16x8*)(sl + f * 1024);
            cmp_p2_qk(kf, A, nref, rla, j, lane, ca, imps, pA);
            cmp_p2_qk(kf, B, nref, rlb, j, lane, cb, imps + 512, pB); }
        asm volatile("" ::: "memory");
        {   bf16x8 vf[8];
#pragma unroll
            for (int f = 0; f < 8; ++f) vf[f] = *(const LAS bf16x8*)(sl + 8192 + f * 1024);
            pv_acc(vf, pA, oa); pv_acc(vf, pB, ob); }
    }
#undef CR_DMAK
#undef CR_DMAV
    select_topk(imps, cur, lane, ma);
    select_topk(imps + 512, cur, lane, mb);
}

__device__ __forceinline__ void qk_exp(const bf16x8 (&kf)[8], bf16x8 q0, bf16x8 q1, float cinit, bool masked, int kpos0, int lo, int hi, int lane, f32x4 (&p)[4], float& lsum) {
    const int quad = lane >> 4;
#pragma unroll
    for (int kt = 0; kt < 4; ++kt) { f32x4 s = {cinit, cinit, cinit, cinit}; s = MFMA16(kf[2 * kt], q0, s); s = MFMA16(kf[2 * kt + 1], q1, s);
#pragma unroll
        for (int r = 0; r < 4; ++r) p[kt][r] = fexp2(s[r]); }
    if (masked) {
#pragma unroll
        for (int kt = 0; kt < 4; ++kt)
#pragma unroll
            for (int r = 0; r < 4; ++r) { const int kpos = kpos0 + 16 * kt + 4 * quad + r; p[kt][r] = (kpos >= lo && kpos <= hi) ? p[kt][r] : 0.f; } }
#pragma unroll
    for (int kt = 0; kt < 4; ++kt) lsum += (p[kt][0] + p[kt][1]) + (p[kt][2] + p[kt][3]);
}
__device__ __forceinline__ void pv_acc(const bf16x8 (&vf)[8], const f32x4 (&p)[4], f32x4 (&o)[4]) {
#pragma unroll
    for (int ks = 0; ks < 2; ++ks) {
        v4u pw; pw.x = pk2(p[2 * ks][0], p[2 * ks][1]); pw.y = pk2(p[2 * ks][2], p[2 * ks][3]); pw.z = pk2(p[2 * ks + 1][0], p[2 * ks + 1][1]); pw.w = pk2(p[2 * ks + 1][2], p[2 * ks + 1][3]);
        const bf16x8 pb = __builtin_bit_cast(bf16x8, pw);
#pragma unroll
        for (int dt = 0; dt < 4; ++dt) o[dt] = MFMA16(vf[2 * dt + ks], pb, o[dt]); }
}
struct TileB { bf16x8 q0, q1; int tb, tq; float gate; };
template <int BR>
__device__ __forceinline__ void attn_branch2(const bf16* Kb, const bf16* Vb, LAS unsigned char* lds, int t0, int cur, float ref, const TileB& A, const TileB& B,
                                             const unsigned (&ma)[4], const unsigned (&mb)[4], const unsigned (&una)[4], const unsigned (&unb)[4], const unsigned (&uu)[4],
                                             int w, int lane, LAS unsigned char* parkA, LAS unsigned char* parkB) {
    const int col = lane & 15, quad = lane >> 4;
    int nblk, wlo = 0;
    unsigned c0 = uu[0], c1 = uu[1], c2 = uu[2], c3 = uu[3], p0 = uu[0], p1 = uu[1], p2 = uu[2], p3 = uu[3];
    if (BR == 0) nblk = __builtin_popcount(c0) + __builtin_popcount(c1) + __builtin_popcount(c2) + __builtin_popcount(c3);
    else { wlo = (t0 >= WIN ? t0 - WIN : 0) >> 6; nblk = cur - wlo + 1; }
    const size_t foff = (size_t)(16 * (w >> 1) + col) * 64 + 32 * (w & 1) + 8 * quad;
#define AT_BITNEXT(a, b, c, d, out) do { if (a) { out = __builtin_ctz(a); a &= a - 1u; } else if (b) { out = 32 + __builtin_ctz(b); b &= b - 1u; } else if (c) { out = 64 + __builtin_ctz(c); c &= c - 1u; } else { out = 96 + __builtin_ctz(d); d &= d - 1u; } } while (0)
#define AT_DMA(j) do { int sg_; if (BR == 0) AT_BITNEXT(p0, p1, p2, p3, sg_); else sg_ = wlo + (j); LAS unsigned char* sl_ = lds + AT_RING + ((j) & (AT_NS - 1)) * AT_SLOT + w * 1024; \
        __builtin_amdgcn_global_load_lds((const unsigned*)(Kb + (size_t)sg_ * 4096 + foff), (LAS unsigned*)sl_, 16, 0, 0); \
        __builtin_amdgcn_global_load_lds((const unsigned*)(Vb + (size_t)sg_ * 4096 + foff), (LAS unsigned*)(sl_ + 8192), 16, 0, 0); } while (0)
    f32x4 oa[4], ob[4]; float lsa = 0.f, lsb = 0.f;
#pragma unroll
    for (int dt = 0; dt < 4; ++dt) { oa[dt] = (f32x4){0.f, 0.f, 0.f, 0.f}; ob[dt] = (f32x4){0.f, 0.f, 0.f, 0.f}; }
    asm volatile("s_waitcnt vmcnt(0)" ::: "memory");
    __builtin_amdgcn_s_barrier();
    asm volatile("" ::: "memory");
    for (int j = 0; j < AT_NS - 1; ++j) if (j < nblk) AT_DMA(j);
    for (int j = 0; j < nblk; ++j) {
        AT_RING_WAIT2(nblk - 1 - j);
        __builtin_amdgcn_s_barrier();
        asm volatile("" ::: "memory");
        if (j + AT_NS - 1 < nblk) AT_DMA(j + AT_NS - 1);
        int sg; if (BR == 0) AT_BITNEXT(c0, c1, c2, c3, sg); else sg = wlo + j;
        bool na, nbb, mka, mkb;
        if (BR == 0) { const int sw = sg >> 5; const unsigned bit = 1u << (sg & 31);
            const unsigned wa = sw == 0 ? una[0] : sw == 1 ? una[1] : sw == 2 ? una[2] : una[3], wb = sw == 0 ? unb[0] : sw == 1 ? unb[1] : sw == 2 ? unb[2] : unb[3];
            int sgo = sg; asm volatile("" : "+s"(sgo));
            na = (wa & bit) != 0u; nbb = (wb & bit) != 0u; mka = mkb = sgo == cur; }
        else { na = (64 * sg + 63 >= A.tb - WIN) && (64 * sg <= A.tb + 3); mka = (64 * sg + 63 > A.tb) || (64 * sg < A.tb + 3 - WIN);
               nbb = (64 * sg + 63 >= B.tb - WIN) && (64 * sg <= B.tb + 3); mkb = (64 * sg + 63 > B.tb) || (64 * sg < B.tb + 3 - WIN); }
        if (na || nbb) {
            const LAS unsigned char* sl = lds + AT_RING + (j & (AT_NS - 1)) * AT_SLOT + lane * 16;
            const int sw = sg >> 5;
            float cia = ref, cib = ref;
            if (BR == 0) { const unsigned mwa = sw == 0 ? ma[0] : sw == 1 ? ma[1] : sw == 2 ? ma[2] : ma[3], mwb = sw == 0 ? mb[0] : sw == 1 ? mb[1] : sw == 2 ? mb[2] : mb[3];
                cia = ((mwa >> (sg & 31)) & 1u) ? ref : -1e30f; cib = ((mwb >> (sg & 31)) & 1u) ? ref : -1e30f; }
            f32x4 pA[4], pB[4];
            {   bf16x8 kf[8];
#pragma unroll
                for (int f = 0; f < 8; ++f) kf[f] = *(const LAS bf16x8*)(sl + f * 1024);
                if (na) qk_exp(kf, A.q0, A.q1, cia, mka, 64 * sg, BR == 0 ? 0 : A.tq - WIN, A.tq, lane, pA, lsa);
                if (nbb) qk_exp(kf, B.q0, B.q1, cib, mkb, 64 * sg, BR == 0 ? 0 : B.tq - WIN, B.tq, lane, pB, lsb); }
            asm volatile("" ::: "memory");
            {   bf16x8 vf[8];
#pragma unroll
                for (int f = 0; f < 8; ++f) vf[f] = *(const LAS bf16x8*)(sl + 8192 + f * 1024);
                if (na) pv_acc(vf, pA, oa);
                if (nbb) pv_acc(vf, pB, ob); }
        }
    }
#undef AT_BITNEXT
#undef AT_DMA
    lsa += __shfl_xor(lsa, 16); lsa += __shfl_xor(lsa, 32); lsb += __shfl_xor(lsb, 16); lsb += __shfl_xor(lsb, 32);
    const float sca = lsa > 0.f ? A.gate / lsa : 0.f, scb = lsb > 0.f ? B.gate / lsb : 0.f;
#pragma unroll
    for (int dt = 0; dt < 4; ++dt) { LAS f32x4* pa_ = (LAS f32x4*)(parkA + dt * 1024); LAS f32x4* pb_ = (LAS f32x4*)(parkB + dt * 1024); *pa_ = *pa_ + oa[dt] * sca; *pb_ = *pb_ + ob[dt] * scb; }
}

__device__ __forceinline__ void attn_prompt_unit(const Params& P, int unit, const AttnRefs& rf, LAS unsigned char* lds, int lane, int wave) {
    unsigned char* ws = P.ws;
    const int w = wave;
    const int gam = unit & 7, pt64 = unit >> 3, b = gam >> 2, g = gam & 3, t0 = 64 * pt64, cur = t0 >> 6;
    const int col = lane & 15, quad = lane >> 4, ql = col >> 2, hl = col & 3;
    LAS unsigned* UNI = (LAS unsigned*)(lds + AT_UNI);
    LAS float* imps = (LAS float*)(lds + AT_IMPS) + wave * 1024;
    const bf16* QN = (const bf16*)(ws + WS_QN); const bf16* QR = (const bf16*)(ws + WS_QR);
    const int tba = t0 + 8 * w, tbb = tba + 4, tqa = tba + ql, tqb = tbb + ql;
    const size_t qoa = (size_t)(b * SEQ + tqa) * D + (4 * g + hl) * 64 + 8 * quad, qob = qoa + 4 * D;
    f32x4 oa[4], ob[4]; unsigned ma[4], mb[4];
    {   TileQ A, B;
        A.q0 = *(const bf16x8*)(QN + qoa); A.q1 = *(const bf16x8*)(QN + qoa + 32); B.q0 = *(const bf16x8*)(QN + qob); B.q1 = *(const bf16x8*)(QN + qob + 32);
        A.tb = tba; A.tq = tqa; B.tb = tbb; B.tq = tqb;
        A.nvis = tqa >= 31 ? ((tqa - 31) >> 4) + 1 : 0; B.nvis = tqb >= 31 ? ((tqb - 31) >> 4) + 1 : 0;
        A.nvt = (tba + 3) >= 31 ? ((tba + 3 - 31) >> 4) + 1 : 0; B.nvt = (tbb + 3) >= 31 ? ((tbb + 3 - 31) >> 4) + 1 : 0;
        const int nvu = (t0 + 63) >= 31 ? ((t0 + 63 - 31) >> 4) + 1 : 0, nb = (nvu + 63) >> 6;
        attn_cmp_ring2((const bf16*)(ws + WS_KCP) + (size_t)gam * 512 * 64, (const bf16*)(ws + WS_VCTP) + (size_t)gam * 8 * 4096, lds, A, B, nb, cur, rf.cmp, imps, w, lane, oa, ob, ma, mb); }
    const float* gta = (const float*)(ws + WS_GATES) + (size_t)(b * SEQ + tqa) * 48 + (4 * g + hl) * 3; const float* gtb = gta + 4 * 48;
    LAS unsigned char* parkA = lds + AT_PARKA + w * 4096 + lane * 16; LAS unsigned char* parkB = lds + AT_PARKB + w * 4096 + lane * 16;
    {   const float ga = gta[0], gb = gtb[0];
#pragma unroll
        for (int dt = 0; dt < 4; ++dt) { *(LAS f32x4*)(parkA + dt * 1024) = oa[dt] * ga; *(LAS f32x4*)(parkB + dt * 1024) = ob[dt] * gb; } }
    unsigned una[4], unb[4];
#pragma unroll
    for (int k = 0; k < 4; ++k) { unsigned u = ma[k]; u |= (unsigned)__shfl_xor((int)u, 4); u |= (unsigned)__shfl_xor((int)u, 8); una[k] = (unsigned)__builtin_amdgcn_readfirstlane((int)u);
        unsigned v = mb[k]; v |= (unsigned)__shfl_xor((int)v, 4); v |= (unsigned)__shfl_xor((int)v, 8); unb[k] = (unsigned)__builtin_amdgcn_readfirstlane((int)v); }
    if (lane == 0) *(LAS v4u*)(UNI + w * 4) = (v4u){una[0] | unb[0], una[1] | unb[1], una[2] | unb[2], una[3] | unb[3]};
    __syncthreads();
    unsigned uu[4];
#pragma unroll
    for (int k = 0; k < 4; ++k) { unsigned x = 0u;
#pragma unroll
        for (int t = 0; t < 8; ++t) x |= UNI[4 * t + k];
        uu[k] = (unsigned)__builtin_amdgcn_readfirstlane((int)x); }
    TileB A, B;
    A.q0 = *(const bf16x8*)(QR + qoa); A.q1 = *(const bf16x8*)(QR + qoa + 32); B.q0 = *(const bf16x8*)(QR + qob); B.q1 = *(const bf16x8*)(QR + qob + 32);
    A.tb = tba; A.tq = tqa; B.tb = tbb; B.tq = tqb;
    A.gate = gta[1]; B.gate = gtb[1];
    attn_branch2<0>((const bf16*)(ws + WS_KS) + (size_t)gam * SEQ * 64, (const bf16*)(ws + WS_VST) + (size_t)gam * 128 * 4096, lds, t0, cur, rf.slc, A, B, ma, mb, una, unb, uu, w, lane, parkA, parkB);
    A.gate = gta[2]; B.gate = gtb[2];
    attn_branch2<1>((const bf16*)(ws + WS_KW) + (size_t)gam * SEQ * 64, (const bf16*)(ws + WS_VWT) + (size_t)gam * 128 * 4096, lds, t0, cur, rf.win, A, B, ma, mb, una, unb, uu, w, lane, parkA, parkB);
    bf16* opa = (bf16*)(ws + WS_O) + (size_t)(b * SEQ + tqa) * D + (4 * g + hl) * 64 + 4 * quad; bf16* opb = opa + 4 * D;
#pragma unroll
    for (int dt = 0; dt < 4; ++dt) { const f32x4 xa = *(const LAS f32x4*)(parkA + dt * 1024), xb = *(const LAS f32x4*)(parkB + dt * 1024);
        v2u wv; wv.x = pk2(xa[0], xa[1]); wv.y = pk2(xa[2], xa[3]); *(v2u*)(opa + 16 * dt) = wv;
        v2u wb; wb.x = pk2(xb[0], xb[1]); wb.y = pk2(xb[2], xb[3]); *(v2u*)(opb + 16 * dt) = wb; }
}

struct DecState { float m[4], l[4]; float o[4][16]; };
__device__ __forceinline__ void dec_job(const float* kbase, const float* vbase, int nkeys, const unsigned (&qp)[4][8], DecState& st, int lane) {
    const int ksub = lane >> 2, dq = lane & 3;
#pragma unroll 1
    for (int k0 = 0; k0 < nkeys; k0 += 16) { const int key = k0 + ksub; const bool ok = key < nkeys;
        const float* kp = kbase + (size_t)key * 256 + 16 * dq; const float* vp = vbase + (size_t)key * 256 + 16 * dq;
        f32x4 k4[4], v4[4];
#pragma unroll
        for (int j = 0; j < 4; ++j) { k4[j] = ok ? *(const f32x4*)(kp + 4 * j) : (f32x4){0.f, 0.f, 0.f, 0.f}; v4[j] = ok ? *(const f32x4*)(vp + 4 * j) : (f32x4){0.f, 0.f, 0.f, 0.f}; }
#pragma unroll
        for (int h = 0; h < 4; ++h) { float d = 0.f;
#pragma unroll
            for (int j = 0; j < 4; ++j) d += (k4[j][0] * bflo(qp[h][2 * j]) + k4[j][1] * bfhi(qp[h][2 * j])) + (k4[j][2] * bflo(qp[h][2 * j + 1]) + k4[j][3] * bfhi(qp[h][2 * j + 1]));
            d += dpp_xor1(d); d += dpp_xor2(d);
            const float sc = ok ? d : -1e30f, mn = fmaxf(st.m[h], sc), al = fexp2(st.m[h] - mn), p = ok ? fexp2(sc - mn) : 0.f;
            st.m[h] = mn; st.l[h] = st.l[h] * al + p;
#pragma unroll
            for (int j = 0; j < 4; ++j)
#pragma unroll
                for (int i = 0; i < 4; ++i) st.o[h][4 * j + i] = st.o[h][4 * j + i] * al + p * v4[j][i]; } }
}

__device__ __forceinline__ void attn_sample_item(const Params& P, int item, const AttnRefs& rf, LAS float* L, int tid, int lane, int wave) {
    unsigned char* ws = P.ws;
    const int s = item >> 2, g = item & 3, row = MP + s;
    LAS float* ocs = L; LAS unsigned* sel = (LAS unsigned*)(L + 256); LAS float* part = L + 260; LAS float* imps = L + 260 + 8 * 4 * 66;
    const float* gates = (const float*)(ws + WS_GATES) + (size_t)row * 48 + 4 * g * 3;
    if (wave == 0) {
        const int col = lane & 15, quad = lane >> 4, ql = col >> 2, hl = col & 3;
        const size_t qoff = (size_t)row * D + (4 * g + hl) * 64 + 8 * quad; const bf16* QN = (const bf16*)(ws + WS_QN);
        const bf16x8 qn0 = *(const bf16x8*)(QN + qoff), qn1 = *(const bf16x8*)(QN + qoff + 32);
        f32x4 oc[4]; unsigned msk[4];
        attn_cmp_select((const bf16*)(ws + WS_KCS) + (size_t)item * 128 * 64, (const bf16*)(ws + WS_VCTS) + (size_t)item * 2 * 4096, 64, qn0, qn1, 127, 8, 32, rf.cmp, imps, lane, oc, msk);
        const float g0 = gates[hl * 3];
        if (ql == 0) {
#pragma unroll
            for (int dt = 0; dt < 4; ++dt)
#pragma unroll
                for (int r = 0; r < 4; ++r) ocs[hl * 64 + 16 * dt + 4 * quad + r] = oc[dt][r] * g0; }
        if (lane == 0) sel[0] = msk[0];
    }
    __syncthreads();
    {
        const unsigned m0 = sel[0];
        const bool isw = wave >= 5;
        const int dq = lane & 3;
        unsigned qp[4][8];
        const bf16* QR = (const bf16*)(ws + WS_QR) + (size_t)row * D + 4 * g * 64 + 16 * dq;
#pragma unroll
        for (int h = 0; h < 4; ++h) { const v4u a = *(const v4u*)(QR + h * 64), b = *(const v4u*)(QR + h * 64 + 8);
            qp[h][0] = a.x; qp[h][1] = a.y; qp[h][2] = a.z; qp[h][3] = a.w; qp[h][4] = b.x; qp[h][5] = b.y; qp[h][6] = b.z; qp[h][7] = b.w; }
        DecState st;
#pragma unroll
        for (int h = 0; h < 4; ++h) { st.m[h] = -1e30f; st.l[h] = 0.f;
#pragma unroll
            for (int i = 0; i < 16; ++i) st.o[h][i] = 0.f; }
        const int* pt = (const int*)P.in[8] + s * 16;
#pragma unroll 1
        for (int jj = 0; jj < 4; ++jj) { const float* kb; const float* vb; int nk = 64;
            if (!isw) { const int J = wave + 5 * jj; if (J > 15) break;
                if (J == 15) { kb = P.out + O_SKS + (size_t)s * 256 + g * 64; vb = P.out + O_SVS + (size_t)s * 256 + g * 64; nk = 1; }
                else { unsigned bits = m0; for (int i = 0; i < J; ++i) bits &= bits - 1u; const int sg = bits ? __builtin_ctz(bits) : 0;
                    const size_t base = ((size_t)pt[sg >> 1] * 128 + (sg & 1) * 64) * 256 + g * 64; kb = P.in[4] + base; vb = P.in[5] + base; }
            } else { const int J = (wave - 5) + 3 * jj; if (J > 8) break;
                if (J == 8) { const size_t base = ((size_t)s * WIN + (WIN - 1)) * 256 + g * 64; kb = P.out + O_WKS + base; vb = P.out + O_WVS + base; nk = 1; }
                else { const size_t base = ((size_t)s * WIN + 64 * J) * 256 + g * 64; kb = P.in[6] + base; vb = P.in[7] + base; } }
            dec_job(kb, vb, nk, qp, st, lane); }
#pragma unroll
        for (int h = 0; h < 4; ++h) { float M = st.m[h]; M = fmaxf(M, __shfl_xor(M, 4)); M = fmaxf(M, __shfl_xor(M, 8)); M = fmaxf(M, __shfl_xor(M, 16)); M = fmaxf(M, __shfl_xor(M, 32));
            const float f = fexp2(st.m[h] - M); st.m[h] = M; st.l[h] *= f;
#pragma unroll
            for (int i = 0; i < 16; ++i) st.o[h][i] *= f; }
#pragma unroll
        for (int h = 0; h < 4; ++h) { float l = st.l[h]; l += __shfl_xor(l, 4); l += __shfl_xor(l, 8); l += __shfl_xor(l, 16); l += __shfl_xor(l, 32); st.l[h] = l;
#pragma unroll
            for (int i = 0; i < 16; ++i) { float v = st.o[h][i]; v += __shfl_xor(v, 4); v += __shfl_xor(v, 8); v += __shfl_xor(v, 16); v += __shfl_xor(v, 32); st.o[h][i] = v; } }
        if (lane < 4) {
#pragma unroll
            for (int h = 0; h < 4; ++h) { LAS float* pp = part + (wave * 4 + h) * 66; if (lane == 0) { pp[0] = st.m[h]; pp[1] = st.l[h]; }
#pragma unroll
                for (int i = 0; i < 16; ++i) pp[2 + 16 * dq + i] = st.o[h][i]; } }
    }
    __syncthreads();
    if (tid < 256) { const int h = tid >> 6, d = tid & 63;
        float res = ocs[h * 64 + d];
#pragma unroll
        for (int br = 0; br < 2; ++br) { const int w0 = br ? 5 : 0, w1 = br ? 8 : 5; float M = -1e30f;
            for (int w = w0; w < w1; ++w) M = fmaxf(M, part[(w * 4 + h) * 66]);
            float Lt = 0.f, Ot = 0.f;
            for (int w = w0; w < w1; ++w) { const LAS float* pp = part + (w * 4 + h) * 66; const float f = fexp2(pp[0] - M); Lt += pp[1] * f; Ot += pp[2 + d] * f; }
            res += (Lt > 0.f ? Ot / Lt : 0.f) * gates[h * 3 + 1 + br]; }
        ((bf16*)(ws + WS_O))[(size_t)row * D + (4 * g + h) * 64 + d] = (bf16)(pk2(res, 0.f) & 0xffffu); }
    __syncthreads();
}

__device__ __forceinline__ void phase_attn(const Params& P, LAS unsigned char* lds, int tid, int lane, int wave) {
    float qg = fabsf(P.in[20][lane]), k0 = fabsf(P.in[24][lane]), k1 = fabsf(P.in[24][64 + lane]), k2 = fabsf(P.in[24][128 + lane]);
    qg = wave_max(qg); k0 = wave_max(k0); k1 = wave_max(k1); k2 = wave_max(k2);
    AttnRefs rf; rf.cmp = -8.0f * 1.4426950409f * qg * k0; rf.slc = -8.0f * 1.4426950409f * qg * k1; rf.win = -8.0f * 1.4426950409f * qg * k2;
    LAS float* L = (LAS float*)lds;
    for (int item = blockIdx.x; item < 512 * ATT_REP_S; item += gridDim.x) attn_sample_item(P, item & 511, rf, L, tid, lane, wave);
    __syncthreads();
    {
        for (int k = 0; k < 4 * ATT_REP_P; ++k) { const int kk = k & 3; const int u0 = blockIdx.x + gridDim.x * kk;
            const int gam = u0 & 7, p0 = u0 >> 3; const int pt64 = (kk & 1) ? (32 * kk + 31 - (p0 & 31)) : p0;
            attn_prompt_unit(P, pt64 * 8 + gam, rf, lds, lane, wave); } }
    const int gtid = blockIdx.x * 512 + tid, ngt = gridDim.x * 512;
    for (int e = gtid; e < (M65 - MT) * 128; e += ngt) *(v4u*)((bf16*)(P.ws + WS_O) + (size_t)MT * D + (size_t)e * 8) = (v4u){0u, 0u, 0u, 0u};
}

constexpr int NPHASE = 15;
__global__ void __launch_bounds__(NWAVES * 64, 2) fwd(Params P) {
    extern __shared__ __attribute__((aligned(16))) unsigned char lds_raw[];
    LAS unsigned char* lds = (LAS unsigned char*)lds_raw;
    const int tid = threadIdx.x, lane = tid & 63, wave = __builtin_amdgcn_readfirstlane(tid >> 6);
    const int G = gridDim.x;
    unsigned char* ws = P.ws;
    for (int u = tid; u < (LDS_BYTES - LDSCTL_OFF) / 4; u += NWAVES * 64) ((LAS unsigned*)(lds + LDSCTL_OFF))[u] = 0u;
    __syncthreads();
    XcdBarrier bar; bar.bar = (unsigned*)(ws + WS_CTL) + CW_BAR; bar.x = 0; bar.st = nullptr;
#if !MK_PER_PHASE
    bar = xcd_barrier_post((unsigned*)(ws + WS_CTL) + CW_BAR, (volatile LAS unsigned*)(lds + MISC_OFF) + 8);
#endif
    const int lo = P.ph_lo, hi = P.ph_hi;
#ifndef PH_MASK
#define PH_MASK 0x7fff
#endif
#define EN(k) (((PH_MASK) >> (k)) & 1)
#ifndef REP_MASK
#define REP_MASK 0
#endif
#define REPS(k) ((((REP_MASK) >> (k)) & 1) + 1)
#define IN(k) (lo <= (k) && (k) < hi)
#if MK_PER_PHASE
#define GRID_BAR(k) do { } while (0)
#else
#define GRID_BAR(k) do { if ((k) + 1 < hi) xcd_barrier(bar); } while (0)
#endif
    bf16* WBIG = (bf16*)(ws + WS_WBIG); bf16* ACTA = (bf16*)(ws + WS_ACTA); float* SSQ = (float*)(ws + WS_SSQ);
    float* MOD = (float*)(ws + WS_MOD); float* BIAS = (float*)(ws + WS_BIAS); float* ROPE = (float*)(ws + WS_ROPE);
    const size_t SSQ_STRIDE = (size_t)M65 * 16;

    if (EN(0) && IN(0)) { for (int rep_ = 0; rep_ < REPS(0); ++rep_) phase0(P, lds, tid, lane, wave); GRID_BAR(0); }
    if (EN(1) && IN(1)) {
        pg8::Gemm g{(const bf16*)(ws + WS_SC), (const bf16*)(ws + WS_WADA), 256, NMOD, 1024, 1024, 1 << 30, 0}; pg8::StaticOrder S; S.init(256, NMOD, G, (int)blockIdx.x);
        EpiMod E{MOD, (bf16*)(ws + WS_SH), P.in[12]};
        pg8::gemm_phase<EpiMod, true>(lds + RING_OFF, g, S, E);
        __syncthreads();
        for (int rep_ = 0; rep_ < REPS(18); ++rep_) phase1_weights(P, lds, lane, wave);
        GRID_BAR(1); }
    if (EN(2) && IN(2)) {
        pg8::Gemm g{(const bf16*)(ws + WS_SH), WBIG, 1024, NBIG, 1024, 1024, 1 << 30, 0}; pg8::StaticOrder S; S.init(1024, NBIG, G, (int)blockIdx.x);
        EpiBias E{BIAS};
        for (int rep_ = 0; rep_ < REPS(2); ++rep_) pg8::gemm_phase<EpiBias, true>(lds + RING_OFF, g, S, E);
        for (int rep_ = 0; rep_ < REPS(15); ++rep_) phase2_tail(P, tid, lane, wave);
        for (int rep_ = 0; rep_ < REPS(16); ++rep_) sample_prepass(P, tid, lane, wave);
        GRID_BAR(2); }
#define COMMON_PHASES(layer) do { \
        const int po = layer ? 12 : 5; \
        if (EN(5) && IN(po)) { \
            pg8::Gemm g{layer ? (const bf16*)(ws + WS_O) : (const bf16*)(ws + WS_UM), layer ? (const bf16*)(ws + WS_WBO) : (const bf16*)(ws + WS_WOUT), MP, 1024, 1024, 1024, 1 << 30, 0}; \
            pg8::StaticOrder S; S.init(MP, 1024, G, (int)blockIdx.x); \
            EpiRes E{layer ? P.out : P.in[0], layer ? P.out + (size_t)MP * D : P.in[1], MOD, layer * 6144 + 2048, P.out, (const float*)(ws + WS_MUL) + (size_t)(layer ? 2 : 0) * 256 * 1024, ACTA, nullptr, nullptr, SSQ + (layer ? 4 : 2) * SSQ_STRIDE}; \
            for (int rep_ = 0; rep_ < (layer ? 1 : REPS(5)); ++rep_) pg8::gemm_phase<EpiRes, true>(lds + RING_OFF, g, S, E); \
            skinny_res(g.A, 1024, 1024, g.Bt, E, lds, tid, lane, wave); \
            GRID_BAR(po); } \
        if (EN(6) && IN(po + 1)) { \
            const int off = layer ? OFF_GU1 : OFF_GU0; \
            pg8::Gemm g{ACTA, WBIG + (size_t)off * 1024, M65, NGU, 1024, 1024, 1 << 30, 0}; pg8::StaticOrder S; S.init(M65, NGU, G, (int)blockIdx.x); \
            EpiGU E{SSQ + (layer ? 4 : 2) * SSQ_STRIDE, BIAS, off, (bf16*)(ws + WS_HID)}; \
            for (int rep_ = 0; rep_ < (layer ? 1 : REPS(6)); ++rep_) pg8::gemm_phase<EpiGU, true>(lds + RING_OFF, g, S, E); \
            GRID_BAR(po + 1); } \
        if (EN(7) && IN(po + 2)) { \
            pg8::Gemm g{(const bf16*)(ws + WS_HID), (const bf16*)(ws + WS_WDN) + (size_t)layer * 1024 * DFF, MP, 1024, DFF, DFF, 1 << 30, 0}; pg8::StaticOrder S; S.init(MP, 1024, G, (int)blockIdx.x); \
            EpiRes E{P.out, P.out + (size_t)MP * D, MOD, layer * 6144 + 5120, P.out, (const float*)(ws + WS_MUL) + (size_t)256 * 1024, layer ? nullptr : ACTA, P.in[22], layer ? nullptr : (bf16*)(ws + WS_AKV), layer ? nullptr : SSQ + 3 * SSQ_STRIDE}; \
            pg8::gemm_phase<EpiRes, true>(lds + RING_OFF, g, S, E); \
            skinny_res(g.A, DFF, DFF, g.Bt, E, lds, tid, lane, wave); \
            GRID_BAR(po + 2); } \
    } while (0)
            if (EN(3) && IN(3)) {
                pg8::Gemm g{ACTA, WBIG + (size_t)OFF_WIN * 1024, MP, NAIN, 1024, 1024, 1 << 30, 0}; pg8::StaticOrder S; S.init(MP, NAIN, G, (int)blockIdx.x);
                EpiAin E{SSQ, BIAS, (bf16*)(ws + WS_U), (bf16*)(ws + WS_V), SSQ + SSQ_STRIDE};
                for (int rep_ = 0; rep_ < REPS(3); ++rep_) pg8::gemm_phase<EpiAin, true>(lds + RING_OFF, g, S, E);
                skinny_ain(ACTA, WBIG + (size_t)OFF_WIN * 1024, E, lds, tid, lane, wave);
                GRID_BAR(3); }
            if (EN(4) && IN(4)) { for (int rep_ = 0; rep_ < REPS(4); ++rep_) phase_tokmix(P, lds, tid, lane, wave); GRID_BAR(4); }
    COMMON_PHASES(0);
            if (EN(8) && IN(8)) {
                { pg8::Gemm g{(const bf16*)(ws + WS_AKV), (const bf16*)(ws + WS_WKV), M65, NKV, 1024, 1024, 1 << 30, 0}; pg8::StaticOrder S; S.init(M65, NKV, G, (int)blockIdx.x);
                  EpiKV E{SSQ + 3 * SSQ_STRIDE, P.in[24], ROPE, P.out, (bf16*)(ws + WS_RC), (bf16*)(ws + WS_KS), (bf16*)(ws + WS_KW), (bf16*)(ws + WS_VST), (bf16*)(ws + WS_VWT)};
                  for (int rep_ = 0; rep_ < REPS(8); ++rep_) pg8::gemm_phase<EpiKV, true>(lds + RING_OFF, g, S, E); }
                { pg8::Gemm g{ACTA, WBIG + (size_t)OFF_Q * 1024, M65, NQP, 1024, 1024, 1 << 30, 0}; pg8::StaticOrder S; S.init(M65, NQP, G, (int)((blockIdx.x + 122) % G));
                  EpiQ E{SSQ + 3 * SSQ_STRIDE, BIAS, P.in[20], ROPE, (bf16*)(ws + WS_QN), (bf16*)(ws + WS_QR), (float*)(ws + WS_GATES)};
                  for (int rep_ = 0; rep_ < REPS(17); ++rep_) pg8::gemm_phase<EpiQ, true>(lds + RING_OFF, g, S, E); }
                GRID_BAR(8); }
            if (EN(9) && IN(9)) {
                pg8::Gemm g{(const bf16*)(ws + WS_RC), (const bf16*)(ws + WS_W1C), 2 * RC_KV, 256, 2048, 1024, RC_KV / 256, (long)256 * 2048}; pg8::StaticOrder S; S.init(2 * RC_KV, 256, G, (int)blockIdx.x);
                EpiCmp E{(const float*)(ws + WS_C1), (bf16*)(ws + WS_H2)};
                for (int rep_ = 0; rep_ < REPS(9); ++rep_) pg8::gemm_phase<EpiCmp, true>(lds + RING_OFF, g, S, E);
                GRID_BAR(9); }
            if (EN(10) && IN(10)) { for (int rep_ = 0; rep_ < REPS(10); ++rep_) phase_w2(P, lane, wave); GRID_BAR(10); }
            if (EN(11) && IN(11)) { for (int rep_ = 0; rep_ < REPS(11); ++rep_) phase_attn(P, lds, tid, lane, wave); GRID_BAR(11); }
    COMMON_PHASES(1);
#undef IN
#undef EN
#undef REPS
#undef GRID_BAR
}

extern "C" void kernel_launch(void* const* d_in, const int* in_sizes, int n_in, void* d_out, int out_size, void* d_ws, size_t ws_size, hipStream_t stream) {
    static int grid = 0;
    if (grid == 0) {
        if (n_in != 32 || ws_size < WS_END) { fprintf(stderr, "kernel_launch: unexpected problem (n_in %d, ws %zu < %zu)\n", n_in, ws_size, (size_t)WS_END); grid = -1; return; }
        int dev = 0, cus = 0;
        if (hipGetDevice(&dev) != hipSuccess || hipDeviceGetAttribute(&cus, hipDeviceAttributeMultiprocessorCount, dev) != hipSuccess) { grid = -1; return; }
        if (hipFuncSetAttribute((const void*)fwd, hipFuncAttributeMaxDynamicSharedMemorySize, LDS_BYTES) != hipSuccess) { fprintf(stderr, "kernel_launch: hipFuncSetAttribute failed\n"); grid = -1; return; }
        int per_cu = 0;
        if (hipOccupancyMaxActiveBlocksPerMultiprocessor(&per_cu, (const void*)fwd, NWAVES * 64, LDS_BYTES) != hipSuccess || per_cu < 1) fprintf(stderr, "kernel_launch: occupancy query says %d\n", per_cu);
        (void)hipGetLastError();
        grid = cus;
    }
    if (grid < 0) return;
    (void)hipMemsetAsync((char*)d_ws + WS_CTL, 0, CTL_ZERO_BYTES, stream);
    Params p{};
    for (int i = 0; i < 32; ++i) p.in[i] = (const float*)d_in[i];
    p.out = (float*)d_out; p.ws = (unsigned char*)d_ws;
#if MK_PER_PHASE
    for (int k = 0; k < NPHASE; ++k) { p.ph_lo = k; p.ph_hi = k + 1; hipLaunchKernelGGL(fwd, dim3(grid), dim3(NWAVES * 64), LDS_BYTES, stream, p); }
#else
    p.ph_lo = 0; p.ph_hi = NPHASE;
    hipLaunchKernelGGL(fwd, dim3(grid), dim3(NWAVES * 64), LDS_BYTES, stream, p);
#endif
    const hipError_t le = hipPeekAtLastError();
    if (le != hipSuccess) fprintf(stderr, "kernel_launch: launch failed: %s\n", hipGetErrorName(le));
}
```

```cpp
#include <hip/hip_runtime.h>
#include <hip/hip_bf16.h>
#include <cstdio>
#include <cstdint>
#include <cmath>

#ifndef MK_PER_PHASE
#define MK_PER_PHASE 0
#endif

namespace pg8 {
#define PG8_LAS __attribute__((address_space(3)))
typedef unsigned short bf16_t;
typedef short bf16x8 __attribute__((ext_vector_type(8)));
typedef float f32x4 __attribute__((ext_vector_type(4)));
typedef unsigned u32x4 __attribute__((ext_vector_type(4)));
typedef unsigned u32x2 __attribute__((ext_vector_type(2)));
constexpr int BM = 256, BK = 64, HALF = 128, HTB = HALF * BK * 2, STAGE_BYTES = 8 * HTB, NXCD = 8, WGM = 8;

__host__ __device__ __forceinline__ int lds_byte(int r, int c) { const int st = (r >> 4) * 2 + (c >> 5), rr = r & 15, cc = c & 31, ob = rr * 64 + cc * 2; return st * 1024 + (ob ^ (((ob >> 9) & 1) << 5)); }
__host__ __device__ __forceinline__ void stage_rc(int b, int& R, int& C) { const int st = b / 1024, sb = b % 1024, swz = sb ^ (((sb >> 9) & 1) << 5); R = (st >> 1) * 16 + swz / 64; C = (st & 1) * 32 + (swz % 64) / 2; }
__host__ __device__ __forceinline__ int perm32(int rho) { const int n = rho >> 4, i = rho & 15; return 8 * (i >> 2) + 4 * n + (i & 3); }

struct Unit { int pm, pn; };
struct Gemm { const bf16_t* A; const bf16_t* Bt; int M, N, K, lda, bsplit; long boff; };

struct StaticOrder {
    int nM, nN, nwg, G, c;
    __host__ __device__ void init(int M, int N, int G_, int c_) { nM = M / BM; nN = N / BM; nwg = nM * nN; G = G_; c = c_; }
    __host__ __device__ bool next(int i, Unit& u) const {
        const long L = (long)i * G + c; if (L >= nwg) return false;
        int wgid = (int)L; { const int q = nwg / NXCD, r = nwg % NXCD, xcd = wgid % NXCD, off = wgid / NXCD; wgid = (xcd < r ? xcd * (q + 1) : r * (q + 1) + (xcd - r) * q) + off; }
        const int nig = WGM * nN, gid = wgid / nig, fm = gid * WGM, gsz = (nM - fm) < WGM ? (nM - fm) : WGM;
        u.pm = fm + ((wgid % nig) % gsz); u.pn = (wgid % nig) / gsz; return true;
    }
};

template <class Epi, bool ALIGN_EPI>
__device__ __forceinline__ void gemm_phase(PG8_LAS unsigned char* lds, const Gemm g, const StaticOrder& S, const Epi& E) {
    const int tid = threadIdx.x, wid = __builtin_amdgcn_readfirstlane(tid >> 6), lane = tid & 63, wr = wid >> 2, wc = wid & 3, fr = lane & 15, fq = lane >> 4;
    const int K = g.K, nt = K / BK, lda = g.lda;
    unsigned voffA[2], voffB[2];
#pragma unroll
    for (int i = 0; i < 2; ++i) { int R, C; stage_rc(tid * 16 + i * 8192, R, C); const int Rb = ((R & ~31) + perm32(R & 31));
        voffA[i] = (unsigned)(R * lda + C) * 2u; voffB[i] = (unsigned)(Rb * K + C) * 2u; }
    const size_t kstep = (size_t)(BK * 2);
    const size_t hstepA = (size_t)HALF * lda * 2, hstepB = (size_t)HALF * K * 2;
    const size_t tstepA = 2 * hstepA, tstepB = 2 * hstepB;
    const unsigned ldsw = (unsigned)wid * 1024u;
    const int aoff = lds_byte(wr * 64 + fr, fq * 8), boff = lds_byte(wc * 32 + fr, fq * 8);
#define PG8_SA(b, h) (((b) * 2 + (h)) * HTB)
#define PG8_SB(b, h) ((4 + (b) * 2 + (h)) * HTB)
#define PG8_STAGE(bufoff, gbase, voff) do { _Pragma("unroll") for (int _i = 0; _i < 2; ++_i) \
        __builtin_amdgcn_global_load_lds((const unsigned*)((const char*)(gbase) + (voff)[_i]), (PG8_LAS unsigned*)(lds + (bufoff) + ldsw + _i * 8192), 16, 0, 0); } while (0)
#define PG8_LDA(dst, b, h) do { _Pragma("unroll") for (int m = 0; m < 4; ++m) _Pragma("unroll") for (int k = 0; k < 2; ++k) dst[m][k] = *(const PG8_LAS bf16x8*)(lds + PG8_SA(b, h) + aoff + m * 2048 + k * 1024); } while (0)
#define PG8_LDB(dst, b, h) do { _Pragma("unroll") for (int n = 0; n < 2; ++n) _Pragma("unroll") for (int k = 0; k < 2; ++k) dst[n][k] = *(const PG8_LAS bf16x8*)(lds + PG8_SB(b, h) + boff + n * 2048 + k * 1024); } while (0)
#define PG8_MMA(ai, bj, At, Bt) do { __builtin_amdgcn_s_setprio(1); _Pragma("unroll") for (int m = 0; m < 4; ++m) _Pragma("unroll") for (int n = 0; n < 2; ++n) _Pragma("unroll") for (int k = 0; k < 2; ++k) \
        acc[ai][bj][m][n] = __builtin_amdgcn_mfma_f32_16x16x32_bf16(Bt[n][k], At[m][k], acc[ai][bj][m][n], 0, 0, 0); __builtin_amdgcn_s_setprio(0); } while (0)
#define PG8_WAIT_V(n) asm volatile("s_waitcnt vmcnt(" #n ")" ::: "memory")
#define PG8_WAIT_L(n) asm volatile("s_waitcnt lgkmcnt(" #n ")" ::: "memory")
#define PG8_BAR __builtin_amdgcn_s_barrier()
#define PG8_SCHED __builtin_amdgcn_sched_barrier(0)
    Unit cur, nxt; int ui = 0;
    if (!S.next(0, cur)) return;
    f32x4 acc[2][2][4][2];
#pragma unroll
    for (int a = 0; a < 2; ++a)
#pragma unroll
        for (int b = 0; b < 2; ++b)
#pragma unroll
            for (int m = 0; m < 4; ++m)
#pragma unroll
                for (int n = 0; n < 2; ++n) acc[a][b][m][n] = (f32x4){0.f, 0.f, 0.f, 0.f};
    bf16x8 At[4][2], B0[2][2], B1[2][2];
    const char* cA = (const char*)g.A + (size_t)cur.pm * tstepA;
    const char* cB = (const char*)g.Bt + (cur.pm >= g.bsplit ? (size_t)g.boff * 2 : (size_t)0) + (size_t)cur.pn * tstepB;
    PG8_STAGE(PG8_SB(0, 0), cB, voffB); PG8_STAGE(PG8_SB(0, 1), cB + hstepB, voffB); PG8_STAGE(PG8_SA(0, 0), cA, voffA); PG8_STAGE(PG8_SA(0, 1), cA + hstepA, voffA);
    if (wr == 1) PG8_BAR;
    PG8_WAIT_V(2); PG8_BAR;
    PG8_STAGE(PG8_SB(1, 0), cB + kstep, voffB); PG8_STAGE(PG8_SA(1, 0), cA + kstep, voffA); PG8_STAGE(PG8_SB(1, 1), cB + hstepB + kstep, voffB);
    PG8_WAIT_V(6); PG8_BAR;
    for (;;) {
        const bool has_next = S.next(ui + 1, nxt);
        const char* nA = has_next ? (const char*)g.A + (size_t)nxt.pm * tstepA : cA;
        const char* nB = has_next ? (const char*)g.Bt + (nxt.pm >= g.bsplit ? (size_t)g.boff * 2 : (size_t)0) + (size_t)nxt.pn * tstepB : cB;
        for (int t = 0; t < nt; t += 2) {
            const bool last = (t == nt - 2);
            const char* a1 = cA + (size_t)(t + 1) * kstep;
            const char* a2 = last ? nA : cA + (size_t)(t + 2) * kstep; const char* b2 = last ? nB : cB + (size_t)(t + 2) * kstep;
            const char* a3 = a2 + kstep; const char* b3 = b2 + kstep;
            PG8_LDB(B0, 0, 0); PG8_LDB(B1, 0, 1); PG8_SCHED; PG8_LDA(At, 0, 0); PG8_STAGE(PG8_SA(1, 1), a1 + hstepA, voffA);
            PG8_WAIT_V(8); PG8_WAIT_L(0); PG8_BAR; PG8_MMA(0, 0, At, B0); PG8_MMA(0, 1, At, B1); PG8_BAR; PG8_SCHED;
            PG8_LDA(At, 0, 1); PG8_STAGE(PG8_SB(0, 0), b2, voffB); PG8_STAGE(PG8_SB(0, 1), b2 + hstepB, voffB); PG8_STAGE(PG8_SA(0, 0), a2, voffA);
            PG8_WAIT_V(8); PG8_WAIT_L(0); PG8_BAR; PG8_MMA(1, 0, At, B0); PG8_MMA(1, 1, At, B1); PG8_BAR; PG8_SCHED;
            PG8_LDB(B0, 1, 0); PG8_LDB(B1, 1, 1); PG8_SCHED; PG8_LDA(At, 1, 0); PG8_STAGE(PG8_SA(0, 1), a2 + hstepA, voffA);
            PG8_WAIT_V(8); PG8_WAIT_L(0); PG8_BAR; PG8_MMA(0, 0, At, B0); PG8_MMA(0, 1, At, B1); PG8_BAR; PG8_SCHED;
            PG8_LDA(At, 1, 1); PG8_STAGE(PG8_SB(1, 0), b3, voffB); PG8_STAGE(PG8_SB(1, 1), b3 + hstepB, voffB); PG8_STAGE(PG8_SA(1, 0), a3, voffA);
            PG8_WAIT_V(8); PG8_WAIT_L(0); PG8_BAR; PG8_MMA(1, 0, At, B0); PG8_MMA(1, 1, At, B1); PG8_BAR; PG8_SCHED;
        }
        if constexpr (ALIGN_EPI) { if (wr == 0) PG8_BAR; }
        E(acc, cur, wr, wc, fr, fq);
        if (!has_next) break;
#pragma unroll
        for (int a = 0; a < 2; ++a)
#pragma unroll
            for (int b = 0; b < 2; ++b)
#pragma unroll
                for (int m = 0; m < 4; ++m)
#pragma unroll
                    for (int n = 0; n < 2; ++n) acc[a][b][m][n] = (f32x4){0.f, 0.f, 0.f, 0.f};
        cur = nxt; cA = nA; cB = nB; ++ui;
        if constexpr (ALIGN_EPI) { if (wr == 1) PG8_BAR; }
    }
    PG8_WAIT_V(0);
    if constexpr (!ALIGN_EPI) { if (wr == 0) PG8_BAR; }
    PG8_BAR;
#undef PG8_SA
#undef PG8_SB
#undef PG8_STAGE
#undef PG8_LDA
#undef PG8_LDB
#undef PG8_MMA
#undef PG8_WAIT_V
#undef PG8_WAIT_L
#undef PG8_BAR
#undef PG8_SCHED
}
}

#define GAS __attribute__((address_space(1)))
#define LAS __attribute__((address_space(3)))
typedef unsigned short bf16;
typedef unsigned v4u __attribute__((ext_vector_type(4)));
typedef unsigned v2u __attribute__((ext_vector_type(2)));
typedef float f32x4 __attribute__((ext_vector_type(4)));
typedef float f32x2 __attribute__((ext_vector_type(2)));
typedef short bf16x8 __attribute__((ext_vector_type(8)));
typedef short bf16x4 __attribute__((ext_vector_type(4)));
typedef __bf16 bf16x2_t __attribute__((ext_vector_type(2)));
typedef GAS unsigned gu32;
#define RLX_AGENT __ATOMIC_RELAXED, __HIP_MEMORY_SCOPE_AGENT
#define LDS_WAIT() asm volatile("s_waitcnt lgkmcnt(0)" ::: "memory")
#define VM_WAIT() asm volatile("s_waitcnt vmcnt(0)" ::: "memory")
__device__ __forceinline__ unsigned pk2(float lo, float hi) { f32x2 v = {lo, hi}; bf16x2_t b = __builtin_convertvector(v, bf16x2_t); return __builtin_bit_cast(unsigned, b); }
__device__ __forceinline__ float bf2f(unsigned short h) { return __builtin_bit_cast(float, (unsigned)h << 16); }
__device__ __forceinline__ float bflo(unsigned w) { return __builtin_bit_cast(float, w << 16); }
__device__ __forceinline__ float bfhi(unsigned w) { return __builtin_bit_cast(float, w & 0xffff0000u); }
__device__ __forceinline__ float fexp2(float x) { return __builtin_amdgcn_exp2f(x); }
__device__ __forceinline__ float frcp(float x) { return __builtin_amdgcn_rcpf(x); }
__device__ __forceinline__ float gelu_t(float x) { const float x2 = x * x; const float e = fexp2(x * (-2.302208198f + -0.1029432357f * x2)); return x * frcp(1.f + e); }
__device__ __forceinline__ float silu_f(float x) { return x * frcp(1.f + fexp2(-1.4426950409f * x)); }
__device__ __forceinline__ float sigmoid_f(float x) { return frcp(1.f + fexp2(-1.4426950409f * x)); }
__device__ __forceinline__ float dpp_xor1(float v) { return __builtin_bit_cast(float, __builtin_amdgcn_update_dpp(0, __builtin_bit_cast(int, v), 0xB1, 0xF, 0xF, true)); }
__device__ __forceinline__ float dpp_xor2(float v) { return __builtin_bit_cast(float, __builtin_amdgcn_update_dpp(0, __builtin_bit_cast(int, v), 0x4E, 0xF, 0xF, true)); }
__device__ __forceinline__ unsigned dpp_xor1u(unsigned v) { return (unsigned)__builtin_amdgcn_update_dpp(0, (int)v, 0xB1, 0xF, 0xF, true); }
__device__ __forceinline__ unsigned dpp_xor2u(unsigned v) { return (unsigned)__builtin_amdgcn_update_dpp(0, (int)v, 0x4E, 0xF, 0xF, true); }
__device__ __forceinline__ float wave_sum(float v) {
#pragma unroll
    for (int o = 1; o < 64; o <<= 1) v += __shfl_xor(v, o);
    return v;
}
__device__ __forceinline__ float wave_max(float v) {
#pragma unroll
    for (int o = 1; o < 64; o <<= 1) v = fmaxf(v, __shfl_xor(v, o));
    return v;
}

#define XB_TMO      128
#define XB_XCNT(j)  (256  + 64 * (j))
#define XB_XSUB(j)  (1280 + 64 * (j))
#define XB_XGEN(j)  (2304 + 64 * (j))
#define XB_TOP      3328
#define XB_TOPGEN   3392
#define XCD_BAR_WORDS 3456
#define XB_SPIN_CAP (1u << 18)

__device__ __forceinline__ unsigned xb_ld(unsigned* p)              { return __hip_atomic_load(p, __ATOMIC_RELAXED, __HIP_MEMORY_SCOPE_AGENT); }
__device__ __forceinline__ unsigned xb_add(unsigned* p, unsigned v) { return __hip_atomic_fetch_add(p, v, __ATOMIC_RELAXED, __HIP_MEMORY_SCOPE_AGENT); }
__device__ __forceinline__ unsigned xb_xcc_id() { return (unsigned)__builtin_amdgcn_s_getreg((3 << 11) | 20) & 0xFu; }
#define XB_SPIN(cond, bar) do { unsigned _sp = 0; while (cond) { __builtin_amdgcn_s_sleep(1); \
    if ((++_sp & 255u) == 0u) { if (xb_ld(&(bar)[XB_TMO])) break; if (_sp > XB_SPIN_CAP) { atomicAdd(&(bar)[XB_TMO], 1u); break; } } } } while (0)

struct XcdBarrier { unsigned* bar; unsigned x; volatile LAS unsigned* st; };

__device__ __forceinline__ XcdBarrier xcd_barrier_post(unsigned* bar, volatile LAS unsigned* st) {
    XcdBarrier b; b.bar = bar; b.x = xb_xcc_id(); b.st = st;
    if (threadIdx.x == 0) (void)xb_add(&bar[XB_XCNT(b.x)], 1u);
    return b;
}
__device__ __forceinline__ void xcd_barrier_complete(unsigned* bar, unsigned x, unsigned& nloc, unsigned& nx) {
    const unsigned G = gridDim.x * gridDim.y * gridDim.z;
    unsigned sum, cnt, mine, sp = 0u;
    for (;;) {
        sum = 0u; cnt = 0u; mine = 0u;
#pragma unroll
        for (unsigned j = 0; j < 16; ++j) { const unsigned c = xb_ld(&bar[XB_XCNT(j)]); sum += c; cnt += (c > 0u) ? 1u : 0u; mine = (j == x) ? c : mine; }
        if (sum == G) break;
        __builtin_amdgcn_s_sleep(1);
        if ((++sp & 255u) == 0u) { if (xb_ld(&bar[XB_TMO])) break; if (sp > XB_SPIN_CAP) { atomicAdd(&bar[XB_TMO], 1u); break; } }
    }
    nloc = mine > 0u ? mine : 1u; nx = cnt > 0u ? cnt : 1u;
}
__device__ __forceinline__ void xcd_barrier(const XcdBarrier& b) {
    asm volatile("s_waitcnt vmcnt(0)" ::: "memory");
    __syncthreads();
    if (threadIdx.x == 0) {
        unsigned* bar = b.bar;
        __builtin_amdgcn_s_waitcnt(0);
        unsigned nloc = b.st[0], nx = b.st[1];
        if (nloc == 0u) { xcd_barrier_complete(bar, b.x, nloc, nx); b.st[0] = nloc; b.st[1] = nx; }
        const unsigned old = xb_add(&bar[XB_XSUB(b.x)], 1u);
        const unsigned gen = old / nloc;
        if (old + 1u == (gen + 1u) * nloc) {
            __builtin_amdgcn_fence(__ATOMIC_RELEASE, "agent");
            asm volatile("s_waitcnt vmcnt(0)" ::: "memory");
            const unsigned og = xb_add(&bar[XB_TOP], 1u);
            const unsigned tg = og / nx;
            if (og + 1u == (tg + 1u) * nx) xb_add(&bar[XB_TOPGEN], 1u);
            else XB_SPIN(xb_ld(&bar[XB_TOPGEN]) == tg, bar);
            __builtin_amdgcn_fence(__ATOMIC_ACQUIRE, "agent");
            xb_add(&bar[XB_XGEN(b.x)], 1u);
            asm volatile("s_waitcnt vmcnt(0)" ::: "memory");
        } else {
            XB_SPIN(xb_ld(&bar[XB_XGEN(b.x)]) == gen, bar);
            __builtin_amdgcn_fence(__ATOMIC_ACQUIRE, "agent");
            asm volatile("s_waitcnt vmcnt(0)" ::: "memory");
        }
    }
    __syncthreads();
}

constexpr int NWAVES = 8;
constexpr int D = 1024, SEQ = 8192, NBATCH = 2, MP = NBATCH * SEQ, MS = 128, MT = MP + MS, M65 = 16640;
constexpr int DFF = 2816, NGU = 2 * DFF, NAIN = 2048, NKV = 1536, NQ = 1072, NQP = 1280;
constexpr int NBIG = NAIN + NGU + NQP + NGU;
constexpr int OFF_WIN = 0, OFF_GU0 = NAIN, OFF_Q = NAIN + NGU, OFF_GU1 = NAIN + NGU + NQP;
constexpr int NMOD = 12288;
constexpr int PAST = 2048, NPAGE = 16, PAGE = 128, WIN = 512;
constexpr int RC_SAMP = 512 * 128, RC_PROMPT = 8 * 512, RC_KV = RC_SAMP + RC_PROMPT;
constexpr float EPS = 1e-6f;
constexpr float C2 = 0.125f * 1.4426950408889634f;

constexpr size_t O_YP = 0, O_YS = 16777216, O_AVP = 16908288, O_AVS = 17170432, O_CKP = 17301504, O_CVP = 21495808, O_SKP = 25690112, O_SVP = 29884416,
                 O_WKP = 34078720, O_WVP = 34340864, O_CKS = 34603008, O_CVS = 34635776, O_SKS = 34668544, O_SVS = 34701312, O_WKS = 34734080, O_WVS = 51511296;

constexpr size_t al256(size_t x) { return (x + 255) & ~(size_t)255; }
constexpr size_t WS_CTL = 0, CTL_ZERO_BYTES = 1u << 20;
constexpr size_t WS_WADA = CTL_ZERO_BYTES;
constexpr size_t WS_WBIG = WS_WADA + (size_t)NMOD * D * 2;
constexpr size_t WS_WOUT = WS_WBIG + (size_t)NBIG * D * 2;
constexpr size_t WS_WBO = WS_WOUT + (size_t)D * D * 2;
constexpr size_t WS_WDN = WS_WBO + (size_t)D * D * 2;
constexpr size_t WS_WKV = WS_WDN + (size_t)2 * D * DFF * 2;
constexpr size_t WS_W1C = WS_WKV + (size_t)NKV * D * 2;
constexpr size_t WS_W2 = WS_W1C + (size_t)2 * 256 * 2048 * 2;
constexpr size_t WS_WSB = WS_W2 + (size_t)2 * 64 * 256 * 2;
constexpr size_t WS_ROPE = WS_WSB + (size_t)8 * 128 * 128 * 2;
constexpr size_t WS_C1 = WS_ROPE + (size_t)8192 * 64 * 4;
constexpr size_t WS_SC = WS_C1 + 2 * 256 * 4;
constexpr size_t WS_MOD = WS_SC + (size_t)256 * D * 2;
constexpr size_t WS_SH = WS_MOD + (size_t)256 * NMOD * 4;
constexpr size_t WS_BIAS = WS_SH + (size_t)4 * 256 * D * 2;
constexpr size_t WS_MUL = WS_BIAS + (size_t)256 * NBIG * 4;
constexpr size_t WS_SSQ = WS_MUL + (size_t)3 * 256 * D * 4;
constexpr size_t WS_ACTA = WS_SSQ + (size_t)5 * M65 * 16 * 4;
constexpr size_t ACT_BYTES = (size_t)M65 * D * 2;
constexpr size_t WS_AKV = WS_ACTA + ACT_BYTES;
constexpr size_t WS_U = WS_AKV + ACT_BYTES;
constexpr size_t WS_V = WS_U + ACT_BYTES;
constexpr size_t WS_UM = WS_V + ACT_BYTES;
constexpr size_t WS_QN = WS_UM + ACT_BYTES;
constexpr size_t WS_QR = WS_QN + ACT_BYTES;
constexpr size_t WS_O = WS_QR + ACT_BYTES;
constexpr size_t WS_GATES = WS_O + ACT_BYTES;
constexpr size_t WS_HID = WS_GATES + (size_t)M65 * 48 * 4;
constexpr size_t WS_KS = WS_HID + (size_t)M65 * DFF * 2;
constexpr size_t WS_KW = WS_KS + (size_t)8 * SEQ * 64 * 2;
constexpr size_t WS_VST = WS_KW + (size_t)8 * SEQ * 64 * 2;
constexpr size_t WS_VWT = WS_VST + (size_t)8 * SEQ * 64 * 2;
constexpr size_t WS_RC = WS_VWT + (size_t)8 * SEQ * 64 * 2;
constexpr size_t WS_H2 = WS_RC + (size_t)2 * RC_KV * 1024 * 2 + 4096;
constexpr size_t WS_KCP = WS_H2 + (size_t)2 * RC_KV * 256 * 2;
constexpr size_t WS_VCTP = WS_KCP + (size_t)8 * 512 * 64 * 2;
constexpr size_t WS_KCS = WS_VCTP + (size_t)8 * 512 * 64 * 2;
constexpr size_t WS_VCTS = WS_KCS + (size_t)512 * 128 * 64 * 2;
constexpr size_t WS_END = WS_VCTS + (size_t)512 * 128 * 64 * 2;
static_assert(WS_WBIG % 256 == 0 && WS_ROPE % 256 == 0 && WS_SC % 256 == 0 && WS_ACTA % 256 == 0 && WS_HID % 256 == 0 && WS_RC % 256 == 0 && WS_H2 % 256 == 0 && WS_KCP % 256 == 0, "ws alignment");
constexpr int CW_BAR = 4096;

constexpr int RING_OFF = 0, RING_BYTES = 131072;
constexpr int LDSCTL_OFF = RING_BYTES, MISC_OFF = LDSCTL_OFF + 320;
constexpr int LDS_BYTES = 163840;

struct Params {
    const float* in[32];
    float* out;
    unsigned char* ws;
    int ph_lo, ph_hi;
};

__device__ __forceinline__ int seq_of(int row) { const int s = row - MP + 2; return row < MP ? (row >> 13) : (s < 255 ? s : 255); }
__device__ __forceinline__ float rstd16(const float* p) {
    const f32x4 a = *(const f32x4*)p, b = *(const f32x4*)(p + 4), c = *(const f32x4*)(p + 8), d = *(const f32x4*)(p + 12);
    const float s = ((a.x + a.y) + (a.z + a.w)) + ((b.x + b.y) + (b.z + b.w)) + ((c.x + c.y) + (c.z + c.w)) + ((d.x + d.y) + (d.z + d.w));
    return rsqrtf(s * (1.0f / 1024.0f) + EPS);
}

using pg8::Unit;
#define EPI_ARGS const pg8::f32x4 (&acc)[2][2][4][2], const Unit& u, int wr, int wc, int fr, int fq

struct EpiMod {
    float* MOD; bf16* SH; const float* b_ada;
    __device__ __forceinline__ void operator()(EPI_ARGS) const { asm volatile("" ::: "memory");
        const int cl = wc * 32 + 8 * fq, c0 = u.pn * 256 + cl;
        const int pl = u.pn % 24, lay = u.pn / 24;
        const int np = (pl < 4) ? 2 * lay : ((pl >= 12 && pl < 16) ? 2 * lay + 1 : -1);
        const int j0 = (pl < 4 ? pl : pl - 12) * 256 + cl;
        f32x4 bv[2][2];
#pragma unroll
        for (int bj = 0; bj < 2; ++bj)
#pragma unroll
            for (int n = 0; n < 2; ++n) bv[bj][n] = *(const f32x4*)(b_ada + c0 + bj * 128 + 4 * n);
#pragma unroll
        for (int ai = 0; ai < 2; ++ai)
#pragma unroll
            for (int m = 0; m < 4; ++m) { const int row = ai * 128 + wr * 64 + m * 16 + fr;
#pragma unroll
                for (int bj = 0; bj < 2; ++bj) { const f32x4 v0 = acc[ai][bj][m][0] + bv[bj][0], v1 = acc[ai][bj][m][1] + bv[bj][1];
                    float* p = MOD + (size_t)row * NMOD + c0 + bj * 128; *(f32x4*)p = v0; *(f32x4*)(p + 4) = v1;
                    if (np >= 0) { v4u w; w.x = pk2(v0[0], v0[1]); w.y = pk2(v0[2], v0[3]); w.z = pk2(v1[0], v1[1]); w.w = pk2(v1[2], v1[3]);
                        *(v4u*)(SH + ((size_t)np * 256 + row) * D + j0 + bj * 128) = w; } } }
    }
};
struct EpiBias {
    float* BIAS;
    __device__ __forceinline__ void operator()(EPI_ARGS) const { asm volatile("" ::: "memory");
        const int lo = u.pm == 0 ? 0 : u.pm == 1 ? 8 : u.pm == 2 ? 30 : 35, hi = u.pm == 0 ? 8 : u.pm == 1 ? 30 : u.pm == 2 ? 35 : 57;
        if (u.pn < lo || u.pn >= hi) return;
        const int c0 = u.pn * 256 + wc * 32 + 8 * fq;
#pragma unroll
        for (int ai = 0; ai < 2; ++ai)
#pragma unroll
            for (int m = 0; m < 4; ++m) { const int row = ai * 128 + wr * 64 + m * 16 + fr;
#pragma unroll
                for (int bj = 0; bj < 2; ++bj) { float* p = BIAS + (size_t)row * NBIG + c0 + bj * 128; *(f32x4*)p = acc[ai][bj][m][0]; *(f32x4*)(p + 4) = acc[ai][bj][m][1]; } }
    }
};
struct EpiAin {
    const float* SSQ0; const float* BIAS; bf16* U; bf16* V; float* SSQV;
    __device__ __forceinline__ void operator()(EPI_ARGS) const { asm volatile("" ::: "memory");
        const int cl = wc * 32 + 8 * fq, c0 = u.pn * 256 + cl; const bool uni = u.pm < 64; const bool isv = u.pn >= 4;
        f32x4 bv[2][2];
        if (uni) { const float* b = BIAS + (size_t)(u.pm >> 5) * NBIG + OFF_WIN + c0;
#pragma unroll
            for (int bj = 0; bj < 2; ++bj)
#pragma unroll
                for (int n = 0; n < 2; ++n) bv[bj][n] = *(const f32x4*)(b + bj * 128 + 4 * n); }
#pragma unroll
        for (int ai = 0; ai < 2; ++ai)
#pragma unroll
            for (int m = 0; m < 4; ++m) { const int row = u.pm * 256 + ai * 128 + wr * 64 + m * 16 + fr;
                const float rs = rstd16(SSQ0 + (size_t)row * 16);
                if (!uni) { const float* b = BIAS + (size_t)seq_of(row) * NBIG + OFF_WIN + c0;
#pragma unroll
                    for (int bj = 0; bj < 2; ++bj)
#pragma unroll
                        for (int n = 0; n < 2; ++n) bv[bj][n] = *(const f32x4*)(b + bj * 128 + 4 * n); }
                float sq = 0.f;
#pragma unroll
                for (int bj = 0; bj < 2; ++bj) { f32x4 v0 = acc[ai][bj][m][0] * rs + bv[bj][0], v1 = acc[ai][bj][m][1] * rs + bv[bj][1];
#pragma unroll
                    for (int i = 0; i < 4; ++i) { v0[i] = gelu_t(v0[i]); v1[i] = gelu_t(v1[i]); sq += v0[i] * v0[i] + v1[i] * v1[i]; }
                    v4u w; w.x = pk2(v0[0], v0[1]); w.y = pk2(v0[2], v0[3]); w.z = pk2(v1[0], v1[1]); w.w = pk2(v1[2], v1[3]);
                    bf16* dst = isv ? V + (size_t)row * D + (c0 - 1024) + bj * 128 : U + (size_t)row * D + c0 + bj * 128;
                    *(v4u*)dst = w; }
                if (isv) { sq += __shfl_xor(sq, 16); sq += __shfl_xor(sq, 32); if (fq == 0) SSQV[(size_t)row * 16 + (u.pn - 4) * 4 + wc] = sq; } }
    }
};
struct EpiGU {
    const float* SSQ; const float* BIAS; int boff; bf16* HID;
    __device__ __forceinline__ void operator()(EPI_ARGS) const { asm volatile("" ::: "memory");
        const int cl = wc * 32 + 8 * fq, c0 = u.pn * 256 + cl; const bool uni = u.pm < 64;
        f32x4 bv[2][2];
        if (uni) { const float* b = BIAS + (size_t)(u.pm >> 5) * NBIG + boff + c0;
#pragma unroll
            for (int bj = 0; bj < 2; ++bj)
#pragma unroll
                for (int n = 0; n < 2; ++n) bv[bj][n] = *(const f32x4*)(b + bj * 128 + 4 * n); }
#pragma unroll
        for (int ai = 0; ai < 2; ++ai)
#pragma unroll
            for (int m = 0; m < 4; ++m) { const int row = u.pm * 256 + ai * 128 + wr * 64 + m * 16 + fr;
                const float rs = rstd16(SSQ + (size_t)row * 16);
                if (!uni) { const float* b = BIAS + (size_t)seq_of(row) * NBIG + boff + c0;
#pragma unroll
                    for (int bj = 0; bj < 2; ++bj)
#pragma unroll
                        for (int n = 0; n < 2; ++n) bv[bj][n] = *(const f32x4*)(b + bj * 128 + 4 * n); }
                float h[8];
#pragma unroll
                for (int n = 0; n < 2; ++n) { const f32x4 zg = acc[ai][0][m][n] * rs + bv[0][n], zu = acc[ai][1][m][n] * rs + bv[1][n];
#pragma unroll
                    for (int i = 0; i < 4; ++i) h[4 * n + i] = silu_f(zg[i]) * zu[i]; }
                v4u w; w.x = pk2(h[0], h[1]); w.y = pk2(h[2], h[3]); w.z = pk2(h[4], h[5]); w.w = pk2(h[6], h[7]);
                *(v4u*)(HID + (size_t)row * DFF + u.pn * 128 + cl) = w; }
    }
};
struct EpiRes {
    const float* xin_p; const float* xin_s;
    const float* MOD; int goff;
    float* out;
    const float* MUL; bf16* A1;
    const float* kvg; bf16* A2;
    float* SSQ;
    __device__ __forceinline__ void operator()(EPI_ARGS) const { asm volatile("" ::: "memory");
        const int cl = wc * 32 + 8 * fq, c0 = u.pn * 256 + cl; const bool uni = u.pm < 64;
        f32x4 gv[2][2], mv[2][2], kv[2][2];
        if (uni) { const int sq_ = u.pm >> 5;
#pragma unroll
            for (int bj = 0; bj < 2; ++bj)
#pragma unroll
                for (int n = 0; n < 2; ++n) { gv[bj][n] = *(const f32x4*)(MOD + (size_t)sq_ * NMOD + goff + c0 + bj * 128 + 4 * n);
                    if (A1) mv[bj][n] = *(const f32x4*)(MUL + (size_t)sq_ * D + c0 + bj * 128 + 4 * n); } }
        if (A2) {
#pragma unroll
            for (int bj = 0; bj < 2; ++bj)
#pragma unroll
                for (int n = 0; n < 2; ++n) kv[bj][n] = *(const f32x4*)(kvg + c0 + bj * 128 + 4 * n); }
#pragma unroll
        for (int ai = 0; ai < 2; ++ai)
#pragma unroll
            for (int m = 0; m < 4; ++m) { const int row = u.pm * 256 + ai * 128 + wr * 64 + m * 16 + fr;
                const bool real = row < MT;
                if (!uni) { const int sq_ = seq_of(row);
#pragma unroll
                    for (int bj = 0; bj < 2; ++bj)
#pragma unroll
                        for (int n = 0; n < 2; ++n) { gv[bj][n] = *(const f32x4*)(MOD + (size_t)sq_ * NMOD + goff + c0 + bj * 128 + 4 * n);
                            if (A1) mv[bj][n] = *(const f32x4*)(MUL + (size_t)sq_ * D + c0 + bj * 128 + 4 * n); } }
                const float* xr = uni ? xin_p + (size_t)row * D : xin_s + (size_t)(real ? row - MP : 0) * D;
                float sq = 0.f;
#pragma unroll
                for (int bj = 0; bj < 2; ++bj) { f32x4 x0 = *(const f32x4*)(xr + c0 + bj * 128), x1 = *(const f32x4*)(xr + c0 + bj * 128 + 4);
                    if (!real) { x0 = (f32x4){0.f, 0.f, 0.f, 0.f}; x1 = x0; }
                    x0 = x0 + gv[bj][0] * acc[ai][bj][m][0]; x1 = x1 + gv[bj][1] * acc[ai][bj][m][1];
                    if (real) { float* p = out + (size_t)row * D + c0 + bj * 128; *(f32x4*)p = x0; *(f32x4*)(p + 4) = x1; }
                    sq += (x0[0] * x0[0] + x0[1] * x0[1]) + (x0[2] * x0[2] + x0[3] * x0[3]) + (x1[0] * x1[0] + x1[1] * x1[1]) + (x1[2] * x1[2] + x1[3] * x1[3]);
                    if (A1) { const f32x4 a = x0 * mv[bj][0], b = x1 * mv[bj][1]; v4u w; w.x = pk2(a[0], a[1]); w.y = pk2(a[2], a[3]); w.z = pk2(b[0], b[1]); w.w = pk2(b[2], b[3]);
                        *(v4u*)(A1 + (size_t)row * D + c0 + bj * 128) = w; }
                    if (A2) { const f32x4 a = x0 * kv[bj][0], b = x1 * kv[bj][1]; v4u w; w.x = pk2(a[0], a[1]); w.y = pk2(a[2], a[3]); w.z = pk2(b[0], b[1]); w.w = pk2(b[2], b[3]);
                        *(v4u*)(A2 + (size_t)row * D + c0 + bj * 128) = w; } }
                if (SSQ) { sq += __shfl_xor(sq, 16); sq += __shfl_xor(sq, 32); if (fq == 0) SSQ[(size_t)row * 16 + u.pn * 4 + wc] = sq; } }
    }
};
struct EpiCmp {
    const float* C1; bf16* H2;
    __device__ __forceinline__ void operator()(EPI_ARGS) const { asm volatile("" ::: "memory");
        const int cl = wc * 32 + 8 * fq; const int kv = u.pm >= (RC_KV / 256) ? 1 : 0;
        f32x4 bv[2][2];
#pragma unroll
        for (int bj = 0; bj < 2; ++bj)
#pragma unroll
            for (int n = 0; n < 2; ++n) bv[bj][n] = *(const f32x4*)(C1 + kv * 256 + cl + bj * 128 + 4 * n);
#pragma unroll
        for (int ai = 0; ai < 2; ++ai)
#pragma unroll
            for (int m = 0; m < 4; ++m) { const size_t row = (size_t)u.pm * 256 + ai * 128 + wr * 64 + m * 16 + fr;
#pragma unroll
                for (int bj = 0; bj < 2; ++bj) { f32x4 v0 = acc[ai][bj][m][0] + bv[bj][0], v1 = acc[ai][bj][m][1] + bv[bj][1];
#pragma unroll
                    for (int i = 0; i < 4; ++i) { v0[i] = gelu_t(v0[i]); v1[i] = gelu_t(v1[i]); }
                    v4u w; w.x = pk2(v0[0], v0[1]); w.y = pk2(v0[2], v0[3]); w.z = pk2(v1[0], v1[1]); w.w = pk2(v1[2], v1[3]);
                    *(v4u*)(H2 + row * 256 + cl + bj * 128) = w; } }
    }
};
struct EpiKV {
    const float* SSQ; const float* kgains; const float* ROPE; float* out;
    bf16* RC; bf16* KS; bf16* KW; bf16* VST; bf16* VWT;
    __device__ __forceinline__ void operator()(EPI_ARGS) const { asm volatile("" ::: "memory");
        const int ty = u.pn, g = wc, d0 = 8 * fq; const bool isk = (ty == 2 || ty == 4);
        f32x4 kg[2][2];
        if (isk) {
#pragma unroll
            for (int bj = 0; bj < 2; ++bj)
#pragma unroll
                for (int n = 0; n < 2; ++n) kg[bj][n] = *(const f32x4*)(kgains + (ty == 2 ? 64 : 128) + 32 * bj + d0 + 4 * n); }
#pragma unroll
        for (int ai = 0; ai < 2; ++ai)
#pragma unroll
            for (int m = 0; m < 4; ++m) { const int row = u.pm * 256 + ai * 128 + wr * 64 + m * 16 + fr;
                const float rs = rstd16(SSQ + (size_t)row * 16);
                f32x4 v[2][2];
#pragma unroll
                for (int bj = 0; bj < 2; ++bj)
#pragma unroll
                    for (int n = 0; n < 2; ++n) v[bj][n] = acc[ai][bj][m][n] * rs;
                const bool prompt = row < MP; const int t = prompt ? (row & (SEQ - 1)) : PAST; const int b = row >> 13;
                if (isk) {
                    float sq = 0.f;
#pragma unroll
                    for (int bj = 0; bj < 2; ++bj)
#pragma unroll
                        for (int n = 0; n < 2; ++n) sq += (v[bj][n][0] * v[bj][n][0] + v[bj][n][1] * v[bj][n][1]) + (v[bj][n][2] * v[bj][n][2] + v[bj][n][3] * v[bj][n][3]);
                    sq += __shfl_xor(sq, 16); sq += __shfl_xor(sq, 32);
                    const float ri = rsqrtf(sq * (1.0f / 64.0f) + EPS);
#pragma unroll
                    for (int n = 0; n < 2; ++n) { const f32x4 cs = *(const f32x4*)(ROPE + (size_t)t * 64 + d0 + 4 * n), sn = *(const f32x4*)(ROPE + (size_t)t * 64 + 32 + d0 + 4 * n);
                        const f32x4 x1 = v[0][n] * ri * kg[0][n], x2 = v[1][n] * ri * kg[1][n];
                        v[0][n] = x1 * cs - x2 * sn; v[1][n] = x2 * cs + x1 * sn; }
                }
                float* fo = nullptr;
                if (prompt) {
                    if (ty < 4) fo = out + (ty == 0 ? O_CKP : ty == 1 ? O_CVP : ty == 2 ? O_SKP : O_SVP) + (size_t)row * 256;
                    else if (t >= SEQ - WIN) fo = out + (ty == 4 ? O_WKP : O_WVP) + ((size_t)b * WIN + (t - (SEQ - WIN))) * 256;
                } else if (row < MT) { const int s = row - MP;
                    if (ty < 4) fo = out + (ty == 0 ? O_CKS : ty == 1 ? O_CVS : ty == 2 ? O_SKS : O_SVS) + (size_t)s * 256;
                    else fo = out + (ty == 4 ? O_WKS : O_WVS) + ((size_t)s * WIN + (WIN - 1)) * 256; }
                if (fo) {
#pragma unroll
                    for (int bj = 0; bj < 2; ++bj) { float* p = fo + g * 64 + 32 * bj + d0; *(f32x4*)p = v[bj][0]; *(f32x4*)(p + 4) = v[bj][1]; } }
                if (prompt) { const int gam = b * 4 + g;
                    if (ty <= 1) { bf16* dst = RC + ((size_t)ty * RC_KV + RC_SAMP + (size_t)gam * 512 + (t >> 4)) * 1024 + (t & 15) * 64 + d0;
#pragma unroll
                        for (int bj = 0; bj < 2; ++bj) { v4u w; w.x = pk2(v[bj][0][0], v[bj][0][1]); w.y = pk2(v[bj][0][2], v[bj][0][3]); w.z = pk2(v[bj][1][0], v[bj][1][1]); w.w = pk2(v[bj][1][2], v[bj][1][3]); *(v4u*)(dst + 32 * bj) = w; }
                    } else if (isk) { bf16* dst = (ty == 2 ? KS : KW) + ((size_t)gam * SEQ + t) * 64 + d0;
#pragma unroll
                        for (int bj = 0; bj < 2; ++bj) { v4u w; w.x = pk2(v[bj][0][0], v[bj][0][1]); w.y = pk2(v[bj][0][2], v[bj][0][3]); w.z = pk2(v[bj][1][0], v[bj][1][1]); w.w = pk2(v[bj][1][2], v[bj][1][3]); *(v4u*)(dst + 32 * bj) = w; }
                    } else { const int kk_ = t & 63; bf16* dst = (ty == 3 ? VST : VWT) + ((size_t)gam * 128 + (t >> 6)) * 4096 + (32 * (kk_ >> 5) + 8 * ((kk_ & 15) >> 2) + 4 * ((kk_ >> 4) & 1) + (kk_ & 3));
#pragma unroll
                        for (int bj = 0; bj < 2; ++bj)
#pragma unroll
                            for (int n = 0; n < 2; ++n)
#pragma unroll
                                for (int i = 0; i < 4; ++i) dst[(32 * bj + d0 + 4 * n + i) * 64] = (bf16)(pk2(v[bj][n][i], 0.f) & 0xffffu); }
                }
            }
    }
};
struct EpiQ {
    const float* SSQ; const float* BIAS; const float* qgain; const float* ROPE; bf16* QN; bf16* QR; float* GATES;
    __device__ __forceinline__ void operator()(EPI_ARGS) const { asm volatile("" ::: "memory");
        const int cl = wc * 32 + 8 * fq, c0 = u.pn * 256 + cl, d0 = 8 * fq; const bool uni = u.pm < 64;
        f32x4 bv[2][2], qg[2][2];
        if (uni) { const float* b = BIAS + (size_t)(u.pm >> 5) * NBIG + OFF_Q + c0;
#pragma unroll
            for (int bj = 0; bj < 2; ++bj)
#pragma unroll
                for (int n = 0; n < 2; ++n) bv[bj][n] = *(const f32x4*)(b + bj * 128 + 4 * n); }
#pragma unroll
        for (int bj = 0; bj < 2; ++bj)
#pragma unroll
            for (int n = 0; n < 2; ++n) qg[bj][n] = *(const f32x4*)(qgain + 32 * bj + d0 + 4 * n);
#pragma unroll
        for (int ai = 0; ai < 2; ++ai)
#pragma unroll
            for (int m = 0; m < 4; ++m) { const int row = u.pm * 256 + ai * 128 + wr * 64 + m * 16 + fr;
                const float rs = rstd16(SSQ + (size_t)row * 16);
                if (!uni) { const float* b = BIAS + (size_t)seq_of(row) * NBIG + OFF_Q + c0;
#pragma unroll
                    for (int bj = 0; bj < 2; ++bj)
#pragma unroll
                        for (int n = 0; n < 2; ++n) bv[bj][n] = *(const f32x4*)(b + bj * 128 + 4 * n); }
                f32x4 v[2][2];
#pragma unroll
                for (int bj = 0; bj < 2; ++bj)
#pragma unroll
                    for (int n = 0; n < 2; ++n) v[bj][n] = acc[ai][bj][m][n] * rs + bv[bj][n];
                if (u.pn == 4) {
                    if (cl < 48) {
#pragma unroll
                        for (int n = 0; n < 2; ++n) { f32x4 s; for (int i = 0; i < 4; ++i) s[i] = sigmoid_f(v[0][n][i]); *(f32x4*)(GATES + (size_t)row * 48 + cl + 4 * n) = s; } }
                    continue; }
                const int t = row < MP ? (row & (SEQ - 1)) : PAST;
                float sq = 0.f;
#pragma unroll
                for (int bj = 0; bj < 2; ++bj)
#pragma unroll
                    for (int n = 0; n < 2; ++n) sq += (v[bj][n][0] * v[bj][n][0] + v[bj][n][1] * v[bj][n][1]) + (v[bj][n][2] * v[bj][n][2] + v[bj][n][3] * v[bj][n][3]);
                sq += __shfl_xor(sq, 16); sq += __shfl_xor(sq, 32);
                const float ri = rsqrtf(sq * (1.0f / 64.0f) + EPS) * C2;
                f32x4 r[2][2];
#pragma unroll
                for (int n = 0; n < 2; ++n) { const f32x4 cs = *(const f32x4*)(ROPE + (size_t)t * 64 + d0 + 4 * n), sn = *(const f32x4*)(ROPE + (size_t)t * 64 + 32 + d0 + 4 * n);
                    v[0][n] = v[0][n] * ri * qg[0][n]; v[1][n] = v[1][n] * ri * qg[1][n];
                    r[0][n] = v[0][n] * cs - v[1][n] * sn; r[1][n] = v[1][n] * cs + v[0][n] * sn; }
                const size_t o = (size_t)row * D + (u.pn * 4 + wc) * 64 + d0;
#pragma unroll
                for (int bj = 0; bj < 2; ++bj) { v4u w; w.x = pk2(v[bj][0][0], v[bj][0][1]); w.y = pk2(v[bj][0][2], v[bj][0][3]); w.z = pk2(v[bj][1][0], v[bj][1][1]); w.w = pk2(v[bj][1][2], v[bj][1][3]); *(v4u*)(QN + o + 32 * bj) = w;
                    v4u x; x.x = pk2(r[bj][0][0], r[bj][0][1]); x.y = pk2(r[bj][0][2], r[bj][0][3]); x.z = pk2(r[bj][1][0], r[bj][1][1]); x.w = pk2(r[bj][1][2], r[bj][1][3]); *(v4u*)(QR + o + 32 * bj) = x; }
            }
    }
};

#define MFMA16(a, b, c) __builtin_amdgcn_mfma_f32_16x16x32_bf16((a), (b), (c), 0, 0, 0)

__device__ __forceinline__ int wperm(int mode, int n) {
    if (mode == 1) { const int up = n >= DFF ? 1 : 0, j = n - up * DFF; return (j >> 7) * 256 + up * 128 + (j & 127); }
    if (mode == 2 || (mode == 3 && n < 1024)) { const int blk = n >> 8, g = (n >> 6) & 3, d = n & 63; return blk * 256 + 128 * (d >> 5) + 32 * g + (d & 31); }
    return n;
}
__device__ __forceinline__ void transpose_item(const float* W, int K, int N, bf16* WT, int row_off, int mode, LAS float* scr, int item, int lane) {
    const int nblk = (N + 31) >> 5, kb = item / nblk, nb = item - kb * nblk, k0 = 64 * kb, n0 = 32 * nb;
    const int nq = n0 + 4 * (lane & 7); const bool okn = nq < N;
    f32x4 v[8];
#pragma unroll
    for (int i = 0; i < 8; ++i) { const int kk = 8 * i + (lane >> 3); v[i] = okn ? *(const f32x4*)(W + (size_t)(k0 + kk) * N + nq) : (f32x4){0.f, 0.f, 0.f, 0.f}; }
#pragma unroll
    for (int i = 0; i < 8; ++i) { const int kk = 8 * i + (lane >> 3); LAS float* d = scr + kk * 33 + 4 * (lane & 7); d[0] = v[i][0]; d[1] = v[i][1]; d[2] = v[i][2]; d[3] = v[i][3]; }
    LDS_WAIT(); asm volatile("" ::: "memory");
    const int c = lane & 7;
#pragma unroll
    for (int j = 0; j < 4; ++j) { const int n = (lane >> 3) + 8 * j; const LAS float* s = scr + (8 * c) * 33 + n;
        v4u o; o.x = pk2(s[0 * 33], s[1 * 33]); o.y = pk2(s[2 * 33], s[3 * 33]); o.z = pk2(s[4 * 33], s[5 * 33]); o.w = pk2(s[6 * 33], s[7 * 33]);
        if (n0 + n < N) *(v4u*)(WT + (size_t)(row_off + wperm(mode, n0 + n)) * K + k0 + 8 * c) = o; }
    LDS_WAIT(); asm volatile("" ::: "memory");
}
#define TR_ITEMS(K, N) (((K) / 64) * (((N) + 31) / 32))

__device__ __forceinline__ void phase0(const Params& P, LAS unsigned char* lds, int tid, int lane, int wave) {
    unsigned char* ws = P.ws;
    const int gw = blockIdx.x * NWAVES + wave, ngw = gridDim.x * NWAVES, gtid = blockIdx.x * 512 + tid, ngt = gridDim.x * 512;
    LAS float* scr = (LAS float*)(lds + wave * 16384);
    constexpr int IT_ADA = TR_ITEMS(1024, 6144);
    for (int it = gw; it < 2 * IT_ADA; it += ngw) { const int l = it / IT_ADA, r = it - l * IT_ADA;
        transpose_item(P.in[11] + (size_t)l * 1024 * 6144, 1024, 6144, (bf16*)(ws + WS_WADA), l * 6144, 0, scr, r, lane); }
    for (int e = gtid; e < 256 * 128; e += ngt) { const int row = e >> 7, c8 = (e & 127) * 8; v4u o = {0u, 0u, 0u, 0u};
        if (row < 130) { const float* src = (row < 2 ? P.in[9] + row * 1024 : P.in[10] + (row - 2) * 1024) + c8; const f32x4 a = *(const f32x4*)src, b = *(const f32x4*)(src + 4);
            o.x = pk2(silu_f(a[0]), silu_f(a[1])); o.y = pk2(silu_f(a[2]), silu_f(a[3])); o.z = pk2(silu_f(b[0]), silu_f(b[1])); o.w = pk2(silu_f(b[2]), silu_f(b[3])); }
        *(v4u*)((bf16*)(ws + WS_SC) + (size_t)row * 1024 + c8) = o; }
    for (int e = gtid; e < SEQ * 32; e += ngt) { const int pos = e >> 5, i = e & 31; const float inv = powf(10000.0f, -(float)i / 32.0f); const float ang = (float)pos * inv; float s, c; sincosf(ang, &s, &c);
        float* R = (float*)(ws + WS_ROPE) + (size_t)pos * 64; R[i] = c; R[32 + i] = s; }
    for (int e = gtid; e < 8 * 128 * 128; e += ngt) { const int t = (e >> 7) & 127, s = e & 127; ((bf16*)(ws + WS_WSB))[e] = (bf16)(pk2(s <= t ? P.in[16][e] : 0.f, 0.f) & 0xffffu); }
    for (int e = gtid; e < (NQP - NQ) * 128; e += ngt) *(v4u*)((bf16*)(ws + WS_WBIG) + (size_t)(OFF_Q + NQ) * 1024 + (size_t)e * 8) = (v4u){0u, 0u, 0u, 0u};
    if (gridDim.x >= 256 ? blockIdx.x < 256 : blockIdx.x == 0) {
        for (int ob = blockIdx.x; ob < 256; ob += (gridDim.x >= 256 ? 256 : 1)) { const int kv = ob >> 7, c0 = (ob & 127) * 2;
            const float* w1 = P.in[26] + (size_t)kv * 2048 * 256 + c0; const float* pe = P.in[25] + kv * 2048;
            const f32x4 pv = *(const f32x4*)(pe + 4 * tid); float s0 = 0.f, s1 = 0.f;
#pragma unroll
            for (int i = 0; i < 4; ++i) { const f32x2 w = *(const f32x2*)(w1 + (size_t)(4 * tid + i) * 256); s0 += pv[i] * w[0]; s1 += pv[i] * w[1]; }
            s0 = wave_sum(s0); s1 = wave_sum(s1);
            LAS float* red = (LAS float*)(lds + 8448);
            __syncthreads();
            if (lane == 0) { red[wave * 2] = s0; red[wave * 2 + 1] = s1; }
            __syncthreads();
            if (tid < 2) { float a = P.in[27][kv * 256 + c0 + tid]; for (int k = 0; k < 8; ++k) a += red[k * 2 + tid]; ((float*)(ws + WS_C1))[kv * 256 + c0 + tid] = a; } } }
}
__device__ __forceinline__ void phase1_weights(const Params& P, LAS unsigned char* lds, int lane, int wave) {
    unsigned char* ws = P.ws;
    const int gw = blockIdx.x * NWAVES + wave, ngw = gridDim.x * NWAVES;
    LAS float* scr = (LAS float*)(lds + wave * 16384);
    constexpr int I0 = TR_ITEMS(1024, 2048), I1 = TR_ITEMS(1024, 5632), I2 = TR_ITEMS(1024, 1072), I3 = TR_ITEMS(1024, 1024), I4 = TR_ITEMS(2816, 1024), I5 = TR_ITEMS(1024, 1536), I6 = TR_ITEMS(2048, 256), I7 = TR_ITEMS(256, 64);
    constexpr int NIT = I0 + 2 * I1 + I2 + 2 * I3 + 2 * I4 + I5 + 2 * I6 + 2 * I7;
    bf16* WBIG = (bf16*)(ws + WS_WBIG);
    for (int it = gw; it < NIT; it += ngw) { int r = it;
        if (r < I0) { transpose_item(P.in[14], 1024, 2048, WBIG, OFF_WIN, 0, scr, r, lane); continue; } r -= I0;
        if (r < I1) { transpose_item(P.in[30], 1024, 5632, WBIG, OFF_GU0, 1, scr, r, lane); continue; } r -= I1;
        if (r < I1) { transpose_item(P.in[30] + (size_t)1024 * 5632, 1024, 5632, WBIG, OFF_GU1, 1, scr, r, lane); continue; } r -= I1;
        if (r < I2) { transpose_item(P.in[19], 1024, 1072, WBIG, OFF_Q, 3, scr, r, lane); continue; } r -= I2;
        if (r < I3) { transpose_item(P.in[18], 1024, 1024, (bf16*)(ws + WS_WOUT), 0, 0, scr, r, lane); continue; } r -= I3;
        if (r < I3) { transpose_item(P.in[21], 1024, 1024, (bf16*)(ws + WS_WBO), 0, 0, scr, r, lane); continue; } r -= I3;
        if (r < I4) { transpose_item(P.in[31], 2816, 1024, (bf16*)(ws + WS_WDN), 0, 0, scr, r, lane); continue; } r -= I4;
        if (r < I4) { transpose_item(P.in[31] + (size_t)2816 * 1024, 2816, 1024, (bf16*)(ws + WS_WDN) + (size_t)1024 * 2816, 0, 0, scr, r, lane); continue; } r -= I4;
        if (r < I5) { transpose_item(P.in[23], 1024, 1536, (bf16*)(ws + WS_WKV), 0, 2, scr, r, lane); continue; } r -= I5;
        if (r < I6) { transpose_item(P.in[26], 2048, 256, (bf16*)(ws + WS_W1C), 0, 0, scr, r, lane); continue; } r -= I6;
        if (r < I6) { transpose_item(P.in[26] + (size_t)2048 * 256, 2048, 256, (bf16*)(ws + WS_W1C) + (size_t)256 * 2048, 0, 0, scr, r, lane); continue; } r -= I6;
        if (r < I7) { transpose_item(P.in[28], 256, 64, (bf16*)(ws + WS_W2), 0, 0, scr, r, lane); continue; } r -= I7;
        transpose_item(P.in[28] + 256 * 64, 256, 64, (bf16*)(ws + WS_W2) + 64 * 256, 0, 0, scr, r, lane);
    }
}
__device__ __forceinline__ void phase2_tail(const Params& P, int tid, int lane, int wave) {
    unsigned char* ws = P.ws;
    const int gw = blockIdx.x * NWAVES + wave, ngw = gridDim.x * NWAVES, gtid = blockIdx.x * 512 + tid, ngt = gridDim.x * 512;
    const float* MOD = (const float*)(ws + WS_MOD); const float* ng = P.in[13];
    for (int e = gtid; e < 3 * 256 * 256; e += ngt) { const int np = e >> 16, sq = (e >> 8) & 255, c = (e & 255) * 4;
        const int lay = np == 0 ? 0 : 1, wh = np == 1 ? 0 : 1;
        const f32x4 g = *(const f32x4*)(ng + (lay * 2 + wh) * 1024 + c), sc = *(const f32x4*)(MOD + (size_t)sq * NMOD + lay * 6144 + (wh ? 4096 : 1024) + c);
        *(f32x4*)((float*)(ws + WS_MUL) + ((size_t)np * 256 + sq) * 1024 + c) = g * (sc + 1.0f); }
    float* SSQ0 = (float*)(ws + WS_SSQ); bf16* A0 = (bf16*)(ws + WS_ACTA);
    for (int r = gw; r < M65; r += ngw) {
        f32x4 v[4]; float s = 0.f;
        if (r < MT) { const float* x = (r < MP ? P.in[0] + (size_t)r * D : P.in[1] + (size_t)(r - MP) * D) + 4 * lane;
#pragma unroll
            for (int j = 0; j < 4; ++j) { v[j] = *(const f32x4*)(x + 256 * j); s += (v[j][0] * v[j][0] + v[j][1] * v[j][1]) + (v[j][2] * v[j][2] + v[j][3] * v[j][3]); }
        } else {
#pragma unroll
            for (int j = 0; j < 4; ++j) v[j] = (f32x4){0.f, 0.f, 0.f, 0.f}; }
        s = wave_sum(s);
        if (lane < 16) SSQ0[(size_t)r * 16 + lane] = lane == 0 ? s : 0.f;
        const int sq = seq_of(r);
#pragma unroll
        for (int j = 0; j < 4; ++j) { const int c = 4 * lane + 256 * j; const f32x4 g = *(const f32x4*)(ng + c), sc = *(const f32x4*)(MOD + (size_t)sq * NMOD + 1024 + c);
            const f32x4 a = v[j] * g * (sc + 1.0f); v2u w; w.x = pk2(a[0], a[1]); w.y = pk2(a[2], a[3]); *(v2u*)(A0 + (size_t)r * D + c) = w; }
    }
}
__device__ __forceinline__ void sample_prepass(const Params& P, int tid, int lane, int wave) {
    unsigned char* ws = P.ws;
    const int gw = blockIdx.x * NWAVES + wave, ngw = gridDim.x * NWAVES;
    const int* pt = (const int*)P.in[8]; bf16* RC = (bf16*)(ws + WS_RC);
    for (int it = gw; it < 2 * 128 * 16 * 4; it += ngw) { const int kv = it >> 13, sq = (it >> 6) & 127, p = (it >> 2) & 15, qtr = it & 3;
        const float* src = P.in[2 + kv] + (size_t)pt[sq * 16 + p] * (128 * 256) + qtr * 8192;
#pragma unroll
        for (int i0 = 0; i0 < 16; i0 += 8) { f32x4 a[8], b[8];
#pragma unroll
            for (int i = 0; i < 8; ++i) { const int e = ((i0 + i) * 64 + lane) * 8; a[i] = __builtin_nontemporal_load((const f32x4*)(src + e)); b[i] = __builtin_nontemporal_load((const f32x4*)(src + e + 4)); }
#pragma unroll
            for (int i = 0; i < 8; ++i) { const int e = ((i0 + i) * 64 + lane) * 8, tok = qtr * 32 + (e >> 8), g = (e >> 6) & 3, d = e & 63;
                v4u w; w.x = pk2(a[i][0], a[i][1]); w.y = pk2(a[i][2], a[i][3]); w.z = pk2(b[i][0], b[i][1]); w.w = pk2(b[i][2], b[i][3]);
                *(v4u*)(RC + ((size_t)kv * RC_KV + (size_t)(sq * 4 + g) * 128 + p * 8 + (tok >> 4)) * 1024 + (tok & 15) * 64 + d) = w; } } }
    for (int it = gw; it < 2 * 128 * 64; it += ngw) { const int kv = it >> 13, s = (it >> 6) & 127, c = it & 63;
        const f32x4* src = (const f32x4*)P.in[6 + kv] + (size_t)s * 32768 + 64; f32x4* dst = (f32x4*)(P.out + (kv ? O_WVS : O_WKS)) + (size_t)s * 32768;
        f32x4 v[8];
#pragma unroll
        for (int i = 0; i < 8; ++i) { const int e = c * 512 + i * 64 + lane; if (e < 32704) v[i] = __builtin_nontemporal_load(src + e); }
#pragma unroll
        for (int i = 0; i < 8; ++i) { const int e = c * 512 + i * 64 + lane; if (e < 32704) __builtin_nontemporal_store(v[i], dst + e); } }
}

__device__ __forceinline__ void skinny_core(const bf16* Arows  , int lda, int K, const bf16* Bt64  , LAS float* RED, int tid, int lane, int wave, float& s0, float& s1) {
    const int col = lane & 15, quad = lane >> 4;
    const int kw = K >> 3;
    const bf16* ap = Arows + (size_t)col * lda + wave * kw + 8 * quad;
    const bf16* bp = Bt64 + (size_t)col * K + wave * kw + 8 * quad;
    f32x4 acc[4];
#pragma unroll
    for (int ct = 0; ct < 4; ++ct) acc[ct] = (f32x4){0.f, 0.f, 0.f, 0.f};
#pragma unroll 4
    for (int k0 = 0; k0 < kw; k0 += 32) { const bf16x8 af = *(const bf16x8*)(ap + k0);
#pragma unroll
        for (int ct = 0; ct < 4; ++ct) { const bf16x8 bf = *(const bf16x8*)(bp + (size_t)ct * 16 * K + k0); acc[ct] = MFMA16(af, bf, acc[ct]); } }
#pragma unroll
    for (int ct = 0; ct < 4; ++ct)
#pragma unroll
        for (int r = 0; r < 4; ++r) RED[((wave * 4 + ct) * 4 + r) * 64 + lane] = acc[ct][r];
    __syncthreads();
    const int r16 = tid >> 5, c2 = (tid & 31) * 2;
    const int base = ((c2 >> 4) * 4 + (r16 & 3)) * 64 + (c2 & 15) + 16 * (r16 >> 2);
    s0 = 0.f; s1 = 0.f;
#pragma unroll
    for (int wv = 0; wv < 8; ++wv) { s0 += RED[wv * 1024 + base]; s1 += RED[wv * 1024 + base + 1]; }
    __syncthreads();
}
__device__ __forceinline__ float half_wave_sum(float v) { v += __shfl_xor(v, 1); v += __shfl_xor(v, 2); v += __shfl_xor(v, 4); v += __shfl_xor(v, 8); v += __shfl_xor(v, 16); return v; }
__device__ __forceinline__ void skinny_res(const bf16* A, int lda, int K, const bf16* Bt, const EpiRes& E, LAS unsigned char* lds, int tid, int lane, int wave) {
    for (int task = blockIdx.x; task < 8 * 16; task += gridDim.x) { const int rt = task >> 4, cg = task & 15;
        float s0, s1;
        skinny_core(A + (size_t)(MP + 16 * rt) * lda, lda, K, Bt + (size_t)(64 * cg) * K, (LAS float*)lds, tid, lane, wave, s0, s1);
        const int srow = 16 * rt + (tid >> 5), row = MP + srow, sq = 2 + srow, c = 64 * cg + (tid & 31) * 2;
        const f32x2 xi = *(const f32x2*)(E.xin_s + (size_t)srow * D + c), gt = *(const f32x2*)(E.MOD + (size_t)sq * NMOD + E.goff + c);
        const float x0 = xi[0] + gt[0] * s0, x1 = xi[1] + gt[1] * s1;
        *(f32x2*)(E.out + (size_t)row * D + c) = (f32x2){x0, x1};
        if (E.A1) { const f32x2 m = *(const f32x2*)(E.MUL + (size_t)sq * D + c); *(unsigned*)(E.A1 + (size_t)row * D + c) = pk2(x0 * m[0], x1 * m[1]); }
        if (E.A2) { const f32x2 m = *(const f32x2*)(E.kvg + c); *(unsigned*)(E.A2 + (size_t)row * D + c) = pk2(x0 * m[0], x1 * m[1]); }
        if (E.SSQ) { const float q = half_wave_sum(x0 * x0 + x1 * x1); if ((tid & 31) == 0) E.SSQ[(size_t)row * 16 + cg] = q; }
    }
}
__device__ __forceinline__ void skinny_ain(const bf16* A, const bf16* Bt, const EpiAin& E, LAS unsigned char* lds, int tid, int lane, int wave) {
    for (int task = blockIdx.x; task < 8 * 32; task += gridDim.x) { const int rt = task >> 5, cg = task & 31;
        float s0, s1;
        skinny_core(A + (size_t)(MP + 16 * rt) * D, D, D, Bt + (size_t)(64 * cg) * D, (LAS float*)lds, tid, lane, wave, s0, s1);
        const int srow = 16 * rt + (tid >> 5), row = MP + srow, sq = 2 + srow, c = 64 * cg + (tid & 31) * 2;
        const float rs = rstd16(E.SSQ0 + (size_t)row * 16);
        const f32x2 bv = *(const f32x2*)(E.BIAS + (size_t)sq * NBIG + OFF_WIN + c);
        const float g0 = gelu_t(s0 * rs + bv[0]), g1 = gelu_t(s1 * rs + bv[1]);
        if (cg < 16) *(unsigned*)(E.U + (size_t)row * D + c) = pk2(g0, g1);
        else { *(unsigned*)(E.V + (size_t)row * D + c - 1024) = pk2(g0, g1); const float q = half_wave_sum(g0 * g0 + g1 * g1); if ((tid & 31) == 0) E.SSQV[(size_t)row * 16 + (cg - 16)] = q; }
    }
}

__device__ __forceinline__ void phase_tokmix(const Params& P, LAS unsigned char* lds, int tid, int lane, int wave) {
    unsigned char* ws = P.ws;
    const bf16* U = (const bf16*)(ws + WS_U); const bf16* V = (const bf16*)(ws + WS_V); bf16* UM = (bf16*)(ws + WS_UM);
    const float* SSQV = (const float*)(ws + WS_SSQ) + (size_t)1 * M65 * 16; const bf16* WSB = (const bf16*)(ws + WS_WSB);
    const float* vgain = P.in[15]; const float* bs = P.in[17];
    LAS bf16* VT = (LAS bf16*)lds;
    const int col = lane & 15, quad = lane >> 4;
    for (int item = blockIdx.x; item < 1024; item += gridDim.x) { const int chunk = item >> 3, g = item & 7, r0 = chunk * 128;
        const bool lastc = (chunk & 63) == 63;
#pragma unroll
        for (int i = 0; i < 4; ++i) { const int e = tid + 512 * i, s = e >> 4, c8 = (e & 15) * 8; const int row = r0 + s;
            const float rs = rstd16(SSQV + (size_t)row * 16);
            const v4u w = *(const v4u*)(V + (size_t)row * D + g * 128 + c8);
            const f32x4 g0 = *(const f32x4*)(vgain + g * 128 + c8), g1 = *(const f32x4*)(vgain + g * 128 + c8 + 4);
            float x[8] = {bflo(w.x) * rs * g0[0], bfhi(w.x) * rs * g0[1], bflo(w.y) * rs * g0[2], bfhi(w.y) * rs * g0[3], bflo(w.z) * rs * g1[0], bfhi(w.z) * rs * g1[1], bflo(w.w) * rs * g1[2], bfhi(w.w) * rs * g1[3]};
#pragma unroll
            for (int k = 0; k < 8; ++k) VT[(c8 + k) * 136 + s] = (bf16)(pk2(x[k], 0.f) & 0xffffu);
            if (lastc) { float* av = P.out + O_AVP + ((size_t)(chunk >> 6) * 128 + s) * D + g * 128 + c8; *(f32x4*)av = (f32x4){x[0], x[1], x[2], x[3]}; *(f32x4*)(av + 4) = (f32x4){x[4], x[5], x[6], x[7]}; } }
        const int t = 16 * wave + col;
        bf16x8 bfr[4];
#pragma unroll
        for (int ks = 0; ks < 4; ++ks) bfr[ks] = (ks <= (wave >> 1)) ? *(const bf16x8*)(WSB + ((size_t)g * 128 + t) * 128 + 32 * ks + 8 * quad) : (bf16x8){0, 0, 0, 0, 0, 0, 0, 0};
        v2u uw[8];
#pragma unroll
        for (int ct = 0; ct < 8; ++ct) uw[ct] = *(const v2u*)(U + (size_t)(r0 + t) * D + g * 128 + 16 * ct + 4 * quad);
        const float bt = bs[g * 128 + t];
        __syncthreads();
        f32x4 acc[8];
#pragma unroll
        for (int ct = 0; ct < 8; ++ct) acc[ct] = (f32x4){0.f, 0.f, 0.f, 0.f};
#pragma unroll
        for (int ks = 0; ks < 4; ++ks) if (ks <= (wave >> 1)) {
#pragma unroll
            for (int ct = 0; ct < 8; ++ct) { const bf16x8 afr = *(const LAS bf16x8*)(VT + (16 * ct + col) * 136 + 32 * ks + 8 * quad); acc[ct] = MFMA16(afr, bfr[ks], acc[ct]); } }
#pragma unroll
        for (int ct = 0; ct < 8; ++ct) { const size_t o = (size_t)(r0 + t) * D + g * 128 + 16 * ct + 4 * quad;
            v2u w; w.x = pk2(bflo(uw[ct].x) * (acc[ct][0] + bt), bfhi(uw[ct].x) * (acc[ct][1] + bt)); w.y = pk2(bflo(uw[ct].y) * (acc[ct][2] + bt), bfhi(uw[ct].y) * (acc[ct][3] + bt)); *(v2u*)(UM + o) = w; }
        __syncthreads();
    }
    const int gw = blockIdx.x * NWAVES + wave, ngw = gridDim.x * NWAVES;
    for (int r = MP + gw; r < M65; r += ngw) {
        const float rs = rstd16(SSQV + (size_t)r * 16);
#pragma unroll
        for (int j = 0; j < 4; ++j) { const int c = 4 * lane + 256 * j, g = c >> 7; v2u w = {0u, 0u};
            if (r < MT) { const v2u vw = *(const v2u*)(V + (size_t)r * D + c), uw = *(const v2u*)(U + (size_t)r * D + c); const f32x4 gn = *(const f32x4*)(vgain + c);
                const f32x4 vn = (f32x4){bflo(vw.x), bfhi(vw.x), bflo(vw.y), bfhi(vw.y)} * rs * gn;
                *(f32x4*)(P.out + O_AVS + (size_t)(r - MP) * D + c) = vn;
                const float w00 = P.in[16][g * 16384], b0 = bs[g * 128];
                w.x = pk2(bflo(uw.x) * (w00 * vn[0] + b0), bfhi(uw.x) * (w00 * vn[1] + b0)); w.y = pk2(bflo(uw.y) * (w00 * vn[2] + b0), bfhi(uw.y) * (w00 * vn[3] + b0)); }
            *(v2u*)(UM + (size_t)r * D + c) = w; } }
}

__device__ __forceinline__ void phase_w2(const Params& P, int lane, int wave) {
    unsigned char* ws = P.ws;
    const int gw = blockIdx.x * NWAVES + wave, ngw = gridDim.x * NWAVES;
    const bf16* H2 = (const bf16*)(ws + WS_H2); const bf16* W2 = (const bf16*)(ws + WS_W2);
    const int col = lane & 15, quad = lane >> 4;
    for (int task = gw; task < 2 * RC_KV / 16; task += ngw) { const int kv = task >= RC_KV / 16 ? 1 : 0; const int R0 = (task - kv * (RC_KV / 16)) * 16;
        const bool samp = R0 < RC_SAMP; const int gam = samp ? (R0 >> 7) : ((R0 - RC_SAMP) >> 9), i0 = samp ? (R0 & 127) : ((R0 - RC_SAMP) & 511);
        const bf16* hrow = H2 + ((size_t)kv * RC_KV + R0 + col) * 256 + 8 * quad; const bf16* wrow = W2 + (size_t)kv * 64 * 256 + (size_t)col * 256 + 8 * quad;
        f32x4 acc[4];
#pragma unroll
        for (int dt = 0; dt < 4; ++dt) acc[dt] = (f32x4){0.f, 0.f, 0.f, 0.f};
#pragma unroll
        for (int ks = 0; ks < 8; ++ks) { const bf16x8 hf = *(const bf16x8*)(hrow + 32 * ks);
#pragma unroll
            for (int dt = 0; dt < 4; ++dt) { const bf16x8 wf = *(const bf16x8*)(wrow + (size_t)dt * 16 * 256 + 32 * ks);
                acc[dt] = kv ? MFMA16(hf, wf, acc[dt]) : MFMA16(wf, hf, acc[dt]); } }
        const float* b2 = P.in[29] + kv * 64;
        if (!kv) {
            float sq = 0.f; f32x4 v[4];
#pragma unroll
            for (int dt = 0; dt < 4; ++dt) { v[dt] = acc[dt] + *(const f32x4*)(b2 + 16 * dt + 4 * quad); sq += (v[dt][0] * v[dt][0] + v[dt][1] * v[dt][1]) + (v[dt][2] * v[dt][2] + v[dt][3] * v[dt][3]); }
            sq += __shfl_xor(sq, 16); sq += __shfl_xor(sq, 32);
            const float ri = rsqrtf(sq * (1.0f / 64.0f) + EPS);
            bf16* dst = (samp ? (bf16*)(ws + WS_KCS) + ((size_t)gam * 128 + i0 + col) * 64 : (bf16*)(ws + WS_KCP) + ((size_t)gam * 512 + i0 + col) * 64) + 4 * quad;
#pragma unroll
            for (int dt = 0; dt < 4; ++dt) { const f32x4 kg = *(const f32x4*)(P.in[24] + 16 * dt + 4 * quad); const f32x4 o = v[dt] * ri * kg; v2u w; w.x = pk2(o[0], o[1]); w.y = pk2(o[2], o[3]); *(v2u*)(dst + 16 * dt) = w; }
        } else {
#pragma unroll
            for (int dt = 0; dt < 4; ++dt) { const int d = 16 * dt + col; const float bb = b2[d];
                const int ip = (i0 & ~63) + 32 * ((i0 >> 5) & 1) + 8 * quad + 4 * ((i0 >> 4) & 1);
                bf16* dst = (samp ? (bf16*)(ws + WS_VCTS) + (size_t)gam * 2 * 4096 : (bf16*)(ws + WS_VCTP) + (size_t)gam * 8 * 4096) + (size_t)(ip >> 6) * 4096 + d * 64 + (ip & 63);
                v2u w; w.x = pk2(acc[dt][0] + bb, acc[dt][1] + bb); w.y = pk2(acc[dt][2] + bb, acc[dt][3] + bb); *(v2u*)dst = w; }
        }
    }
}

#ifndef ATT_REP_P
#define ATT_REP_P 1
#endif
#ifndef ATT_REP_S
#define ATT_REP_S 1
#endif

__device__ __forceinline__ void load_k8(const bf16* kb, int lane, bf16x8 (&kf)[8]) {
    const int col = lane & 15, quad = lane >> 4;
#pragma unroll
    for (int kt = 0; kt < 4; ++kt) { const bf16* kp = kb + (size_t)(16 * kt + col) * 64 + 8 * quad; kf[2 * kt] = *(const bf16x8*)kp; kf[2 * kt + 1] = *(const bf16x8*)(kp + 32); }
}
__device__ __forceinline__ void load_vt8(const bf16* vtb, int pitch, int lane, bf16x8 (&vf)[8]) {
    const int col = lane & 15, quad = lane >> 4;
#pragma unroll
    for (int dt = 0; dt < 4; ++dt)
#pragma unroll
        for (int ks = 0; ks < 2; ++ks) vf[2 * dt + ks] = *(const bf16x8*)(vtb + (size_t)(16 * dt + col) * pitch + 32 * ks + 8 * quad);
}
__device__ __forceinline__ void select_topk(LAS float* imps, int cur, int lane, unsigned (&msk)[4]) {
    const int col = lane & 15, quad = lane >> 4, ql = col >> 2, hl = col & 3;
#pragma unroll
    for (int w = 0; w < 4; ++w) msk[w] = 0u;
    if (cur <= 15) { msk[0] = (2u << cur) - 1u; return; }
    asm volatile("s_waitcnt lgkmcnt(0)" ::: "memory");
    const int lq = hl + 4 * quad;
    unsigned key[8];
#pragma unroll
    for (int e = 0; e < 8; ++e) { const int sg = lq + 16 * e; const float v = imps[ql * 128 + sg]; key[e] = (sg >= 1 && sg <= cur - 2) ? ((__builtin_bit_cast(unsigned, v) & ~127u) | (unsigned)sg) : 0u; }
    for (int it = 0; it < 13; ++it) {
        unsigned mx = key[0];
#pragma unroll
        for (int e = 1; e < 8; ++e) mx = mx > key[e] ? mx : key[e];
        { unsigned o = dpp_xor1u(mx); mx = mx > o ? mx : o; o = dpp_xor2u(mx); mx = mx > o ? mx : o; o = (unsigned)__shfl_xor((int)mx, 16); mx = mx > o ? mx : o; o = (unsigned)__shfl_xor((int)mx, 32); mx = mx > o ? mx : o; }
        const unsigned sg = mx & 127u, bit = mx ? (1u << (sg & 31u)) : 0u, w = sg >> 5;
        msk[0] |= w == 0u ? bit : 0u; msk[1] |= w == 1u ? bit : 0u; msk[2] |= w == 2u ? bit : 0u; msk[3] |= w == 3u ? bit : 0u;
#pragma unroll
        for (int e = 0; e < 8; ++e) key[e] = key[e] == mx ? 0u : key[e];
    }
    msk[0] |= 1u;
#pragma unroll
    for (int k = 0; k < 2; ++k) { const unsigned sg = (unsigned)(cur - k), bit = 1u << (sg & 31u), w = sg >> 5;
        msk[0] |= w == 0u ? bit : 0u; msk[1] |= w == 1u ? bit : 0u; msk[2] |= w == 2u ? bit : 0u; msk[3] |= w == 3u ? bit : 0u; }
}

__device__ __forceinline__ void attn_cmp_select(const bf16* kc, const bf16* vct, int vpitch, bf16x8 qn0, bf16x8 qn1, int nvis, int nkt, int cur, float nref,
                                                LAS float* imps, int lane, f32x4 (&oc)[4], unsigned (&msk)[4]) {
    const int col = lane & 15, quad = lane >> 4, ql = col >> 2, hl = col & 3;
    const int nb = (nkt + 3) >> 2;
    float lsum = 0.f;
    {   bf16x8 kfA[8], kfB[8];
        if (nb > 0) load_k8(kc, lane, kfA);
        for (int blk = 0; blk < nb; ++blk) {
            if (blk + 1 < nb) load_k8(kc + (size_t)(blk + 1) * 4096, lane, kfB);
#pragma unroll
            for (int kt = 0; kt < 4; ++kt) { f32x4 s = {nref, nref, nref, nref}; s = MFMA16(kfA[2 * kt], qn0, s); s = MFMA16(kfA[2 * kt + 1], qn1, s);
#pragma unroll
                for (int r = 0; r < 4; ++r) lsum += (64 * blk + 16 * kt + 4 * quad + r < nvis) ? fexp2(s[r]) : 0.f; }
#pragma unroll
            for (int i = 0; i < 8; ++i) kfA[i] = kfB[i];
        } }
    float l = lsum + __shfl_xor(lsum, 16); l += __shfl_xor(l, 32);
    const float rl = l > 0.f ? 1.0f / l : 0.f;
#pragma unroll
    for (int dt = 0; dt < 4; ++dt) oc[dt] = (f32x4){0.f, 0.f, 0.f, 0.f};
    float carry = 0.f;
    {   bf16x8 kfA[8], kfB[8], vfA[8];
        if (nb > 0) load_k8(kc, lane, kfA);
        for (int blk = 0; blk < nb; ++blk) {
            load_vt8(vct + (size_t)blk * 4096, 64, lane, vfA);
            if (blk + 1 < nb) load_k8(kc + (size_t)(blk + 1) * 4096, lane, kfB);
            float pa[4][4];
#pragma unroll
            for (int kt = 0; kt < 4; ++kt) { f32x4 s = {nref, nref, nref, nref}; s = MFMA16(kfA[2 * kt], qn0, s); s = MFMA16(kfA[2 * kt + 1], qn1, s);
                float hs[4];
#pragma unroll
                for (int r = 0; r < 4; ++r) { const float p = (64 * blk + 16 * kt + 4 * quad + r < nvis) ? fexp2(s[r]) * rl : 0.f; pa[kt][r] = p; float h = p + dpp_xor1(p); h += dpp_xor2(h); hs[r] = h; }
                const float tot = (hs[0] + hs[1]) + (hs[2] + hs[3]);
                const float up = __shfl(hs[3], (lane + 48) & 63);
                const float prev = quad == 0 ? carry : up; carry = up;
                if (hl == 0) imps[ql * 128 + 16 * blk + 4 * kt + quad] = tot + prev; }
#pragma unroll
            for (int ks = 0; ks < 2; ++ks) { v4u pw; pw.x = pk2(pa[2 * ks][0], pa[2 * ks][1]); pw.y = pk2(pa[2 * ks][2], pa[2 * ks][3]); pw.z = pk2(pa[2 * ks + 1][0], pa[2 * ks + 1][1]); pw.w = pk2(pa[2 * ks + 1][2], pa[2 * ks + 1][3]);
                const bf16x8 pb = __builtin_bit_cast(bf16x8, pw);
#pragma unroll
                for (int dt = 0; dt < 4; ++dt) oc[dt] = MFMA16(vfA[2 * dt + ks], pb, oc[dt]); }
#pragma unroll
            for (int i = 0; i < 8; ++i) kfA[i] = kfB[i];
        } }
    select_topk(imps, cur, lane, msk);
}

__device__ __forceinline__ void tile_step(const bf16x8 (&kf)[8], const bf16x8 (&vf)[8], bf16x8 q0, bf16x8 q1, float cinit, bool masked, int kpos0, int lo, int hi, int lane, f32x4 (&o)[4], float& lsum) {
    const int quad = lane >> 4;
    f32x4 p[4];
#pragma unroll
    for (int kt = 0; kt < 4; ++kt) { f32x4 s = {cinit, cinit, cinit, cinit}; s = MFMA16(kf[2 * kt], q0, s); s = MFMA16(kf[2 * kt + 1], q1, s);
#pragma unroll
        for (int r = 0; r < 4; ++r) p[kt][r] = fexp2(s[r]); }
    if (masked) {
#pragma unroll
        for (int kt = 0; kt < 4; ++kt)
#pragma unroll
            for (int r = 0; r < 4; ++r) { const int kpos = kpos0 + 16 * kt + 4 * quad + r; p[kt][r] = (kpos >= lo && kpos <= hi) ? p[kt][r] : 0.f; } }
#pragma unroll
    for (int kt = 0; kt < 4; ++kt) lsum += (p[kt][0] + p[kt][1]) + (p[kt][2] + p[kt][3]);
#pragma unroll
    for (int ks = 0; ks < 2; ++ks) {
        v4u pw; pw.x = pk2(p[2 * ks][0], p[2 * ks][1]); pw.y = pk2(p[2 * ks][2], p[2 * ks][3]); pw.z = pk2(p[2 * ks + 1][0], p[2 * ks + 1][1]); pw.w = pk2(p[2 * ks + 1][2], p[2 * ks + 1][3]);
        const bf16x8 pb = __builtin_bit_cast(bf16x8, pw);
#pragma unroll
        for (int dt = 0; dt < 4; ++dt) o[dt] = MFMA16(vf[2 * dt + ks], pb, o[dt]); }
}

struct AttnRefs { float cmp, slc, win; };

constexpr int AT_RING = 0, AT_SLOT = 16384, AT_NS = 4;
constexpr int AT_IMPS = AT_NS * AT_SLOT;
constexpr int AT_PARKA = AT_IMPS, AT_PARKB = AT_IMPS + 32768;
constexpr int AT_UNI = RING_BYTES + 1024;
static_assert(AT_PARKB + 32768 <= RING_BYTES && AT_UNI + 256 <= LDS_BYTES, "attention LDS map");
#define AT_WAITV(n) asm volatile("s_waitcnt vmcnt(" #n ")" ::: "memory")
#define AT_RING_WAIT2(rem) do { const int r_ = (rem); if (r_ >= 2) AT_WAITV(4); else if (r_ == 1) AT_WAITV(2); else AT_WAITV(0); } while (0)
#define AT_RING_WAIT1(rem) do { const int r_ = (rem); if (r_ >= 2) AT_WAITV(2); else if (r_ == 1) AT_WAITV(1); else AT_WAITV(0); } while (0)

struct TileQ { bf16x8 q0, q1; int nvis, nvt, tb, tq; };
__device__ __forceinline__ void pv_acc(const bf16x8 (&vf)[8], const f32x4 (&p)[4], f32x4 (&o)[4]);

__device__ __forceinline__ void cmp_p1_step(const bf16x8 (&kf)[8], const TileQ& T, float nref, int j, int lane, float& lsum) {
    const int quad = lane >> 4;
#pragma unroll
    for (int kt = 0; kt < 4; ++kt) { f32x4 s = {nref, nref, nref, nref}; s = MFMA16(kf[2 * kt], T.q0, s); s = MFMA16(kf[2 * kt + 1], T.q1, s);
#pragma unroll
        for (int r = 0; r < 4; ++r) lsum += (64 * j + 16 * kt + 4 * quad + r < T.nvis) ? fexp2(s[r]) : 0.f; }
}
__device__ __forceinline__ void cmp_p2_qk(const bf16x8 (&kf)[8], const TileQ& T, float nref, float rl, int j, int lane, float& carry, LAS float* imps, f32x4 (&pa)[4]) {
    const int col = lane & 15, quad = lane >> 4, ql = col >> 2, hl = col & 3;
#pragma unroll
    for (int kt = 0; kt < 4; ++kt) { f32x4 s = {nref, nref, nref, nref}; s = MFMA16(kf[2 * kt], T.q0, s); s = MFMA16(kf[2 * kt + 1], T.q1, s);
        float hs[4];
#pragma unroll
        for (int r = 0; r < 4; ++r) { const float p = (64 * j + 16 * kt + 4 * quad + r < T.nvis) ? fexp2(s[r]) * rl : 0.f; pa[kt][r] = p; float h = p + dpp_xor1(p); h += dpp_xor2(h); hs[r] = h; }
        const float tot = (hs[0] + hs[1]) + (hs[2] + hs[3]);
        const float up = __shfl(hs[3], (lane + 48) & 63);
        const float prev = quad == 0 ? carry : up; carry = up;
        if (hl == 0) imps[ql * 128 + 16 * j + 4 * kt + quad] = tot + prev; }
}

__device__ __forceinline__ void attn_cmp_ring2(const bf16* Kb, const bf16* Vb, LAS unsigned char* lds, const TileQ& A, const TileQ& B, int nb, int cur, float nref,
                                               LAS float* imps, int w, int lane, f32x4 (&oa)[4], f32x4 (&ob)[4], unsigned (&ma)[4], unsigned (&mb)[4]) {
    const int col = lane & 15, quad = lane >> 4;
    const size_t foff = (size_t)(16 * (w >> 1) + col) * 64 + 32 * (w & 1) + 8 * quad;
#define CR_DMAK(j) __builtin_amdgcn_global_load_lds((const unsigned*)(Kb + (size_t)(j) * 4096 + foff), (LAS unsigned*)(lds + AT_RING + ((j) & (AT_NS - 1)) * AT_SLOT + w * 1024), 16, 0, 0)
#define CR_DMAV(j) __builtin_amdgcn_global_load_lds((const unsigned*)(Vb + (size_t)(j) * 4096 + foff), (LAS unsigned*)(lds + AT_RING + ((j) & (AT_NS - 1)) * AT_SLOT + 8192 + w * 1024), 16, 0, 0)
    float lsa = 0.f, lsb = 0.f;
    asm volatile("s_waitcnt vmcnt(0)" ::: "memory"); __builtin_amdgcn_s_barrier(); asm volatile("" ::: "memory");
    for (int j = 0; j < AT_NS - 1; ++j) if (j < nb) CR_DMAK(j);
    for (int j = 0; j < nb; ++j) {
        AT_RING_WAIT1(nb - 1 - j);
        __builtin_amdgcn_s_barrier(); asm volatile("" ::: "memory");
        if (j + AT_NS - 1 < nb) CR_DMAK(j + AT_NS - 1);
        if (64 * j < B.nvt) {
            const LAS unsigned char* sl = lds + AT_RING + (j & (AT_NS - 1)) * AT_SLOT + lane * 16;
            bf16x8 kf[8];
#pragma unroll
            for (int f = 0; f < 8; ++f) kf[f] = *(const LAS bf16x8*)(sl + f * 1024);
            if (64 * j < A.nvt) cmp_p1_step(kf, A, nref, j, lane, lsa);
            cmp_p1_step(kf, B, nref, j, lane, lsb); }
    }
    lsa += __shfl_xor(lsa, 16); lsa += __shfl_xor(lsa, 32); lsb += __shfl_xor(lsb, 16); lsb += __shfl_xor(lsb, 32);
    const float rla = lsa > 0.f ? 1.0f / lsa : 0.f, rlb = lsb > 0.f ? 1.0f / lsb : 0.f;
#pragma unroll
    for (int dt = 0; dt < 4; ++dt) { oa[dt] = (f32x4){0.f, 0.f, 0.f, 0.f}; ob[dt] = (f32x4){0.f, 0.f, 0.f, 0.f}; }
    float ca = 0.f, cb = 0.f;
    asm volatile("s_waitcnt vmcnt(0)" ::: "memory"); __builtin_amdgcn_s_barrier(); asm volatile("" ::: "memory");
    for (int j = 0; j < AT_NS - 1; ++j) if (j < nb) { CR_DMAK(j); CR_DMAV(j); }
    for (int j = 0; j < nb; ++j) {
        AT_RING_WAIT2(nb - 1 - j);
        __builtin_amdgcn_s_barrier(); asm volatile("" ::: "memory");
        if (j + AT_NS - 1 < nb) { CR_DMAK(j + AT_NS - 1); CR_DMAV(j + AT_NS - 1); }
        const LAS unsigned char* sl = lds + AT_RING + (j & (AT_NS - 1)) * AT_SLOT + lane * 16;
        f32x4 pA[4], pB[4];
        {   bf16x8 kf[8];
#pragma unroll
            for (int f = 0; f < 8; ++f) kf[f] = *(const LAS bf16x8*)(sl + f * 1024);
            cmp_p2_qk(kf, A, nref, rla, j, lane, ca, imps, pA);
            cmp_p2_qk(kf, B, nref, rlb, j, lane, cb, imps + 512, pB); }
        asm volatile("" ::: "memory");
        {   bf16x8 vf[8];
#pragma unroll
            for (int f = 0; f < 8; ++f) vf[f] = *(const LAS bf16x8*)(sl + 8192 + f * 1024);
            pv_acc(vf, pA, oa); pv_acc(vf, pB, ob); }
    }
#undef CR_DMAK
#undef CR_DMAV
    select_topk(imps, cur, lane, ma);
    select_topk(imps + 512, cur, lane, mb);
}

__device__ __forceinline__ void qk_exp(const bf16x8 (&kf)[8], bf16x8 q0, bf16x8 q1, float cinit, bool masked, int kpos0, int lo, int hi, int lane, f32x4 (&p)[4], float& lsum) {
    const int quad = lane >> 4;
#pragma unroll
    for (int kt = 0; kt < 4; ++kt) { f32x4 s = {cinit, cinit, cinit, cinit}; s = MFMA16(kf[2 * kt], q0, s); s = MFMA16(kf[2 * kt + 1], q1, s);
#pragma unroll
        for (int r = 0; r < 4; ++r) p[kt][r] = fexp2(s[r]); }
    if (masked) {
#pragma unroll
        for (int kt = 0; kt < 4; ++kt)
#pragma unroll
            for (int r = 0; r < 4; ++r) { const int kpos = kpos0 + 16 * kt + 4 * quad + r; p[kt][r] = (kpos >= lo && kpos <= hi) ? p[kt][r] : 0.f; } }
#pragma unroll
    for (int kt = 0; kt < 4; ++kt) lsum += (p[kt][0] + p[kt][1]) + (p[kt][2] + p[kt][3]);
}
__device__ __forceinline__ void pv_acc(const bf16x8 (&vf)[8], const f32x4 (&p)[4], f32x4 (&o)[4]) {
#pragma unroll
    for (int ks = 0; ks < 2; ++ks) {
        v4u pw; pw.x = pk2(p[2 * ks][0], p[2 * ks][1]); pw.y = pk2(p[2 * ks][2], p[2 * ks][3]); pw.z = pk2(p[2 * ks + 1][0], p[2 * ks + 1][1]); pw.w = pk2(p[2 * ks + 1][2], p[2 * ks + 1][3]);
        const bf16x8 pb = __builtin_bit_cast(bf16x8, pw);
#pragma unroll
        for (int dt = 0; dt < 4; ++dt) o[dt] = MFMA16(vf[2 * dt + ks], pb, o[dt]); }
}
struct TileB { bf16x8 q0, q1; int tb, tq; float gate; };
template <int BR>
__device__ __forceinline__ void attn_branch2(const bf16* Kb, const bf16* Vb, LAS unsigned char* lds, int t0, int cur, float ref, const TileB& A, const TileB& B,
                                             const unsigned (&ma)[4], const unsigned (&mb)[4], const unsigned (&una)[4], const unsigned (&unb)[4], const unsigned (&uu)[4],
                                             int w, int lane, LAS unsigned char* parkA, LAS unsigned char* parkB) {
    const int col = lane & 15, quad = lane >> 4;
    int nblk, wlo = 0;
    unsigned c0 = uu[0], c1 = uu[1], c2 = uu[2], c3 = uu[3], p0 = uu[0], p1 = uu[1], p2 = uu[2], p3 = uu[3];
    if (BR == 0) nblk = __builtin_popcount(c0) + __builtin_popcount(c1) + __builtin_popcount(c2) + __builtin_popcount(c3);
    else { wlo = (t0 >= WIN ? t0 - WIN : 0) >> 6; nblk = cur - wlo + 1; }
    const size_t foff = (size_t)(16 * (w >> 1) + col) * 64 + 32 * (w & 1) + 8 * quad;
#define AT_BITNEXT(a, b, c, d, out) do { if (a) { out = __builtin_ctz(a); a &= a - 1u; } else if (b) { out = 32 + __builtin_ctz(b); b &= b - 1u; } else if (c) { out = 64 + __builtin_ctz(c); c &= c - 1u; } else { out = 96 + __builtin_ctz(d); d &= d - 1u; } } while (0)
#define AT_DMA(j) do { int sg_; if (BR == 0) AT_BITNEXT(p0, p1, p2, p3, sg_); else sg_ = wlo + (j); LAS unsigned char* sl_ = lds + AT_RING + ((j) & (AT_NS - 1)) * AT_SLOT + w * 1024; \
        __builtin_amdgcn_global_load_lds((const unsigned*)(Kb + (size_t)sg_ * 4096 + foff), (LAS unsigned*)sl_, 16, 0, 0); \
        __builtin_amdgcn_global_load_lds((const unsigned*)(Vb + (size_t)sg_ * 4096 + foff), (LAS unsigned*)(sl_ + 8192), 16, 0, 0); } while (0)
    f32x4 oa[4], ob[4]; float lsa = 0.f, lsb = 0.f;
#pragma unroll
    for (int dt = 0; dt < 4; ++dt) { oa[dt] = (f32x4){0.f, 0.f, 0.f, 0.f}; ob[dt] = (f32x4){0.f, 0.f, 0.f, 0.f}; }
    asm volatile("s_waitcnt vmcnt(0)" ::: "memory");
    __builtin_amdgcn_s_barrier();
    asm volatile("" ::: "memory");
    for (int j = 0; j < AT_NS - 1; ++j) if (j < nblk) AT_DMA(j);
    for (int j = 0; j < nblk; ++j) {
        AT_RING_WAIT2(nblk - 1 - j);
        __builtin_amdgcn_s_barrier();
        asm volatile("" ::: "memory");
        if (j + AT_NS - 1 < nblk) AT_DMA(j + AT_NS - 1);
        int sg; if (BR == 0) AT_BITNEXT(c0, c1, c2, c3, sg); else sg = wlo + j;
        bool na, nbb, mka, mkb;
        if (BR == 0) { const int sw = sg >> 5; const unsigned bit = 1u << (sg & 31);
            const unsigned wa = sw == 0 ? una[0] : sw == 1 ? una[1] : sw == 2 ? una[2] : una[3], wb = sw == 0 ? unb[0] : sw == 1 ? unb[1] : sw == 2 ? unb[2] : unb[3];
            int sgo = sg; asm volatile("" : "+s"(sgo));
            na = (wa & bit) != 0u; nbb = (wb & bit) != 0u; mka = mkb = sgo == cur; }
        else { na = (64 * sg + 63 >= A.tb - WIN) && (64 * sg <= A.tb + 3); mka = (64 * sg + 63 > A.tb) || (64 * sg < A.tb + 3 - WIN);
               nbb = (64 * sg + 63 >= B.tb - WIN) && (64 * sg <= B.tb + 3); mkb = (64 * sg + 63 > B.tb) || (64 * sg < B.tb + 3 - WIN); }
        if (na || nbb) {
            const LAS unsigned char* sl = lds + AT_RING + (j & (AT_NS - 1)) * AT_SLOT + lane * 16;
            const int sw = sg >> 5;
            float cia = ref, cib = ref;
            if (BR == 0) { const unsigned mwa = sw == 0 ? ma[0] : sw == 1 ? ma[1] : sw == 2 ? ma[2] : ma[3], mwb = sw == 0 ? mb[0] : sw == 1 ? mb[1] : sw == 2 ? mb[2] : mb[3];
                cia = ((mwa >> (sg & 31)) & 1u) ? ref : -1e30f; cib = ((mwb >> (sg & 31)) & 1u) ? ref : -1e30f; }
            f32x4 pA[4], pB[4];
            {   bf16x8 kf[8];
#pragma unroll
                for (int f = 0; f < 8; ++f) kf[f] = *(const LAS bf16x8*)(sl + f * 1024);
                if (na) qk_exp(kf, A.q0, A.q1, cia, mka, 64 * sg, BR == 0 ? 0 : A.tq - WIN, A.tq, lane, pA, lsa);
                if (nbb) qk_exp(kf, B.q0, B.q1, cib, mkb, 64 * sg, BR == 0 ? 0 : B.tq - WIN, B.tq, lane, pB, lsb); }
            asm volatile("" ::: "memory");
            {   bf16x8 vf[8];
#pragma unroll
                for (int f = 0; f < 8; ++f) vf[f] = *(const LAS bf16x8*)(sl + 8192 + f * 1024);
                if (na) pv_acc(vf, pA, oa);
                if (nbb) pv_acc(vf, pB, ob); }
        }
    }
#undef AT_BITNEXT
#undef AT_DMA
    lsa += __shfl_xor(lsa, 16); lsa += __shfl_xor(lsa, 32); lsb += __shfl_xor(lsb, 16); lsb += __shfl_xor(lsb, 32);
    const float sca = lsa > 0.f ? A.gate / lsa : 0.f, scb = lsb > 0.f ? B.gate / lsb : 0.f;
#pragma unroll
    for (int dt = 0; dt < 4; ++dt) { LAS f32x4* pa_ = (LAS f32x4*)(parkA + dt * 1024); LAS f32x4* pb_ = (LAS f32x4*)(parkB + dt * 1024); *pa_ = *pa_ + oa[dt] * sca; *pb_ = *pb_ + ob[dt] * scb; }
}

__device__ __forceinline__ void attn_prompt_unit(const Params& P, int unit, const AttnRefs& rf, LAS unsigned char* lds, int lane, int wave) {
    unsigned char* ws = P.ws;
    const int w = wave;
    const int gam = unit & 7, pt64 = unit >> 3, b = gam >> 2, g = gam & 3, t0 = 64 * pt64, cur = t0 >> 6;
    const int col = lane & 15, quad = lane >> 4, ql = col >> 2, hl = col & 3;
    LAS unsigned* UNI = (LAS unsigned*)(lds + AT_UNI);
    LAS float* imps = (LAS float*)(lds + AT_IMPS) + wave * 1024;
    const bf16* QN = (const bf16*)(ws + WS_QN); const bf16* QR = (const bf16*)(ws + WS_QR);
    const int tba = t0 + 8 * w, tbb = tba + 4, tqa = tba + ql, tqb = tbb + ql;
    const size_t qoa = (size_t)(b * SEQ + tqa) * D + (4 * g + hl) * 64 + 8 * quad, qob = qoa + 4 * D;
    f32x4 oa[4], ob[4]; unsigned ma[4], mb[4];
    {   TileQ A, B;
        A.q0 = *(const bf16x8*)(QN + qoa); A.q1 = *(const bf16x8*)(QN + qoa + 32); B.q0 = *(const bf16x8*)(QN + qob); B.q1 = *(const bf16x8*)(QN + qob + 32);
        A.tb = tba; A.tq = tqa; B.tb = tbb; B.tq = tqb;
        A.nvis = tqa >= 31 ? ((tqa - 31) >> 4) + 1 : 0; B.nvis = tqb >= 31 ? ((tqb - 31) >> 4) + 1 : 0;
        A.nvt = (tba + 3) >= 31 ? ((tba + 3 - 31) >> 4) + 1 : 0; B.nvt = (tbb + 3) >= 31 ? ((tbb + 3 - 31) >> 4) + 1 : 0;
        const int nvu = (t0 + 63) >= 31 ? ((t0 + 63 - 31) >> 4) + 1 : 0, nb = (nvu + 63) >> 6;
        attn_cmp_ring2((const bf16*)(ws + WS_KCP) + (size_t)gam * 512 * 64, (const bf16*)(ws + WS_VCTP) + (size_t)gam * 8 * 4096, lds, A, B, nb, cur, rf.cmp, imps, w, lane, oa, ob, ma, mb); }
    const float* gta = (const float*)(ws + WS_GATES) + (size_t)(b * SEQ + tqa) * 48 + (4 * g + hl) * 3; const float* gtb = gta + 4 * 48;
    LAS unsigned char* parkA = lds + AT_PARKA + w * 4096 + lane * 16; LAS unsigned char* parkB = lds + AT_PARKB + w * 4096 + lane * 16;
    {   const float ga = gta[0], gb = gtb[0];
#pragma unroll
        for (int dt = 0; dt < 4; ++dt) { *(LAS f32x4*)(parkA + dt * 1024) = oa[dt] * ga; *(LAS f32x4*)(parkB + dt * 1024) = ob[dt] * gb; } }
    unsigned una[4], unb[4];
#pragma unroll
    for (int k = 0; k < 4; ++k) { unsigned u = ma[k]; u |= (unsigned)__shfl_xor((int)u, 4); u |= (unsigned)__shfl_xor((int)u, 8); una[k] = (unsigned)__builtin_amdgcn_readfirstlane((int)u);
        unsigned v = mb[k]; v |= (unsigned)__shfl_xor((int)v, 4); v |= (unsigned)__shfl_xor((int)v, 8); unb[k] = (unsigned)__builtin_amdgcn_readfirstlane((int)v); }
    if (lane == 0) *(LAS v4u*)(UNI + w * 4) = (v4u){una[0] | unb[0], una[1] | unb[1], una[2] | unb[2], una[3] | unb[3]};
    __syncthreads();
    unsigned uu[4];
#pragma unroll
    for (int k = 0; k < 4; ++k) { unsigned x = 0u;
#pragma unroll
        for (int t = 0; t < 8; ++t) x |= UNI[4 * t + k];
        uu[k] = (unsigned)__builtin_amdgcn_readfirstlane((int)x); }
    TileB A, B;
    A.q0 = *(const bf16x8*)(QR + qoa); A.q1 = *(const bf16x8*)(QR + qoa + 32); B.q0 = *(const bf16x8*)(QR + qob); B.q1 = *(const bf16x8*)(QR + qob + 32);
    A.tb = tba; A.tq = tqa; B.tb = tbb; B.tq = tqb;
    A.gate = gta[1]; B.gate = gtb[1];
    attn_branch2<0>((const bf16*)(ws + WS_KS) + (size_t)gam * SEQ * 64, (const bf16*)(ws + WS_VST) + (size_t)gam * 128 * 4096, lds, t0, cur, rf.slc, A, B, ma, mb, una, unb, uu, w, lane, parkA, parkB);
    A.gate = gta[2]; B.gate = gtb[2];
    attn_branch2<1>((const bf16*)(ws + WS_KW) + (size_t)gam * SEQ * 64, (const bf16*)(ws + WS_VWT) + (size_t)gam * 128 * 4096, lds, t0, cur, rf.win, A, B, ma, mb, una, unb, uu, w, lane, parkA, parkB);
    bf16* opa = (bf16*)(ws + WS_O) + (size_t)(b * SEQ + tqa) * D + (4 * g + hl) * 64 + 4 * quad; bf16* opb = opa + 4 * D;
#pragma unroll
    for (int dt = 0; dt < 4; ++dt) { const f32x4 xa = *(const LAS f32x4*)(parkA + dt * 1024), xb = *(const LAS f32x4*)(parkB + dt * 1024);
        v2u wv; wv.x = pk2(xa[0], xa[1]); wv.y = pk2(xa[2], xa[3]); *(v2u*)(opa + 16 * dt) = wv;
        v2u wb; wb.x = pk2(xb[0], xb[1]); wb.y = pk2(xb[2], xb[3]); *(v2u*)(opb + 16 * dt) = wb; }
}

struct DecState { float m[4], l[4]; float o[4][16]; };
__device__ __forceinline__ void dec_job(const float* kbase, const float* vbase, int nkeys, const unsigned (&qp)[4][8], DecState& st, int lane) {
    const int ksub = lane >> 2, dq = lane & 3;
    const float* kp = kbase + (size_t)ksub * 256 + 16 * dq; const float* vp = vbase + (size_t)ksub * 256 + 16 * dq;
    f32x4 kc[4], kn[4];
#pragma unroll
    for (int j = 0; j < 4; ++j) { kc[j] = (ksub < nkeys) ? *(const f32x4*)(kp + 4 * j) : (f32x4){0.f, 0.f, 0.f, 0.f}; kn[j] = kc[j]; }
#pragma unroll 1
    for (int k0 = 0; k0 < nkeys; k0 += 16) { const bool ok = k0 + ksub < nkeys;
        f32x4 vc[4];
#pragma unroll
        for (int j = 0; j < 4; ++j) vc[j] = ok ? *(const f32x4*)(vp + (size_t)k0 * 256 + 4 * j) : (f32x4){0.f, 0.f, 0.f, 0.f};
        if (k0 + 16 < nkeys) { const bool okn = k0 + 16 + ksub < nkeys;
#pragma unroll
            for (int j = 0; j < 4; ++j) kn[j] = okn ? *(const f32x4*)(kp + (size_t)(k0 + 16) * 256 + 4 * j) : (f32x4){0.f, 0.f, 0.f, 0.f}; }
        float pr[4], alv[4];
#pragma unroll
        for (int h = 0; h < 4; ++h) { float d = 0.f;
#pragma unroll
            for (int j = 0; j < 4; ++j) d += (kc[j][0] * bflo(qp[h][2 * j]) + kc[j][1] * bfhi(qp[h][2 * j])) + (kc[j][2] * bflo(qp[h][2 * j + 1]) + kc[j][3] * bfhi(qp[h][2 * j + 1]));
            d += dpp_xor1(d); d += dpp_xor2(d);
            const float sc = ok ? d : -1e30f, mn = fmaxf(st.m[h], sc); alv[h] = fexp2(st.m[h] - mn); pr[h] = ok ? fexp2(sc - mn) : 0.f;
            st.m[h] = mn; st.l[h] = st.l[h] * alv[h] + pr[h]; }
#pragma unroll
        for (int h = 0; h < 4; ++h)
#pragma unroll
            for (int j = 0; j < 4; ++j)
#pragma unroll
                for (int i = 0; i < 4; ++i) st.o[h][4 * j + i] = st.o[h][4 * j + i] * alv[h] + pr[h] * vc[j][i];
#pragma unroll
        for (int j = 0; j < 4; ++j) kc[j] = kn[j]; }
}

__device__ __forceinline__ void attn_sample_item(const Params& P, int item, const AttnRefs& rf, LAS float* L, int tid, int lane, int wave) {
    unsigned char* ws = P.ws;
    const int s = item >> 2, g = item & 3, row = MP + s;
    LAS float* ocs = L; LAS unsigned* sel = (LAS unsigned*)(L + 256); LAS float* part = L + 260; LAS float* imps = L + 260 + 8 * 4 * 66;
    const float* gates = (const float*)(ws + WS_GATES) + (size_t)row * 48 + 4 * g * 3;
    if (wave == 0) {
        const int col = lane & 15, quad = lane >> 4, ql = col >> 2, hl = col & 3;
        const size_t qoff = (size_t)row * D + (4 * g + hl) * 64 + 8 * quad; const bf16* QN = (const bf16*)(ws + WS_QN);
        const bf16x8 qn0 = *(const bf16x8*)(QN + qoff), qn1 = *(const bf16x8*)(QN + qoff + 32);
        f32x4 oc[4]; unsigned msk[4];
        attn_cmp_select((const bf16*)(ws + WS_KCS) + (size_t)item * 128 * 64, (const bf16*)(ws + WS_VCTS) + (size_t)item * 2 * 4096, 64, qn0, qn1, 127, 8, 32, rf.cmp, imps, lane, oc, msk);
        const float g0 = gates[hl * 3];
        if (ql == 0) {
#pragma unroll
            for (int dt = 0; dt < 4; ++dt)
#pragma unroll
                for (int r = 0; r < 4; ++r) ocs[hl * 64 + 16 * dt + 4 * quad + r] = oc[dt][r] * g0; }
        if (lane == 0) sel[0] = msk[0];
    }
    __syncthreads();
    {
        const unsigned m0 = sel[0];
        const bool isw = wave >= 5;
        const int dq = lane & 3;
        unsigned qp[4][8];
        const bf16* QR = (const bf16*)(ws + WS_QR) + (size_t)row * D + 4 * g * 64 + 16 * dq;
#pragma unroll
        for (int h = 0; h < 4; ++h) { const v4u a = *(const v4u*)(QR + h * 64), b = *(const v4u*)(QR + h * 64 + 8);
            qp[h][0] = a.x; qp[h][1] = a.y; qp[h][2] = a.z; qp[h][3] = a.w; qp[h][4] = b.x; qp[h][5] = b.y; qp[h][6] = b.z; qp[h][7] = b.w; }
        DecState st;
#pragma unroll
        for (int h = 0; h < 4; ++h) { st.m[h] = -1e30f; st.l[h] = 0.f;
#pragma unroll
            for (int i = 0; i < 16; ++i) st.o[h][i] = 0.f; }
        const int* pt = (const int*)P.in[8] + s * 16;
#pragma unroll 1
        for (int jj = 0; jj < 4; ++jj) { const float* kb; const float* vb; int nk = 64;
            if (!isw) { const int J = wave + 5 * jj; if (J > 15) break;
                if (J == 15) { kb = P.out + O_SKS + (size_t)s * 256 + g * 64; vb = P.out + O_SVS + (size_t)s * 256 + g * 64; nk = 1; }
                else { unsigned bits = m0; for (int i = 0; i < J; ++i) bits &= bits - 1u; const int sg = bits ? __builtin_ctz(bits) : 0;
                    const size_t base = ((size_t)pt[sg >> 1] * 128 + (sg & 1) * 64) * 256 + g * 64; kb = P.in[4] + base; vb = P.in[5] + base; }
            } else { const int J = (wave - 5) + 3 * jj; if (J > 8) break;
                if (J == 8) { const size_t base = ((size_t)s * WIN + (WIN - 1)) * 256 + g * 64; kb = P.out + O_WKS + base; vb = P.out + O_WVS + base; nk = 1; }
                else { const size_t base = ((size_t)s * WIN + 64 * J) * 256 + g * 64; kb = P.in[6] + base; vb = P.in[7] + base; } }
            dec_job(kb, vb, nk, qp, st, lane); }
#pragma unroll
        for (int h = 0; h < 4; ++h) { float M = st.m[h]; M = fmaxf(M, __shfl_xor(M, 4)); M = fmaxf(M, __shfl_xor(M, 8)); M = fmaxf(M, __shfl_xor(M, 16)); M = fmaxf(M, __shfl_xor(M, 32));
            const float f = fexp2(st.m[h] - M); st.m[h] = M; st.l[h] *= f;
#pragma unroll
            for (int i = 0; i < 16; ++i) st.o[h][i] *= f; }
#pragma unroll
        for (int h = 0; h < 4; ++h) { float l = st.l[h]; l += __shfl_xor(l, 4); l += __shfl_xor(l, 8); l += __shfl_xor(l, 16); l += __shfl_xor(l, 32); st.l[h] = l;
#pragma unroll
            for (int i = 0; i < 16; ++i) { float v = st.o[h][i]; v += __shfl_xor(v, 4); v += __shfl_xor(v, 8); v += __shfl_xor(v, 16); v += __shfl_xor(v, 32); st.o[h][i] = v; } }
        if (lane < 4) {
#pragma unroll
            for (int h = 0; h < 4; ++h) { LAS float* pp = part + (wave * 4 + h) * 66; if (lane == 0) { pp[0] = st.m[h]; pp[1] = st.l[h]; }
#pragma unroll
                for (int i = 0; i < 16; ++i) pp[2 + 16 * dq + i] = st.o[h][i]; } }
    }
    __syncthreads();
    if (tid < 256) { const int h = tid >> 6, d = tid & 63;
        float res = ocs[h * 64 + d];
#pragma unroll
        for (int br = 0; br < 2; ++br) { const int w0 = br ? 5 : 0, w1 = br ? 8 : 5; float M = -1e30f;
            for (int w = w0; w < w1; ++w) M = fmaxf(M, part[(w * 4 + h) * 66]);
            float Lt = 0.f, Ot = 0.f;
            for (int w = w0; w < w1; ++w) { const LAS float* pp = part + (w * 4 + h) * 66; const float f = fexp2(pp[0] - M); Lt += pp[1] * f; Ot += pp[2 + d] * f; }
            res += (Lt > 0.f ? Ot / Lt : 0.f) * gates[h * 3 + 1 + br]; }
        ((bf16*)(ws + WS_O))[(size_t)row * D + (4 * g + h) * 64 + d] = (bf16)(pk2(res, 0.f) & 0xffffu); }
    __syncthreads();
}

__device__ __forceinline__ void phase_attn(const Params& P, LAS unsigned char* lds, int tid, int lane, int wave) {
    float qg = fabsf(P.in[20][lane]), k0 = fabsf(P.in[24][lane]), k1 = fabsf(P.in[24][64 + lane]), k2 = fabsf(P.in[24][128 + lane]);
    qg = wave_max(qg); k0 = wave_max(k0); k1 = wave_max(k1); k2 = wave_max(k2);
    AttnRefs rf; rf.cmp = -8.0f * 1.4426950409f * qg * k0; rf.slc = -8.0f * 1.4426950409f * qg * k1; rf.win = -8.0f * 1.4426950409f * qg * k2;
    LAS float* L = (LAS float*)lds;
    for (int item = blockIdx.x; item < 512 * ATT_REP_S; item += gridDim.x) attn_sample_item(P, item & 511, rf, L, tid, lane, wave);
    __syncthreads();
    {
        for (int k = 0; k < 4 * ATT_REP_P; ++k) { const int kk = k & 3; const int u0 = blockIdx.x + gridDim.x * kk;
            const int gam = u0 & 7, p0 = u0 >> 3; const int pt64 = (kk & 1) ? (32 * kk + 31 - (p0 & 31)) : p0;
            attn_prompt_unit(P, pt64 * 8 + gam, rf, lds, lane, wave); } }
    const int gtid = blockIdx.x * 512 + tid, ngt = gridDim.x * 512;
    for (int e = gtid; e < (M65 - MT) * 128; e += ngt) *(v4u*)((bf16*)(P.ws + WS_O) + (size_t)MT * D + (size_t)e * 8) = (v4u){0u, 0u, 0u, 0u};
}

constexpr int NPHASE = 15;
__global__ void __launch_bounds__(NWAVES * 64, 2) fwd(Params P) {
    extern __shared__ __attribute__((aligned(16))) unsigned char lds_raw[];
    LAS unsigned char* lds = (LAS unsigned char*)lds_raw;
    const int tid = threadIdx.x, lane = tid & 63, wave = __builtin_amdgcn_readfirstlane(tid >> 6);
    const int G = gridDim.x;
    unsigned char* ws = P.ws;
    for (int u = tid; u < (LDS_BYTES - LDSCTL_OFF) / 4; u += NWAVES * 64) ((LAS unsigned*)(lds + LDSCTL_OFF))[u] = 0u;
    __syncthreads();
    XcdBarrier bar; bar.bar = (unsigned*)(ws + WS_CTL) + CW_BAR; bar.x = 0; bar.st = nullptr;
#if !MK_PER_PHASE
    bar = xcd_barrier_post((unsigned*)(ws + WS_CTL) + CW_BAR, (volatile LAS unsigned*)(lds + MISC_OFF) + 8);
#endif
    const int lo = P.ph_lo, hi = P.ph_hi;
#ifndef PH_MASK
#define PH_MASK 0x7fff
#endif
#define EN(k) (((PH_MASK) >> (k)) & 1)
#ifndef REP_MASK
#define REP_MASK 0
#endif
#define REPS(k) ((((REP_MASK) >> (k)) & 1) + 1)
#define IN(k) (lo <= (k) && (k) < hi)
#if MK_PER_PHASE
#define GRID_BAR(k) do { } while (0)
#else
#define GRID_BAR(k) do { if ((k) + 1 < hi) xcd_barrier(bar); } while (0)
#endif
    bf16* WBIG = (bf16*)(ws + WS_WBIG); bf16* ACTA = (bf16*)(ws + WS_ACTA); float* SSQ = (float*)(ws + WS_SSQ);
    float* MOD = (float*)(ws + WS_MOD); float* BIAS = (float*)(ws + WS_BIAS); float* ROPE = (float*)(ws + WS_ROPE);
    const size_t SSQ_STRIDE = (size_t)M65 * 16;

    if (EN(0) && IN(0)) { for (int rep_ = 0; rep_ < REPS(0); ++rep_) phase0(P, lds, tid, lane, wave); GRID_BAR(0); }
    if (EN(1) && IN(1)) {
        pg8::Gemm g{(const bf16*)(ws + WS_SC), (const bf16*)(ws + WS_WADA), 256, NMOD, 1024, 1024, 1 << 30, 0}; pg8::StaticOrder S; S.init(256, NMOD, G, (int)blockIdx.x);
        EpiMod E{MOD, (bf16*)(ws + WS_SH), P.in[12]};
        pg8::gemm_phase<EpiMod, true>(lds + RING_OFF, g, S, E);
        __syncthreads();
        for (int rep_ = 0; rep_ < REPS(18); ++rep_) phase1_weights(P, lds, lane, wave);
        GRID_BAR(1); }
    if (EN(2) && IN(2)) {
        pg8::Gemm g{(const bf16*)(ws + WS_SH), WBIG, 1024, NBIG, 1024, 1024, 1 << 30, 0}; pg8::StaticOrder S; S.init(1024, NBIG, G, (int)blockIdx.x);
        EpiBias E{BIAS};
        for (int rep_ = 0; rep_ < REPS(2); ++rep_) pg8::gemm_phase<EpiBias, true>(lds + RING_OFF, g, S, E);
        for (int rep_ = 0; rep_ < REPS(15); ++rep_) phase2_tail(P, tid, lane, wave);
        for (int rep_ = 0; rep_ < REPS(16); ++rep_) sample_prepass(P, tid, lane, wave);
        GRID_BAR(2); }
#define COMMON_PHASES(layer) do { \
        const int po = layer ? 12 : 5; \
        if (EN(5) && IN(po)) { \
            pg8::Gemm g{layer ? (const bf16*)(ws + WS_O) : (const bf16*)(ws + WS_UM), layer ? (const bf16*)(ws + WS_WBO) : (const bf16*)(ws + WS_WOUT), MP, 1024, 1024, 1024, 1 << 30, 0}; \
            pg8::StaticOrder S; S.init(MP, 1024, G, (int)blockIdx.x); \
            EpiRes E{layer ? P.out : P.in[0], layer ? P.out + (size_t)MP * D : P.in[1], MOD, layer * 6144 + 2048, P.out, (const float*)(ws + WS_MUL) + (size_t)(layer ? 2 : 0) * 256 * 1024, ACTA, nullptr, nullptr, SSQ + (layer ? 4 : 2) * SSQ_STRIDE}; \
            for (int rep_ = 0; rep_ < (layer ? 1 : REPS(5)); ++rep_) pg8::gemm_phase<EpiRes, true>(lds + RING_OFF, g, S, E); \
            skinny_res(g.A, 1024, 1024, g.Bt, E, lds, tid, lane, wave); \
            GRID_BAR(po); } \
        if (EN(6) && IN(po + 1)) { \
            const int off = layer ? OFF_GU1 : OFF_GU0; \
            pg8::Gemm g{ACTA, WBIG + (size_t)off * 1024, M65, NGU, 1024, 1024, 1 << 30, 0}; pg8::StaticOrder S; S.init(M65, NGU, G, (int)blockIdx.x); \
            EpiGU E{SSQ + (layer ? 4 : 2) * SSQ_STRIDE, BIAS, off, (bf16*)(ws + WS_HID)}; \
            for (int rep_ = 0; rep_ < (layer ? 1 : REPS(6)); ++rep_) pg8::gemm_phase<EpiGU, true>(lds + RING_OFF, g, S, E); \
            GRID_BAR(po + 1); } \
        if (EN(7) && IN(po + 2)) { \
            pg8::Gemm g{(const bf16*)(ws + WS_HID), (const bf16*)(ws + WS_WDN) + (size_t)layer * 1024 * DFF, MP, 1024, DFF, DFF, 1 << 30, 0}; pg8::StaticOrder S; S.init(MP, 1024, G, (int)blockIdx.x); \
            EpiRes E{P.out, P.out + (size_t)MP * D, MOD, layer * 6144 + 5120, P.out, (const float*)(ws + WS_MUL) + (size_t)256 * 1024, layer ? nullptr : ACTA, P.in[22], layer ? nullptr : (bf16*)(ws + WS_AKV), layer ? nullptr : SSQ + 3 * SSQ_STRIDE}; \
            pg8::gemm_phase<EpiRes, true>(lds + RING_OFF, g, S, E); \
            skinny_res(g.A, DFF, DFF, g.Bt, E, lds, tid, lane, wave); \
            GRID_BAR(po + 2); } \
    } while (0)
            if (EN(3) && IN(3)) {
                pg8::Gemm g{ACTA, WBIG + (size_t)OFF_WIN * 1024, MP, NAIN, 1024, 1024, 1 << 30, 0}; pg8::StaticOrder S; S.init(MP, NAIN, G, (int)blockIdx.x);
                EpiAin E{SSQ, BIAS, (bf16*)(ws + WS_U), (bf16*)(ws + WS_V), SSQ + SSQ_STRIDE};
                for (int rep_ = 0; rep_ < REPS(3); ++rep_) pg8::gemm_phase<EpiAin, true>(lds + RING_OFF, g, S, E);
                skinny_ain(ACTA, WBIG + (size_t)OFF_WIN * 1024, E, lds, tid, lane, wave);
                GRID_BAR(3); }
            if (EN(4) && IN(4)) { for (int rep_ = 0; rep_ < REPS(4); ++rep_) phase_tokmix(P, lds, tid, lane, wave); GRID_BAR(4); }
    COMMON_PHASES(0);
            if (EN(8) && IN(8)) {
                { pg8::Gemm g{(const bf16*)(ws + WS_AKV), (const bf16*)(ws + WS_WKV), M65, NKV, 1024, 1024, 1 << 30, 0}; pg8::StaticOrder S; S.init(M65, NKV, G, (int)blockIdx.x);
                  EpiKV E{SSQ + 3 * SSQ_STRIDE, P.in[24], ROPE, P.out, (bf16*)(ws + WS_RC), (bf16*)(ws + WS_KS), (bf16*)(ws + WS_KW), (bf16*)(ws + WS_VST), (bf16*)(ws + WS_VWT)};
                  for (int rep_ = 0; rep_ < REPS(8); ++rep_) pg8::gemm_phase<EpiKV, true>(lds + RING_OFF, g, S, E); }
                { pg8::Gemm g{ACTA, WBIG + (size_t)OFF_Q * 1024, M65, NQP, 1024, 1024, 1 << 30, 0}; pg8::StaticOrder S; S.init(M65, NQP, G, (int)((blockIdx.x + 122) % G));
                  EpiQ E{SSQ + 3 * SSQ_STRIDE, BIAS, P.in[20], ROPE, (bf16*)(ws + WS_QN), (bf16*)(ws + WS_QR), (float*)(ws + WS_GATES)};
                  for (int rep_ = 0; rep_ < REPS(17); ++rep_) pg8::gemm_phase<EpiQ, true>(lds + RING_OFF, g, S, E); }
                GRID_BAR(8); }
            if (EN(9) && IN(9)) {
                pg8::Gemm g{(const bf16*)(ws + WS_RC), (const bf16*)(ws + WS_W1C), 2 * RC_KV, 256, 2048, 1024, RC_KV / 256, (long)256 * 2048}; pg8::StaticOrder S; S.init(2 * RC_KV, 256, G, (int)blockIdx.x);
                EpiCmp E{(const float*)(ws + WS_C1), (bf16*)(ws + WS_H2)};
                for (int rep_ = 0; rep_ < REPS(9); ++rep_) pg8::gemm_phase<EpiCmp, true>(lds + RING_OFF, g, S, E);
                GRID_BAR(9); }
            if (EN(10) && IN(10)) { for (int rep_ = 0; rep_ < REPS(10); ++rep_) phase_w2(P, lane, wave); GRID_BAR(10); }
            if (EN(11) && IN(11)) { for (int rep_ = 0; rep_ < REPS(11); ++rep_) phase_attn(P, lds, tid, lane, wave); GRID_BAR(11); }
    COMMON_PHASES(1);
#undef IN
#undef EN
#undef REPS
#undef GRID_BAR
}

extern "C" void kernel_launch(void* const* d_in, const int* in_sizes, int n_in, void* d_out, int out_size, void* d_ws, size_t ws_size, hipStream_t stream) {
    static int grid = 0;
    if (grid == 0) {
        if (n_in != 32 || ws_size < WS_END) { fprintf(stderr, "kernel_launch: unexpected problem (n_in %d, ws %zu < %zu)\n", n_in, ws_size, (size_t)WS_END); grid = -1; return; }
        int dev = 0, cus = 0;
        if (hipGetDevice(&dev) != hipSuccess || hipDeviceGetAttribute(&cus, hipDeviceAttributeMultiprocessorCount, dev) != hipSuccess) { grid = -1; return; }
        if (hipFuncSetAttribute((const void*)fwd, hipFuncAttributeMaxDynamicSharedMemorySize, LDS_BYTES) != hipSuccess) { fprintf(stderr, "kernel_launch: hipFuncSetAttribute failed\n"); grid = -1; return; }
        int per_cu = 0;
        if (hipOccupancyMaxActiveBlocksPerMultiprocessor(&per_cu, (const void*)fwd, NWAVES * 64, LDS_BYTES) != hipSuccess || per_cu < 1) fprintf(stderr, "kernel_launch: occupancy query says %d\n", per_cu);
        (void)hipGetLastError();
        grid = cus;
    }
    if (grid < 0) return;
    (void)hipMemsetAsync((char*)d_ws + WS_CTL, 0, CTL_ZERO_BYTES, stream);
    Params p{};
    for (int i = 0; i < 32; ++i) p.in[i] = (const float*)d_in[i];
    p.out = (float*)d_out; p.ws = (unsigned char*)d_ws;
#if MK_PER_PHASE
    for (int k = 0; k < NPHASE; ++k) { p.ph_lo = k; p.ph_hi = k + 1; hipLaunchKernelGGL(fwd, dim3(grid), dim3(NWAVES * 64), LDS_BYTES, stream, p); }
#else
    p.ph_lo = 0; p.ph_hi = NPHASE;
    hipLaunchKernelGGL(fwd, dim3(grid), dim3(NWAVES * 64), LDS_BYTES, stream, p);
#endif
    const hipError_t le = hipPeekAtLastError();
    if (le != hipSuccess) fprintf(stderr, "kernel_launch: launch failed: %s\n", hipGetErrorName(le));
}
```

```cpp
#include <hip/hip_runtime.h>
#include <hip/hip_bf16.h>
#include <cstdio>
#include <cstdint>
#include <cmath>

#ifndef MK_PER_PHASE
#define MK_PER_PHASE 0
#endif

namespace pg8 {
#define PG8_LAS __attribute__((address_space(3)))
typedef unsigned short bf16_t;
typedef short bf16x8 __attribute__((ext_vector_type(8)));
typedef float f32x4 __attribute__((ext_vector_type(4)));
typedef unsigned u32x4 __attribute__((ext_vector_type(4)));
typedef unsigned u32x2 __attribute__((ext_vector_type(2)));
constexpr int BM = 256, BK = 64, HALF = 128, HTB = HALF * BK * 2, STAGE_BYTES = 8 * HTB, NXCD = 8, WGM = 8;

__host__ __device__ __forceinline__ int lds_byte(int r, int c) { const int st = (r >> 4) * 2 + (c >> 5), rr = r & 15, cc = c & 31, ob = rr * 64 + cc * 2; return st * 1024 + (ob ^ (((ob >> 9) & 1) << 5)); }
__host__ __device__ __forceinline__ void stage_rc(int b, int& R, int& C) { const int st = b / 1024, sb = b % 1024, swz = sb ^ (((sb >> 9) & 1) << 5); R = (st >> 1) * 16 + swz / 64; C = (st & 1) * 32 + (swz % 64) / 2; }
__host__ __device__ __forceinline__ int perm32(int rho) { const int n = rho >> 4, i = rho & 15; return 8 * (i >> 2) + 4 * n + (i & 3); }

struct Unit { int pm, pn; };
struct Gemm { const bf16_t* A; const bf16_t* Bt; int M, N, K, lda, bsplit; long boff; };

struct StaticOrder {
    int nM, nN, nwg, G, c;
    int cut = 1 << 30, off0 = 0, off1 = 0;
    int diag = 0;
    __host__ __device__ void init(int M, int N, int G_, int c_) { nM = M / BM; nN = N / BM; nwg = nM * nN; G = G_; c = c_; }
    __host__ __device__ bool next(int i, Unit& u) const {
        const long L = (long)i * G + c;
        if (diag) { if (L >= 57) return false; u.pn = (int)L; u.pm = L < 8 ? 0 : L < 30 ? 1 : L < 35 ? 2 : 3; return true; }
        if (L >= nwg) return false;
        int wgid = (int)L; { const int q = nwg / NXCD, r = nwg % NXCD, xcd = wgid % NXCD, off = wgid / NXCD; wgid = (xcd < r ? xcd * (q + 1) : r * (q + 1) + (xcd - r) * q) + off; }
        const int nig = WGM * nN, gid = wgid / nig, fm = gid * WGM, gsz = (nM - fm) < WGM ? (nM - fm) : WGM;
        u.pm = fm + ((wgid % nig) % gsz); u.pn = (wgid % nig) / gsz; u.pm += u.pm < cut ? off0 : off1; return true;
    }
};

template <class Epi, bool ALIGN_EPI>
__device__ __forceinline__ void gemm_phase(PG8_LAS unsigned char* lds, const Gemm g, const StaticOrder& S, const Epi& E) {
    const int tid = threadIdx.x, wid = __builtin_amdgcn_readfirstlane(tid >> 6), lane = tid & 63, wr = wid >> 2, wc = wid & 3, fr = lane & 15, fq = lane >> 4;
    const int K = g.K, nt = K / BK, lda = g.lda;
    unsigned voffA[2], voffB[2];
#pragma unroll
    for (int i = 0; i < 2; ++i) { int R, C; stage_rc(tid * 16 + i * 8192, R, C); const int Rb = ((R & ~31) + perm32(R & 31));
        voffA[i] = (unsigned)(R * lda + C) * 2u; voffB[i] = (unsigned)(Rb * K + C) * 2u; }
    const size_t kstep = (size_t)(BK * 2);
    const size_t hstepA = (size_t)HALF * lda * 2, hstepB = (size_t)HALF * K * 2;
    const size_t tstepA = 2 * hstepA, tstepB = 2 * hstepB;
    const unsigned ldsw = (unsigned)wid * 1024u;
    const int aoff = lds_byte(wr * 64 + fr, fq * 8), boff = lds_byte(wc * 32 + fr, fq * 8);
#define PG8_SA(b, h) (((b) * 2 + (h)) * HTB)
#define PG8_SB(b, h) ((4 + (b) * 2 + (h)) * HTB)
#define PG8_STAGE(bufoff, gbase, voff) do { _Pragma("unroll") for (int _i = 0; _i < 2; ++_i) \
        __builtin_amdgcn_global_load_lds((const unsigned*)((const char*)(gbase) + (voff)[_i]), (PG8_LAS unsigned*)(lds + (bufoff) + ldsw + _i * 8192), 16, 0, 0); } while (0)
#define PG8_LDA(dst, b, h) do { _Pragma("unroll") for (int m = 0; m < 4; ++m) _Pragma("unroll") for (int k = 0; k < 2; ++k) dst[m][k] = *(const PG8_LAS bf16x8*)(lds + PG8_SA(b, h) + aoff + m * 2048 + k * 1024); } while (0)
#define PG8_LDB(dst, b, h) do { _Pragma("unroll") for (int n = 0; n < 2; ++n) _Pragma("unroll") for (int k = 0; k < 2; ++k) dst[n][k] = *(const PG8_LAS bf16x8*)(lds + PG8_SB(b, h) + boff + n * 2048 + k * 1024); } while (0)
#define PG8_MMA(ai, bj, At, Bt) do { __builtin_amdgcn_s_setprio(1); _Pragma("unroll") for (int m = 0; m < 4; ++m) _Pragma("unroll") for (int n = 0; n < 2; ++n) _Pragma("unroll") for (int k = 0; k < 2; ++k) \
        acc[ai][bj][m][n] = __builtin_amdgcn_mfma_f32_16x16x32_bf16(Bt[n][k], At[m][k], acc[ai][bj][m][n], 0, 0, 0); __builtin_amdgcn_s_setprio(0); } while (0)
#define PG8_WAIT_V(n) asm volatile("s_waitcnt vmcnt(" #n ")" ::: "memory")
#define PG8_WAIT_L(n) asm volatile("s_waitcnt lgkmcnt(" #n ")" ::: "memory")
#define PG8_BAR __builtin_amdgcn_s_barrier()
#define PG8_SCHED __builtin_amdgcn_sched_barrier(0)
    Unit cur, nxt; int ui = 0;
    if (!S.next(0, cur)) return;
    f32x4 acc[2][2][4][2];
#pragma unroll
    for (int a = 0; a < 2; ++a)
#pragma unroll
        for (int b = 0; b < 2; ++b)
#pragma unroll
            for (int m = 0; m < 4; ++m)
#pragma unroll
                for (int n = 0; n < 2; ++n) acc[a][b][m][n] = (f32x4){0.f, 0.f, 0.f, 0.f};
    bf16x8 At[4][2], B0[2][2], B1[2][2];
    const char* cA = (const char*)g.A + (size_t)cur.pm * tstepA;
    const char* cB = (const char*)g.Bt + (cur.pm >= g.bsplit ? (size_t)g.boff * 2 : (size_t)0) + (size_t)cur.pn * tstepB;
    PG8_STAGE(PG8_SB(0, 0), cB, voffB); PG8_STAGE(PG8_SB(0, 1), cB + hstepB, voffB); PG8_STAGE(PG8_SA(0, 0), cA, voffA); PG8_STAGE(PG8_SA(0, 1), cA + hstepA, voffA);
    if (wr == 1) PG8_BAR;
    PG8_WAIT_V(2); PG8_BAR;
    PG8_STAGE(PG8_SB(1, 0), cB + kstep, voffB); PG8_STAGE(PG8_SA(1, 0), cA + kstep, voffA); PG8_STAGE(PG8_SB(1, 1), cB + hstepB + kstep, voffB);
    PG8_WAIT_V(6); PG8_BAR;
    for (;;) {
        const bool has_next = S.next(ui + 1, nxt);
        const char* nA = has_next ? (const char*)g.A + (size_t)nxt.pm * tstepA : cA;
        const char* nB = has_next ? (const char*)g.Bt + (nxt.pm >= g.bsplit ? (size_t)g.boff * 2 : (size_t)0) + (size_t)nxt.pn * tstepB : cB;
        for (int t = 0; t < nt; t += 2) {
            const bool last = (t == nt - 2);
            const char* a1 = cA + (size_t)(t + 1) * kstep;
            const char* a2 = last ? nA : cA + (size_t)(t + 2) * kstep; const char* b2 = last ? nB : cB + (size_t)(t + 2) * kstep;
            const char* a3 = a2 + kstep; const char* b3 = b2 + kstep;
            PG8_LDB(B0, 0, 0); PG8_LDB(B1, 0, 1); PG8_SCHED; PG8_LDA(At, 0, 0); PG8_STAGE(PG8_SA(1, 1), a1 + hstepA, voffA);
            PG8_WAIT_V(8); PG8_WAIT_L(0); PG8_BAR; PG8_MMA(0, 0, At, B0); PG8_MMA(0, 1, At, B1); PG8_BAR; PG8_SCHED;
            PG8_LDA(At, 0, 1); PG8_STAGE(PG8_SB(0, 0), b2, voffB); PG8_STAGE(PG8_SB(0, 1), b2 + hstepB, voffB); PG8_STAGE(PG8_SA(0, 0), a2, voffA);
            PG8_WAIT_V(8); PG8_WAIT_L(0); PG8_BAR; PG8_MMA(1, 0, At, B0); PG8_MMA(1, 1, At, B1); PG8_BAR; PG8_SCHED;
            PG8_LDB(B0, 1, 0); PG8_LDB(B1, 1, 1); PG8_SCHED; PG8_LDA(At, 1, 0); PG8_STAGE(PG8_SA(0, 1), a2 + hstepA, voffA);
            PG8_WAIT_V(8); PG8_WAIT_L(0); PG8_BAR; PG8_MMA(0, 0, At, B0); PG8_MMA(0, 1, At, B1); PG8_BAR; PG8_SCHED;
            PG8_LDA(At, 1, 1); PG8_STAGE(PG8_SB(1, 0), b3, voffB); PG8_STAGE(PG8_SB(1, 1), b3 + hstepB, voffB); PG8_STAGE(PG8_SA(1, 0), a3, voffA);
            PG8_WAIT_V(8); PG8_WAIT_L(0); PG8_BAR; PG8_MMA(1, 0, At, B0); PG8_MMA(1, 1, At, B1); PG8_BAR; PG8_SCHED;
        }
        if constexpr (ALIGN_EPI) { if (wr == 0) PG8_BAR; }
        E(acc, cur, wr, wc, fr, fq);
        if (!has_next) break;
#pragma unroll
        for (int a = 0; a < 2; ++a)
#pragma unroll
            for (int b = 0; b < 2; ++b)
#pragma unroll
                for (int m = 0; m < 4; ++m)
#pragma unroll
                    for (int n = 0; n < 2; ++n) acc[a][b][m][n] = (f32x4){0.f, 0.f, 0.f, 0.f};
        cur = nxt; cA = nA; cB = nB; ++ui;
        if constexpr (ALIGN_EPI) { if (wr == 1) PG8_BAR; }
    }
    PG8_WAIT_V(0);
    if constexpr (!ALIGN_EPI) { if (wr == 0) PG8_BAR; }
    PG8_BAR;
#undef PG8_SA
#undef PG8_SB
#undef PG8_STAGE
#undef PG8_LDA
#undef PG8_LDB
#undef PG8_MMA
#undef PG8_WAIT_V
#undef PG8_WAIT_L
#undef PG8_BAR
#undef PG8_SCHED
}
}

#define GAS __attribute__((address_space(1)))
#define LAS __attribute__((address_space(3)))
typedef unsigned short bf16;
typedef unsigned v4u __attribute__((ext_vector_type(4)));
typedef unsigned v2u __attribute__((ext_vector_type(2)));
typedef float f32x4 __attribute__((ext_vector_type(4)));
typedef float f32x2 __attribute__((ext_vector_type(2)));
typedef short bf16x8 __attribute__((ext_vector_type(8)));
typedef short bf16x4 __attribute__((ext_vector_type(4)));
typedef __bf16 bf16x2_t __attribute__((ext_vector_type(2)));
typedef GAS unsigned gu32;
#define RLX_AGENT __ATOMIC_RELAXED, __HIP_MEMORY_SCOPE_AGENT
#define LDS_WAIT() asm volatile("s_waitcnt lgkmcnt(0)" ::: "memory")
#define VM_WAIT() asm volatile("s_waitcnt vmcnt(0)" ::: "memory")
__device__ __forceinline__ unsigned pk2(float lo, float hi) { f32x2 v = {lo, hi}; bf16x2_t b = __builtin_convertvector(v, bf16x2_t); return __builtin_bit_cast(unsigned, b); }
__device__ __forceinline__ float bf2f(unsigned short h) { return __builtin_bit_cast(float, (unsigned)h << 16); }
__device__ __forceinline__ float bflo(unsigned w) { return __builtin_bit_cast(float, w << 16); }
__device__ __forceinline__ float bfhi(unsigned w) { return __builtin_bit_cast(float, w & 0xffff0000u); }
__device__ __forceinline__ float fexp2(float x) { return __builtin_amdgcn_exp2f(x); }
__device__ __forceinline__ float frcp(float x) { return __builtin_amdgcn_rcpf(x); }
__device__ __forceinline__ float gelu_t(float x) { const float x2 = x * x; const float e = fexp2(x * (-2.302208198f + -0.1029432357f * x2)); return x * frcp(1.f + e); }
__device__ __forceinline__ float silu_f(float x) { return x * frcp(1.f + fexp2(-1.4426950409f * x)); }
__device__ __forceinline__ float sigmoid_f(float x) { return frcp(1.f + fexp2(-1.4426950409f * x)); }
__device__ __forceinline__ float dpp_xor1(float v) { return __builtin_bit_cast(float, __builtin_amdgcn_update_dpp(0, __builtin_bit_cast(int, v), 0xB1, 0xF, 0xF, true)); }
__device__ __forceinline__ float dpp_xor2(float v) { return __builtin_bit_cast(float, __builtin_amdgcn_update_dpp(0, __builtin_bit_cast(int, v), 0x4E, 0xF, 0xF, true)); }
__device__ __forceinline__ unsigned dpp_xor1u(unsigned v) { return (unsigned)__builtin_amdgcn_update_dpp(0, (int)v, 0xB1, 0xF, 0xF, true); }
__device__ __forceinline__ unsigned dpp_xor2u(unsigned v) { return (unsigned)__builtin_amdgcn_update_dpp(0, (int)v, 0x4E, 0xF, 0xF, true); }
__device__ __forceinline__ float wave_sum(float v) {
#pragma unroll
    for (int o = 1; o < 64; o <<= 1) v += __shfl_xor(v, o);
    return v;
}
__device__ __forceinline__ float wave_max(float v) {
#pragma unroll
    for (int o = 1; o < 64; o <<= 1) v = fmaxf(v, __shfl_xor(v, o));
    return v;
}

#define XB_TMO      128
#define XB_XCNT(j)  (256  + 64 * (j))
#define XB_XSUB(j)  (1280 + 64 * (j))
#define XB_XGEN(j)  (2304 + 64 * (j))
#define XB_TOP      3328
#define XB_TOPGEN   3392
#define XCD_BAR_WORDS 3456
#define XB_SPIN_CAP (1u << 18)

__device__ __forceinline__ unsigned xb_ld(unsigned* p)              { return __hip_atomic_load(p, __ATOMIC_RELAXED, __HIP_MEMORY_SCOPE_AGENT); }
__device__ __forceinline__ unsigned xb_add(unsigned* p, unsigned v) { return __hip_atomic_fetch_add(p, v, __ATOMIC_RELAXED, __HIP_MEMORY_SCOPE_AGENT); }
__device__ __forceinline__ unsigned xb_xcc_id() { return (unsigned)__builtin_amdgcn_s_getreg((3 << 11) | 20) & 0xFu; }
#define XB_SPIN(cond, bar) do { unsigned _sp = 0; while (cond) { __builtin_amdgcn_s_sleep(1); \
    if ((++_sp & 255u) == 0u) { if (xb_ld(&(bar)[XB_TMO])) break; if (_sp > XB_SPIN_CAP) { atomicAdd(&(bar)[XB_TMO], 1u); break; } } } } while (0)

struct XcdBarrier { unsigned* bar; unsigned x; volatile LAS unsigned* st; };

__device__ __forceinline__ XcdBarrier xcd_barrier_post(unsigned* bar, volatile LAS unsigned* st) {
    XcdBarrier b; b.bar = bar; b.x = xb_xcc_id(); b.st = st;
    if (threadIdx.x == 0) (void)xb_add(&bar[XB_XCNT(b.x)], 1u);
    return b;
}
__device__ __forceinline__ void xcd_barrier_complete(unsigned* bar, unsigned x, unsigned& nloc, unsigned& nx) {
    const unsigned G = gridDim.x * gridDim.y * gridDim.z;
    unsigned sum, cnt, mine, sp = 0u;
    for (;;) {
        sum = 0u; cnt = 0u; mine = 0u;
#pragma unroll
        for (unsigned j = 0; j < 16; ++j) { const unsigned c = xb_ld(&bar[XB_XCNT(j)]); sum += c; cnt += (c > 0u) ? 1u : 0u; mine = (j == x) ? c : mine; }
        if (sum == G) break;
        __builtin_amdgcn_s_sleep(1);
        if ((++sp & 255u) == 0u) { if (xb_ld(&bar[XB_TMO])) break; if (sp > XB_SPIN_CAP) { atomicAdd(&bar[XB_TMO], 1u); break; } }
    }
    nloc = mine > 0u ? mine : 1u; nx = cnt > 0u ? cnt : 1u;
}
__device__ __forceinline__ void xcd_barrier(const XcdBarrier& b) {
    asm volatile("s_waitcnt vmcnt(0)" ::: "memory");
    __syncthreads();
    if (threadIdx.x == 0) {
        unsigned* bar = b.bar;
        __builtin_amdgcn_s_waitcnt(0);
        unsigned nloc = b.st[0], nx = b.st[1];
        if (nloc == 0u) { xcd_barrier_complete(bar, b.x, nloc, nx); b.st[0] = nloc; b.st[1] = nx; }
        const unsigned old = xb_add(&bar[XB_XSUB(b.x)], 1u);
        const unsigned gen = old / nloc;
        if (old + 1u == (gen + 1u) * nloc) {
            __builtin_amdgcn_fence(__ATOMIC_RELEASE, "agent");
            asm volatile("s_waitcnt vmcnt(0)" ::: "memory");
            const unsigned og = xb_add(&bar[XB_TOP], 1u);
            const unsigned tg = og / nx;
            if (og + 1u == (tg + 1u) * nx) xb_add(&bar[XB_TOPGEN], 1u);
            else XB_SPIN(xb_ld(&bar[XB_TOPGEN]) == tg, bar);
            __builtin_amdgcn_fence(__ATOMIC_ACQUIRE, "agent");
            xb_add(&bar[XB_XGEN(b.x)], 1u);
            asm volatile("s_waitcnt vmcnt(0)" ::: "memory");
        } else {
            XB_SPIN(xb_ld(&bar[XB_XGEN(b.x)]) == gen, bar);
            __builtin_amdgcn_fence(__ATOMIC_ACQUIRE, "agent");
            asm volatile("s_waitcnt vmcnt(0)" ::: "memory");
        }
    }
    __syncthreads();
}

constexpr int NWAVES = 8;
constexpr int D = 1024, SEQ = 8192, NBATCH = 2, MP = NBATCH * SEQ, MS = 128, MT = MP + MS, M65 = 16640;
constexpr int DFF = 2816, NGU = 2 * DFF, NAIN = 2048, NKV = 1536, NQ = 1072, NQP = 1280;
constexpr int NBIG = NAIN + NGU + NQP + NGU;
constexpr int OFF_WIN = 0, OFF_GU0 = NAIN, OFF_Q = NAIN + NGU, OFF_GU1 = NAIN + NGU + NQP;
constexpr int NMOD = 12288;
constexpr int PAST = 2048, NPAGE = 16, PAGE = 128, WIN = 512;
constexpr int RC_SAMP = 512 * 128, RC_PROMPT = 8 * 512, RC_KV = RC_SAMP + RC_PROMPT;
constexpr float EPS = 1e-6f;
constexpr float C2 = 0.125f * 1.4426950408889634f;

constexpr size_t O_YP = 0, O_YS = 16777216, O_AVP = 16908288, O_AVS = 17170432, O_CKP = 17301504, O_CVP = 21495808, O_SKP = 25690112, O_SVP = 29884416,
                 O_WKP = 34078720, O_WVP = 34340864, O_CKS = 34603008, O_CVS = 34635776, O_SKS = 34668544, O_SVS = 34701312, O_WKS = 34734080, O_WVS = 51511296;

constexpr size_t al256(size_t x) { return (x + 255) & ~(size_t)255; }
constexpr size_t WS_CTL = 0, CTL_ZERO_BYTES = 1u << 20;
constexpr size_t WS_WADA = CTL_ZERO_BYTES;
constexpr size_t WS_WBIG = WS_WADA + (size_t)NMOD * D * 2;
constexpr size_t WS_WOUT = WS_WBIG + (size_t)NBIG * D * 2;
constexpr size_t WS_WBO = WS_WOUT + (size_t)D * D * 2;
constexpr size_t WS_WDN = WS_WBO + (size_t)D * D * 2;
constexpr size_t WS_WKV = WS_WDN + (size_t)2 * D * DFF * 2;
constexpr size_t WS_W1C = WS_WKV + (size_t)NKV * D * 2;
constexpr size_t WS_W2 = WS_W1C + (size_t)2 * 256 * 2048 * 2;
constexpr size_t WS_WSB = WS_W2 + (size_t)2 * 64 * 256 * 2;
constexpr size_t WS_ROPE = WS_WSB + (size_t)8 * 128 * 128 * 2;
constexpr size_t WS_C1 = WS_ROPE + (size_t)8192 * 64 * 4;
constexpr size_t WS_SC = WS_C1 + 2 * 256 * 4;
constexpr size_t WS_MOD = WS_SC + (size_t)256 * D * 2;
constexpr size_t WS_SH = WS_MOD + (size_t)256 * NMOD * 4;
constexpr size_t WS_BIAS = WS_SH + (size_t)4 * 256 * D * 2;
constexpr size_t WS_MUL = WS_BIAS + (size_t)256 * NBIG * 4;
constexpr size_t WS_SSQ = WS_MUL + (size_t)3 * 256 * D * 4;
constexpr size_t WS_ACTA = WS_SSQ + (size_t)5 * M65 * 16 * 4;
constexpr size_t ACT_BYTES = (size_t)M65 * D * 2;
constexpr size_t WS_AKV = WS_ACTA + ACT_BYTES;
constexpr size_t WS_U = WS_AKV + ACT_BYTES;
constexpr size_t WS_V = WS_U + ACT_BYTES;
constexpr size_t WS_UM = WS_V + ACT_BYTES;
constexpr size_t WS_QN = WS_UM + ACT_BYTES;
constexpr size_t WS_QR = WS_QN + ACT_BYTES;
constexpr size_t WS_O = WS_QR + ACT_BYTES;
constexpr size_t WS_GATES = WS_O + ACT_BYTES;
constexpr size_t WS_HID = WS_GATES + (size_t)M65 * 48 * 4;
constexpr size_t WS_KS = WS_HID + (size_t)M65 * DFF * 2;
constexpr size_t WS_KW = WS_KS + (size_t)8 * SEQ * 64 * 2;
constexpr size_t WS_VST = WS_KW + (size_t)8 * SEQ * 64 * 2;
constexpr size_t WS_VWT = WS_VST + (size_t)8 * SEQ * 64 * 2;
constexpr size_t WS_RC = WS_VWT + (size_t)8 * SEQ * 64 * 2;
constexpr size_t WS_H2 = WS_RC + (size_t)2 * RC_KV * 1024 * 2 + 4096;
constexpr size_t WS_KCP = WS_H2 + (size_t)2 * RC_KV * 256 * 2;
constexpr size_t WS_VCTP = WS_KCP + (size_t)8 * 512 * 64 * 2;
constexpr size_t WS_KCS = WS_VCTP + (size_t)8 * 512 * 64 * 2;
constexpr size_t WS_VCTS = WS_KCS + (size_t)512 * 128 * 64 * 2;
constexpr size_t WS_END = WS_VCTS + (size_t)512 * 128 * 64 * 2;
static_assert(WS_WBIG % 256 == 0 && WS_ROPE % 256 == 0 && WS_SC % 256 == 0 && WS_ACTA % 256 == 0 && WS_HID % 256 == 0 && WS_RC % 256 == 0 && WS_H2 % 256 == 0 && WS_KCP % 256 == 0, "ws alignment");
constexpr int CW_BAR = 4096;

constexpr int RING_OFF = 0, RING_BYTES = 131072;
constexpr int LDSCTL_OFF = RING_BYTES, MISC_OFF = LDSCTL_OFF + 320;
constexpr int LDS_BYTES = 163840;

struct Params {
    const float* in[32];
    float* out;
    unsigned char* ws;
    int ph_lo, ph_hi;
};

__device__ __forceinline__ int seq_of(int row) { const int s = row - MP + 2; return row < MP ? (row >> 13) : (s < 255 ? s : 255); }
__device__ __forceinline__ float rstd1(float ssq) { return rsqrtf(ssq * (1.0f / 1024.0f) + EPS); }
__device__ __forceinline__ void ssq_add(float* p, float v) { __hip_atomic_fetch_add(p, v, __ATOMIC_RELAXED, __HIP_MEMORY_SCOPE_AGENT); }
#define LOAD_RS8(rs, SSQP, pm) do { _Pragma("unroll") for (int ai_ = 0; ai_ < 2; ++ai_) _Pragma("unroll") for (int m_ = 0; m_ < 4; ++m_) rs[ai_][m_] = (SSQP)[(size_t)(pm) * 256 + ai_ * 128 + wr * 64 + m_ * 16 + fr]; \
    _Pragma("unroll") for (int ai_ = 0; ai_ < 2; ++ai_) _Pragma("unroll") for (int m_ = 0; m_ < 4; ++m_) rs[ai_][m_] = rstd1(rs[ai_][m_]); } while (0)

using pg8::Unit;
#define EPI_ARGS const pg8::f32x4 (&acc)[2][2][4][2], const Unit& u, int wr, int wc, int fr, int fq

struct EpiMod {
    float* MOD; bf16* SH; const float* b_ada;
    __device__ __forceinline__ void operator()(EPI_ARGS) const { asm volatile("" ::: "memory");
        const int cl = wc * 32 + 8 * fq, c0 = u.pn * 256 + cl;
        const int pl = u.pn % 24, lay = u.pn / 24;
        const int np = (pl < 4) ? 2 * lay : ((pl >= 12 && pl < 16) ? 2 * lay + 1 : -1);
        const int j0 = (pl < 4 ? pl : pl - 12) * 256 + cl;
        f32x4 bv[2][2];
#pragma unroll
        for (int bj = 0; bj < 2; ++bj)
#pragma unroll
            for (int n = 0; n < 2; ++n) bv[bj][n] = *(const f32x4*)(b_ada + c0 + bj * 128 + 4 * n);
#pragma unroll
        for (int ai = 0; ai < 2; ++ai)
#pragma unroll
            for (int m = 0; m < 4; ++m) { const int row = ai * 128 + wr * 64 + m * 16 + fr;
#pragma unroll
                for (int bj = 0; bj < 2; ++bj) { const f32x4 v0 = acc[ai][bj][m][0] + bv[bj][0], v1 = acc[ai][bj][m][1] + bv[bj][1];
                    float* p = MOD + (size_t)row * NMOD + c0 + bj * 128; *(f32x4*)p = v0; *(f32x4*)(p + 4) = v1;
                    if (np >= 0) { v4u w; w.x = pk2(v0[0], v0[1]); w.y = pk2(v0[2], v0[3]); w.z = pk2(v1[0], v1[1]); w.w = pk2(v1[2], v1[3]);
                        *(v4u*)(SH + ((size_t)np * 256 + row) * D + j0 + bj * 128) = w; } } }
    }
};
struct EpiBias {
    float* BIAS;
    __device__ __forceinline__ void operator()(EPI_ARGS) const { asm volatile("" ::: "memory");
        const int lo = u.pm == 0 ? 0 : u.pm == 1 ? 8 : u.pm == 2 ? 30 : 35, hi = u.pm == 0 ? 8 : u.pm == 1 ? 30 : u.pm == 2 ? 35 : 57;
        if (u.pn < lo || u.pn >= hi) return;
        const int c0 = u.pn * 256 + wc * 32 + 8 * fq;
#pragma unroll
        for (int ai = 0; ai < 2; ++ai)
#pragma unroll
            for (int m = 0; m < 4; ++m) { const int row = ai * 128 + wr * 64 + m * 16 + fr;
#pragma unroll
                for (int bj = 0; bj < 2; ++bj) { float* p = BIAS + (size_t)row * NBIG + c0 + bj * 128; *(f32x4*)p = acc[ai][bj][m][0]; *(f32x4*)(p + 4) = acc[ai][bj][m][1]; } }
    }
};
struct EpiAin {
    const float* SSQ0; const float* BIAS; bf16* U; bf16* V; float* SSQV;
    __device__ __forceinline__ void operator()(EPI_ARGS) const { asm volatile("" ::: "memory");
        const int cl = wc * 32 + 8 * fq, c0 = u.pn * 256 + cl; const bool uni = u.pm < 64; const bool isv = u.pn >= 4;
        float rsv[2][4]; LOAD_RS8(rsv, SSQ0, u.pm);
        f32x4 bv[2][2];
        if (uni) { const float* b = BIAS + (size_t)(u.pm >> 5) * NBIG + OFF_WIN + c0;
#pragma unroll
            for (int bj = 0; bj < 2; ++bj)
#pragma unroll
                for (int n = 0; n < 2; ++n) bv[bj][n] = *(const f32x4*)(b + bj * 128 + 4 * n); }
#pragma unroll
        for (int ai = 0; ai < 2; ++ai)
#pragma unroll
            for (int m = 0; m < 4; ++m) { const int row = u.pm * 256 + ai * 128 + wr * 64 + m * 16 + fr;
                const float rs = rsv[ai][m];
                if (!uni) { const float* b = BIAS + (size_t)seq_of(row) * NBIG + OFF_WIN + c0;
#pragma unroll
                    for (int bj = 0; bj < 2; ++bj)
#pragma unroll
                        for (int n = 0; n < 2; ++n) bv[bj][n] = *(const f32x4*)(b + bj * 128 + 4 * n); }
                float sq = 0.f;
#pragma unroll
                for (int bj = 0; bj < 2; ++bj) { f32x4 v0 = acc[ai][bj][m][0] * rs + bv[bj][0], v1 = acc[ai][bj][m][1] * rs + bv[bj][1];
#pragma unroll
                    for (int i = 0; i < 4; ++i) { v0[i] = gelu_t(v0[i]); v1[i] = gelu_t(v1[i]); sq += v0[i] * v0[i] + v1[i] * v1[i]; }
                    v4u w; w.x = pk2(v0[0], v0[1]); w.y = pk2(v0[2], v0[3]); w.z = pk2(v1[0], v1[1]); w.w = pk2(v1[2], v1[3]);
                    bf16* dst = isv ? V + (size_t)row * D + (c0 - 1024) + bj * 128 : U + (size_t)row * D + c0 + bj * 128;
                    *(v4u*)dst = w; }
                if (isv) { sq += __shfl_xor(sq, 16); sq += __shfl_xor(sq, 32); if (fq == 0) ssq_add(SSQV + row, sq); } }
    }
};
struct EpiGU {
    const float* SSQ; const float* BIAS; int boff; bf16* HID;
    __device__ __forceinline__ void operator()(EPI_ARGS) const { asm volatile("" ::: "memory");
        const int cl = wc * 32 + 8 * fq, c0 = u.pn * 256 + cl; const bool uni = u.pm < 64;
        float rsv[2][4]; LOAD_RS8(rsv, SSQ, u.pm);
        f32x4 bv[2][2];
        if (uni) { const float* b = BIAS + (size_t)(u.pm >> 5) * NBIG + boff + c0;
#pragma unroll
            for (int bj = 0; bj < 2; ++bj)
#pragma unroll
                for (int n = 0; n < 2; ++n) bv[bj][n] = *(const f32x4*)(b + bj * 128 + 4 * n); }
#pragma unroll
        for (int ai = 0; ai < 2; ++ai)
#pragma unroll
            for (int m = 0; m < 4; ++m) { const int row = u.pm * 256 + ai * 128 + wr * 64 + m * 16 + fr;
                const float rs = rsv[ai][m];
                if (!uni) { const float* b = BIAS + (size_t)seq_of(row) * NBIG + boff + c0;
#pragma unroll
                    for (int bj = 0; bj < 2; ++bj)
#pragma unroll
                        for (int n = 0; n < 2; ++n) bv[bj][n] = *(const f32x4*)(b + bj * 128 + 4 * n); }
                float h[8];
#pragma unroll
                for (int n = 0; n < 2; ++n) { const f32x4 zg = acc[ai][0][m][n] * rs + bv[0][n], zu = acc[ai][1][m][n] * rs + bv[1][n];
#pragma unroll
                    for (int i = 0; i < 4; ++i) h[4 * n + i] = silu_f(zg[i]) * zu[i]; }
                v4u w; w.x = pk2(h[0], h[1]); w.y = pk2(h[2], h[3]); w.z = pk2(h[4], h[5]); w.w = pk2(h[6], h[7]);
                *(v4u*)(HID + (size_t)row * DFF + u.pn * 128 + cl) = w; }
    }
};
template <bool XF32, bool OF32>
struct EpiRes {
    const float* xin_p; const float* xin_s;
    const bf16* xb_in;
    const float* MOD; int goff;
    float* out; bf16* xb_out;
    const float* MUL; bf16* A1;
    float* SSQ;
    __device__ __forceinline__ void operator()(EPI_ARGS) const { asm volatile("" ::: "memory");
        const int cl = wc * 32 + 8 * fq, c0 = u.pn * 256 + cl; const bool uni = u.pm < 64;
        f32x4 gv[2][2], mv[2][2];
        if (uni) { const int sq_ = u.pm >> 5;
#pragma unroll
            for (int bj = 0; bj < 2; ++bj)
#pragma unroll
                for (int n = 0; n < 2; ++n) { gv[bj][n] = *(const f32x4*)(MOD + (size_t)sq_ * NMOD + goff + c0 + bj * 128 + 4 * n);
                    if (A1) mv[bj][n] = *(const f32x4*)(MUL + (size_t)sq_ * D + c0 + bj * 128 + 4 * n); } }
        f32x4 xq[2][2][2]; v4u xw[2][2];
#define ER_LOAD(it) do { const int row_ = u.pm * 256 + ((it) >> 2) * 128 + wr * 64 + ((it) & 3) * 16 + fr; \
            if (XF32) { const float* xr_ = uni ? xin_p + (size_t)row_ * D : xin_s + (size_t)(row_ < MT ? row_ - MP : 0) * D; \
                _Pragma("unroll") for (int bj = 0; bj < 2; ++bj) { xq[(it) & 1][bj][0] = *(const f32x4*)(xr_ + c0 + bj * 128); xq[(it) & 1][bj][1] = *(const f32x4*)(xr_ + c0 + bj * 128 + 4); } } \
            else { _Pragma("unroll") for (int bj = 0; bj < 2; ++bj) xw[(it) & 1][bj] = *(const v4u*)(xb_in + (size_t)row_ * D + c0 + bj * 128); } } while (0)
        ER_LOAD(0);
#pragma unroll
        for (int it = 0; it < 8; ++it) { const int ai = it >> 2, m = it & 3; const int row = u.pm * 256 + ai * 128 + wr * 64 + m * 16 + fr;
                if (it + 1 < 8) ER_LOAD(it + 1);
                const bool real = row < MT;
                if (!uni) { const int sq_ = seq_of(row);
#pragma unroll
                    for (int bj = 0; bj < 2; ++bj)
#pragma unroll
                        for (int n = 0; n < 2; ++n) { gv[bj][n] = *(const f32x4*)(MOD + (size_t)sq_ * NMOD + goff + c0 + bj * 128 + 4 * n);
                            if (A1) mv[bj][n] = *(const f32x4*)(MUL + (size_t)sq_ * D + c0 + bj * 128 + 4 * n); } }
                float sq = 0.f;
#pragma unroll
                for (int bj = 0; bj < 2; ++bj) { f32x4 x0, x1;
                    if (XF32) { x0 = xq[it & 1][bj][0]; x1 = xq[it & 1][bj][1]; }
                    else { const v4u w_ = xw[it & 1][bj]; x0 = (f32x4){bflo(w_.x), bfhi(w_.x), bflo(w_.y), bfhi(w_.y)}; x1 = (f32x4){bflo(w_.z), bfhi(w_.z), bflo(w_.w), bfhi(w_.w)}; }
                    if (!real) { x0 = (f32x4){0.f, 0.f, 0.f, 0.f}; x1 = x0; }
                    x0 = x0 + gv[bj][0] * acc[ai][bj][m][0]; x1 = x1 + gv[bj][1] * acc[ai][bj][m][1];
                    if (OF32) { if (real) { float* p = out + (size_t)row * D + c0 + bj * 128; *(f32x4*)p = x0; *(f32x4*)(p + 4) = x1; } }
                    else { v4u w; w.x = pk2(x0[0], x0[1]); w.y = pk2(x0[2], x0[3]); w.z = pk2(x1[0], x1[1]); w.w = pk2(x1[2], x1[3]); *(v4u*)(xb_out + (size_t)row * D + c0 + bj * 128) = w; }
                    sq += (x0[0] * x0[0] + x0[1] * x0[1]) + (x0[2] * x0[2] + x0[3] * x0[3]) + (x1[0] * x1[0] + x1[1] * x1[1]) + (x1[2] * x1[2] + x1[3] * x1[3]);
                    if (A1) { const f32x4 a = x0 * mv[bj][0], b = x1 * mv[bj][1]; v4u w; w.x = pk2(a[0], a[1]); w.y = pk2(a[2], a[3]); w.z = pk2(b[0], b[1]); w.w = pk2(b[2], b[3]);
                        *(v4u*)(A1 + (size_t)row * D + c0 + bj * 128) = w; } }
                if (SSQ) { sq += __shfl_xor(sq, 16); sq += __shfl_xor(sq, 32); if (fq == 0) ssq_add(SSQ + row, sq); } }
#undef ER_LOAD
    }
};
struct EpiCmp {
    const float* C1; bf16* H2;
    __device__ __forceinline__ void operator()(EPI_ARGS) const { asm volatile("" ::: "memory");
        const int cl = wc * 32 + 8 * fq; const int kv = u.pm >= (RC_KV / 256) ? 1 : 0;
        f32x4 bv[2][2];
#pragma unroll
        for (int bj = 0; bj < 2; ++bj)
#pragma unroll
            for (int n = 0; n < 2; ++n) bv[bj][n] = *(const f32x4*)(C1 + kv * 256 + cl + bj * 128 + 4 * n);
#pragma unroll
        for (int ai = 0; ai < 2; ++ai)
#pragma unroll
            for (int m = 0; m < 4; ++m) { const size_t row = (size_t)u.pm * 256 + ai * 128 + wr * 64 + m * 16 + fr;
#pragma unroll
                for (int bj = 0; bj < 2; ++bj) { f32x4 v0 = acc[ai][bj][m][0] + bv[bj][0], v1 = acc[ai][bj][m][1] + bv[bj][1];
#pragma unroll
                    for (int i = 0; i < 4; ++i) { v0[i] = gelu_t(v0[i]); v1[i] = gelu_t(v1[i]); }
                    v4u w; w.x = pk2(v0[0], v0[1]); w.y = pk2(v0[2], v0[3]); w.z = pk2(v1[0], v1[1]); w.w = pk2(v1[2], v1[3]);
                    *(v4u*)(H2 + row * 256 + cl + bj * 128) = w; } }
    }
};
struct EpiKV {
    const float* SSQ; const float* kgains; const float* ROPE; float* out;
    bf16* RC; bf16* KS; bf16* KW; bf16* VST; bf16* VWT;
    __device__ __forceinline__ void operator()(EPI_ARGS) const { asm volatile("" ::: "memory");
        const int ty = u.pn, g = wc, d0 = 8 * fq; const bool isk = (ty == 2 || ty == 4);
        float rsv[2][4]; LOAD_RS8(rsv, SSQ, u.pm);
        f32x4 kg[2][2];
        if (isk) {
#pragma unroll
            for (int bj = 0; bj < 2; ++bj)
#pragma unroll
                for (int n = 0; n < 2; ++n) kg[bj][n] = *(const f32x4*)(kgains + (ty == 2 ? 64 : 128) + 32 * bj + d0 + 4 * n); }
#pragma unroll
        for (int ai = 0; ai < 2; ++ai)
#pragma unroll
            for (int m = 0; m < 4; ++m) { const int row = u.pm * 256 + ai * 128 + wr * 64 + m * 16 + fr;
                const float rs = rsv[ai][m];
                f32x4 v[2][2];
#pragma unroll
                for (int bj = 0; bj < 2; ++bj)
#pragma unroll
                    for (int n = 0; n < 2; ++n) v[bj][n] = acc[ai][bj][m][n] * rs;
                const bool prompt = row < MP; const int t = prompt ? (row & (SEQ - 1)) : PAST; const int b = row >> 13;
                if (isk) {
                    float sq = 0.f;
#pragma unroll
                    for (int bj = 0; bj < 2; ++bj)
#pragma unroll
                        for (int n = 0; n < 2; ++n) sq += (v[bj][n][0] * v[bj][n][0] + v[bj][n][1] * v[bj][n][1]) + (v[bj][n][2] * v[bj][n][2] + v[bj][n][3] * v[bj][n][3]);
                    sq += __shfl_xor(sq, 16); sq += __shfl_xor(sq, 32);
                    const float ri = rsqrtf(sq * (1.0f / 64.0f) + EPS);
#pragma unroll
                    for (int n = 0; n < 2; ++n) { const f32x4 cs = *(const f32x4*)(ROPE + (size_t)t * 64 + d0 + 4 * n), sn = *(const f32x4*)(ROPE + (size_t)t * 64 + 32 + d0 + 4 * n);
                        const f32x4 x1 = v[0][n] * ri * kg[0][n], x2 = v[1][n] * ri * kg[1][n];
                        v[0][n] = x1 * cs - x2 * sn; v[1][n] = x2 * cs + x1 * sn; }
                }
                float* fo = nullptr;
                if (prompt) {
                    if (ty < 4) fo = out + (ty == 0 ? O_CKP : ty == 1 ? O_CVP : ty == 2 ? O_SKP : O_SVP) + (size_t)row * 256;
                    else if (t >= SEQ - WIN) fo = out + (ty == 4 ? O_WKP : O_WVP) + ((size_t)b * WIN + (t - (SEQ - WIN))) * 256;
                } else if (row < MT) { const int s = row - MP;
                    if (ty < 4) fo = out + (ty == 0 ? O_CKS : ty == 1 ? O_CVS : ty == 2 ? O_SKS : O_SVS) + (size_t)s * 256;
                    else fo = out + (ty == 4 ? O_WKS : O_WVS) + ((size_t)s * WIN + (WIN - 1)) * 256; }
                if (fo) {
#pragma unroll
                    for (int bj = 0; bj < 2; ++bj) { float* p = fo + g * 64 + 32 * bj + d0; *(f32x4*)p = v[bj][0]; *(f32x4*)(p + 4) = v[bj][1]; } }
                if (prompt) { const int gam = b * 4 + g;
                    if (ty <= 1) { bf16* dst = RC + ((size_t)ty * RC_KV + RC_SAMP + (size_t)gam * 512 + (t >> 4)) * 1024 + (t & 15) * 64 + d0;
#pragma unroll
                        for (int bj = 0; bj < 2; ++bj) { v4u w; w.x = pk2(v[bj][0][0], v[bj][0][1]); w.y = pk2(v[bj][0][2], v[bj][0][3]); w.z = pk2(v[bj][1][0], v[bj][1][1]); w.w = pk2(v[bj][1][2], v[bj][1][3]); *(v4u*)(dst + 32 * bj) = w; }
                    } else if (isk) { bf16* dst = (ty == 2 ? KS : KW) + ((size_t)gam * SEQ + t) * 64 + d0;
#pragma unroll
                        for (int bj = 0; bj < 2; ++bj) { v4u w; w.x = pk2(v[bj][0][0], v[bj][0][1]); w.y = pk2(v[bj][0][2], v[bj][0][3]); w.z = pk2(v[bj][1][0], v[bj][1][1]); w.w = pk2(v[bj][1][2], v[bj][1][3]); *(v4u*)(dst + 32 * bj) = w; }
                    } else { const int kk_ = t & 63; bf16* dst = (ty == 3 ? VST : VWT) + ((size_t)gam * 128 + (t >> 6)) * 4096 + (32 * (kk_ >> 5) + 8 * ((kk_ & 15) >> 2) + 4 * ((kk_ >> 4) & 1) + (kk_ & 3));
#pragma unroll
                        for (int bj = 0; bj < 2; ++bj)
#pragma unroll
                            for (int n = 0; n < 2; ++n)
#pragma unroll
                                for (int i = 0; i < 4; ++i) dst[(32 * bj + d0 + 4 * n + i) * 64] = (bf16)(pk2(v[bj][n][i], 0.f) & 0xffffu); }
                }
            }
    }
};
struct EpiQ {
    const float* SSQ; const float* BIAS; const float* qgain; const float* ROPE; bf16* QN; bf16* QR; float* GATES;
    __device__ __forceinline__ void operator()(EPI_ARGS) const { asm volatile("" ::: "memory");
        const int cl = wc * 32 + 8 * fq, c0 = u.pn * 256 + cl, d0 = 8 * fq; const bool uni = u.pm < 64;
        float rsv[2][4]; LOAD_RS8(rsv, SSQ, u.pm);
        f32x4 bv[2][2], qg[2][2];
        if (uni) { const float* b = BIAS + (size_t)(u.pm >> 5) * NBIG + OFF_Q + c0;
#pragma unroll
            for (int bj = 0; bj < 2; ++bj)
#pragma unroll
                for (int n = 0; n < 2; ++n) bv[bj][n] = *(const f32x4*)(b + bj * 128 + 4 * n); }
#pragma unroll
        for (int bj = 0; bj < 2; ++bj)
#pragma unroll
            for (int n = 0; n < 2; ++n) qg[bj][n] = *(const f32x4*)(qgain + 32 * bj + d0 + 4 * n);
#pragma unroll
        for (int ai = 0; ai < 2; ++ai)
#pragma unroll
            for (int m = 0; m < 4; ++m) { const int row = u.pm * 256 + ai * 128 + wr * 64 + m * 16 + fr;
                const float rs = rsv[ai][m];
                if (!uni) { const float* b = BIAS + (size_t)seq_of(row) * NBIG + OFF_Q + c0;
#pragma unroll
                    for (int bj = 0; bj < 2; ++bj)
#pragma unroll
                        for (int n = 0; n < 2; ++n) bv[bj][n] = *(const f32x4*)(b + bj * 128 + 4 * n); }
                f32x4 v[2][2];
#pragma unroll
                for (int bj = 0; bj < 2; ++bj)
#pragma unroll
                    for (int n = 0; n < 2; ++n) v[bj][n] = acc[ai][bj][m][n] * rs + bv[bj][n];
                if (u.pn == 4) {
                    if (cl < 48) {
#pragma unroll
                        for (int n = 0; n < 2; ++n) { f32x4 s; for (int i = 0; i < 4; ++i) s[i] = sigmoid_f(v[0][n][i]); *(f32x4*)(GATES + (size_t)row * 48 + cl + 4 * n) = s; } }
                    continue; }
                const int t = row < MP ? (row & (SEQ - 1)) : PAST;
                float sq = 0.f;
#pragma unroll
                for (int bj = 0; bj < 2; ++bj)
#pragma unroll
                    for (int n = 0; n < 2; ++n) sq += (v[bj][n][0] * v[bj][n][0] + v[bj][n][1] * v[bj][n][1]) + (v[bj][n][2] * v[bj][n][2] + v[bj][n][3] * v[bj][n][3]);
                sq += __shfl_xor(sq, 16); sq += __shfl_xor(sq, 32);
                const float ri = rsqrtf(sq * (1.0f / 64.0f) + EPS) * C2;
                f32x4 r[2][2];
#pragma unroll
                for (int n = 0; n < 2; ++n) { const f32x4 cs = *(const f32x4*)(ROPE + (size_t)t * 64 + d0 + 4 * n), sn = *(const f32x4*)(ROPE + (size_t)t * 64 + 32 + d0 + 4 * n);
                    v[0][n] = v[0][n] * ri * qg[0][n]; v[1][n] = v[1][n] * ri * qg[1][n];
                    r[0][n] = v[0][n] * cs - v[1][n] * sn; r[1][n] = v[1][n] * cs + v[0][n] * sn; }
                const size_t o = (size_t)row * D + (u.pn * 4 + wc) * 64 + d0;
#pragma unroll
                for (int bj = 0; bj < 2; ++bj) { v4u w; w.x = pk2(v[bj][0][0], v[bj][0][1]); w.y = pk2(v[bj][0][2], v[bj][0][3]); w.z = pk2(v[bj][1][0], v[bj][1][1]); w.w = pk2(v[bj][1][2], v[bj][1][3]); *(v4u*)(QN + o + 32 * bj) = w;
                    v4u x; x.x = pk2(r[bj][0][0], r[bj][0][1]); x.y = pk2(r[bj][0][2], r[bj][0][3]); x.z = pk2(r[bj][1][0], r[bj][1][1]); x.w = pk2(r[bj][1][2], r[bj][1][3]); *(v4u*)(QR + o + 32 * bj) = x; }
            }
    }
};

#define MFMA16(a, b, c) __builtin_amdgcn_mfma_f32_16x16x32_bf16((a), (b), (c), 0, 0, 0)

__device__ __forceinline__ int wperm(int mode, int n) {
    if (mode == 1) { const int up = n >= DFF ? 1 : 0, j = n - up * DFF; return (j >> 7) * 256 + up * 128 + (j & 127); }
    if (mode == 2 || (mode == 3 && n < 1024)) { const int blk = n >> 8, g = (n >> 6) & 3, d = n & 63; return blk * 256 + 128 * (d >> 5) + 32 * g + (d & 31); }
    return n;
}
__device__ __forceinline__ void transpose_item(const float* W, int K, int N, bf16* WT, int row_off, int mode, LAS float* scr, int item, int lane, const float* kscale = nullptr) {
    const int nblk = (N + 31) >> 5, kb = item / nblk, nb = item - kb * nblk, k0 = 64 * kb, n0 = 32 * nb;
    const int nq = n0 + 4 * (lane & 7); const bool okn = nq < N;
    f32x4 v[8];
#pragma unroll
    for (int i = 0; i < 8; ++i) { const int kk = 8 * i + (lane >> 3); v[i] = okn ? *(const f32x4*)(W + (size_t)(k0 + kk) * N + nq) : (f32x4){0.f, 0.f, 0.f, 0.f}; if (kscale) v[i] = v[i] * kscale[k0 + kk]; }
#pragma unroll
    for (int i = 0; i < 8; ++i) { const int kk = 8 * i + (lane >> 3); LAS float* d = scr + kk * 33 + 4 * (lane & 7); d[0] = v[i][0]; d[1] = v[i][1]; d[2] = v[i][2]; d[3] = v[i][3]; }
    LDS_WAIT(); asm volatile("" ::: "memory");
    const int c = lane & 7;
#pragma unroll
    for (int j = 0; j < 4; ++j) { const int n = (lane >> 3) + 8 * j; const LAS float* s = scr + (8 * c) * 33 + n;
        v4u o; o.x = pk2(s[0 * 33], s[1 * 33]); o.y = pk2(s[2 * 33], s[3 * 33]); o.z = pk2(s[4 * 33], s[5 * 33]); o.w = pk2(s[6 * 33], s[7 * 33]);
        if (n0 + n < N) *(v4u*)(WT + (size_t)(row_off + wperm(mode, n0 + n)) * K + k0 + 8 * c) = o; }
    LDS_WAIT(); asm volatile("" ::: "memory");
}
#define TR_ITEMS(K, N) (((K) / 64) * (((N) + 31) / 32))

__device__ __forceinline__ void phase0(const Params& P, LAS unsigned char* lds, int tid, int lane, int wave) {
    unsigned char* ws = P.ws;
    const int gw = blockIdx.x * NWAVES + wave, ngw = gridDim.x * NWAVES, gtid = blockIdx.x * 512 + tid, ngt = gridDim.x * 512;
    LAS float* scr = (LAS float*)(lds + wave * 16384);
    constexpr int IT_ADA = TR_ITEMS(1024, 6144);
    for (int it = gw; it < 2 * IT_ADA; it += ngw) { const int l = it / IT_ADA, r = it - l * IT_ADA;
        transpose_item(P.in[11] + (size_t)l * 1024 * 6144, 1024, 6144, (bf16*)(ws + WS_WADA), l * 6144, 0, scr, r, lane); }
    for (int e = gtid; e < 256 * 128; e += ngt) { const int row = e >> 7, c8 = (e & 127) * 8; v4u o = {0u, 0u, 0u, 0u};
        if (row < 130) { const float* src = (row < 2 ? P.in[9] + row * 1024 : P.in[10] + (row - 2) * 1024) + c8; const f32x4 a = *(const f32x4*)src, b = *(const f32x4*)(src + 4);
            o.x = pk2(silu_f(a[0]), silu_f(a[1])); o.y = pk2(silu_f(a[2]), silu_f(a[3])); o.z = pk2(silu_f(b[0]), silu_f(b[1])); o.w = pk2(silu_f(b[2]), silu_f(b[3])); }
        *(v4u*)((bf16*)(ws + WS_SC) + (size_t)row * 1024 + c8) = o; }
    for (int e = gtid; e < SEQ * 32; e += ngt) { const int pos = e >> 5, i = e & 31; const float inv = powf(10000.0f, -(float)i / 32.0f); const float ang = (float)pos * inv; float s, c; sincosf(ang, &s, &c);
        float* R = (float*)(ws + WS_ROPE) + (size_t)pos * 64; R[i] = c; R[32 + i] = s; }
    for (int e = gtid; e < 8 * 128 * 128; e += ngt) { const int t = (e >> 7) & 127, s = e & 127; ((bf16*)(ws + WS_WSB))[e] = (bf16)(pk2(s <= t ? P.in[16][e] : 0.f, 0.f) & 0xffffu); }
    for (int e = gtid; e < 5 * M65; e += ngt) ((float*)(ws + WS_SSQ))[e] = 0.f;
    for (int e = gtid; e < (NQP - NQ) * 128; e += ngt) *(v4u*)((bf16*)(ws + WS_WBIG) + (size_t)(OFF_Q + NQ) * 1024 + (size_t)e * 8) = (v4u){0u, 0u, 0u, 0u};
    if (gridDim.x >= 256 ? blockIdx.x < 256 : blockIdx.x == 0) {
        for (int ob = blockIdx.x; ob < 256; ob += (gridDim.x >= 256 ? 256 : 1)) { const int kv = ob >> 7, c0 = (ob & 127) * 2;
            const float* w1 = P.in[26] + (size_t)kv * 2048 * 256 + c0; const float* pe = P.in[25] + kv * 2048;
            const f32x4 pv = *(const f32x4*)(pe + 4 * tid); float s0 = 0.f, s1 = 0.f;
#pragma unroll
            for (int i = 0; i < 4; ++i) { const f32x2 w = *(const f32x2*)(w1 + (size_t)(4 * tid + i) * 256); s0 += pv[i] * w[0]; s1 += pv[i] * w[1]; }
            s0 = wave_sum(s0); s1 = wave_sum(s1);
            LAS float* red = (LAS float*)(lds + 8448);
            __syncthreads();
            if (lane == 0) { red[wave * 2] = s0; red[wave * 2 + 1] = s1; }
            __syncthreads();
            if (tid < 2) { float a = P.in[27][kv * 256 + c0 + tid]; for (int k = 0; k < 8; ++k) a += red[k * 2 + tid]; ((float*)(ws + WS_C1))[kv * 256 + c0 + tid] = a; } } }
}
__device__ __forceinline__ void phase1_weights(const Params& P, LAS unsigned char* lds, int lane, int wave) {
    unsigned char* ws = P.ws;
    constexpr int NMU = NMOD / 256;
    if ((int)gridDim.x > 2 * NMU && (int)blockIdx.x < NMU) return;
    const int skip = (int)gridDim.x > 2 * NMU ? NMU : 0;
    const int gw = ((int)blockIdx.x - skip) * NWAVES + wave, ngw = ((int)gridDim.x - skip) * NWAVES;
    LAS float* scr = (LAS float*)(lds + wave * 16384);
    constexpr int I0 = TR_ITEMS(1024, 2048), I1 = TR_ITEMS(1024, 5632), I2 = TR_ITEMS(1024, 1072), I3 = TR_ITEMS(1024, 1024), I4 = TR_ITEMS(2816, 1024), I5 = TR_ITEMS(1024, 1536), I6 = TR_ITEMS(2048, 256), I7 = TR_ITEMS(256, 64);
    constexpr int NIT = I0 + 2 * I1 + I2 + 2 * I3 + 2 * I4 + I5 + 2 * I6 + 2 * I7;
    bf16* WBIG = (bf16*)(ws + WS_WBIG);
    for (int it = gw; it < NIT; it += ngw) { int r = it;
        if (r < I0) { transpose_item(P.in[14], 1024, 2048, WBIG, OFF_WIN, 0, scr, r, lane); continue; } r -= I0;
        if (r < I1) { transpose_item(P.in[30], 1024, 5632, WBIG, OFF_GU0, 1, scr, r, lane); continue; } r -= I1;
        if (r < I1) { transpose_item(P.in[30] + (size_t)1024 * 5632, 1024, 5632, WBIG, OFF_GU1, 1, scr, r, lane); continue; } r -= I1;
        if (r < I2) { transpose_item(P.in[19], 1024, 1072, WBIG, OFF_Q, 3, scr, r, lane); continue; } r -= I2;
        if (r < I3) { transpose_item(P.in[18], 1024, 1024, (bf16*)(ws + WS_WOUT), 0, 0, scr, r, lane); continue; } r -= I3;
        if (r < I3) { transpose_item(P.in[21], 1024, 1024, (bf16*)(ws + WS_WBO), 0, 0, scr, r, lane); continue; } r -= I3;
        if (r < I4) { transpose_item(P.in[31], 2816, 1024, (bf16*)(ws + WS_WDN), 0, 0, scr, r, lane); continue; } r -= I4;
        if (r < I4) { transpose_item(P.in[31] + (size_t)2816 * 1024, 2816, 1024, (bf16*)(ws + WS_WDN) + (size_t)1024 * 2816, 0, 0, scr, r, lane); continue; } r -= I4;
        if (r < I5) { transpose_item(P.in[23], 1024, 1536, (bf16*)(ws + WS_WKV), 0, 2, scr, r, lane, P.in[22]); continue; } r -= I5;
        if (r < I6) { transpose_item(P.in[26], 2048, 256, (bf16*)(ws + WS_W1C), 0, 0, scr, r, lane); continue; } r -= I6;
        if (r < I6) { transpose_item(P.in[26] + (size_t)2048 * 256, 2048, 256, (bf16*)(ws + WS_W1C) + (size_t)256 * 2048, 0, 0, scr, r, lane); continue; } r -= I6;
        if (r < I7) { transpose_item(P.in[28], 256, 64, (bf16*)(ws + WS_W2), 0, 0, scr, r, lane); continue; } r -= I7;
        transpose_item(P.in[28] + 256 * 64, 256, 64, (bf16*)(ws + WS_W2) + 64 * 256, 0, 0, scr, r, lane);
    }
}
__device__ __forceinline__ void phase2_tail(const Params& P, int tid, int lane, int wave) {
    unsigned char* ws = P.ws;
    constexpr int NBU = 57;
    if ((int)gridDim.x > 2 * NBU && (int)blockIdx.x < NBU) return;
    const int skip = (int)gridDim.x > 2 * NBU ? NBU : 0;
    const int gw = ((int)blockIdx.x - skip) * NWAVES + wave, ngw = ((int)gridDim.x - skip) * NWAVES, gtid = ((int)blockIdx.x - skip) * 512 + tid, ngt = ((int)gridDim.x - skip) * 512;
    const float* MOD = (const float*)(ws + WS_MOD); const float* ng = P.in[13];
    for (int e = gtid; e < 3 * 256 * 256; e += ngt) { const int np = e >> 16, sq = (e >> 8) & 255, c = (e & 255) * 4;
        const int lay = np == 0 ? 0 : 1, wh = np == 1 ? 0 : 1;
        const f32x4 g = *(const f32x4*)(ng + (lay * 2 + wh) * 1024 + c), sc = *(const f32x4*)(MOD + (size_t)sq * NMOD + lay * 6144 + (wh ? 4096 : 1024) + c);
        *(f32x4*)((float*)(ws + WS_MUL) + ((size_t)np * 256 + sq) * 1024 + c) = g * (sc + 1.0f); }
    float* SSQ0 = (float*)(ws + WS_SSQ); bf16* A0 = (bf16*)(ws + WS_ACTA);
    for (int r0 = gw; r0 < M65; r0 += 2 * ngw) {
        const int r1 = r0 + ngw; const bool h1 = r1 < M65;
        f32x4 va[4], vb[4]; float sa = 0.f, sb = 0.f;
#pragma unroll
        for (int j = 0; j < 4; ++j) { va[j] = (f32x4){0.f, 0.f, 0.f, 0.f}; vb[j] = va[j]; }
        if (r0 < MT) { const float* x = (r0 < MP ? P.in[0] + (size_t)r0 * D : P.in[1] + (size_t)(r0 - MP) * D) + 4 * lane;
#pragma unroll
            for (int j = 0; j < 4; ++j) va[j] = *(const f32x4*)(x + 256 * j); }
        if (h1 && r1 < MT) { const float* x = (r1 < MP ? P.in[0] + (size_t)r1 * D : P.in[1] + (size_t)(r1 - MP) * D) + 4 * lane;
#pragma unroll
            for (int j = 0; j < 4; ++j) vb[j] = *(const f32x4*)(x + 256 * j); }
        const int sqa = seq_of(r0), sqb = seq_of(h1 ? r1 : r0);
        f32x4 ga[4], gb[4];
#pragma unroll
        for (int j = 0; j < 4; ++j) { const int c = 4 * lane + 256 * j; const f32x4 g = *(const f32x4*)(ng + c);
            ga[j] = g * (*(const f32x4*)(MOD + (size_t)sqa * NMOD + 1024 + c) + 1.0f); gb[j] = g * (*(const f32x4*)(MOD + (size_t)sqb * NMOD + 1024 + c) + 1.0f); }
#pragma unroll
        for (int j = 0; j < 4; ++j) { sa += (va[j][0] * va[j][0] + va[j][1] * va[j][1]) + (va[j][2] * va[j][2] + va[j][3] * va[j][3]); sb += (vb[j][0] * vb[j][0] + vb[j][1] * vb[j][1]) + (vb[j][2] * vb[j][2] + vb[j][3] * vb[j][3]); }
        sa = wave_sum(sa); sb = wave_sum(sb);
        if (lane == 0) { SSQ0[r0] = sa; if (h1) SSQ0[r1] = sb; }
#pragma unroll
        for (int j = 0; j < 4; ++j) { const int c = 4 * lane + 256 * j;
            { const f32x4 a = va[j] * ga[j]; v2u w; w.x = pk2(a[0], a[1]); w.y = pk2(a[2], a[3]); *(v2u*)(A0 + (size_t)r0 * D + c) = w; }
            if (h1) { const f32x4 a = vb[j] * gb[j]; v2u w; w.x = pk2(a[0], a[1]); w.y = pk2(a[2], a[3]); *(v2u*)(A0 + (size_t)r1 * D + c) = w; } }
    }
}
__device__ __forceinline__ void sample_prepass(const Params& P, int tid, int lane, int wave) {
    unsigned char* ws = P.ws;
    const int gw = blockIdx.x * NWAVES + wave, ngw = gridDim.x * NWAVES;
    const int* pt = (const int*)P.in[8]; bf16* RC = (bf16*)(ws + WS_RC);
    for (int it = gw; it < 2 * 128 * 16 * 4; it += ngw) { const int kv = it >> 13, sq = (it >> 6) & 127, p = (it >> 2) & 15, qtr = it & 3;
        const float* src = P.in[2 + kv] + (size_t)pt[sq * 16 + p] * (128 * 256) + qtr * 8192;
#pragma unroll
        for (int i0 = 0; i0 < 16; i0 += 8) { f32x4 a[8], b[8];
#pragma unroll
            for (int i = 0; i < 8; ++i) { const int e = ((i0 + i) * 64 + lane) * 8; a[i] = __builtin_nontemporal_load((const f32x4*)(src + e)); b[i] = __builtin_nontemporal_load((const f32x4*)(src + e + 4)); }
#pragma unroll
            for (int i = 0; i < 8; ++i) { const int e = ((i0 + i) * 64 + lane) * 8, tok = qtr * 32 + (e >> 8), g = (e >> 6) & 3, d = e & 63;
                v4u w; w.x = pk2(a[i][0], a[i][1]); w.y = pk2(a[i][2], a[i][3]); w.z = pk2(b[i][0], b[i][1]); w.w = pk2(b[i][2], b[i][3]);
                *(v4u*)(RC + ((size_t)kv * RC_KV + (size_t)(sq * 4 + g) * 128 + p * 8 + (tok >> 4)) * 1024 + (tok & 15) * 64 + d) = w; } } }
}
__device__ __forceinline__ void window_copy(const Params& P, int kv, int first, int nwg, int lane, int wave) {
    const int gw = first * NWAVES + wave, ngw = nwg * NWAVES;
    for (int it = gw; it < 128 * 64; it += ngw) { const int s = it >> 6, c = it & 63;
        const f32x4* src = (const f32x4*)P.in[6 + kv] + (size_t)s * 32768 + 64; f32x4* dst = (f32x4*)(P.out + (kv ? O_WVS : O_WKS)) + (size_t)s * 32768;
        f32x4 v[8];
#pragma unroll
        for (int i = 0; i < 8; ++i) { const int e = c * 512 + i * 64 + lane; if (e < 32704) v[i] = __builtin_nontemporal_load(src + e); }
#pragma unroll
        for (int i = 0; i < 8; ++i) { const int e = c * 512 + i * 64 + lane; if (e < 32704) __builtin_nontemporal_store(v[i], dst + e); } }
}
__device__ __forceinline__ void skinny_core(const bf16* Arows  , int lda, int K, const bf16* Bt64  , LAS float* RED, int tid, int lane, int wave, float& s0, float& s1) {
    const int col = lane & 15, quad = lane >> 4;
    const int kw = K >> 3;
    const bf16* ap = Arows + (size_t)col * lda + wave * kw + 8 * quad;
    const bf16* bp = Bt64 + (size_t)col * K + wave * kw + 8 * quad;
    f32x4 acc[4];
#pragma unroll
    for (int ct = 0; ct < 4; ++ct) acc[ct] = (f32x4){0.f, 0.f, 0.f, 0.f};
#pragma unroll 4
    for (int k0 = 0; k0 < kw; k0 += 32) { const bf16x8 af = *(const bf16x8*)(ap + k0);
#pragma unroll
        for (int ct = 0; ct < 4; ++ct) { const bf16x8 bf = *(const bf16x8*)(bp + (size_t)ct * 16 * K + k0); acc[ct] = MFMA16(af, bf, acc[ct]); } }
#pragma unroll
    for (int ct = 0; ct < 4; ++ct)
#pragma unroll
        for (int r = 0; r < 4; ++r) RED[((wave * 4 + ct) * 4 + r) * 64 + lane] = acc[ct][r];
    __syncthreads();
    const int r16 = tid >> 5, c2 = (tid & 31) * 2;
    const int base = ((c2 >> 4) * 4 + (r16 & 3)) * 64 + (c2 & 15) + 16 * (r16 >> 2);
    s0 = 0.f; s1 = 0.f;
#pragma unroll
    for (int wv = 0; wv < 8; ++wv) { s0 += RED[wv * 1024 + base]; s1 += RED[wv * 1024 + base + 1]; }
    __syncthreads();
}
__device__ __forceinline__ float half_wave_sum(float v) { v += __shfl_xor(v, 1); v += __shfl_xor(v, 2); v += __shfl_xor(v, 4); v += __shfl_xor(v, 8); v += __shfl_xor(v, 16); return v; }
template <bool XF32, bool OF32>
__device__ __forceinline__ void skinny_res(const bf16* A, int lda, int K, const bf16* Bt, const EpiRes<XF32, OF32>& E, LAS unsigned char* lds, int tid, int lane, int wave) {
    for (int task = blockIdx.x; task < 8 * 16; task += gridDim.x) { const int rt = task >> 4, cg = task & 15;
        float s0, s1;
        skinny_core(A + (size_t)(MP + 16 * rt) * lda, lda, K, Bt + (size_t)(64 * cg) * K, (LAS float*)lds, tid, lane, wave, s0, s1);
        const int srow = 16 * rt + (tid >> 5), row = MP + srow, sq = 2 + srow, c = 64 * cg + (tid & 31) * 2;
        float xi0, xi1;
        if (XF32) { const f32x2 xi = *(const f32x2*)(E.xin_s + (size_t)srow * D + c); xi0 = xi[0]; xi1 = xi[1]; }
        else { const unsigned w_ = *(const unsigned*)(E.xb_in + (size_t)row * D + c); xi0 = bflo(w_); xi1 = bfhi(w_); }
        const f32x2 gt = *(const f32x2*)(E.MOD + (size_t)sq * NMOD + E.goff + c);
        const float x0 = xi0 + gt[0] * s0, x1 = xi1 + gt[1] * s1;
        if (OF32) *(f32x2*)(E.out + (size_t)row * D + c) = (f32x2){x0, x1};
        else *(unsigned*)(E.xb_out + (size_t)row * D + c) = pk2(x0, x1);
        if (E.A1) { const f32x2 m = *(const f32x2*)(E.MUL + (size_t)sq * D + c); *(unsigned*)(E.A1 + (size_t)row * D + c) = pk2(x0 * m[0], x1 * m[1]); }
        if (E.SSQ) { const float q = half_wave_sum(x0 * x0 + x1 * x1); if ((tid & 31) == 0) ssq_add(E.SSQ + row, q); }
    }
}
__device__ __forceinline__ void skinny_ain(const bf16* A, const bf16* Bt, const EpiAin& E, LAS unsigned char* lds, int tid, int lane, int wave) {
    for (int task = blockIdx.x; task < 8 * 32; task += gridDim.x) { const int rt = task >> 5, cg = task & 31;
        float s0, s1;
        skinny_core(A + (size_t)(MP + 16 * rt) * D, D, D, Bt + (size_t)(64 * cg) * D, (LAS float*)lds, tid, lane, wave, s0, s1);
        const int srow = 16 * rt + (tid >> 5), row = MP + srow, sq = 2 + srow, c = 64 * cg + (tid & 31) * 2;
        const float rs = rstd1(E.SSQ0[row]);
        const f32x2 bv = *(const f32x2*)(E.BIAS + (size_t)sq * NBIG + OFF_WIN + c);
        const float g0 = gelu_t(s0 * rs + bv[0]), g1 = gelu_t(s1 * rs + bv[1]);
        if (cg < 16) *(unsigned*)(E.U + (size_t)row * D + c) = pk2(g0, g1);
        else { *(unsigned*)(E.V + (size_t)row * D + c - 1024) = pk2(g0, g1); const float q = half_wave_sum(g0 * g0 + g1 * g1); if ((tid & 31) == 0) ssq_add(E.SSQV + row, q); }
    }
}

__device__ __forceinline__ void phase_tokmix(const Params& P, LAS unsigned char* lds, int tid, int lane, int wave) {
    unsigned char* ws = P.ws;
    const bf16* U = (const bf16*)(ws + WS_U); const bf16* V = (const bf16*)(ws + WS_V); bf16* UM = (bf16*)(ws + WS_UM);
    const float* SSQV = (const float*)(ws + WS_SSQ) + (size_t)1 * M65; const bf16* WSB = (const bf16*)(ws + WS_WSB);
    const float* vgain = P.in[15]; const float* bs = P.in[17];
    const int col = lane & 15, quad = lane >> 4;
    v4u wv[4]; float rsn[4];
#define TM_LOAD(item_) do { const int chunk_ = (item_) >> 3, g_ = (item_) & 7; _Pragma("unroll") for (int i = 0; i < 4; ++i) { const int e = tid + 512 * i, s = e >> 4, c8 = (e & 15) * 8; const int row = chunk_ * 128 + s; \
        rsn[i] = SSQV[row]; wv[i] = *(const v4u*)(V + (size_t)row * D + g_ * 128 + c8); } } while (0)
#define TM_STORE(item_, VT_) do { const int chunk_ = (item_) >> 3, g_ = (item_) & 7; const bool lastc_ = (chunk_ & 63) == 63; _Pragma("unroll") for (int i = 0; i < 4; ++i) { const int e = tid + 512 * i, s = e >> 4, c8 = (e & 15) * 8; \
        const float rs = rstd1(rsn[i]); const v4u w = wv[i]; \
        const f32x4 g0 = *(const f32x4*)(vgain + g_ * 128 + c8), g1 = *(const f32x4*)(vgain + g_ * 128 + c8 + 4); \
        float x[8] = {bflo(w.x) * rs * g0[0], bfhi(w.x) * rs * g0[1], bflo(w.y) * rs * g0[2], bfhi(w.y) * rs * g0[3], bflo(w.z) * rs * g1[0], bfhi(w.z) * rs * g1[1], bflo(w.w) * rs * g1[2], bfhi(w.w) * rs * g1[3]}; \
        _Pragma("unroll") for (int k = 0; k < 8; ++k) (VT_)[(c8 + k) * 136 + (s ^ c8)] = (bf16)(pk2(x[k], 0.f) & 0xffffu); \
        if (lastc_) { float* av = P.out + O_AVP + ((size_t)(chunk_ >> 6) * 128 + s) * D + g_ * 128 + c8; *(f32x4*)av = (f32x4){x[0], x[1], x[2], x[3]}; *(f32x4*)(av + 4) = (f32x4){x[4], x[5], x[6], x[7]}; } } } while (0)
    int buf = 0;
    if ((int)blockIdx.x < 1024) { TM_LOAD((int)blockIdx.x); TM_STORE((int)blockIdx.x, (LAS bf16*)lds); }
    for (int item = blockIdx.x; item < 1024; item += gridDim.x) { const int chunk = item >> 3, g = item & 7, r0 = chunk * 128;
        LAS bf16* VT = (LAS bf16*)(lds + buf * 36864);
        const int nxt = item + (int)gridDim.x;
        if (nxt < 1024) TM_LOAD(nxt);
        const int t = 16 * wave + col;
        bf16x8 bfr[4];
#pragma unroll
        for (int ks = 0; ks < 4; ++ks) bfr[ks] = (ks <= (wave >> 1)) ? *(const bf16x8*)(WSB + ((size_t)g * 128 + t) * 128 + 32 * ks + 8 * quad) : (bf16x8){0, 0, 0, 0, 0, 0, 0, 0};
        v2u uw[8];
#pragma unroll
        for (int ct = 0; ct < 8; ++ct) uw[ct] = *(const v2u*)(U + (size_t)(r0 + t) * D + g * 128 + 16 * ct + 4 * quad);
        const float bt = bs[g * 128 + t];
        __syncthreads();
        f32x4 acc[8];
#pragma unroll
        for (int ct = 0; ct < 8; ++ct) acc[ct] = (f32x4){0.f, 0.f, 0.f, 0.f};
#pragma unroll
        for (int ks = 0; ks < 4; ++ks) if (ks <= (wave >> 1)) {
#pragma unroll
            for (int ct = 0; ct < 8; ++ct) { const bf16x8 afr = *(const LAS bf16x8*)(VT + (16 * ct + col) * 136 + ((32 * ks + 8 * quad) ^ (16 * ct + (col & 8))))    ; acc[ct] = MFMA16(afr, bfr[ks], acc[ct]); } }
#pragma unroll
        for (int ct = 0; ct < 8; ++ct) { const size_t o = (size_t)(r0 + t) * D + g * 128 + 16 * ct + 4 * quad;
            v2u w; w.x = pk2(bflo(uw[ct].x) * (acc[ct][0] + bt), bfhi(uw[ct].x) * (acc[ct][1] + bt)); w.y = pk2(bflo(uw[ct].y) * (acc[ct][2] + bt), bfhi(uw[ct].y) * (acc[ct][3] + bt)); *(v2u*)(UM + o) = w; }
        buf ^= 1;
        if (nxt < 1024) TM_STORE(nxt, (LAS bf16*)(lds + buf * 36864));
    }
#undef TM_LOAD
#undef TM_STORE
    const int gw = blockIdx.x * NWAVES + wave, ngw = gridDim.x * NWAVES;
    for (int r = MP + gw; r < M65; r += ngw) {
        const float rs = rstd1(SSQV[r]);
#pragma unroll
        for (int j = 0; j < 4; ++j) { const int c = 4 * lane + 256 * j, g = c >> 7; v2u w = {0u, 0u};
            if (r < MT) { const v2u vw = *(const v2u*)(V + (size_t)r * D + c), uw = *(const v2u*)(U + (size_t)r * D + c); const f32x4 gn = *(const f32x4*)(vgain + c);
                const f32x4 vn = (f32x4){bflo(vw.x), bfhi(vw.x), bflo(vw.y), bfhi(vw.y)} * rs * gn;
                *(f32x4*)(P.out + O_AVS + (size_t)(r - MP) * D + c) = vn;
                const float w00 = P.in[16][g * 16384], b0 = bs[g * 128];
                w.x = pk2(bflo(uw.x) * (w00 * vn[0] + b0), bfhi(uw.x) * (w00 * vn[1] + b0)); w.y = pk2(bflo(uw.y) * (w00 * vn[2] + b0), bfhi(uw.y) * (w00 * vn[3] + b0)); }
            *(v2u*)(UM + (size_t)r * D + c) = w; } }
}

__device__ __forceinline__ void w2_stage(const Params& P, LAS unsigned char* lds, int tid) {
    const bf16* W2 = (const bf16*)(P.ws + WS_W2);
#pragma unroll
    for (int i = 0; i < 8; ++i) { const int p = tid + 512 * i, f = p >> 6, l = p & 63, kv = f >> 5, dt = (f >> 3) & 3, ks = f & 7;
        *(LAS v4u*)(lds + (size_t)p * 16) = *(const v4u*)(W2 + (size_t)kv * 64 * 256 + (size_t)(16 * dt + (l & 15)) * 256 + 32 * ks + 8 * (l >> 4)); }
}
__device__ __forceinline__ void w2_load(const Params& P, int kv, int R0, int lane, bf16x8 (&hf)[8]) {
    const bf16* hrow = (const bf16*)(P.ws + WS_H2) + ((size_t)kv * RC_KV + R0 + (lane & 15)) * 256 + 8 * (lane >> 4);
#pragma unroll
    for (int ks = 0; ks < 8; ++ks) hf[ks] = *(const bf16x8*)(hrow + 32 * ks);
}
__device__ __forceinline__ void w2_task(const Params& P, const LAS unsigned char* lds, int kv, int R0, int lane, const bf16x8 (&hf)[8]) {
    unsigned char* ws = P.ws;
    const int col = lane & 15, quad = lane >> 4;
    const bool samp = R0 < RC_SAMP; const int gam = samp ? (R0 >> 7) : ((R0 - RC_SAMP) >> 9), i0 = samp ? (R0 & 127) : ((R0 - RC_SAMP) & 511);
    f32x4 acc[4];
#pragma unroll
    for (int dt = 0; dt < 4; ++dt) acc[dt] = (f32x4){0.f, 0.f, 0.f, 0.f};
#pragma unroll
    for (int ks = 0; ks < 8; ++ks)
#pragma unroll
        for (int dt = 0; dt < 4; ++dt) { const bf16x8 wf = *(const LAS bf16x8*)(lds + ((kv * 4 + dt) * 8 + ks) * 1024 + lane * 16);
            acc[dt] = kv ? MFMA16(hf[ks], wf, acc[dt]) : MFMA16(wf, hf[ks], acc[dt]); }
    const float* b2 = P.in[29] + kv * 64;
    if (!kv) {
        float sq = 0.f; f32x4 v[4];
#pragma unroll
        for (int dt = 0; dt < 4; ++dt) { v[dt] = acc[dt] + *(const f32x4*)(b2 + 16 * dt + 4 * quad); sq += (v[dt][0] * v[dt][0] + v[dt][1] * v[dt][1]) + (v[dt][2] * v[dt][2] + v[dt][3] * v[dt][3]); }
        sq += __shfl_xor(sq, 16); sq += __shfl_xor(sq, 32);
        const float ri = rsqrtf(sq * (1.0f / 64.0f) + EPS);
        bf16* dst = (samp ? (bf16*)(ws + WS_KCS) + ((size_t)gam * 128 + i0 + col) * 64 : (bf16*)(ws + WS_KCP) + ((size_t)gam * 512 + i0 + col) * 64) + 4 * quad;
#pragma unroll
        for (int dt = 0; dt < 4; ++dt) { const f32x4 kg = *(const f32x4*)(P.in[24] + 16 * dt + 4 * quad); const f32x4 o = v[dt] * ri * kg; v2u w; w.x = pk2(o[0], o[1]); w.y = pk2(o[2], o[3]); *(v2u*)(dst + 16 * dt) = w; }
    } else {
#pragma unroll
        for (int dt = 0; dt < 4; ++dt) { const int d = 16 * dt + col; const float bb = b2[d];
            const int ip = (i0 & ~63) + 32 * ((i0 >> 5) & 1) + 8 * quad + 4 * ((i0 >> 4) & 1);
            bf16* dst = (samp ? (bf16*)(ws + WS_VCTS) + (size_t)gam * 2 * 4096 : (bf16*)(ws + WS_VCTP) + (size_t)gam * 8 * 4096) + (size_t)(ip >> 6) * 4096 + d * 64 + (ip & 63);
            v2u w; w.x = pk2(acc[dt][0] + bb, acc[dt][1] + bb); w.y = pk2(acc[dt][2] + bb, acc[dt][3] + bb); *(v2u*)dst = w; }
    }
}
__device__ __forceinline__ void w2_own_units(const Params& P, LAS unsigned char* lds, const pg8::StaticOrder& S, int tid, int lane, int wave) {
    asm volatile("s_waitcnt vmcnt(0)" ::: "memory");
    __syncthreads();
    __builtin_amdgcn_fence(__ATOMIC_ACQUIRE, "agent");
    w2_stage(P, lds, tid);
    __syncthreads();
    pg8::Unit u0, u1, u2; const bool h0 = S.next(0, u0), h1 = S.next(1, u1), h2 = S.next(2, u2);
    bf16x8 fa[8], fb[8];
#define W2_UNIT(has, u) do { if (has) { const int kv = (u).pm >= RC_KV / 256 ? 1 : 0, Rb = ((u).pm - kv * (RC_KV / 256)) * 256; \
        w2_load(P, kv, Rb + 16 * wave, lane, fa); w2_load(P, kv, Rb + 16 * (wave + 8), lane, fb); \
        w2_task(P, lds, kv, Rb + 16 * wave, lane, fa); w2_task(P, lds, kv, Rb + 16 * (wave + 8), lane, fb); } } while (0)
    W2_UNIT(h0, u0); W2_UNIT(h1, u1); W2_UNIT(h2, u2);
#undef W2_UNIT
}

#ifndef ATT_REP_P
#define ATT_REP_P 1
#endif
#ifndef ATT_REP_S
#define ATT_REP_S 1
#endif

__device__ __forceinline__ void load_k8(const bf16* kb, int lane, bf16x8 (&kf)[8]) {
    const int col = lane & 15, quad = lane >> 4;
#pragma unroll
    for (int kt = 0; kt < 4; ++kt) { const bf16* kp = kb + (size_t)(16 * kt + col) * 64 + 8 * quad; kf[2 * kt] = *(const bf16x8*)kp; kf[2 * kt + 1] = *(const bf16x8*)(kp + 32); }
}
__device__ __forceinline__ void load_vt8(const bf16* vtb, int pitch, int lane, bf16x8 (&vf)[8]) {
    const int col = lane & 15, quad = lane >> 4;
#pragma unroll
    for (int dt = 0; dt < 4; ++dt)
#pragma unroll
        for (int ks = 0; ks < 2; ++ks) vf[2 * dt + ks] = *(const bf16x8*)(vtb + (size_t)(16 * dt + col) * pitch + 32 * ks + 8 * quad);
}
__device__ __forceinline__ void select_topk(LAS float* imps, int cur, int lane, unsigned (&msk)[4]) {
    const int col = lane & 15, quad = lane >> 4, ql = col >> 2, hl = col & 3;
#pragma unroll
    for (int w = 0; w < 4; ++w) msk[w] = 0u;
    if (cur <= 15) { msk[0] = (2u << cur) - 1u; return; }
    asm volatile("s_waitcnt lgkmcnt(0)" ::: "memory");
    const int lq = hl + 4 * quad;
    unsigned key[8];
#pragma unroll
    for (int e = 0; e < 8; ++e) { const int sg = lq + 16 * e; const float v = imps[ql * 128 + sg]; key[e] = (sg >= 1 && sg <= cur - 2) ? ((__builtin_bit_cast(unsigned, v) & ~127u) | (unsigned)sg) : 0u; }
    for (int it = 0; it < 13; ++it) {
        unsigned mx = key[0];
#pragma unroll
        for (int e = 1; e < 8; ++e) mx = mx > key[e] ? mx : key[e];
        { unsigned o = dpp_xor1u(mx); mx = mx > o ? mx : o; o = dpp_xor2u(mx); mx = mx > o ? mx : o; o = (unsigned)__shfl_xor((int)mx, 16); mx = mx > o ? mx : o; o = (unsigned)__shfl_xor((int)mx, 32); mx = mx > o ? mx : o; }
        const unsigned sg = mx & 127u, bit = mx ? (1u << (sg & 31u)) : 0u, w = sg >> 5;
        msk[0] |= w == 0u ? bit : 0u; msk[1] |= w == 1u ? bit : 0u; msk[2] |= w == 2u ? bit : 0u; msk[3] |= w == 3u ? bit : 0u;
#pragma unroll
        for (int e = 0; e < 8; ++e) key[e] = key[e] == mx ? 0u : key[e];
    }
    msk[0] |= 1u;
#pragma unroll
    for (int k = 0; k < 2; ++k) { const unsigned sg = (unsigned)(cur - k), bit = 1u << (sg & 31u), w = sg >> 5;
        msk[0] |= w == 0u ? bit : 0u; msk[1] |= w == 1u ? bit : 0u; msk[2] |= w == 2u ? bit : 0u; msk[3] |= w == 3u ? bit : 0u; }
}

__device__ __forceinline__ void attn_cmp_select(const bf16* kc, const bf16* vct, int vpitch, bf16x8 qn0, bf16x8 qn1, int nvis, int nkt, int cur, float nref,
                                                LAS float* imps, int lane, f32x4 (&oc)[4], unsigned (&msk)[4]) {
    const int col = lane & 15, quad = lane >> 4, ql = col >> 2, hl = col & 3;
    const int nb = (nkt + 3) >> 2;
    float lsum = 0.f;
    {   bf16x8 kfA[8], kfB[8];
        if (nb > 0) load_k8(kc, lane, kfA);
        for (int blk = 0; blk < nb; ++blk) {
            if (blk + 1 < nb) load_k8(kc + (size_t)(blk + 1) * 4096, lane, kfB);
#pragma unroll
            for (int kt = 0; kt < 4; ++kt) { f32x4 s = {nref, nref, nref, nref}; s = MFMA16(kfA[2 * kt], qn0, s); s = MFMA16(kfA[2 * kt + 1], qn1, s);
#pragma unroll
                for (int r = 0; r < 4; ++r) lsum += (64 * blk + 16 * kt + 4 * quad + r < nvis) ? fexp2(s[r]) : 0.f; }
#pragma unroll
            for (int i = 0; i < 8; ++i) kfA[i] = kfB[i];
        } }
    float l = lsum + __shfl_xor(lsum, 16); l += __shfl_xor(l, 32);
    const float rl = l > 0.f ? 1.0f / l : 0.f;
#pragma unroll
    for (int dt = 0; dt < 4; ++dt) oc[dt] = (f32x4){0.f, 0.f, 0.f, 0.f};
    float carry = 0.f;
    {   bf16x8 kfA[8], kfB[8], vfA[8];
        if (nb > 0) load_k8(kc, lane, kfA);
        for (int blk = 0; blk < nb; ++blk) {
            load_vt8(vct + (size_t)blk * 4096, 64, lane, vfA);
            if (blk + 1 < nb) load_k8(kc + (size_t)(blk + 1) * 4096, lane, kfB);
            float pa[4][4];
#pragma unroll
            for (int kt = 0; kt < 4; ++kt) { f32x4 s = {nref, nref, nref, nref}; s = MFMA16(kfA[2 * kt], qn0, s); s = MFMA16(kfA[2 * kt + 1], qn1, s);
                float hs[4];
#pragma unroll
                for (int r = 0; r < 4; ++r) { const float p = (64 * blk + 16 * kt + 4 * quad + r < nvis) ? fexp2(s[r]) * rl : 0.f; pa[kt][r] = p; float h = p + dpp_xor1(p); h += dpp_xor2(h); hs[r] = h; }
                const float tot = (hs[0] + hs[1]) + (hs[2] + hs[3]);
                const float up = __shfl(hs[3], (lane + 48) & 63);
                const float prev = quad == 0 ? carry : up; carry = up;
                if (hl == 0) imps[ql * 128 + 16 * blk + 4 * kt + quad] = tot + prev; }
#pragma unroll
            for (int ks = 0; ks < 2; ++ks) { v4u pw; pw.x = pk2(pa[2 * ks][0], pa[2 * ks][1]); pw.y = pk2(pa[2 * ks][2], pa[2 * ks][3]); pw.z = pk2(pa[2 * ks + 1][0], pa[2 * ks + 1][1]); pw.w = pk2(pa[2 * ks + 1][2], pa[2 * ks + 1][3]);
                const bf16x8 pb = __builtin_bit_cast(bf16x8, pw);
#pragma unroll
                for (int dt = 0; dt < 4; ++dt) oc[dt] = MFMA16(vfA[2 * dt + ks], pb, oc[dt]); }
#pragma unroll
            for (int i = 0; i < 8; ++i) kfA[i] = kfB[i];
        } }
    select_topk(imps, cur, lane, msk);
}

__device__ __forceinline__ void tile_step(const bf16x8 (&kf)[8], const bf16x8 (&vf)[8], bf16x8 q0, bf16x8 q1, float cinit, bool masked, int kpos0, int lo, int hi, int lane, f32x4 (&o)[4], float& lsum) {
    const int quad = lane >> 4;
    f32x4 p[4];
#pragma unroll
    for (int kt = 0; kt < 4; ++kt) { f32x4 s = {cinit, cinit, cinit, cinit}; s = MFMA16(kf[2 * kt], q0, s); s = MFMA16(kf[2 * kt + 1], q1, s);
#pragma unroll
        for (int r = 0; r < 4; ++r) p[kt][r] = fexp2(s[r]); }
    if (masked) {
#pragma unroll
        for (int kt = 0; kt < 4; ++kt)
#pragma unroll
            for (int r = 0; r < 4; ++r) { const int kpos = kpos0 + 16 * kt + 4 * quad + r; p[kt][r] = (kpos >= lo && kpos <= hi) ? p[kt][r] : 0.f; } }
#pragma unroll
    for (int kt = 0; kt < 4; ++kt) lsum += (p[kt][0] + p[kt][1]) + (p[kt][2] + p[kt][3]);
#pragma unroll
    for (int ks = 0; ks < 2; ++ks) {
        v4u pw; pw.x = pk2(p[2 * ks][0], p[2 * ks][1]); pw.y = pk2(p[2 * ks][2], p[2 * ks][3]); pw.z = pk2(p[2 * ks + 1][0], p[2 * ks + 1][1]); pw.w = pk2(p[2 * ks + 1][2], p[2 * ks + 1][3]);
        const bf16x8 pb = __builtin_bit_cast(bf16x8, pw);
#pragma unroll
        for (int dt = 0; dt < 4; ++dt) o[dt] = MFMA16(vf[2 * dt + ks], pb, o[dt]); }
}

struct AttnRefs { float cmp, slc, win; };

constexpr int AT_RING = 0, AT_SLOT = 16384, AT_NS = 4;
constexpr int AT_IMPS = AT_NS * AT_SLOT;
constexpr int AT_PARKA = AT_IMPS, AT_PARKB = AT_IMPS + 32768;
constexpr int AT_UNI = RING_BYTES + 1024;
static_assert(AT_PARKB + 32768 <= RING_BYTES && AT_UNI + 256 <= LDS_BYTES, "attention LDS map");
#define AT_WAITV(n) asm volatile("s_waitcnt vmcnt(" #n ")" ::: "memory")
#define AT_RING_WAIT2(rem) do { const int r_ = (rem); if (r_ >= 2) AT_WAITV(4); else if (r_ == 1) AT_WAITV(2); else AT_WAITV(0); } while (0)
#define AT_RING_WAIT1(rem) do { const int r_ = (rem); if (r_ >= 2) AT_WAITV(2); else if (r_ == 1) AT_WAITV(1); else AT_WAITV(0); } while (0)

struct TileQ { bf16x8 q0, q1; int nvis, nvt, tb, tq; };
__device__ __forceinline__ void pv_acc(const bf16x8 (&vf)[8], const f32x4 (&p)[4], f32x4 (&o)[4]);

__device__ __forceinline__ void cmp_p1_step(const bf16x8 (&kf)[8], const TileQ& T, float nref, int j, int lane, float& lsum) {
    const int quad = lane >> 4;
#pragma unroll
    for (int kt = 0; kt < 4; ++kt) { f32x4 s = {nref, nref, nref, nref}; s = MFMA16(kf[2 * kt], T.q0, s); s = MFMA16(kf[2 * kt + 1], T.q1, s);
#pragma unroll
        for (int r = 0; r < 4; ++r) lsum += (64 * j + 16 * kt + 4 * quad + r < T.nvis) ? fexp2(s[r]) : 0.f; }
}
__device__ __forceinline__ void cmp_p2_qk(const bf16x8 (&kf)[8], const TileQ& T, float nref, float rl, int j, int lane, float& carry, LAS float* imps, f32x4 (&pa)[4]) {
    const int col = lane & 15, quad = lane >> 4, ql = col >> 2, hl = col & 3;
#pragma unroll
    for (int kt = 0; kt < 4; ++kt) { f32x4 s = {nref, nref, nref, nref}; s = MFMA16(kf[2 * kt], T.q0, s); s = MFMA16(kf[2 * kt + 1], T.q1, s);
        float hs[4];
#pragma unroll
        for (int r = 0; r < 4; ++r) { const float p = (64 * j + 16 * kt + 4 * quad + r < T.nvis) ? fexp2(s[r]) * rl : 0.f; pa[kt][r] = p; float h = p + dpp_xor1(p); h += dpp_xor2(h); hs[r] = h; }
        const float tot = (hs[0] + hs[1]) + (hs[2] + hs[3]);
        const float up = __shfl(hs[3], (lane + 48) & 63);
        const float prev = quad == 0 ? carry : up; carry = up;
        if (hl == 0) imps[ql * 128 + 16 * j + 4 * kt + quad] = tot + prev; }
}

__device__ __forceinline__ void attn_cmp_ring2(const bf16* Kb, const bf16* Vb, LAS unsigned char* lds, const TileQ& A, const TileQ& B, int nb, int cur, float nref,
                                               LAS float* imps, int w, int lane, f32x4 (&oa)[4], f32x4 (&ob)[4], unsigned (&ma)[4], unsigned (&mb)[4]) {
    const int col = lane & 15, quad = lane >> 4;
    const size_t foff = (size_t)(16 * (w >> 1) + col) * 64 + 32 * (w & 1) + 8 * quad;
#define CR_DMAK(j) __builtin_amdgcn_global_load_lds((const unsigned*)(Kb + (size_t)(j) * 4096 + foff), (LAS unsigned*)(lds + AT_RING + ((j) & (AT_NS - 1)) * AT_SLOT + w * 1024), 16, 0, 0)
#define CR_DMAV(j) __builtin_amdgcn_global_load_lds((const unsigned*)(Vb + (size_t)(j) * 4096 + foff), (LAS unsigned*)(lds + AT_RING + ((j) & (AT_NS - 1)) * AT_SLOT + 8192 + w * 1024), 16, 0, 0)
    float lsa = 0.f, lsb = 0.f;
    asm volatile("s_waitcnt vmcnt(0)" ::: "memory"); __builtin_amdgcn_s_barrier(); asm volatile("" ::: "memory");
    for (int j = 0; j < AT_NS - 1; ++j) if (j < nb) CR_DMAK(j);
    for (int j = 0; j < nb; ++j) {
        AT_RING_WAIT1(nb - 1 - j);
        __builtin_amdgcn_s_barrier(); asm volatile("" ::: "memory");
        if (j + AT_NS - 1 < nb) CR_DMAK(j + AT_NS - 1);
        if (64 * j < B.nvt) {
            const LAS unsigned char* sl = lds + AT_RING + (j & (AT_NS - 1)) * AT_SLOT + lane * 16;
            bf16x8 kf[8];
#pragma unroll
            for (int f = 0; f < 8; ++f) kf[f] = *(const LAS bf16x8*)(sl + f * 1024);
            if (64 * j < A.nvt) cmp_p1_step(kf, A, nref, j, lane, lsa);
            cmp_p1_step(kf, B, nref, j, lane, lsb); }
    }
    lsa += __shfl_xor(lsa, 16); lsa += __shfl_xor(lsa, 32); lsb += __shfl_xor(lsb, 16); lsb += __shfl_xor(lsb, 32);
    const float rla = lsa > 0.f ? 1.0f / lsa : 0.f, rlb = lsb > 0.f ? 1.0f / lsb : 0.f;
#pragma unroll
    for (int dt = 0; dt < 4; ++dt) { oa[dt] = (f32x4){0.f, 0.f, 0.f, 0.f}; ob[dt] = (f32x4){0.f, 0.f, 0.f, 0.f}; }
    float ca = 0.f, cb = 0.f;
    asm volatile("s_waitcnt vmcnt(0)" ::: "memory"); __builtin_amdgcn_s_barrier(); asm volatile("" ::: "memory");
    for (int j = 0; j < AT_NS - 1; ++j) if (j < nb) { CR_DMAK(j); CR_DMAV(j); }
    for (int j = 0; j < nb; ++j) {
        AT_RING_WAIT2(nb - 1 - j);
        __builtin_amdgcn_s_barrier(); asm volatile("" ::: "memory");
        if (j + AT_NS - 1 < nb) { CR_DMAK(j + AT_NS - 1); CR_DMAV(j + AT_NS - 1); }
        const LAS unsigned char* sl = lds + AT_RING + (j & (AT_NS - 1)) * AT_SLOT + lane * 16;
        f32x4 pA[4], pB[4];
        {   bf16x8 kf[8];
#pragma unroll
            for (int f = 0; f < 8; ++f) kf[f] = *(const LAS bf16x8*)(sl + f * 1024);
            cmp_p2_qk(kf, A, nref, rla, j, lane, ca, imps, pA);
            cmp_p2_qk(kf, B, nref, rlb, j, lane, cb, imps + 512, pB); }
        asm volatile("" ::: "memory");
        {   bf16x8 vf[8];
#pragma unroll
            for (int f = 0; f < 8; ++f) vf[f] = *(const LAS bf16x8*)(sl + 8192 + f * 1024);
            pv_acc(vf, pA, oa); pv_acc(vf, pB, ob); }
    }
#undef CR_DMAK
#undef CR_DMAV
    select_topk(imps, cur, lane, ma);
    select_topk(imps + 512, cur, lane, mb);
}

__device__ __forceinline__ void qk_exp(const bf16x8 (&kf)[8], bf16x8 q0, bf16x8 q1, float cinit, bool masked, int kpos0, int lo, int hi, int lane, f32x4 (&p)[4], float& lsum) {
    const int quad = lane >> 4;
#pragma unroll
    for (int kt = 0; kt < 4; ++kt) { f32x4 s = {cinit, cinit, cinit, cinit}; s = MFMA16(kf[2 * kt], q0, s); s = MFMA16(kf[2 * kt + 1], q1, s);
#pragma unroll
        for (int r = 0; r < 4; ++r) p[kt][r] = fexp2(s[r]); }
    if (masked) {
#pragma unroll
        for (int kt = 0; kt < 4; ++kt)
#pragma unroll
            for (int r = 0; r < 4; ++r) { const int kpos = kpos0 + 16 * kt + 4 * quad + r; p[kt][r] = (kpos >= lo && kpos <= hi) ? p[kt][r] : 0.f; } }
#pragma unroll
    for (int kt = 0; kt < 4; ++kt) lsum += (p[kt][0] + p[kt][1]) + (p[kt][2] + p[kt][3]);
}
__device__ __forceinline__ void pv_acc(const bf16x8 (&vf)[8], const f32x4 (&p)[4], f32x4 (&o)[4]) {
#pragma unroll
    for (int ks = 0; ks < 2; ++ks) {
        v4u pw; pw.x = pk2(p[2 * ks][0], p[2 * ks][1]); pw.y = pk2(p[2 * ks][2], p[2 * ks][3]); pw.z = pk2(p[2 * ks + 1][0], p[2 * ks + 1][1]); pw.w = pk2(p[2 * ks + 1][2], p[2 * ks + 1][3]);
        const bf16x8 pb = __builtin_bit_cast(bf16x8, pw);
#pragma unroll
        for (int dt = 0; dt < 4; ++dt) o[dt] = MFMA16(vf[2 * dt + ks], pb, o[dt]); }
}
struct TileB { bf16x8 q0, q1; int tb, tq; float gate; };
template <int BR>
__device__ __forceinline__ void attn_branch2(const bf16* Kb, const bf16* Vb, LAS unsigned char* lds, int t0, int cur, float ref, const TileB& A, const TileB& B,
                                             const unsigned (&ma)[4], const unsigned (&mb)[4], const unsigned (&una)[4], const unsigned (&unb)[4], const unsigned (&uu)[4],
                                             int w, int lane, LAS unsigned char* parkA, LAS unsigned char* parkB) {
    const int col = lane & 15, quad = lane >> 4;
    int nblk, wlo = 0;
    unsigned c0 = uu[0], c1 = uu[1], c2 = uu[2], c3 = uu[3], p0 = uu[0], p1 = uu[1], p2 = uu[2], p3 = uu[3];
    if (BR == 0) nblk = __builtin_popcount(c0) + __builtin_popcount(c1) + __builtin_popcount(c2) + __builtin_popcount(c3);
    else { wlo = (t0 >= WIN ? t0 - WIN : 0) >> 6; nblk = cur - wlo + 1; }
    const size_t foff = (size_t)(16 * (w >> 1) + col) * 64 + 32 * (w & 1) + 8 * quad;
#define AT_BITNEXT(a, b, c, d, out) do { if (a) { out = __builtin_ctz(a); a &= a - 1u; } else if (b) { out = 32 + __builtin_ctz(b); b &= b - 1u; } else if (c) { out = 64 + __builtin_ctz(c); c &= c - 1u; } else { out = 96 + __builtin_ctz(d); d &= d - 1u; } } while (0)
#define AT_DMA(j) do { int sg_; if (BR == 0) AT_BITNEXT(p0, p1, p2, p3, sg_); else sg_ = wlo + (j); LAS unsigned char* sl_ = lds + AT_RING + ((j) & (AT_NS - 1)) * AT_SLOT + w * 1024; \
        __builtin_amdgcn_global_load_lds((const unsigned*)(Kb + (size_t)sg_ * 4096 + foff), (LAS unsigned*)sl_, 16, 0, 0); \
        __builtin_amdgcn_global_load_lds((const unsigned*)(Vb + (size_t)sg_ * 4096 + foff), (LAS unsigned*)(sl_ + 8192), 16, 0, 0); } while (0)
    f32x4 oa[4], ob[4]; float lsa = 0.f, lsb = 0.f;
#pragma unroll
    for (int dt = 0; dt < 4; ++dt) { oa[dt] = (f32x4){0.f, 0.f, 0.f, 0.f}; ob[dt] = (f32x4){0.f, 0.f, 0.f, 0.f}; }
    asm volatile("s_waitcnt vmcnt(0)" ::: "memory");
    __builtin_amdgcn_s_barrier();
    asm volatile("" ::: "memory");
    for (int j = 0; j < AT_NS - 1; ++j) if (j < nblk) AT_DMA(j);
    for (int j = 0; j < nblk; ++j) {
        AT_RING_WAIT2(nblk - 1 - j);
        __builtin_amdgcn_s_barrier();
        asm volatile("" ::: "memory");
        if (j + AT_NS - 1 < nblk) AT_DMA(j + AT_NS - 1);
        int sg; if (BR == 0) AT_BITNEXT(c0, c1, c2, c3, sg); else sg = wlo + j;
        bool na, nbb, mka, mkb;
        if (BR == 0) { const int sw = sg >> 5; const unsigned bit = 1u << (sg & 31);
            const unsigned wa = sw == 0 ? una[0] : sw == 1 ? una[1] : sw == 2 ? una[2] : una[3], wb = sw == 0 ? unb[0] : sw == 1 ? unb[1] : sw == 2 ? unb[2] : unb[3];
            int sgo = sg; asm volatile("" : "+s"(sgo));
            na = (wa & bit) != 0u; nbb = (wb & bit) != 0u; mka = mkb = sgo == cur;
            }
        else { na = (64 * sg + 63 >= A.tb - WIN) && (64 * sg <= A.tb + 3); mka = (64 * sg + 63 > A.tb) || (64 * sg < A.tb + 3 - WIN);
               nbb = (64 * sg + 63 >= B.tb - WIN) && (64 * sg <= B.tb + 3); mkb = (64 * sg + 63 > B.tb) || (64 * sg < B.tb + 3 - WIN); }
        if (na || nbb) {
            const LAS unsigned char* sl = lds + AT_RING + (j & (AT_NS - 1)) * AT_SLOT + lane * 16;
            const int sw = sg >> 5;
            float cia = ref, cib = ref;
            if (BR == 0) { const unsigned mwa = sw == 0 ? ma[0] : sw == 1 ? ma[1] : sw == 2 ? ma[2] : ma[3], mwb = sw == 0 ? mb[0] : sw == 1 ? mb[1] : sw == 2 ? mb[2] : mb[3];
                cia = ((mwa >> (sg & 31)) & 1u) ? ref : -1e30f; cib = ((mwb >> (sg & 31)) & 1u) ? ref : -1e30f; }
            f32x4 pA[4], pB[4];
            {   bf16x8 kf[8];
#pragma unroll
                for (int f = 0; f < 8; ++f) kf[f] = *(const LAS bf16x8*)(sl + f * 1024);
                if (na) qk_exp(kf, A.q0, A.q1, cia, mka, 64 * sg, BR == 0 ? 0 : A.tq - WIN, A.tq, lane, pA, lsa);
                if (nbb) qk_exp(kf, B.q0, B.q1, cib, mkb, 64 * sg, BR == 0 ? 0 : B.tq - WIN, B.tq, lane, pB, lsb); }
            asm volatile("" ::: "memory");
            {   bf16x8 vf[8];
#pragma unroll
                for (int f = 0; f < 8; ++f) vf[f] = *(const LAS bf16x8*)(sl + 8192 + f * 1024);
                if (na) pv_acc(vf, pA, oa);
                if (nbb) pv_acc(vf, pB, ob); }
        }
    }
#undef AT_BITNEXT
#undef AT_DMA
    lsa += __shfl_xor(lsa, 16); lsa += __shfl_xor(lsa, 32); lsb += __shfl_xor(lsb, 16); lsb += __shfl_xor(lsb, 32);
    const float sca = lsa > 0.f ? A.gate / lsa : 0.f, scb = lsb > 0.f ? B.gate / lsb : 0.f;
#pragma unroll
    for (int dt = 0; dt < 4; ++dt) { LAS f32x4* pa_ = (LAS f32x4*)(parkA + dt * 1024); LAS f32x4* pb_ = (LAS f32x4*)(parkB + dt * 1024); *pa_ = *pa_ + oa[dt] * sca; *pb_ = *pb_ + ob[dt] * scb; }
}

__device__ __forceinline__ void attn_prompt_unit(const Params& P, int unit, const AttnRefs& rf, LAS unsigned char* lds, int lane, int wave) {
    unsigned char* ws = P.ws;
    const int w = wave;
    const int gam = unit & 7, pt64 = unit >> 3, b = gam >> 2, g = gam & 3, t0 = 64 * pt64, cur = t0 >> 6;
    const int col = lane & 15, quad = lane >> 4, ql = col >> 2, hl = col & 3;
    LAS unsigned* UNI = (LAS unsigned*)(lds + AT_UNI);
    LAS float* imps = (LAS float*)(lds + AT_IMPS) + wave * 1024;
    const bf16* QN = (const bf16*)(ws + WS_QN); const bf16* QR = (const bf16*)(ws + WS_QR);
    const int tba = t0 + 8 * w, tbb = tba + 4, tqa = tba + ql, tqb = tbb + ql;
    const size_t qoa = (size_t)(b * SEQ + tqa) * D + (4 * g + hl) * 64 + 8 * quad, qob = qoa + 4 * D;
    f32x4 oa[4], ob[4]; unsigned ma[4], mb[4];
    {   TileQ A, B;
        A.q0 = *(const bf16x8*)(QN + qoa); A.q1 = *(const bf16x8*)(QN + qoa + 32); B.q0 = *(const bf16x8*)(QN + qob); B.q1 = *(const bf16x8*)(QN + qob + 32);
        A.tb = tba; A.tq = tqa; B.tb = tbb; B.tq = tqb;
        A.nvis = tqa >= 31 ? ((tqa - 31) >> 4) + 1 : 0; B.nvis = tqb >= 31 ? ((tqb - 31) >> 4) + 1 : 0;
        A.nvt = (tba + 3) >= 31 ? ((tba + 3 - 31) >> 4) + 1 : 0; B.nvt = (tbb + 3) >= 31 ? ((tbb + 3 - 31) >> 4) + 1 : 0;
        const int nvu = (t0 + 63) >= 31 ? ((t0 + 63 - 31) >> 4) + 1 : 0, nb = (nvu + 63) >> 6;
        attn_cmp_ring2((const bf16*)(ws + WS_KCP) + (size_t)gam * 512 * 64, (const bf16*)(ws + WS_VCTP) + (size_t)gam * 8 * 4096, lds, A, B, nb, cur, rf.cmp, imps, w, lane, oa, ob, ma, mb); }
    const float* gta = (const float*)(ws + WS_GATES) + (size_t)(b * SEQ + tqa) * 48 + (4 * g + hl) * 3; const float* gtb = gta + 4 * 48;
    LAS unsigned char* parkA = lds + AT_PARKA + w * 4096 + lane * 16; LAS unsigned char* parkB = lds + AT_PARKB + w * 4096 + lane * 16;
    {   const float ga = gta[0], gb = gtb[0];
#pragma unroll
        for (int dt = 0; dt < 4; ++dt) { *(LAS f32x4*)(parkA + dt * 1024) = oa[dt] * ga; *(LAS f32x4*)(parkB + dt * 1024) = ob[dt] * gb; } }
    unsigned una[4], unb[4];
#pragma unroll
    for (int k = 0; k < 4; ++k) { unsigned u = ma[k]; u |= (unsigned)__shfl_xor((int)u, 4); u |= (unsigned)__shfl_xor((int)u, 8); una[k] = (unsigned)__builtin_amdgcn_readfirstlane((int)u);
        unsigned v = mb[k]; v |= (unsigned)__shfl_xor((int)v, 4); v |= (unsigned)__shfl_xor((int)v, 8); unb[k] = (unsigned)__builtin_amdgcn_readfirstlane((int)v); }
    if (lane == 0) *(LAS v4u*)(UNI + w * 4) = (v4u){una[0] | unb[0], una[1] | unb[1], una[2] | unb[2], una[3] | unb[3]};
    __syncthreads();
    unsigned uu[4];
#pragma unroll
    for (int k = 0; k < 4; ++k) { unsigned x = 0u;
#pragma unroll
        for (int t = 0; t < 8; ++t) x |= UNI[4 * t + k];
        uu[k] = (unsigned)__builtin_amdgcn_readfirstlane((int)x); }
    TileB A, B;
    A.q0 = *(const bf16x8*)(QR + qoa); A.q1 = *(const bf16x8*)(QR + qoa + 32); B.q0 = *(const bf16x8*)(QR + qob); B.q1 = *(const bf16x8*)(QR + qob + 32);
    A.tb = tba; A.tq = tqa; B.tb = tbb; B.tq = tqb;
    A.gate = gta[1]; B.gate = gtb[1];
    attn_branch2<0>((const bf16*)(ws + WS_KS) + (size_t)gam * SEQ * 64, (const bf16*)(ws + WS_VST) + (size_t)gam * 128 * 4096, lds, t0, cur, rf.slc, A, B, ma, mb, una, unb, uu, w, lane, parkA, parkB);
    A.gate = gta[2]; B.gate = gtb[2];
    attn_branch2<1>((const bf16*)(ws + WS_KW) + (size_t)gam * SEQ * 64, (const bf16*)(ws + WS_VWT) + (size_t)gam * 128 * 4096, lds, t0, cur, rf.win, A, B, ma, mb, una, unb, uu, w, lane, parkA, parkB);
    bf16* opa = (bf16*)(ws + WS_O) + (size_t)(b * SEQ + tqa) * D + (4 * g + hl) * 64 + 4 * quad; bf16* opb = opa + 4 * D;
#pragma unroll
    for (int dt = 0; dt < 4; ++dt) { const f32x4 xa = *(const LAS f32x4*)(parkA + dt * 1024), xb = *(const LAS f32x4*)(parkB + dt * 1024);
        v2u wv; wv.x = pk2(xa[0], xa[1]); wv.y = pk2(xa[2], xa[3]); *(v2u*)(opa + 16 * dt) = wv;
        v2u wb; wb.x = pk2(xb[0], xb[1]); wb.y = pk2(xb[2], xb[3]); *(v2u*)(opb + 16 * dt) = wb; }
}

struct DecState { float m[4], l[4]; float o[4][8]; };
__device__ __forceinline__ void dec_step(const f32x4 (&kk)[2], const f32x4 (&vv)[2], bool ok, const unsigned (&qp)[4][4], DecState& st) {
#pragma unroll
    for (int h = 0; h < 4; ++h) {
        float d = (kk[0][0] * bflo(qp[h][0]) + kk[0][1] * bfhi(qp[h][0])) + (kk[0][2] * bflo(qp[h][1]) + kk[0][3] * bfhi(qp[h][1]))
                + (kk[1][0] * bflo(qp[h][2]) + kk[1][1] * bfhi(qp[h][2])) + (kk[1][2] * bflo(qp[h][3]) + kk[1][3] * bfhi(qp[h][3]));
        d += dpp_xor1(d); d += dpp_xor2(d); d += __shfl_xor(d, 4);
        const float sc = ok ? d : -1e30f, mn = fmaxf(st.m[h], sc), al = fexp2(st.m[h] - mn), p = ok ? fexp2(sc - mn) : 0.f;
        st.m[h] = mn; st.l[h] = st.l[h] * al + p;
#pragma unroll
        for (int j = 0; j < 2; ++j)
#pragma unroll
            for (int i = 0; i < 4; ++i) st.o[h][4 * j + i] = st.o[h][4 * j + i] * al + p * vv[j][i]; }
}
__device__ __forceinline__ void dec_job(const float* kbase, const float* vbase, int nkeys, const unsigned (&qp)[4][4], DecState& st, int lane) {
    const int ks8 = lane >> 3, d8 = lane & 7;
    const float* kp = kbase + (size_t)ks8 * 256 + 8 * d8; const float* vp = vbase + (size_t)ks8 * 256 + 8 * d8;
    const f32x4 z4 = {0.f, 0.f, 0.f, 0.f};
    f32x4 kc[2][2], vc[2][2], kn[2][2], vn[2][2];
#pragma unroll
    for (int a = 0; a < 2; ++a) { const bool ok0 = 8 * a + ks8 < nkeys;
#pragma unroll
        for (int j = 0; j < 2; ++j) { kc[a][j] = ok0 ? *(const f32x4*)(kp + (size_t)(8 * a) * 256 + 4 * j) : z4; vc[a][j] = ok0 ? *(const f32x4*)(vp + (size_t)(8 * a) * 256 + 4 * j) : z4; kn[a][j] = kc[a][j]; vn[a][j] = vc[a][j]; } }
#pragma unroll 1
    for (int k0 = 0; k0 < nkeys; k0 += 16) {
        if (k0 + 16 < nkeys) {
#pragma unroll
            for (int a = 0; a < 2; ++a) { const bool okn = k0 + 16 + 8 * a + ks8 < nkeys;
#pragma unroll
                for (int j = 0; j < 2; ++j) { kn[a][j] = okn ? *(const f32x4*)(kp + (size_t)(k0 + 16 + 8 * a) * 256 + 4 * j) : z4; vn[a][j] = okn ? *(const f32x4*)(vp + (size_t)(k0 + 16 + 8 * a) * 256 + 4 * j) : z4; } } }
        dec_step(kc[0], vc[0], k0 + ks8 < nkeys, qp, st);
        dec_step(kc[1], vc[1], k0 + 8 + ks8 < nkeys, qp, st);
#pragma unroll
        for (int a = 0; a < 2; ++a)
#pragma unroll
            for (int j = 0; j < 2; ++j) { kc[a][j] = kn[a][j]; vc[a][j] = vn[a][j]; } }
}

__device__ __forceinline__ void dec_publish(DecState& st, LAS float* slot, int lane) {
    const int d8 = lane & 7;
#pragma unroll
    for (int h = 0; h < 4; ++h) { float M = st.m[h]; M = fmaxf(M, __shfl_xor(M, 8)); M = fmaxf(M, __shfl_xor(M, 16)); M = fmaxf(M, __shfl_xor(M, 32));
        const float f = fexp2(st.m[h] - M); st.m[h] = M; float l = st.l[h] * f; l += __shfl_xor(l, 8); l += __shfl_xor(l, 16); l += __shfl_xor(l, 32); st.l[h] = l;
#pragma unroll
        for (int i = 0; i < 8; ++i) { float v = st.o[h][i] * f; v += __shfl_xor(v, 8); v += __shfl_xor(v, 16); v += __shfl_xor(v, 32); st.o[h][i] = v; } }
    if (lane < 8) {
#pragma unroll
        for (int h = 0; h < 4; ++h) { LAS float* pp = slot + h * 66; if (lane == 0) { pp[0] = st.m[h]; pp[1] = st.l[h]; }
#pragma unroll
            for (int i = 0; i < 8; ++i) pp[2 + 8 * d8 + i] = st.o[h][i]; } }
}
__device__ __forceinline__ void dec_reset(DecState& st) {
#pragma unroll
    for (int h = 0; h < 4; ++h) { st.m[h] = -1e30f; st.l[h] = 0.f;
#pragma unroll
        for (int i = 0; i < 8; ++i) st.o[h][i] = 0.f; }
}
__device__ __forceinline__ void attn_sample_item(const Params& P, int item, const AttnRefs& rf, LAS float* L, int tid, int lane, int wave) {
    unsigned char* ws = P.ws;
    const int s = item >> 2, g = item & 3, row = MP + s;
    LAS float* ocs = L; LAS unsigned* sel = (LAS unsigned*)(L + 256); LAS float* part = L + 260; LAS float* imps = L + 260 + 15 * 4 * 66;
    const float* gates = (const float*)(ws + WS_GATES) + (size_t)row * 48 + 4 * g * 3;
    const int d8 = lane & 7;
    unsigned qp[4][4];
    {   const bf16* QR = (const bf16*)(ws + WS_QR) + (size_t)row * D + 4 * g * 64 + 8 * d8;
#pragma unroll
        for (int h = 0; h < 4; ++h) { const v4u a = *(const v4u*)(QR + h * 64); qp[h][0] = a.x; qp[h][1] = a.y; qp[h][2] = a.z; qp[h][3] = a.w; } }
    DecState st;
    if (wave == 0) {
        const int col = lane & 15, quad = lane >> 4, ql = col >> 2, hl = col & 3;
        const size_t qoff = (size_t)row * D + (4 * g + hl) * 64 + 8 * quad; const bf16* QN = (const bf16*)(ws + WS_QN);
        const bf16x8 qn0 = *(const bf16x8*)(QN + qoff), qn1 = *(const bf16x8*)(QN + qoff + 32);
        f32x4 oc[4]; unsigned msk[4];
        attn_cmp_select((const bf16*)(ws + WS_KCS) + (size_t)item * 128 * 64, (const bf16*)(ws + WS_VCTS) + (size_t)item * 2 * 4096, 64, qn0, qn1, 127, 8, 32, rf.cmp, imps, lane, oc, msk);
        const float g0 = gates[hl * 3];
        if (ql == 0) {
#pragma unroll
            for (int dt = 0; dt < 4; ++dt)
#pragma unroll
                for (int r = 0; r < 4; ++r) ocs[hl * 64 + 16 * dt + 4 * quad + r] = oc[dt][r] * g0; }
        if (lane == 0) sel[0] = msk[0];
    } else {
        dec_reset(st);
#pragma unroll 1
        for (int J = wave - 1; J <= 8; J += 7) { const float* kb; const float* vb; int nk = 64;
            if (J == 8) { const size_t base = ((size_t)s * WIN + (WIN - 1)) * 256 + g * 64; kb = P.out + O_WKS + base; vb = P.out + O_WVS + base; nk = 1; }
            else { const size_t base = ((size_t)s * WIN + 64 * J) * 256 + g * 64; kb = P.in[6] + base; vb = P.in[7] + base; }
            dec_job(kb, vb, nk, qp, st, lane); }
        dec_publish(st, part + (8 + wave - 1) * 4 * 66, lane);
    }
    __syncthreads();
    {   const unsigned m0 = sel[0];
        const int* pt = (const int*)P.in[8] + s * 16;
        dec_reset(st);
#pragma unroll 1
        for (int J = wave; J <= 15; J += 8) { const float* kb; const float* vb; int nk = 64;
            if (J == 15) { kb = P.out + O_SKS + (size_t)s * 256 + g * 64; vb = P.out + O_SVS + (size_t)s * 256 + g * 64; nk = 1; }
            else { unsigned bits = m0; for (int i = 0; i < J; ++i) bits &= bits - 1u; const int sg = bits ? __builtin_ctz(bits) : 0;
                const size_t base = ((size_t)pt[sg >> 1] * 128 + (sg & 1) * 64) * 256 + g * 64; kb = P.in[4] + base; vb = P.in[5] + base; }
            dec_job(kb, vb, nk, qp, st, lane); }
        dec_publish(st, part + wave * 4 * 66, lane);
    }
    __syncthreads();
    if (tid < 256) { const int h = tid >> 6, d = tid & 63;
        float res = ocs[h * 64 + d];
#pragma unroll
        for (int br = 0; br < 2; ++br) { const int w0 = br ? 8 : 0, w1 = br ? 15 : 8; float M = -1e30f;
            for (int w = w0; w < w1; ++w) M = fmaxf(M, part[(w * 4 + h) * 66]);
            float Lt = 0.f, Ot = 0.f;
            for (int w = w0; w < w1; ++w) { const LAS float* pp = part + (w * 4 + h) * 66; const float f = fexp2(pp[0] - M); Lt += pp[1] * f; Ot += pp[2 + d] * f; }
            res += (Lt > 0.f ? Ot / Lt : 0.f) * gates[h * 3 + 1 + br]; }
        ((bf16*)(ws + WS_O))[(size_t)row * D + (4 * g + h) * 64 + d] = (bf16)(pk2(res, 0.f) & 0xffffu); }
    __syncthreads();
}

__device__ __forceinline__ void attn_refs(const Params& P, int lane, AttnRefs& rf) {
    float qg = fabsf(P.in[20][lane]), k0 = fabsf(P.in[24][lane]), k1 = fabsf(P.in[24][64 + lane]), k2 = fabsf(P.in[24][128 + lane]);
    qg = wave_max(qg); k0 = wave_max(k0); k1 = wave_max(k1); k2 = wave_max(k2);
    rf.cmp = -8.0f * 1.4426950409f * qg * k0; rf.slc = -8.0f * 1.4426950409f * qg * k1; rf.win = -8.0f * 1.4426950409f * qg * k2;
}
__device__ __forceinline__ void phase_attn(const Params& P, const AttnRefs& rf, LAS unsigned char* lds, int tid, int lane, int wave) {
    {
        for (int k = 0; k < ATT_REP_P; ++k)
        for (int u0 = blockIdx.x; u0 < 1024; u0 += gridDim.x) { const int gam = u0 & 7, p0 = u0 >> 3, kk = p0 >> 5; const int pt64 = (kk & 1) ? (32 * kk + 31 - (p0 & 31)) : p0;
            attn_prompt_unit(P, pt64 * 8 + gam, rf, lds, lane, wave); } }
    const int gtid = blockIdx.x * 512 + tid, ngt = gridDim.x * 512;
    for (int e = gtid; e < (M65 - MT) * 128; e += ngt) *(v4u*)((bf16*)(P.ws + WS_O) + (size_t)MT * D + (size_t)e * 8) = (v4u){0u, 0u, 0u, 0u};
}

constexpr int NPHASE = 15;
__global__ void __launch_bounds__(NWAVES * 64, 2) fwd(Params P) {
    extern __shared__ __attribute__((aligned(16))) unsigned char lds_raw[];
    LAS unsigned char* lds = (LAS unsigned char*)lds_raw;
    const int tid = threadIdx.x, lane = tid & 63, wave = __builtin_amdgcn_readfirstlane(tid >> 6);
    const int G = gridDim.x;
    unsigned char* ws = P.ws;
    for (int u = tid; u < (LDS_BYTES - LDSCTL_OFF) / 4; u += NWAVES * 64) ((LAS unsigned*)(lds + LDSCTL_OFF))[u] = 0u;
    __syncthreads();
    XcdBarrier bar; bar.bar = (unsigned*)(ws + WS_CTL) + CW_BAR; bar.x = 0; bar.st = nullptr;
#if !MK_PER_PHASE
    bar = xcd_barrier_post((unsigned*)(ws + WS_CTL) + CW_BAR, (volatile LAS unsigned*)(lds + MISC_OFF) + 8);
#endif
    const int lo = P.ph_lo, hi = P.ph_hi;
#ifndef PH_MASK
#define PH_MASK 0x7fff
#endif
#define EN(k) (((PH_MASK) >> (k)) & 1)
#ifndef REP_MASK
#define REP_MASK 0
#endif
#define REPS(k) ((((REP_MASK) >> (k)) & 1) + 1)
#define IN(k) (lo <= (k) && (k) < hi)
#ifdef PROBE_PH
#define STAMP2(k) do { if (blockIdx.x == 0 && tid == 0) ((unsigned long long*)(ws + WS_CTL + 65536))[32 + (k)] = __builtin_amdgcn_s_memrealtime(); } while (0)
#define STAMP3(k) do { if (blockIdx.x == 0 && tid == 0) ((unsigned long long*)(ws + WS_CTL + 65536))[64 + (k)] = __builtin_amdgcn_s_memrealtime(); } while (0)
#else
#define STAMP2(k) do { } while (0)
#define STAMP3(k) do { } while (0)
#endif

#if MK_PER_PHASE
#define GRID_BAR(k) do { } while (0)
#else
#ifdef PROBE_PH
#define GRID_BAR(k) do { if ((k) + 1 < hi) xcd_barrier(bar); if (blockIdx.x == 0 && tid == 0) ((unsigned long long*)(ws + WS_CTL + 65536))[(k) + 1] = __builtin_amdgcn_s_memrealtime(); } while (0)
#else
#define GRID_BAR(k) do { if ((k) + 1 < hi) xcd_barrier(bar); } while (0)
#endif
#endif
    bf16* WBIG = (bf16*)(ws + WS_WBIG); bf16* ACTA = (bf16*)(ws + WS_ACTA); bf16* XB = (bf16*)(ws + WS_AKV); float* SSQ = (float*)(ws + WS_SSQ);
    float* MOD = (float*)(ws + WS_MOD); float* BIAS = (float*)(ws + WS_BIAS); float* ROPE = (float*)(ws + WS_ROPE);
    const size_t SSQ_STRIDE = (size_t)M65;

#ifdef PROBE_PH
    if (blockIdx.x == 0 && tid == 0) ((unsigned long long*)(ws + WS_CTL + 65536))[0] = __builtin_amdgcn_s_memrealtime();
#endif
    if (EN(0) && IN(0)) { for (int rep_ = 0; rep_ < REPS(0); ++rep_) phase0(P, lds, tid, lane, wave); GRID_BAR(0); }
    if (EN(1) && IN(1)) {
        pg8::Gemm g{(const bf16*)(ws + WS_SC), (const bf16*)(ws + WS_WADA), 256, NMOD, 1024, 1024, 1 << 30, 0}; pg8::StaticOrder S; S.init(256, NMOD, G, (int)blockIdx.x);
        EpiMod E{MOD, (bf16*)(ws + WS_SH), P.in[12]};
        pg8::gemm_phase<EpiMod, true>(lds + RING_OFF, g, S, E);
        __syncthreads();
        for (int rep_ = 0; rep_ < REPS(18); ++rep_) phase1_weights(P, lds, lane, wave);
        GRID_BAR(1); }
    if (EN(2) && IN(2)) {
        pg8::Gemm g{(const bf16*)(ws + WS_SH), WBIG, 1024, NBIG, 1024, 1024, 1 << 30, 0}; pg8::StaticOrder S; S.init(1024, NBIG, G, (int)blockIdx.x); S.diag = 1;
        EpiBias E{BIAS};
        for (int rep_ = 0; rep_ < REPS(2); ++rep_) pg8::gemm_phase<EpiBias, true>(lds + RING_OFF, g, S, E);
        for (int rep_ = 0; rep_ < REPS(15); ++rep_) phase2_tail(P, tid, lane, wave);
        for (int rep_ = 0; rep_ < REPS(16); ++rep_) sample_prepass(P, tid, lane, wave);
        GRID_BAR(2); }
#ifdef NO_SKINNY
#define SKINNY_ON(x) do { } while (0)
#else
#define SKINNY_ON(x) x
#endif
#define COMMON_PHASES(layer) do { \
        const int po = layer ? 12 : 5; \
        if (EN(5) && IN(po)) { \
            pg8::Gemm g{layer ? (const bf16*)(ws + WS_O) : (const bf16*)(ws + WS_UM), layer ? (const bf16*)(ws + WS_WBO) : (const bf16*)(ws + WS_WOUT), MP, 1024, 1024, 1024, 1 << 30, 0}; \
            pg8::StaticOrder S; S.init(MP, 1024, G, (int)blockIdx.x); \
            EpiRes<(layer) == 0, false> E{P.in[0], P.in[1], XB, MOD, layer * 6144 + 2048, nullptr, XB, (const float*)(ws + WS_MUL) + (size_t)(layer ? 2 : 0) * 256 * 1024, ACTA, SSQ + (layer ? 4 : 2) * SSQ_STRIDE}; \
            for (int rep_ = 0; rep_ < (layer ? 1 : REPS(5)); ++rep_) pg8::gemm_phase<EpiRes<(layer) == 0, false>, false>(lds + RING_OFF, g, S, E); \
            STAMP2(po); SKINNY_ON(skinny_res(g.A, 1024, 1024, g.Bt, E, lds, tid, lane, wave)); STAMP3(po); \
            GRID_BAR(po); } \
        if (EN(6) && IN(po + 1)) { \
            const int off = layer ? OFF_GU1 : OFF_GU0; \
            pg8::Gemm g{ACTA, WBIG + (size_t)off * 1024, M65, NGU, 1024, 1024, 1 << 30, 0}; pg8::StaticOrder S; S.init(M65, NGU, G, (int)blockIdx.x); \
            EpiGU E{SSQ + (layer ? 4 : 2) * SSQ_STRIDE, BIAS, off, (bf16*)(ws + WS_HID)}; \
            for (int rep_ = 0; rep_ < (layer ? 1 : REPS(6)); ++rep_) pg8::gemm_phase<EpiGU, true>(lds + RING_OFF, g, S, E); \
            { const int nu = (M65 / 256) * (NGU / 256), nx = nu - (nu / G) * G; \
              if (nx > 0) { if ((int)blockIdx.x >= nx) window_copy(P, layer, (int)blockIdx.x - nx, G - nx, lane, wave); } else window_copy(P, layer, (int)blockIdx.x, G, lane, wave); } \
            GRID_BAR(po + 1); } \
        if (EN(7) && IN(po + 2)) { \
            pg8::Gemm g{(const bf16*)(ws + WS_HID), (const bf16*)(ws + WS_WDN) + (size_t)layer * 1024 * DFF, MP, 1024, DFF, DFF, 1 << 30, 0}; pg8::StaticOrder S; S.init(MP, 1024, G, (int)blockIdx.x); \
            EpiRes<false, (layer) == 1> E{nullptr, nullptr, XB, MOD, layer * 6144 + 5120, P.out, XB, (const float*)(ws + WS_MUL) + (size_t)256 * 1024, layer ? nullptr : ACTA, layer ? nullptr : SSQ + 3 * SSQ_STRIDE}; \
            pg8::gemm_phase<EpiRes<false, (layer) == 1>, false>(lds + RING_OFF, g, S, E); \
            STAMP2(po + 2); SKINNY_ON(skinny_res(g.A, DFF, DFF, g.Bt, E, lds, tid, lane, wave)); STAMP3(po + 2); \
            GRID_BAR(po + 2); } \
    } while (0)
            if (EN(3) && IN(3)) {
                pg8::Gemm g{ACTA, WBIG + (size_t)OFF_WIN * 1024, MP, NAIN, 1024, 1024, 1 << 30, 0}; pg8::StaticOrder S; S.init(MP, NAIN, G, (int)blockIdx.x);
                EpiAin E{SSQ, BIAS, (bf16*)(ws + WS_U), (bf16*)(ws + WS_V), SSQ + SSQ_STRIDE};
                for (int rep_ = 0; rep_ < REPS(3); ++rep_) pg8::gemm_phase<EpiAin, true>(lds + RING_OFF, g, S, E);
                skinny_ain(ACTA, WBIG + (size_t)OFF_WIN * 1024, E, lds, tid, lane, wave);
                GRID_BAR(3); }
            if (EN(4) && IN(4)) { for (int rep_ = 0; rep_ < REPS(4); ++rep_) phase_tokmix(P, lds, tid, lane, wave); GRID_BAR(4); }
    COMMON_PHASES(0);
            if (EN(8) && IN(8)) {
                { pg8::Gemm g{(const bf16*)(ws + WS_AKV), (const bf16*)(ws + WS_WKV), M65, NKV, 1024, 1024, 1 << 30, 0}; pg8::StaticOrder S; S.init(M65, NKV, G, (int)blockIdx.x);
                  EpiKV E{SSQ + 3 * SSQ_STRIDE, P.in[24], ROPE, P.out, (bf16*)(ws + WS_RC), (bf16*)(ws + WS_KS), (bf16*)(ws + WS_KW), (bf16*)(ws + WS_VST), (bf16*)(ws + WS_VWT)};
                  for (int rep_ = 0; rep_ < REPS(8); ++rep_) pg8::gemm_phase<EpiKV, true>(lds + RING_OFF, g, S, E); }
                { pg8::Gemm g{ACTA, WBIG + (size_t)OFF_Q * 1024, M65, NQP, 1024, 1024, 1 << 30, 0}; pg8::StaticOrder S; S.init(M65, NQP, G, (int)((blockIdx.x + 122) % G));
                  EpiQ E{SSQ + 3 * SSQ_STRIDE, BIAS, P.in[20], ROPE, (bf16*)(ws + WS_QN), (bf16*)(ws + WS_QR), (float*)(ws + WS_GATES)};
                  for (int rep_ = 0; rep_ < REPS(17); ++rep_) pg8::gemm_phase<EpiQ, true>(lds + RING_OFF, g, S, E); }
                GRID_BAR(8); }
            if (EN(9) && IN(9)) {
                constexpr int NCB = RC_PROMPT * 2 / 256;
                EpiCmp E{(const float*)(ws + WS_C1), (bf16*)(ws + WS_H2)};
                pg8::Gemm g{(const bf16*)(ws + WS_RC), (const bf16*)(ws + WS_W1C), 2 * RC_KV, 256, 2048, 1024, RC_KV / 256, (long)256 * 2048};
                {   pg8::StaticOrder S; S.init(2 * RC_SAMP, 256, G, (int)blockIdx.x); S.cut = RC_SAMP / 256; S.off0 = 0; S.off1 = RC_PROMPT / 256;
                    pg8::gemm_phase<EpiCmp, true>(lds + RING_OFF, g, S, E);
                    STAMP2(9); w2_own_units(P, lds, S, tid, lane, wave); STAMP3(9); }
#if !MK_PER_PHASE
                xcd_barrier(bar);
#endif
                AttnRefs rf; attn_refs(P, lane, rf);
                if ((int)blockIdx.x < NCB) {
                    pg8::StaticOrder S; S.init(2 * RC_PROMPT, 256, NCB, (int)blockIdx.x); S.cut = RC_PROMPT / 256; S.off0 = RC_SAMP / 256; S.off1 = RC_KV / 256 + RC_SAMP / 256 - RC_PROMPT / 256;
                    pg8::gemm_phase<EpiCmp, true>(lds + RING_OFF, g, S, E);
                    w2_own_units(P, lds, S, tid, lane, wave);
                    __syncthreads(); }
                {   unsigned* ticket = (unsigned*)(ws + WS_CTL) + 2048;
                    LAS unsigned* tk = (LAS unsigned*)(lds + RING_BYTES + 512);
                    for (;;) {
                        if (tid == 0) *tk = __hip_atomic_fetch_add(ticket, 1u, __ATOMIC_RELAXED, __HIP_MEMORY_SCOPE_AGENT);
                        __syncthreads();
                        const unsigned item = *tk;
                        __syncthreads();
                        if (item >= 512u) break;
                        attn_sample_item(P, (int)item, rf, (LAS float*)lds, tid, lane, wave); } }
                GRID_BAR(9); }
            if (EN(11) && IN(11)) {
                AttnRefs rf; attn_refs(P, lane, rf);
                phase_attn(P, rf, lds, tid, lane, wave); GRID_BAR(11); }
    COMMON_PHASES(1);
#ifdef PROBE_PH
    if (blockIdx.x == 0) {
        __syncthreads();
        const unsigned long long* st = (const unsigned long long*)(ws + WS_CTL + 65536);
        const int sel = (PROBE_PH) % 100; unsigned long long t1 = st[sel + 1], t0 = (PROBE_PH) >= 100 ? st[0] : st[sel];
        if ((PROBE_PH) >= 300) { t0 = st[32 + sel]; t1 = st[64 + sel]; } else if ((PROBE_PH) >= 200) { t0 = st[sel]; t1 = st[32 + sel]; }
        const float us = (float)(t1 - t0) * 0.01f; const float eps = sqrtf(us * (((PROBE_PH) >= 100 && (PROBE_PH) < 200) ? 1e-4f : 1e-3f));
        for (int e = tid; e < 128 * 1024; e += 512) P.out[O_AVS + e] *= (1.0f + eps); }
#endif
#undef IN
#undef EN
#undef REPS
#undef GRID_BAR
}

extern "C" void kernel_launch(void* const* d_in, const int* in_sizes, int n_in, void* d_out, int out_size, void* d_ws, size_t ws_size, hipStream_t stream) {
    static int grid = 0;
    if (grid == 0) {
        if (n_in != 32 || ws_size < WS_END) { fprintf(stderr, "kernel_launch: unexpected problem (n_in %d, ws %zu < %zu)\n", n_in, ws_size, (size_t)WS_END); grid = -1; return; }
        int dev = 0, cus = 0;
        if (hipGetDevice(&dev) != hipSuccess || hipDeviceGetAttribute(&cus, hipDeviceAttributeMultiprocessorCount, dev) != hipSuccess) { grid = -1; return; }
        if (hipFuncSetAttribute((const void*)fwd, hipFuncAttributeMaxDynamicSharedMemorySize, LDS_BYTES) != hipSuccess) { fprintf(stderr, "kernel_launch: hipFuncSetAttribute failed\n"); grid = -1; return; }
        int per_cu = 0;
        if (hipOccupancyMaxActiveBlocksPerMultiprocessor(&per_cu, (const void*)fwd, NWAVES * 64, LDS_BYTES) != hipSuccess || per_cu < 1) fprintf(stderr, "kernel_launch: occupancy query says %d\n", per_cu);
        (void)hipGetLastError();
        grid = cus;
    }
    if (grid < 0) return;
    (void)hipMemsetAsync((char*)d_ws + WS_CTL, 0, CTL_ZERO_BYTES, stream);
    Params p{};
    for (int i = 0; i < 32; ++i) p.in[i] = (const float*)d_in[i];
    p.out = (float*)d_out; p.ws = (unsigned char*)d_ws;
#if MK_PER_PHASE
    for (int k = 0; k < NPHASE; ++k) { p.ph_lo = k; p.ph_hi = k + 1; hipLaunchKernelGGL(fwd, dim3(grid), dim3(NWAVES * 64), LDS_BYTES, stream, p); }
#else
    p.ph_lo = 0; p.ph_hi = NPHASE;
    hipLaunchKernelGGL(fwd, dim3(grid), dim3(NWAVES * 64), LDS_BYTES, stream, p);
#endif
    const hipError_t le = hipPeekAtLastError();
    if (le != hipSuccess) fprintf(stderr, "kernel_launch: launch failed: %s\n", hipGetErrorName(le));
}
```

```cpp
#include <hip/hip_runtime.h>
#include <hip/hip_bf16.h>
#include <cstdio>
#include <cstdint>
#include <cmath>

#ifndef MK_PER_PHASE
#define MK_PER_PHASE 0
#endif

namespace pg8 {
#define PG8_LAS __attribute__((address_space(3)))
typedef unsigned short bf16_t;
typedef short bf16x8 __attribute__((ext_vector_type(8)));
typedef float f32x4 __attribute__((ext_vector_type(4)));
typedef unsigned u32x4 __attribute__((ext_vector_type(4)));
typedef unsigned u32x2 __attribute__((ext_vector_type(2)));
constexpr int BM = 256, BK = 64, HALF = 128, HTB = HALF * BK * 2, STAGE_BYTES = 8 * HTB, NXCD = 8, WGM = 8;

__host__ __device__ __forceinline__ int lds_byte(int r, int c) { const int st = (r >> 4) * 2 + (c >> 5), rr = r & 15, cc = c & 31, ob = rr * 64 + cc * 2; return st * 1024 + (ob ^ (((ob >> 9) & 1) << 5)); }
__host__ __device__ __forceinline__ void stage_rc(int b, int& R, int& C) { const int st = b / 1024, sb = b % 1024, swz = sb ^ (((sb >> 9) & 1) << 5); R = (st >> 1) * 16 + swz / 64; C = (st & 1) * 32 + (swz % 64) / 2; }
__host__ __device__ __forceinline__ int perm32(int rho) { const int n = rho >> 4, i = rho & 15; return 8 * (i >> 2) + 4 * n + (i & 3); }

struct Unit { int pm, pn; };
struct Gemm { const bf16_t* A; const bf16_t* Bt; int M, N, K, lda, bsplit; long boff; };

struct StaticOrder {
    int nM, nN, nwg, G, c;
    int cut = 1 << 30, off0 = 0, off1 = 0;
    int diag = 0;
    __host__ __device__ void init(int M, int N, int G_, int c_) { nM = M / BM; nN = N / BM; nwg = nM * nN; G = G_; c = c_; }
    __host__ __device__ bool next(int i, Unit& u) const {
        const long L = (long)i * G + c;
        if (diag) { if (L >= 57) return false; u.pn = (int)L; u.pm = L < 8 ? 0 : L < 30 ? 1 : L < 35 ? 2 : 3; return true; }
        if (L >= nwg) return false;
        int wgid = (int)L; { const int q = nwg / NXCD, r = nwg % NXCD, xcd = wgid % NXCD, off = wgid / NXCD; wgid = (xcd < r ? xcd * (q + 1) : r * (q + 1) + (xcd - r) * q) + off; }
        const int nig = WGM * nN, gid = wgid / nig, fm = gid * WGM, gsz = (nM - fm) < WGM ? (nM - fm) : WGM;
        u.pm = fm + ((wgid % nig) % gsz); u.pn = (wgid % nig) / gsz; u.pm += u.pm < cut ? off0 : off1; return true;
    }
};

template <class Epi, bool ALIGN_EPI>
__device__ __forceinline__ void gemm_phase(PG8_LAS unsigned char* lds, const Gemm g, const StaticOrder& S, const Epi& E) {
    const int tid = threadIdx.x, wid = __builtin_amdgcn_readfirstlane(tid >> 6), lane = tid & 63, wr = wid >> 2, wc = wid & 3, fr = lane & 15, fq = lane >> 4;
    const int K = g.K, nt = K / BK, lda = g.lda;
    unsigned voffA[2], voffB[2];
#pragma unroll
    for (int i = 0; i < 2; ++i) { int R, C; stage_rc(tid * 16 + i * 8192, R, C); const int Rb = ((R & ~31) + perm32(R & 31));
        voffA[i] = (unsigned)(R * lda + C) * 2u; voffB[i] = (unsigned)(Rb * K + C) * 2u; }
    const size_t kstep = (size_t)(BK * 2);
    const size_t hstepA = (size_t)HALF * lda * 2, hstepB = (size_t)HALF * K * 2;
    const size_t tstepA = 2 * hstepA, tstepB = 2 * hstepB;
    const unsigned ldsw = (unsigned)wid * 1024u;
    const int aoff = lds_byte(wr * 64 + fr, fq * 8), boff = lds_byte(wc * 32 + fr, fq * 8);
#define PG8_SA(b, h) (((b) * 2 + (h)) * HTB)
#define PG8_SB(b, h) ((4 + (b) * 2 + (h)) * HTB)
#define PG8_STAGE(bufoff, gbase, voff) do { _Pragma("unroll") for (int _i = 0; _i < 2; ++_i) \
        __builtin_amdgcn_global_load_lds((const unsigned*)((const char*)(gbase) + (voff)[_i]), (PG8_LAS unsigned*)(lds + (bufoff) + ldsw + _i * 8192), 16, 0, 0); } while (0)
#define PG8_LDA(dst, b, h) do { _Pragma("unroll") for (int m = 0; m < 4; ++m) _Pragma("unroll") for (int k = 0; k < 2; ++k) dst[m][k] = *(const PG8_LAS bf16x8*)(lds + PG8_SA(b, h) + aoff + m * 2048 + k * 1024); } while (0)
#define PG8_LDB(dst, b, h) do { _Pragma("unroll") for (int n = 0; n < 2; ++n) _Pragma("unroll") for (int k = 0; k < 2; ++k) dst[n][k] = *(const PG8_LAS bf16x8*)(lds + PG8_SB(b, h) + boff + n * 2048 + k * 1024); } while (0)
#define PG8_MMA(ai, bj, At, Bt) do { __builtin_amdgcn_s_setprio(1); _Pragma("unroll") for (int m = 0; m < 4; ++m) _Pragma("unroll") for (int n = 0; n < 2; ++n) _Pragma("unroll") for (int k = 0; k < 2; ++k) \
        acc[ai][bj][m][n] = __builtin_amdgcn_mfma_f32_16x16x32_bf16(Bt[n][k], At[m][k], acc[ai][bj][m][n], 0, 0, 0); __builtin_amdgcn_s_setprio(0); } while (0)
#define PG8_WAIT_V(n) asm volatile("s_waitcnt vmcnt(" #n ")" ::: "memory")
#define PG8_WAIT_L(n) asm volatile("s_waitcnt lgkmcnt(" #n ")" ::: "memory")
#define PG8_BAR __builtin_amdgcn_s_barrier()
#define PG8_SCHED __builtin_amdgcn_sched_barrier(0)
    Unit cur, nxt; int ui = 0;
    if (!S.next(0, cur)) return;
    f32x4 acc[2][2][4][2];
#pragma unroll
    for (int a = 0; a < 2; ++a)
#pragma unroll
        for (int b = 0; b < 2; ++b)
#pragma unroll
            for (int m = 0; m < 4; ++m)
#pragma unroll
                for (int n = 0; n < 2; ++n) acc[a][b][m][n] = (f32x4){0.f, 0.f, 0.f, 0.f};
    bf16x8 At[4][2], B0[2][2], B1[2][2];
    const char* cA = (const char*)g.A + (size_t)cur.pm * tstepA;
    const char* cB = (const char*)g.Bt + (cur.pm >= g.bsplit ? (size_t)g.boff * 2 : (size_t)0) + (size_t)cur.pn * tstepB;
    PG8_STAGE(PG8_SB(0, 0), cB, voffB); PG8_STAGE(PG8_SB(0, 1), cB + hstepB, voffB); PG8_STAGE(PG8_SA(0, 0), cA, voffA); PG8_STAGE(PG8_SA(0, 1), cA + hstepA, voffA);
    if (wr == 1) PG8_BAR;
    PG8_WAIT_V(2); PG8_BAR;
    PG8_STAGE(PG8_SB(1, 0), cB + kstep, voffB); PG8_STAGE(PG8_SA(1, 0), cA + kstep, voffA); PG8_STAGE(PG8_SB(1, 1), cB + hstepB + kstep, voffB);
    PG8_WAIT_V(6); PG8_BAR;
    for (;;) {
        const bool has_next = S.next(ui + 1, nxt);
        const char* nA = has_next ? (const char*)g.A + (size_t)nxt.pm * tstepA : cA;
        const char* nB = has_next ? (const char*)g.Bt + (nxt.pm >= g.bsplit ? (size_t)g.boff * 2 : (size_t)0) + (size_t)nxt.pn * tstepB : cB;
        for (int t = 0; t < nt; t += 2) {
            const bool last = (t == nt - 2);
            const char* a1 = cA + (size_t)(t + 1) * kstep;
            const char* a2 = last ? nA : cA + (size_t)(t + 2) * kstep; const char* b2 = last ? nB : cB + (size_t)(t + 2) * kstep;
            const char* a3 = a2 + kstep; const char* b3 = b2 + kstep;
            PG8_LDB(B0, 0, 0); PG8_LDB(B1, 0, 1); PG8_SCHED; PG8_LDA(At, 0, 0); PG8_STAGE(PG8_SA(1, 1), a1 + hstepA, voffA);
            PG8_WAIT_V(8); PG8_WAIT_L(0); PG8_BAR; PG8_MMA(0, 0, At, B0); PG8_MMA(0, 1, At, B1); PG8_BAR; PG8_SCHED;
            PG8_LDA(At, 0, 1); PG8_STAGE(PG8_SB(0, 0), b2, voffB); PG8_STAGE(PG8_SB(0, 1), b2 + hstepB, voffB); PG8_STAGE(PG8_SA(0, 0), a2, voffA);
            PG8_WAIT_V(8); PG8_WAIT_L(0); PG8_BAR; PG8_MMA(1, 0, At, B0); PG8_MMA(1, 1, At, B1); PG8_BAR; PG8_SCHED;
            PG8_LDB(B0, 1, 0); PG8_LDB(B1, 1, 1); PG8_SCHED; PG8_LDA(At, 1, 0); PG8_STAGE(PG8_SA(0, 1), a2 + hstepA, voffA);
            PG8_WAIT_V(8); PG8_WAIT_L(0); PG8_BAR; PG8_MMA(0, 0, At, B0); PG8_MMA(0, 1, At, B1); PG8_BAR; PG8_SCHED;
            PG8_LDA(At, 1, 1); PG8_STAGE(PG8_SB(1, 0), b3, voffB); PG8_STAGE(PG8_SB(1, 1), b3 + hstepB, voffB); PG8_STAGE(PG8_SA(1, 0), a3, voffA);
            PG8_WAIT_V(8); PG8_WAIT_L(0); PG8_BAR; PG8_MMA(1, 0, At, B0); PG8_MMA(1, 1, At, B1); PG8_BAR; PG8_SCHED;
        }
        if constexpr (ALIGN_EPI) { if (wr == 0) PG8_BAR; }
        E(acc, cur, wr, wc, fr, fq);
        if (!has_next) break;
#pragma unroll
        for (int a = 0; a < 2; ++a)
#pragma unroll
            for (int b = 0; b < 2; ++b)
#pragma unroll
                for (int m = 0; m < 4; ++m)
#pragma unroll
                    for (int n = 0; n < 2; ++n) acc[a][b][m][n] = (f32x4){0.f, 0.f, 0.f, 0.f};
        cur = nxt; cA = nA; cB = nB; ++ui;
        if constexpr (ALIGN_EPI) { if (wr == 1) PG8_BAR; }
    }
    PG8_WAIT_V(0);
    if constexpr (!ALIGN_EPI) { if (wr == 0) PG8_BAR; }
    PG8_BAR;
#undef PG8_SA
#undef PG8_SB
#undef PG8_STAGE
#undef PG8_LDA
#undef PG8_LDB
#undef PG8_MMA
#undef PG8_WAIT_V
#undef PG8_WAIT_L
#undef PG8_BAR
#undef PG8_SCHED
}
}

#define GAS __attribute__((address_space(1)))
#define LAS __attribute__((address_space(3)))
typedef unsigned short bf16;
typedef unsigned v4u __attribute__((ext_vector_type(4)));
typedef unsigned v2u __attribute__((ext_vector_type(2)));
typedef float f32x4 __attribute__((ext_vector_type(4)));
typedef float f32x2 __attribute__((ext_vector_type(2)));
typedef short bf16x8 __attribute__((ext_vector_type(8)));
typedef short bf16x4 __attribute__((ext_vector_type(4)));
typedef __bf16 bf16x2_t __attribute__((ext_vector_type(2)));
typedef GAS unsigned gu32;
#define RLX_AGENT __ATOMIC_RELAXED, __HIP_MEMORY_SCOPE_AGENT
#define LDS_WAIT() asm volatile("s_waitcnt lgkmcnt(0)" ::: "memory")
#define VM_WAIT() asm volatile("s_waitcnt vmcnt(0)" ::: "memory")
__device__ __forceinline__ unsigned pk2(float lo, float hi) { f32x2 v = {lo, hi}; bf16x2_t b = __builtin_convertvector(v, bf16x2_t); return __builtin_bit_cast(unsigned, b); }
__device__ __forceinline__ float bf2f(unsigned short h) { return __builtin_bit_cast(float, (unsigned)h << 16); }
__device__ __forceinline__ float bflo(unsigned w) { return __builtin_bit_cast(float, w << 16); }
__device__ __forceinline__ float bfhi(unsigned w) { return __builtin_bit_cast(float, w & 0xffff0000u); }
__device__ __forceinline__ float fexp2(float x) { return __builtin_amdgcn_exp2f(x); }
__device__ __forceinline__ float frcp(float x) { return __builtin_amdgcn_rcpf(x); }
__device__ __forceinline__ float gelu_t(float x) { const float x2 = x * x; const float e = fexp2(x * (-2.302208198f + -0.1029432357f * x2)); return x * frcp(1.f + e); }
__device__ __forceinline__ float silu_f(float x) { return x * frcp(1.f + fexp2(-1.4426950409f * x)); }
__device__ __forceinline__ float sigmoid_f(float x) { return frcp(1.f + fexp2(-1.4426950409f * x)); }
__device__ __forceinline__ float dpp_xor1(float v) { return __builtin_bit_cast(float, __builtin_amdgcn_update_dpp(0, __builtin_bit_cast(int, v), 0xB1, 0xF, 0xF, true)); }
__device__ __forceinline__ float dpp_xor2(float v) { return __builtin_bit_cast(float, __builtin_amdgcn_update_dpp(0, __builtin_bit_cast(int, v), 0x4E, 0xF, 0xF, true)); }
__device__ __forceinline__ unsigned dpp_xor1u(unsigned v) { return (unsigned)__builtin_amdgcn_update_dpp(0, (int)v, 0xB1, 0xF, 0xF, true); }
__device__ __forceinline__ unsigned dpp_xor2u(unsigned v) { return (unsigned)__builtin_amdgcn_update_dpp(0, (int)v, 0x4E, 0xF, 0xF, true); }
__device__ __forceinline__ float wave_sum(float v) {
#pragma unroll
    for (int o = 1; o < 64; o <<= 1) v += __shfl_xor(v, o);
    return v;
}
__device__ __forceinline__ float wave_max(float v) {
#pragma unroll
    for (int o = 1; o < 64; o <<= 1) v = fmaxf(v, __shfl_xor(v, o));
    return v;
}

#define XB_TMO      128
#define XB_XCNT(j)  (256  + 64 * (j))
#define XB_XSUB(j)  (1280 + 64 * (j))
#define XB_XGEN(j)  (2304 + 64 * (j))
#define XB_TOP      3328
#define XB_TOPGEN   3392
#define XCD_BAR_WORDS 3456
#define XB_SPIN_CAP (1u << 18)

__device__ __forceinline__ unsigned xb_ld(unsigned* p)              { return __hip_atomic_load(p, __ATOMIC_RELAXED, __HIP_MEMORY_SCOPE_AGENT); }
__device__ __forceinline__ unsigned xb_add(unsigned* p, unsigned v) { return __hip_atomic_fetch_add(p, v, __ATOMIC_RELAXED, __HIP_MEMORY_SCOPE_AGENT); }
__device__ __forceinline__ unsigned xb_xcc_id() { return (unsigned)__builtin_amdgcn_s_getreg((3 << 11) | 20) & 0xFu; }
#define XB_SPIN(cond, bar) do { unsigned _sp = 0; while (cond) { __builtin_amdgcn_s_sleep(1); \
    if ((++_sp & 255u) == 0u) { if (xb_ld(&(bar)[XB_TMO])) break; if (_sp > XB_SPIN_CAP) { atomicAdd(&(bar)[XB_TMO], 1u); break; } } } } while (0)

struct XcdBarrier { unsigned* bar; unsigned x; volatile LAS unsigned* st; };

__device__ __forceinline__ XcdBarrier xcd_barrier_post(unsigned* bar, volatile LAS unsigned* st) {
    XcdBarrier b; b.bar = bar; b.x = xb_xcc_id(); b.st = st;
    if (threadIdx.x == 0) (void)xb_add(&bar[XB_XCNT(b.x)], 1u);
    return b;
}
__device__ __forceinline__ void xcd_barrier_complete(unsigned* bar, unsigned x, unsigned& nloc, unsigned& nx) {
    const unsigned G = gridDim.x * gridDim.y * gridDim.z;
    unsigned sum, cnt, mine, sp = 0u;
    for (;;) {
        sum = 0u; cnt = 0u; mine = 0u;
#pragma unroll
        for (unsigned j = 0; j < 16; ++j) { const unsigned c = xb_ld(&bar[XB_XCNT(j)]); sum += c; cnt += (c > 0u) ? 1u : 0u; mine = (j == x) ? c : mine; }
        if (sum == G) break;
        __builtin_amdgcn_s_sleep(1);
        if ((++sp & 255u) == 0u) { if (xb_ld(&bar[XB_TMO])) break; if (sp > XB_SPIN_CAP) { atomicAdd(&bar[XB_TMO], 1u); break; } }
    }
    nloc = mine > 0u ? mine : 1u; nx = cnt > 0u ? cnt : 1u;
}
__device__ __forceinline__ void xcd_barrier(const XcdBarrier& b) {
    asm volatile("s_waitcnt vmcnt(0)" ::: "memory");
    __syncthreads();
    if (threadIdx.x == 0) {
        unsigned* bar = b.bar;
        __builtin_amdgcn_s_waitcnt(0);
        unsigned nloc = b.st[0], nx = b.st[1];
        if (nloc == 0u) { xcd_barrier_complete(bar, b.x, nloc, nx); b.st[0] = nloc; b.st[1] = nx; }
        const unsigned old = xb_add(&bar[XB_XSUB(b.x)], 1u);
        const unsigned gen = old / nloc;
        if (old + 1u == (gen + 1u) * nloc) {
            __builtin_amdgcn_fence(__ATOMIC_RELEASE, "agent");
            asm volatile("s_waitcnt vmcnt(0)" ::: "memory");
            const unsigned og = xb_add(&bar[XB_TOP], 1u);
            const unsigned tg = og / nx;
            if (og + 1u == (tg + 1u) * nx) xb_add(&bar[XB_TOPGEN], 1u);
            else XB_SPIN(xb_ld(&bar[XB_TOPGEN]) == tg, bar);
            __builtin_amdgcn_fence(__ATOMIC_ACQUIRE, "agent");
            xb_add(&bar[XB_XGEN(b.x)], 1u);
            asm volatile("s_waitcnt vmcnt(0)" ::: "memory");
        } else {
            XB_SPIN(xb_ld(&bar[XB_XGEN(b.x)]) == gen, bar);
            __builtin_amdgcn_fence(__ATOMIC_ACQUIRE, "agent");
            asm volatile("s_waitcnt vmcnt(0)" ::: "memory");
        }
    }
    __syncthreads();
}

constexpr int NWAVES = 8;
constexpr int D = 1024, SEQ = 8192, NBATCH = 2, MP = NBATCH * SEQ, MS = 128, MT = MP + MS, M65 = 16640;
constexpr int DFF = 2816, NGU = 2 * DFF, NAIN = 2048, NKV = 1536, NQ = 1072, NQP = 1280;
constexpr int NBIG = NAIN + NGU + NQP + NGU;
constexpr int OFF_WIN = 0, OFF_GU0 = NAIN, OFF_Q = NAIN + NGU, OFF_GU1 = NAIN + NGU + NQP;
constexpr int NMOD = 12288;
constexpr int PAST = 2048, NPAGE = 16, PAGE = 128, WIN = 512;
constexpr int RC_SAMP = 512 * 128, RC_PROMPT = 8 * 512, RC_KV = RC_SAMP + RC_PROMPT;
constexpr float EPS = 1e-6f;
constexpr float C2 = 0.125f * 1.4426950408889634f;

constexpr size_t O_YP = 0, O_YS = 16777216, O_AVP = 16908288, O_AVS = 17170432, O_CKP = 17301504, O_CVP = 21495808, O_SKP = 25690112, O_SVP = 29884416,
                 O_WKP = 34078720, O_WVP = 34340864, O_CKS = 34603008, O_CVS = 34635776, O_SKS = 34668544, O_SVS = 34701312, O_WKS = 34734080, O_WVS = 51511296;

constexpr size_t al256(size_t x) { return (x + 255) & ~(size_t)255; }
constexpr size_t WS_CTL = 0, CTL_BYTES = 1u << 20, CTL_ZERO_BYTES = 32768;
constexpr size_t WS_WADA = CTL_BYTES;
constexpr size_t WS_WBIG = WS_WADA + (size_t)NMOD * D * 2;
constexpr size_t WS_WOUT = WS_WBIG + (size_t)NBIG * D * 2;
constexpr size_t WS_WBO = WS_WOUT + (size_t)D * D * 2;
constexpr size_t WS_WDN = WS_WBO + (size_t)D * D * 2;
constexpr size_t WS_WKV = WS_WDN + (size_t)2 * D * DFF * 2;
constexpr size_t WS_W1C = WS_WKV + (size_t)NKV * D * 2;
constexpr size_t WS_W2 = WS_W1C + (size_t)2 * 256 * 2048 * 2;
constexpr size_t WS_WSB = WS_W2 + (size_t)2 * 64 * 256 * 2;
constexpr size_t WS_ROPE = WS_WSB + (size_t)8 * 128 * 128 * 2;
constexpr size_t WS_C1 = WS_ROPE + (size_t)8192 * 64 * 4;
constexpr size_t WS_SC = WS_C1 + 2 * 256 * 4;
constexpr size_t WS_MOD = WS_SC + (size_t)256 * D * 2;
constexpr size_t WS_SH = WS_MOD + (size_t)256 * NMOD * 4;
constexpr size_t WS_BIAS = WS_SH + (size_t)4 * 256 * D * 2;
constexpr size_t WS_MUL = WS_BIAS + (size_t)256 * NBIG * 4;
constexpr size_t WS_SSQ = WS_MUL + (size_t)3 * 256 * D * 4;
constexpr size_t WS_ACTA = WS_SSQ + (size_t)5 * M65 * 16 * 4;
constexpr size_t ACT_BYTES = (size_t)M65 * D * 2;
constexpr size_t WS_AKV = WS_ACTA + ACT_BYTES;
constexpr size_t WS_U = WS_AKV + ACT_BYTES;
constexpr size_t WS_V = WS_U + ACT_BYTES;
constexpr size_t WS_UM = WS_V + ACT_BYTES;
constexpr size_t WS_QN = WS_UM + ACT_BYTES;
constexpr size_t WS_QR = WS_QN + ACT_BYTES;
constexpr size_t WS_O = WS_QR + ACT_BYTES;
constexpr size_t WS_GATES = WS_O + ACT_BYTES;
constexpr size_t WS_HID = WS_GATES + (size_t)M65 * 48 * 4;
constexpr size_t WS_KS = WS_HID + (size_t)M65 * DFF * 2;
constexpr size_t WS_KW = WS_KS + (size_t)8 * SEQ * 64 * 2;
constexpr size_t WS_VST = WS_KW + (size_t)8 * SEQ * 64 * 2;
constexpr size_t WS_VWT = WS_VST + (size_t)8 * SEQ * 64 * 2;
constexpr size_t WS_RC = WS_VWT + (size_t)8 * SEQ * 64 * 2;
constexpr size_t WS_H2 = WS_RC + (size_t)2 * RC_KV * 1024 * 2 + 4096;
constexpr size_t WS_KCP = WS_H2 + (size_t)2 * RC_KV * 256 * 2;
constexpr size_t WS_VCTP = WS_KCP + (size_t)8 * 512 * 64 * 2;
constexpr size_t WS_KCS = WS_VCTP + (size_t)8 * 512 * 64 * 2;
constexpr size_t WS_VCTS = WS_KCS + (size_t)512 * 128 * 64 * 2;
constexpr size_t WS_END = WS_VCTS + (size_t)512 * 128 * 64 * 2;
static_assert(WS_WBIG % 256 == 0 && WS_ROPE % 256 == 0 && WS_SC % 256 == 0 && WS_ACTA % 256 == 0 && WS_HID % 256 == 0 && WS_RC % 256 == 0 && WS_H2 % 256 == 0 && WS_KCP % 256 == 0, "ws alignment");
constexpr int CW_BAR = 4096;

constexpr int RING_OFF = 0, RING_BYTES = 131072;
constexpr int LDSCTL_OFF = RING_BYTES, MISC_OFF = LDSCTL_OFF + 320;
constexpr int LDS_BYTES = 163840;

struct Params {
    const float* in[32];
    float* out;
    unsigned char* ws;
    int ph_lo, ph_hi;
};

__device__ __forceinline__ int seq_of(int row) { const int s = row - MP + 2; return row < MP ? (row >> 13) : (s < 255 ? s : 255); }
__device__ __forceinline__ float rstd1(float ssq) { return rsqrtf(ssq * (1.0f / 1024.0f) + EPS); }
__device__ __forceinline__ void ssq_add(float* p, float v) { __hip_atomic_fetch_add(p, v, __ATOMIC_RELAXED, __HIP_MEMORY_SCOPE_AGENT); }
#define LOAD_RS8(rs, SSQP, pm) do { _Pragma("unroll") for (int ai_ = 0; ai_ < 2; ++ai_) _Pragma("unroll") for (int m_ = 0; m_ < 4; ++m_) rs[ai_][m_] = (SSQP)[(size_t)(pm) * 256 + ai_ * 128 + wr * 64 + m_ * 16 + fr]; \
    _Pragma("unroll") for (int ai_ = 0; ai_ < 2; ++ai_) _Pragma("unroll") for (int m_ = 0; m_ < 4; ++m_) rs[ai_][m_] = rstd1(rs[ai_][m_]); } while (0)

using pg8::Unit;
#define EPI_ARGS const pg8::f32x4 (&acc)[2][2][4][2], const Unit& u, int wr, int wc, int fr, int fq

struct EpiMod {
    float* MOD; bf16* SH; const float* b_ada;
    __device__ __forceinline__ void operator()(EPI_ARGS) const { asm volatile("" ::: "memory");
        const int cl = wc * 32 + 8 * fq, c0 = u.pn * 256 + cl;
        const int pl = u.pn % 24, lay = u.pn / 24;
        const int np = (pl < 4) ? 2 * lay : ((pl >= 12 && pl < 16) ? 2 * lay + 1 : -1);
        const int j0 = (pl < 4 ? pl : pl - 12) * 256 + cl;
        f32x4 bv[2][2];
#pragma unroll
        for (int bj = 0; bj < 2; ++bj)
#pragma unroll
            for (int n = 0; n < 2; ++n) bv[bj][n] = *(const f32x4*)(b_ada + c0 + bj * 128 + 4 * n);
#pragma unroll
        for (int ai = 0; ai < 2; ++ai)
#pragma unroll
            for (int m = 0; m < 4; ++m) { const int row = ai * 128 + wr * 64 + m * 16 + fr;
#pragma unroll
                for (int bj = 0; bj < 2; ++bj) { const f32x4 v0 = acc[ai][bj][m][0] + bv[bj][0], v1 = acc[ai][bj][m][1] + bv[bj][1];
                    float* p = MOD + (size_t)row * NMOD + c0 + bj * 128; *(f32x4*)p = v0; *(f32x4*)(p + 4) = v1;
                    if (np >= 0) { v4u w; w.x = pk2(v0[0], v0[1]); w.y = pk2(v0[2], v0[3]); w.z = pk2(v1[0], v1[1]); w.w = pk2(v1[2], v1[3]);
                        *(v4u*)(SH + ((size_t)np * 256 + row) * D + j0 + bj * 128) = w; } } }
    }
};
struct EpiBias {
    float* BIAS;
    __device__ __forceinline__ void operator()(EPI_ARGS) const { asm volatile("" ::: "memory");
        const int lo = u.pm == 0 ? 0 : u.pm == 1 ? 8 : u.pm == 2 ? 30 : 35, hi = u.pm == 0 ? 8 : u.pm == 1 ? 30 : u.pm == 2 ? 35 : 57;
        if (u.pn < lo || u.pn >= hi) return;
        const int c0 = u.pn * 256 + wc * 32 + 8 * fq;
#pragma unroll
        for (int ai = 0; ai < 2; ++ai)
#pragma unroll
            for (int m = 0; m < 4; ++m) { const int row = ai * 128 + wr * 64 + m * 16 + fr;
#pragma unroll
                for (int bj = 0; bj < 2; ++bj) { float* p = BIAS + (size_t)row * NBIG + c0 + bj * 128; *(f32x4*)p = acc[ai][bj][m][0]; *(f32x4*)(p + 4) = acc[ai][bj][m][1]; } }
    }
};
struct EpiAin {
    const float* SSQ0; const float* BIAS; bf16* U; bf16* V; float* SSQV;
    __device__ __forceinline__ void operator()(EPI_ARGS) const { asm volatile("" ::: "memory");
        const int cl = wc * 32 + 8 * fq, c0 = u.pn * 256 + cl; const bool uni = u.pm < 64; const bool isv = u.pn >= 4;
        float rsv[2][4]; LOAD_RS8(rsv, SSQ0, u.pm);
        f32x4 bv[2][2];
        if (uni) { const float* b = BIAS + (size_t)(u.pm >> 5) * NBIG + OFF_WIN + c0;
#pragma unroll
            for (int bj = 0; bj < 2; ++bj)
#pragma unroll
                for (int n = 0; n < 2; ++n) bv[bj][n] = *(const f32x4*)(b + bj * 128 + 4 * n); }
#pragma unroll
        for (int ai = 0; ai < 2; ++ai)
#pragma unroll
            for (int m = 0; m < 4; ++m) { const int row = u.pm * 256 + ai * 128 + wr * 64 + m * 16 + fr;
                const float rs = rsv[ai][m];
                if (!uni) { const float* b = BIAS + (size_t)seq_of(row) * NBIG + OFF_WIN + c0;
#pragma unroll
                    for (int bj = 0; bj < 2; ++bj)
#pragma unroll
                        for (int n = 0; n < 2; ++n) bv[bj][n] = *(const f32x4*)(b + bj * 128 + 4 * n); }
                float sq = 0.f;
#pragma unroll
                for (int bj = 0; bj < 2; ++bj) { f32x4 v0 = acc[ai][bj][m][0] * rs + bv[bj][0], v1 = acc[ai][bj][m][1] * rs + bv[bj][1];
#pragma unroll
                    for (int i = 0; i < 4; ++i) { v0[i] = gelu_t(v0[i]); v1[i] = gelu_t(v1[i]); sq += v0[i] * v0[i] + v1[i] * v1[i]; }
                    v4u w; w.x = pk2(v0[0], v0[1]); w.y = pk2(v0[2], v0[3]); w.z = pk2(v1[0], v1[1]); w.w = pk2(v1[2], v1[3]);
                    bf16* dst = isv ? V + (size_t)row * D + (c0 - 1024) + bj * 128 : U + (size_t)row * D + c0 + bj * 128;
                    *(v4u*)dst = w; }
                if (isv) { sq += __shfl_xor(sq, 16); sq += __shfl_xor(sq, 32); if (fq == 0) ssq_add(SSQV + row, sq); } }
    }
};
struct EpiGU {
    const float* SSQ; const float* BIAS; int boff; bf16* HID;
    __device__ __forceinline__ void operator()(EPI_ARGS) const { asm volatile("" ::: "memory");
        const int cl = wc * 32 + 8 * fq, c0 = u.pn * 256 + cl; const bool uni = u.pm < 64;
        float rsv[2][4]; LOAD_RS8(rsv, SSQ, u.pm);
        f32x4 bv[2][2];
        if (uni) { const float* b = BIAS + (size_t)(u.pm >> 5) * NBIG + boff + c0;
#pragma unroll
            for (int bj = 0; bj < 2; ++bj)
#pragma unroll
                for (int n = 0; n < 2; ++n) bv[bj][n] = *(const f32x4*)(b + bj * 128 + 4 * n); }
#pragma unroll
        for (int ai = 0; ai < 2; ++ai)
#pragma unroll
            for (int m = 0; m < 4; ++m) { const int row = u.pm * 256 + ai * 128 + wr * 64 + m * 16 + fr;
                const float rs = rsv[ai][m];
                if (!uni) { const float* b = BIAS + (size_t)seq_of(row) * NBIG + boff + c0;
#pragma unroll
                    for (int bj = 0; bj < 2; ++bj)
#pragma unroll
                        for (int n = 0; n < 2; ++n) bv[bj][n] = *(const f32x4*)(b + bj * 128 + 4 * n); }
                float h[8];
#pragma unroll
                for (int n = 0; n < 2; ++n) { const f32x4 zg = acc[ai][0][m][n] * rs + bv[0][n], zu = acc[ai][1][m][n] * rs + bv[1][n];
#pragma unroll
                    for (int i = 0; i < 4; ++i) h[4 * n + i] = silu_f(zg[i]) * zu[i]; }
                v4u w; w.x = pk2(h[0], h[1]); w.y = pk2(h[2], h[3]); w.z = pk2(h[4], h[5]); w.w = pk2(h[6], h[7]);
                *(v4u*)(HID + (size_t)row * DFF + u.pn * 128 + cl) = w; }
    }
};
template <bool XF32, bool OF32>
struct EpiRes {
    const float* xin_p; const float* xin_s;
    const bf16* xb_in;
    const float* MOD; int goff;
    float* out; bf16* xb_out;
    const float* MUL; bf16* A1;
    float* SSQ;
    __device__ __forceinline__ void operator()(EPI_ARGS) const { asm volatile("" ::: "memory");
        const int cl = wc * 32 + 8 * fq, c0 = u.pn * 256 + cl; const bool uni = u.pm < 64;
        f32x4 gv[2][2], mv[2][2];
        if (uni) { const int sq_ = u.pm >> 5;
#pragma unroll
            for (int bj = 0; bj < 2; ++bj)
#pragma unroll
                for (int n = 0; n < 2; ++n) { gv[bj][n] = *(const f32x4*)(MOD + (size_t)sq_ * NMOD + goff + c0 + bj * 128 + 4 * n);
                    if (A1) mv[bj][n] = *(const f32x4*)(MUL + (size_t)sq_ * D + c0 + bj * 128 + 4 * n); } }
        f32x4 xq[2][2][2]; v4u xw[2][2];
#define ER_LOAD(it) do { const int row_ = u.pm * 256 + ((it) >> 2) * 128 + wr * 64 + ((it) & 3) * 16 + fr; \
            if (XF32) { const float* xr_ = uni ? xin_p + (size_t)row_ * D : xin_s + (size_t)(row_ < MT ? row_ - MP : 0) * D; \
                _Pragma("unroll") for (int bj = 0; bj < 2; ++bj) { xq[(it) & 1][bj][0] = *(const f32x4*)(xr_ + c0 + bj * 128); xq[(it) & 1][bj][1] = *(const f32x4*)(xr_ + c0 + bj * 128 + 4); } } \
            else { _Pragma("unroll") for (int bj = 0; bj < 2; ++bj) xw[(it) & 1][bj] = *(const v4u*)(xb_in + (size_t)row_ * D + c0 + bj * 128); } } while (0)
        ER_LOAD(0);
#pragma unroll
        for (int it = 0; it < 8; ++it) { const int ai = it >> 2, m = it & 3; const int row = u.pm * 256 + ai * 128 + wr * 64 + m * 16 + fr;
                if (it + 1 < 8) ER_LOAD(it + 1);
                const bool real = row < MT;
                if (!uni) { const int sq_ = seq_of(row);
#pragma unroll
                    for (int bj = 0; bj < 2; ++bj)
#pragma unroll
                        for (int n = 0; n < 2; ++n) { gv[bj][n] = *(const f32x4*)(MOD + (size_t)sq_ * NMOD + goff + c0 + bj * 128 + 4 * n);
                            if (A1) mv[bj][n] = *(const f32x4*)(MUL + (size_t)sq_ * D + c0 + bj * 128 + 4 * n); } }
                float sq = 0.f;
#pragma unroll
                for (int bj = 0; bj < 2; ++bj) { f32x4 x0, x1;
                    if (XF32) { x0 = xq[it & 1][bj][0]; x1 = xq[it & 1][bj][1]; }
                    else { const v4u w_ = xw[it & 1][bj]; x0 = (f32x4){bflo(w_.x), bfhi(w_.x), bflo(w_.y), bfhi(w_.y)}; x1 = (f32x4){bflo(w_.z), bfhi(w_.z), bflo(w_.w), bfhi(w_.w)}; }
                    if (!real) { x0 = (f32x4){0.f, 0.f, 0.f, 0.f}; x1 = x0; }
                    x0 = x0 + gv[bj][0] * acc[ai][bj][m][0]; x1 = x1 + gv[bj][1] * acc[ai][bj][m][1];
                    if (OF32) { if (real) { float* p = out + (size_t)row * D + c0 + bj * 128; *(f32x4*)p = x0; *(f32x4*)(p + 4) = x1; } }
                    else { v4u w; w.x = pk2(x0[0], x0[1]); w.y = pk2(x0[2], x0[3]); w.z = pk2(x1[0], x1[1]); w.w = pk2(x1[2], x1[3]); *(v4u*)(xb_out + (size_t)row * D + c0 + bj * 128) = w; }
                    sq += (x0[0] * x0[0] + x0[1] * x0[1]) + (x0[2] * x0[2] + x0[3] * x0[3]) + (x1[0] * x1[0] + x1[1] * x1[1]) + (x1[2] * x1[2] + x1[3] * x1[3]);
                    if (A1) { const f32x4 a = x0 * mv[bj][0], b = x1 * mv[bj][1]; v4u w; w.x = pk2(a[0], a[1]); w.y = pk2(a[2], a[3]); w.z = pk2(b[0], b[1]); w.w = pk2(b[2], b[3]);
                        *(v4u*)(A1 + (size_t)row * D + c0 + bj * 128) = w; } }
                if (SSQ) { sq += __shfl_xor(sq, 16); sq += __shfl_xor(sq, 32); if (fq == 0) ssq_add(SSQ + row, sq); } }
#undef ER_LOAD
    }
};
struct EpiCmp {
    const float* C1; bf16* H2;
    __device__ __forceinline__ void operator()(EPI_ARGS) const { asm volatile("" ::: "memory");
        const int cl = wc * 32 + 8 * fq; const int kv = u.pm >= (RC_KV / 256) ? 1 : 0;
        f32x4 bv[2][2];
#pragma unroll
        for (int bj = 0; bj < 2; ++bj)
#pragma unroll
            for (int n = 0; n < 2; ++n) bv[bj][n] = *(const f32x4*)(C1 + kv * 256 + cl + bj * 128 + 4 * n);
#pragma unroll
        for (int ai = 0; ai < 2; ++ai)
#pragma unroll
            for (int m = 0; m < 4; ++m) { const size_t row = (size_t)u.pm * 256 + ai * 128 + wr * 64 + m * 16 + fr;
#pragma unroll
                for (int bj = 0; bj < 2; ++bj) { f32x4 v0 = acc[ai][bj][m][0] + bv[bj][0], v1 = acc[ai][bj][m][1] + bv[bj][1];
#pragma unroll
                    for (int i = 0; i < 4; ++i) { v0[i] = gelu_t(v0[i]); v1[i] = gelu_t(v1[i]); }
                    v4u w; w.x = pk2(v0[0], v0[1]); w.y = pk2(v0[2], v0[3]); w.z = pk2(v1[0], v1[1]); w.w = pk2(v1[2], v1[3]);
                    *(v4u*)(H2 + row * 256 + cl + bj * 128) = w; } }
    }
};
struct EpiKV {
    const float* SSQ; const float* kgains; const float* ROPE; float* out;
    bf16* RC; bf16* KS; bf16* KW; bf16* VST; bf16* VWT;
    __device__ __forceinline__ void operator()(EPI_ARGS) const { asm volatile("" ::: "memory");
        const int ty = u.pn, g = wc, d0 = 8 * fq; const bool isk = (ty == 2 || ty == 4);
        float rsv[2][4]; LOAD_RS8(rsv, SSQ, u.pm);
        f32x4 kg[2][2];
        if (isk) {
#pragma unroll
            for (int bj = 0; bj < 2; ++bj)
#pragma unroll
                for (int n = 0; n < 2; ++n) kg[bj][n] = *(const f32x4*)(kgains + (ty == 2 ? 64 : 128) + 32 * bj + d0 + 4 * n); }
#pragma unroll
        for (int ai = 0; ai < 2; ++ai)
#pragma unroll
            for (int m = 0; m < 4; ++m) { const int row = u.pm * 256 + ai * 128 + wr * 64 + m * 16 + fr;
                const float rs = rsv[ai][m];
                f32x4 v[2][2];
#pragma unroll
                for (int bj = 0; bj < 2; ++bj)
#pragma unroll
                    for (int n = 0; n < 2; ++n) v[bj][n] = acc[ai][bj][m][n] * rs;
                const bool prompt = row < MP; const int t = prompt ? (row & (SEQ - 1)) : PAST; const int b = row >> 13;
                if (isk) {
                    float sq = 0.f;
#pragma unroll
                    for (int bj = 0; bj < 2; ++bj)
#pragma unroll
                        for (int n = 0; n < 2; ++n) sq += (v[bj][n][0] * v[bj][n][0] + v[bj][n][1] * v[bj][n][1]) + (v[bj][n][2] * v[bj][n][2] + v[bj][n][3] * v[bj][n][3]);
                    sq += __shfl_xor(sq, 16); sq += __shfl_xor(sq, 32);
                    const float ri = rsqrtf(sq * (1.0f / 64.0f) + EPS);
#pragma unroll
                    for (int n = 0; n < 2; ++n) { const f32x4 cs = *(const f32x4*)(ROPE + (size_t)t * 64 + d0 + 4 * n), sn = *(const f32x4*)(ROPE + (size_t)t * 64 + 32 + d0 + 4 * n);
                        const f32x4 x1 = v[0][n] * ri * kg[0][n], x2 = v[1][n] * ri * kg[1][n];
                        v[0][n] = x1 * cs - x2 * sn; v[1][n] = x2 * cs + x1 * sn; }
                }
                float* fo = nullptr;
                if (prompt) {
                    if (ty < 4) fo = out + (ty == 0 ? O_CKP : ty == 1 ? O_CVP : ty == 2 ? O_SKP : O_SVP) + (size_t)row * 256;
                    else if (t >= SEQ - WIN) fo = out + (ty == 4 ? O_WKP : O_WVP) + ((size_t)b * WIN + (t - (SEQ - WIN))) * 256;
                } else if (row < MT) { const int s = row - MP;
                    if (ty < 4) fo = out + (ty == 0 ? O_CKS : ty == 1 ? O_CVS : ty == 2 ? O_SKS : O_SVS) + (size_t)s * 256;
                    else fo = out + (ty == 4 ? O_WKS : O_WVS) + ((size_t)s * WIN + (WIN - 1)) * 256; }
                if (fo) {
#pragma unroll
                    for (int bj = 0; bj < 2; ++bj) { float* p = fo + g * 64 + 32 * bj + d0; *(f32x4*)p = v[bj][0]; *(f32x4*)(p + 4) = v[bj][1]; } }
                if (prompt) { const int gam = b * 4 + g;
                    if (ty <= 1) { bf16* dst = RC + ((size_t)ty * RC_KV + RC_SAMP + (size_t)gam * 512 + (t >> 4)) * 1024 + (t & 15) * 64 + d0;
#pragma unroll
                        for (int bj = 0; bj < 2; ++bj) { v4u w; w.x = pk2(v[bj][0][0], v[bj][0][1]); w.y = pk2(v[bj][0][2], v[bj][0][3]); w.z = pk2(v[bj][1][0], v[bj][1][1]); w.w = pk2(v[bj][1][2], v[bj][1][3]); *(v4u*)(dst + 32 * bj) = w; }
                    } else if (isk) { bf16* dst = (ty == 2 ? KS : KW) + ((size_t)gam * SEQ + t) * 64 + d0;
#pragma unroll
                        for (int bj = 0; bj < 2; ++bj) { v4u w; w.x = pk2(v[bj][0][0], v[bj][0][1]); w.y = pk2(v[bj][0][2], v[bj][0][3]); w.z = pk2(v[bj][1][0], v[bj][1][1]); w.w = pk2(v[bj][1][2], v[bj][1][3]); *(v4u*)(dst + 32 * bj) = w; }
                    } else { const int kk_ = t & 63; bf16* dst = (ty == 3 ? VST : VWT) + ((size_t)gam * 128 + (t >> 6)) * 4096 + (32 * (kk_ >> 5) + 8 * ((kk_ & 15) >> 2) + 4 * ((kk_ >> 4) & 1) + (kk_ & 3));
#pragma unroll
                        for (int bj = 0; bj < 2; ++bj)
#pragma unroll
                            for (int n = 0; n < 2; ++n)
#pragma unroll
                                for (int i = 0; i < 4; ++i) dst[(32 * bj + d0 + 4 * n + i) * 64] = (bf16)(pk2(v[bj][n][i], 0.f) & 0xffffu); }
                }
            }
    }
};
struct EpiQ {
    const float* SSQ; const float* BIAS; const float* qgain; const float* ROPE; bf16* QN; bf16* QR; float* GATES;
    __device__ __forceinline__ void operator()(EPI_ARGS) const { asm volatile("" ::: "memory");
        const int cl = wc * 32 + 8 * fq, c0 = u.pn * 256 + cl, d0 = 8 * fq; const bool uni = u.pm < 64;
        float rsv[2][4]; LOAD_RS8(rsv, SSQ, u.pm);
        f32x4 bv[2][2], qg[2][2];
        if (uni) { const float* b = BIAS + (size_t)(u.pm >> 5) * NBIG + OFF_Q + c0;
#pragma unroll
            for (int bj = 0; bj < 2; ++bj)
#pragma unroll
                for (int n = 0; n < 2; ++n) bv[bj][n] = *(const f32x4*)(b + bj * 128 + 4 * n); }
#pragma unroll
        for (int bj = 0; bj < 2; ++bj)
#pragma unroll
            for (int n = 0; n < 2; ++n) qg[bj][n] = *(const f32x4*)(qgain + 32 * bj + d0 + 4 * n);
#pragma unroll
        for (int ai = 0; ai < 2; ++ai)
#pragma unroll
            for (int m = 0; m < 4; ++m) { const int row = u.pm * 256 + ai * 128 + wr * 64 + m * 16 + fr;
                const float rs = rsv[ai][m];
                if (!uni) { const float* b = BIAS + (size_t)seq_of(row) * NBIG + OFF_Q + c0;
#pragma unroll
                    for (int bj = 0; bj < 2; ++bj)
#pragma unroll
                        for (int n = 0; n < 2; ++n) bv[bj][n] = *(const f32x4*)(b + bj * 128 + 4 * n); }
                f32x4 v[2][2];
#pragma unroll
                for (int bj = 0; bj < 2; ++bj)
#pragma unroll
                    for (int n = 0; n < 2; ++n) v[bj][n] = acc[ai][bj][m][n] * rs + bv[bj][n];
                if (u.pn == 4) {
                    if (cl < 48) {
#pragma unroll
                        for (int n = 0; n < 2; ++n) { f32x4 s; for (int i = 0; i < 4; ++i) s[i] = sigmoid_f(v[0][n][i]); *(f32x4*)(GATES + (size_t)row * 48 + cl + 4 * n) = s; } }
                    continue; }
                const int t = row < MP ? (row & (SEQ - 1)) : PAST;
                float sq = 0.f;
#pragma unroll
                for (int bj = 0; bj < 2; ++bj)
#pragma unroll
                    for (int n = 0; n < 2; ++n) sq += (v[bj][n][0] * v[bj][n][0] + v[bj][n][1] * v[bj][n][1]) + (v[bj][n][2] * v[bj][n][2] + v[bj][n][3] * v[bj][n][3]);
                sq += __shfl_xor(sq, 16); sq += __shfl_xor(sq, 32);
                const float ri = rsqrtf(sq * (1.0f / 64.0f) + EPS) * C2;
                f32x4 r[2][2];
#pragma unroll
                for (int n = 0; n < 2; ++n) { const f32x4 cs = *(const f32x4*)(ROPE + (size_t)t * 64 + d0 + 4 * n), sn = *(const f32x4*)(ROPE + (size_t)t * 64 + 32 + d0 + 4 * n);
                    v[0][n] = v[0][n] * ri * qg[0][n]; v[1][n] = v[1][n] * ri * qg[1][n];
                    r[0][n] = v[0][n] * cs - v[1][n] * sn; r[1][n] = v[1][n] * cs + v[0][n] * sn; }
                const size_t o = (size_t)row * D + (u.pn * 4 + wc) * 64 + d0;
#pragma unroll
                for (int bj = 0; bj < 2; ++bj) { v4u w; w.x = pk2(v[bj][0][0], v[bj][0][1]); w.y = pk2(v[bj][0][2], v[bj][0][3]); w.z = pk2(v[bj][1][0], v[bj][1][1]); w.w = pk2(v[bj][1][2], v[bj][1][3]); *(v4u*)(QN + o + 32 * bj) = w;
                    v4u x; x.x = pk2(r[bj][0][0], r[bj][0][1]); x.y = pk2(r[bj][0][2], r[bj][0][3]); x.z = pk2(r[bj][1][0], r[bj][1][1]); x.w = pk2(r[bj][1][2], r[bj][1][3]); *(v4u*)(QR + o + 32 * bj) = x; }
            }
    }
};

#define MFMA16(a, b, c) __builtin_amdgcn_mfma_f32_16x16x32_bf16((a), (b), (c), 0, 0, 0)

__device__ __forceinline__ int wperm(int mode, int n) {
    if (mode == 1) { const int up = n >= DFF ? 1 : 0, j = n - up * DFF; return (j >> 7) * 256 + up * 128 + (j & 127); }
    if (mode == 2 || (mode == 3 && n < 1024)) { const int blk = n >> 8, g = (n >> 6) & 3, d = n & 63; return blk * 256 + 128 * (d >> 5) + 32 * g + (d & 31); }
    return n;
}
__device__ __forceinline__ void transpose_item(const float* W, int K, int N, bf16* WT, int row_off, int mode, LAS float* scr, int item, int lane, const float* kscale = nullptr) {
    const int nblk = (N + 31) >> 5, kb = item / nblk, nb = item - kb * nblk, k0 = 64 * kb, n0 = 32 * nb;
    const int nq = n0 + 4 * (lane & 7); const bool okn = nq < N;
    f32x4 v[8];
#pragma unroll
    for (int i = 0; i < 8; ++i) { const int kk = 8 * i + (lane >> 3); v[i] = okn ? *(const f32x4*)(W + (size_t)(k0 + kk) * N + nq) : (f32x4){0.f, 0.f, 0.f, 0.f}; if (kscale) v[i] = v[i] * kscale[k0 + kk]; }
#pragma unroll
    for (int i = 0; i < 8; ++i) { const int kk = 8 * i + (lane >> 3); LAS float* d = scr + kk * 33 + 4 * (lane & 7); d[0] = v[i][0]; d[1] = v[i][1]; d[2] = v[i][2]; d[3] = v[i][3]; }
    LDS_WAIT(); asm volatile("" ::: "memory");
    const int c = lane & 7;
#pragma unroll
    for (int j = 0; j < 4; ++j) { const int n = (lane >> 3) + 8 * j; const LAS float* s = scr + (8 * c) * 33 + n;
        v4u o; o.x = pk2(s[0 * 33], s[1 * 33]); o.y = pk2(s[2 * 33], s[3 * 33]); o.z = pk2(s[4 * 33], s[5 * 33]); o.w = pk2(s[6 * 33], s[7 * 33]);
        if (n0 + n < N) *(v4u*)(WT + (size_t)(row_off + wperm(mode, n0 + n)) * K + k0 + 8 * c) = o; }
    LDS_WAIT(); asm volatile("" ::: "memory");
}
#define TR_ITEMS(K, N) (((K) / 64) * (((N) + 31) / 32))

__device__ __forceinline__ void phase0(const Params& P, LAS unsigned char* lds, int tid, int lane, int wave) {
    unsigned char* ws = P.ws;
    const int gw = blockIdx.x * NWAVES + wave, ngw = gridDim.x * NWAVES, gtid = blockIdx.x * 512 + tid, ngt = gridDim.x * 512;
    LAS float* scr = (LAS float*)(lds + wave * 16384);
    constexpr int IT_ADA = TR_ITEMS(1024, 6144);
    for (int it = gw; it < 2 * IT_ADA; it += ngw) { const int l = it / IT_ADA, r = it - l * IT_ADA;
        transpose_item(P.in[11] + (size_t)l * 1024 * 6144, 1024, 6144, (bf16*)(ws + WS_WADA), l * 6144, 0, scr, r, lane); }
    for (int e = gtid; e < 256 * 128; e += ngt) { const int row = e >> 7, c8 = (e & 127) * 8; v4u o = {0u, 0u, 0u, 0u};
        if (row < 130) { const float* src = (row < 2 ? P.in[9] + row * 1024 : P.in[10] + (row - 2) * 1024) + c8; const f32x4 a = *(const f32x4*)src, b = *(const f32x4*)(src + 4);
            o.x = pk2(silu_f(a[0]), silu_f(a[1])); o.y = pk2(silu_f(a[2]), silu_f(a[3])); o.z = pk2(silu_f(b[0]), silu_f(b[1])); o.w = pk2(silu_f(b[2]), silu_f(b[3])); }
        *(v4u*)((bf16*)(ws + WS_SC) + (size_t)row * 1024 + c8) = o; }
    for (int e = gtid; e < SEQ * 32; e += ngt) { const int pos = e >> 5, i = e & 31; const float inv = powf(10000.0f, -(float)i / 32.0f); const float ang = (float)pos * inv; float s, c; sincosf(ang, &s, &c);
        float* R = (float*)(ws + WS_ROPE) + (size_t)pos * 64; R[i] = c; R[32 + i] = s; }
    for (int e = gtid; e < 8 * 128 * 128; e += ngt) { const int t = (e >> 7) & 127, s = e & 127; ((bf16*)(ws + WS_WSB))[e] = (bf16)(pk2(s <= t ? P.in[16][e] : 0.f, 0.f) & 0xffffu); }
    for (int e = gtid; e < 5 * M65; e += ngt) ((float*)(ws + WS_SSQ))[e] = 0.f;
    for (int e = gtid; e < (NQP - NQ) * 128; e += ngt) *(v4u*)((bf16*)(ws + WS_WBIG) + (size_t)(OFF_Q + NQ) * 1024 + (size_t)e * 8) = (v4u){0u, 0u, 0u, 0u};
    if (gridDim.x >= 256 ? blockIdx.x < 256 : blockIdx.x == 0) {
        for (int ob = blockIdx.x; ob < 256; ob += (gridDim.x >= 256 ? 256 : 1)) { const int kv = ob >> 7, c0 = (ob & 127) * 2;
            const float* w1 = P.in[26] + (size_t)kv * 2048 * 256 + c0; const float* pe = P.in[25] + kv * 2048;
            const f32x4 pv = *(const f32x4*)(pe + 4 * tid); float s0 = 0.f, s1 = 0.f;
#pragma unroll
            for (int i = 0; i < 4; ++i) { const f32x2 w = *(const f32x2*)(w1 + (size_t)(4 * tid + i) * 256); s0 += pv[i] * w[0]; s1 += pv[i] * w[1]; }
            s0 = wave_sum(s0); s1 = wave_sum(s1);
            LAS float* red = (LAS float*)(lds + 8448);
            __syncthreads();
            if (lane == 0) { red[wave * 2] = s0; red[wave * 2 + 1] = s1; }
            __syncthreads();
            if (tid < 2) { float a = P.in[27][kv * 256 + c0 + tid]; for (int k = 0; k < 8; ++k) a += red[k * 2 + tid]; ((float*)(ws + WS_C1))[kv * 256 + c0 + tid] = a; } } }
}
__device__ __forceinline__ void phase1_weights(const Params& P, LAS unsigned char* lds, int lane, int wave) {
    unsigned char* ws = P.ws;
    constexpr int NMU = NMOD / 256;
    if ((int)gridDim.x > 2 * NMU && (int)blockIdx.x < NMU) return;
    const int skip = (int)gridDim.x > 2 * NMU ? NMU : 0;
    const int gw = ((int)blockIdx.x - skip) * NWAVES + wave, ngw = ((int)gridDim.x - skip) * NWAVES;
    LAS float* scr = (LAS float*)(lds + wave * 16384);
    constexpr int I0 = TR_ITEMS(1024, 2048), I1 = TR_ITEMS(1024, 5632), I2 = TR_ITEMS(1024, 1072), I3 = TR_ITEMS(1024, 1024), I4 = TR_ITEMS(2816, 1024), I5 = TR_ITEMS(1024, 1536), I6 = TR_ITEMS(2048, 256), I7 = TR_ITEMS(256, 64);
    constexpr int NIT = I0 + 2 * I1 + I2 + 2 * I3 + 2 * I4 + I5 + 2 * I6 + 2 * I7;
    bf16* WBIG = (bf16*)(ws + WS_WBIG);
    for (int it = gw; it < NIT; it += ngw) { int r = it;
        if (r < I0) { transpose_item(P.in[14], 1024, 2048, WBIG, OFF_WIN, 0, scr, r, lane); continue; } r -= I0;
        if (r < I1) { transpose_item(P.in[30], 1024, 5632, WBIG, OFF_GU0, 1, scr, r, lane); continue; } r -= I1;
        if (r < I1) { transpose_item(P.in[30] + (size_t)1024 * 5632, 1024, 5632, WBIG, OFF_GU1, 1, scr, r, lane); continue; } r -= I1;
        if (r < I2) { transpose_item(P.in[19], 1024, 1072, WBIG, OFF_Q, 3, scr, r, lane); continue; } r -= I2;
        if (r < I3) { transpose_item(P.in[18], 1024, 1024, (bf16*)(ws + WS_WOUT), 0, 0, scr, r, lane); continue; } r -= I3;
        if (r < I3) { transpose_item(P.in[21], 1024, 1024, (bf16*)(ws + WS_WBO), 0, 0, scr, r, lane); continue; } r -= I3;
        if (r < I4) { transpose_item(P.in[31], 2816, 1024, (bf16*)(ws + WS_WDN), 0, 0, scr, r, lane); continue; } r -= I4;
        if (r < I4) { transpose_item(P.in[31] + (size_t)2816 * 1024, 2816, 1024, (bf16*)(ws + WS_WDN) + (size_t)1024 * 2816, 0, 0, scr, r, lane); continue; } r -= I4;
        if (r < I5) { transpose_item(P.in[23], 1024, 1536, (bf16*)(ws + WS_WKV), 0, 2, scr, r, lane, P.in[22]); continue; } r -= I5;
        if (r < I6) { transpose_item(P.in[26], 2048, 256, (bf16*)(ws + WS_W1C), 0, 0, scr, r, lane); continue; } r -= I6;
        if (r < I6) { transpose_item(P.in[26] + (size_t)2048 * 256, 2048, 256, (bf16*)(ws + WS_W1C) + (size_t)256 * 2048, 0, 0, scr, r, lane); continue; } r -= I6;
        if (r < I7) { transpose_item(P.in[28], 256, 64, (bf16*)(ws + WS_W2), 0, 0, scr, r, lane); continue; } r -= I7;
        transpose_item(P.in[28] + 256 * 64, 256, 64, (bf16*)(ws + WS_W2) + 64 * 256, 0, 0, scr, r, lane);
    }
}
__device__ __forceinline__ void phase2_tail(const Params& P, int tid, int lane, int wave) {
    unsigned char* ws = P.ws;
    constexpr int NBU = 57;
    if ((int)gridDim.x > 2 * NBU && (int)blockIdx.x < NBU) return;
    const int skip = (int)gridDim.x > 2 * NBU ? NBU : 0;
    const int gw = ((int)blockIdx.x - skip) * NWAVES + wave, ngw = ((int)gridDim.x - skip) * NWAVES, gtid = ((int)blockIdx.x - skip) * 512 + tid, ngt = ((int)gridDim.x - skip) * 512;
    const float* MOD = (const float*)(ws + WS_MOD); const float* ng = P.in[13];
    for (int e = gtid; e < 3 * 256 * 256; e += ngt) { const int np = e >> 16, sq = (e >> 8) & 255, c = (e & 255) * 4;
        const int lay = np == 0 ? 0 : 1, wh = np == 1 ? 0 : 1;
        const f32x4 g = *(const f32x4*)(ng + (lay * 2 + wh) * 1024 + c), sc = *(const f32x4*)(MOD + (size_t)sq * NMOD + lay * 6144 + (wh ? 4096 : 1024) + c);
        *(f32x4*)((float*)(ws + WS_MUL) + ((size_t)np * 256 + sq) * 1024 + c) = g * (sc + 1.0f); }
    float* SSQ0 = (float*)(ws + WS_SSQ); bf16* A0 = (bf16*)(ws + WS_ACTA);
    for (int r0 = gw; r0 < M65; r0 += 2 * ngw) {
        const int r1 = r0 + ngw; const bool h1 = r1 < M65;
        f32x4 va[4], vb[4]; float sa = 0.f, sb = 0.f;
#pragma unroll
        for (int j = 0; j < 4; ++j) { va[j] = (f32x4){0.f, 0.f, 0.f, 0.f}; vb[j] = va[j]; }
        if (r0 < MT) { const float* x = (r0 < MP ? P.in[0] + (size_t)r0 * D : P.in[1] + (size_t)(r0 - MP) * D) + 4 * lane;
#pragma unroll
            for (int j = 0; j < 4; ++j) va[j] = *(const f32x4*)(x + 256 * j); }
        if (h1 && r1 < MT) { const float* x = (r1 < MP ? P.in[0] + (size_t)r1 * D : P.in[1] + (size_t)(r1 - MP) * D) + 4 * lane;
#pragma unroll
            for (int j = 0; j < 4; ++j) vb[j] = *(const f32x4*)(x + 256 * j); }
        const int sqa = seq_of(r0), sqb = seq_of(h1 ? r1 : r0);
        f32x4 ga[4], gb[4];
#pragma unroll
        for (int j = 0; j < 4; ++j) { const int c = 4 * lane + 256 * j; const f32x4 g = *(const f32x4*)(ng + c);
            ga[j] = g * (*(const f32x4*)(MOD + (size_t)sqa * NMOD + 1024 + c) + 1.0f); gb[j] = g * (*(const f32x4*)(MOD + (size_t)sqb * NMOD + 1024 + c) + 1.0f); }
#pragma unroll
        for (int j = 0; j < 4; ++j) { sa += (va[j][0] * va[j][0] + va[j][1] * va[j][1]) + (va[j][2] * va[j][2] + va[j][3] * va[j][3]); sb += (vb[j][0] * vb[j][0] + vb[j][1] * vb[j][1]) + (vb[j][2] * vb[j][2] + vb[j][3] * vb[j][3]); }
        sa = wave_sum(sa); sb = wave_sum(sb);
        if (lane == 0) { SSQ0[r0] = sa; if (h1) SSQ0[r1] = sb; }
#pragma unroll
        for (int j = 0; j < 4; ++j) { const int c = 4 * lane + 256 * j;
            { const f32x4 a = va[j] * ga[j]; v2u w; w.x = pk2(a[0], a[1]); w.y = pk2(a[2], a[3]); *(v2u*)(A0 + (size_t)r0 * D + c) = w; }
            if (h1) { const f32x4 a = vb[j] * gb[j]; v2u w; w.x = pk2(a[0], a[1]); w.y = pk2(a[2], a[3]); *(v2u*)(A0 + (size_t)r1 * D + c) = w; } }
    }
}
__device__ __forceinline__ void sample_prepass(const Params& P, int tid, int lane, int wave) {
    unsigned char* ws = P.ws;
    const int gw = blockIdx.x * NWAVES + wave, ngw = gridDim.x * NWAVES;
    const int* pt = (const int*)P.in[8]; bf16* RC = (bf16*)(ws + WS_RC);
    for (int it = gw; it < 2 * 128 * 16 * 4; it += ngw) { const int kv = it >> 13, sq = (it >> 6) & 127, p = (it >> 2) & 15, qtr = it & 3;
        const float* src = P.in[2 + kv] + (size_t)pt[sq * 16 + p] * (128 * 256) + qtr * 8192;
#pragma unroll
        for (int i0 = 0; i0 < 16; i0 += 8) { f32x4 a[8], b[8];
#pragma unroll
            for (int i = 0; i < 8; ++i) { const int e = ((i0 + i) * 64 + lane) * 8; a[i] = __builtin_nontemporal_load((const f32x4*)(src + e)); b[i] = __builtin_nontemporal_load((const f32x4*)(src + e + 4)); }
#pragma unroll
            for (int i = 0; i < 8; ++i) { const int e = ((i0 + i) * 64 + lane) * 8, tok = qtr * 32 + (e >> 8), g = (e >> 6) & 3, d = e & 63;
                v4u w; w.x = pk2(a[i][0], a[i][1]); w.y = pk2(a[i][2], a[i][3]); w.z = pk2(b[i][0], b[i][1]); w.w = pk2(b[i][2], b[i][3]);
                *(v4u*)(RC + ((size_t)kv * RC_KV + (size_t)(sq * 4 + g) * 128 + p * 8 + (tok >> 4)) * 1024 + (tok & 15) * 64 + d) = w; } } }
}
__device__ __forceinline__ void window_copy(const Params& P, int kv, int first, int nwg, int lane, int wave) {
    const int gw = first * NWAVES + wave, ngw = nwg * NWAVES;
    for (int it = gw; it < 128 * 64; it += ngw) { const int s = it >> 6, c = it & 63;
        const f32x4* src = (const f32x4*)P.in[6 + kv] + (size_t)s * 32768 + 64; f32x4* dst = (f32x4*)(P.out + (kv ? O_WVS : O_WKS)) + (size_t)s * 32768;
        f32x4 v[8];
#pragma unroll
        for (int i = 0; i < 8; ++i) { const int e = c * 512 + i * 64 + lane; if (e < 32704) v[i] = __builtin_nontemporal_load(src + e); }
#pragma unroll
        for (int i = 0; i < 8; ++i) { const int e = c * 512 + i * 64 + lane; if (e < 32704) __builtin_nontemporal_store(v[i], dst + e); } }
}
__device__ __forceinline__ void skinny_core(const bf16* Arows  , int lda, int K, const bf16* Bt64  , LAS float* RED, int tid, int lane, int wave, float& s0, float& s1) {
    const int col = lane & 15, quad = lane >> 4;
    const int kw = K >> 3;
    const bf16* ap = Arows + (size_t)col * lda + wave * kw + 8 * quad;
    const bf16* bp = Bt64 + (size_t)col * K + wave * kw + 8 * quad;
    f32x4 acc[4];
#pragma unroll
    for (int ct = 0; ct < 4; ++ct) acc[ct] = (f32x4){0.f, 0.f, 0.f, 0.f};
#pragma unroll 4
    for (int k0 = 0; k0 < kw; k0 += 32) { const bf16x8 af = *(const bf16x8*)(ap + k0);
#pragma unroll
        for (int ct = 0; ct < 4; ++ct) { const bf16x8 bf = *(const bf16x8*)(bp + (size_t)ct * 16 * K + k0); acc[ct] = MFMA16(af, bf, acc[ct]); } }
#pragma unroll
    for (int ct = 0; ct < 4; ++ct)
#pragma unroll
        for (int r = 0; r < 4; ++r) RED[((wave * 4 + ct) * 4 + r) * 64 + lane] = acc[ct][r];
    __syncthreads();
    const int r16 = tid >> 5, c2 = (tid & 31) * 2;
    const int base = ((c2 >> 4) * 4 + (r16 & 3)) * 64 + (c2 & 15) + 16 * (r16 >> 2);
    s0 = 0.f; s1 = 0.f;
#pragma unroll
    for (int wv = 0; wv < 8; ++wv) { s0 += RED[wv * 1024 + base]; s1 += RED[wv * 1024 + base + 1]; }
    __syncthreads();
}
__device__ __forceinline__ float half_wave_sum(float v) { v += __shfl_xor(v, 1); v += __shfl_xor(v, 2); v += __shfl_xor(v, 4); v += __shfl_xor(v, 8); v += __shfl_xor(v, 16); return v; }
template <bool XF32, bool OF32>
__device__ __forceinline__ void skinny_res(const bf16* A, int lda, int K, const bf16* Bt, const EpiRes<XF32, OF32>& E, LAS unsigned char* lds, int tid, int lane, int wave) {
    for (int task = blockIdx.x; task < 8 * 16; task += gridDim.x) { const int rt = task >> 4, cg = task & 15;
        float s0, s1;
        skinny_core(A + (size_t)(MP + 16 * rt) * lda, lda, K, Bt + (size_t)(64 * cg) * K, (LAS float*)lds, tid, lane, wave, s0, s1);
        const int srow = 16 * rt + (tid >> 5), row = MP + srow, sq = 2 + srow, c = 64 * cg + (tid & 31) * 2;
        float xi0, xi1;
        if (XF32) { const f32x2 xi = *(const f32x2*)(E.xin_s + (size_t)srow * D + c); xi0 = xi[0]; xi1 = xi[1]; }
        else { const unsigned w_ = *(const unsigned*)(E.xb_in + (size_t)row * D + c); xi0 = bflo(w_); xi1 = bfhi(w_); }
        const f32x2 gt = *(const f32x2*)(E.MOD + (size_t)sq * NMOD + E.goff + c);
        const float x0 = xi0 + gt[0] * s0, x1 = xi1 + gt[1] * s1;
        if (OF32) *(f32x2*)(E.out + (size_t)row * D + c) = (f32x2){x0, x1};
        else *(unsigned*)(E.xb_out + (size_t)row * D + c) = pk2(x0, x1);
        if (E.A1) { const f32x2 m = *(const f32x2*)(E.MUL + (size_t)sq * D + c); *(unsigned*)(E.A1 + (size_t)row * D + c) = pk2(x0 * m[0], x1 * m[1]); }
        if (E.SSQ) { const float q = half_wave_sum(x0 * x0 + x1 * x1); if ((tid & 31) == 0) ssq_add(E.SSQ + row, q); }
    }
}
__device__ __forceinline__ void skinny_ain(const bf16* A, const bf16* Bt, const EpiAin& E, LAS unsigned char* lds, int tid, int lane, int wave) {
    for (int task = blockIdx.x; task < 8 * 32; task += gridDim.x) { const int rt = task >> 5, cg = task & 31;
        float s0, s1;
        skinny_core(A + (size_t)(MP + 16 * rt) * D, D, D, Bt + (size_t)(64 * cg) * D, (LAS float*)lds, tid, lane, wave, s0, s1);
        const int srow = 16 * rt + (tid >> 5), row = MP + srow, sq = 2 + srow, c = 64 * cg + (tid & 31) * 2;
        const float rs = rstd1(E.SSQ0[row]);
        const f32x2 bv = *(const f32x2*)(E.BIAS + (size_t)sq * NBIG + OFF_WIN + c);
        const float g0 = gelu_t(s0 * rs + bv[0]), g1 = gelu_t(s1 * rs + bv[1]);
        if (cg < 16) *(unsigned*)(E.U + (size_t)row * D + c) = pk2(g0, g1);
        else { *(unsigned*)(E.V + (size_t)row * D + c - 1024) = pk2(g0, g1); const float q = half_wave_sum(g0 * g0 + g1 * g1); if ((tid & 31) == 0) ssq_add(E.SSQV + row, q); }
    }
}

__device__ __forceinline__ void phase_tokmix(const Params& P, LAS unsigned char* lds, int tid, int lane, int wave) {
    unsigned char* ws = P.ws;
    const bf16* U = (const bf16*)(ws + WS_U); const bf16* V = (const bf16*)(ws + WS_V); bf16* UM = (bf16*)(ws + WS_UM);
    const float* SSQV = (const float*)(ws + WS_SSQ) + (size_t)1 * M65; const bf16* WSB = (const bf16*)(ws + WS_WSB);
    const float* vgain = P.in[15]; const float* bs = P.in[17];
    const int col = lane & 15, quad = lane >> 4;
    v4u wv[4]; float rsn[4];
#define TM_LOAD(item_) do { const int chunk_ = (item_) >> 3, g_ = (item_) & 7; _Pragma("unroll") for (int i = 0; i < 4; ++i) { const int e = tid + 512 * i, s = e >> 4, c8 = (e & 15) * 8; const int row = chunk_ * 128 + s; \
        rsn[i] = SSQV[row]; wv[i] = *(const v4u*)(V + (size_t)row * D + g_ * 128 + c8); } } while (0)
#define TM_STORE(item_, VT_) do { const int chunk_ = (item_) >> 3, g_ = (item_) & 7; const bool lastc_ = (chunk_ & 63) == 63; _Pragma("unroll") for (int i = 0; i < 4; ++i) { const int e = tid + 512 * i, s = e >> 4, c8 = (e & 15) * 8; \
        const float rs = rstd1(rsn[i]); const v4u w = wv[i]; \
        const f32x4 g0 = *(const f32x4*)(vgain + g_ * 128 + c8), g1 = *(const f32x4*)(vgain + g_ * 128 + c8 + 4); \
        float x[8] = {bflo(w.x) * rs * g0[0], bfhi(w.x) * rs * g0[1], bflo(w.y) * rs * g0[2], bfhi(w.y) * rs * g0[3], bflo(w.z) * rs * g1[0], bfhi(w.z) * rs * g1[1], bflo(w.w) * rs * g1[2], bfhi(w.w) * rs * g1[3]}; \
        _Pragma("unroll") for (int k = 0; k < 8; ++k) (VT_)[(c8 + k) * 136 + s] = (bf16)(pk2(x[k], 0.f) & 0xffffu); \
        if (lastc_) { float* av = P.out + O_AVP + ((size_t)(chunk_ >> 6) * 128 + s) * D + g_ * 128 + c8; *(f32x4*)av = (f32x4){x[0], x[1], x[2], x[3]}; *(f32x4*)(av + 4) = (f32x4){x[4], x[5], x[6], x[7]}; } } } while (0)
    int buf = 0;
    if ((int)blockIdx.x < 1024) { TM_LOAD((int)blockIdx.x); TM_STORE((int)blockIdx.x, (LAS bf16*)lds); }
    for (int item = blockIdx.x; item < 1024; item += gridDim.x) { const int chunk = item >> 3, g = item & 7, r0 = chunk * 128;
        LAS bf16* VT = (LAS bf16*)(lds + buf * 36864);
        const int nxt = item + (int)gridDim.x;
        if (nxt < 1024) TM_LOAD(nxt);
        const int t = 16 * wave + col;
        bf16x8 bfr[4];
#pragma unroll
        for (int ks = 0; ks < 4; ++ks) bfr[ks] = (ks <= (wave >> 1)) ? *(const bf16x8*)(WSB + ((size_t)g * 128 + t) * 128 + 32 * ks + 8 * quad) : (bf16x8){0, 0, 0, 0, 0, 0, 0, 0};
        v2u uw[8];
#pragma unroll
        for (int ct = 0; ct < 8; ++ct) uw[ct] = *(const v2u*)(U + (size_t)(r0 + t) * D + g * 128 + 16 * ct + 4 * quad);
        const float bt = bs[g * 128 + t];
        __syncthreads();
        f32x4 acc[8];
#pragma unroll
        for (int ct = 0; ct < 8; ++ct) acc[ct] = (f32x4){0.f, 0.f, 0.f, 0.f};
#pragma unroll
        for (int ks = 0; ks < 4; ++ks) if (ks <= (wave >> 1)) {
#pragma unroll
            for (int ct = 0; ct < 8; ++ct) { const bf16x8 afr = *(const LAS bf16x8*)(VT + (16 * ct + col) * 136 + 32 * ks + 8 * quad); acc[ct] = MFMA16(afr, bfr[ks], acc[ct]); } }
#pragma unroll
        for (int ct = 0; ct < 8; ++ct) { const size_t o = (size_t)(r0 + t) * D + g * 128 + 16 * ct + 4 * quad;
            v2u w; w.x = pk2(bflo(uw[ct].x) * (acc[ct][0] + bt), bfhi(uw[ct].x) * (acc[ct][1] + bt)); w.y = pk2(bflo(uw[ct].y) * (acc[ct][2] + bt), bfhi(uw[ct].y) * (acc[ct][3] + bt)); *(v2u*)(UM + o) = w; }
        buf ^= 1;
        if (nxt < 1024) TM_STORE(nxt, (LAS bf16*)(lds + buf * 36864));
    }
#undef TM_LOAD
#undef TM_STORE
    const int gw = blockIdx.x * NWAVES + wave, ngw = gridDim.x * NWAVES;
    for (int r = MP + gw; r < M65; r += ngw) {
        const float rs = rstd1(SSQV[r]);
#pragma unroll
        for (int j = 0; j < 4; ++j) { const int c = 4 * lane + 256 * j, g = c >> 7; v2u w = {0u, 0u};
            if (r < MT) { const v2u vw = *(const v2u*)(V + (size_t)r * D + c), uw = *(const v2u*)(U + (size_t)r * D + c); const f32x4 gn = *(const f32x4*)(vgain + c);
                const f32x4 vn = (f32x4){bflo(vw.x), bfhi(vw.x), bflo(vw.y), bfhi(vw.y)} * rs * gn;
                *(f32x4*)(P.out + O_AVS + (size_t)(r - MP) * D + c) = vn;
                const float w00 = P.in[16][g * 16384], b0 = bs[g * 128];
                w.x = pk2(bflo(uw.x) * (w00 * vn[0] + b0), bfhi(uw.x) * (w00 * vn[1] + b0)); w.y = pk2(bflo(uw.y) * (w00 * vn[2] + b0), bfhi(uw.y) * (w00 * vn[3] + b0)); }
            *(v2u*)(UM + (size_t)r * D + c) = w; } }
}

__device__ __forceinline__ void w2_stage(const Params& P, LAS unsigned char* lds, int tid) {
    const bf16* W2 = (const bf16*)(P.ws + WS_W2);
#pragma unroll
    for (int i = 0; i < 8; ++i) { const int p = tid + 512 * i, f = p >> 6, l = p & 63, kv = f >> 5, dt = (f >> 3) & 3, ks = f & 7;
        *(LAS v4u*)(lds + (size_t)p * 16) = *(const v4u*)(W2 + (size_t)kv * 64 * 256 + (size_t)(16 * dt + (l & 15)) * 256 + 32 * ks + 8 * (l >> 4)); }
}
__device__ __forceinline__ void w2_load(const Params& P, int kv, int R0, int lane, bf16x8 (&hf)[8]) {
    const bf16* hrow = (const bf16*)(P.ws + WS_H2) + ((size_t)kv * RC_KV + R0 + (lane & 15)) * 256 + 8 * (lane >> 4);
#pragma unroll
    for (int ks = 0; ks < 8; ++ks) hf[ks] = *(const bf16x8*)(hrow + 32 * ks);
}
__device__ __forceinline__ void w2_task(const Params& P, const LAS unsigned char* lds, int kv, int R0, int lane, const bf16x8 (&hf)[8]) {
    unsigned char* ws = P.ws;
    const int col = lane & 15, quad = lane >> 4;
    const bool samp = R0 < RC_SAMP; const int gam = samp ? (R0 >> 7) : ((R0 - RC_SAMP) >> 9), i0 = samp ? (R0 & 127) : ((R0 - RC_SAMP) & 511);
    f32x4 acc[4];
#pragma unroll
    for (int dt = 0; dt < 4; ++dt) acc[dt] = (f32x4){0.f, 0.f, 0.f, 0.f};
#pragma unroll
    for (int ks = 0; ks < 8; ++ks)
#pragma unroll
        for (int dt = 0; dt < 4; ++dt) { const bf16x8 wf = *(const LAS bf16x8*)(lds + ((kv * 4 + dt) * 8 + ks) * 1024 + lane * 16);
            acc[dt] = kv ? MFMA16(hf[ks], wf, acc[dt]) : MFMA16(wf, hf[ks], acc[dt]); }
    const float* b2 = P.in[29] + kv * 64;
    if (!kv) {
        float sq = 0.f; f32x4 v[4];
#pragma unroll
        for (int dt = 0; dt < 4; ++dt) { v[dt] = acc[dt] + *(const f32x4*)(b2 + 16 * dt + 4 * quad); sq += (v[dt][0] * v[dt][0] + v[dt][1] * v[dt][1]) + (v[dt][2] * v[dt][2] + v[dt][3] * v[dt][3]); }
        sq += __shfl_xor(sq, 16); sq += __shfl_xor(sq, 32);
        const float ri = rsqrtf(sq * (1.0f / 64.0f) + EPS);
        bf16* dst = (samp ? (bf16*)(ws + WS_KCS) + ((size_t)gam * 128 + i0 + col) * 64 : (bf16*)(ws + WS_KCP) + ((size_t)gam * 512 + i0 + col) * 64) + 4 * quad;
#pragma unroll
        for (int dt = 0; dt < 4; ++dt) { const f32x4 kg = *(const f32x4*)(P.in[24] + 16 * dt + 4 * quad); const f32x4 o = v[dt] * ri * kg; v2u w; w.x = pk2(o[0], o[1]); w.y = pk2(o[2], o[3]); *(v2u*)(dst + 16 * dt) = w; }
    } else {
#pragma unroll
        for (int dt = 0; dt < 4; ++dt) { const int d = 16 * dt + col; const float bb = b2[d];
            const int ip = (i0 & ~63) + 32 * ((i0 >> 5) & 1) + 8 * quad + 4 * ((i0 >> 4) & 1);
            bf16* dst = (samp ? (bf16*)(ws + WS_VCTS) + (size_t)gam * 2 * 4096 : (bf16*)(ws + WS_VCTP) + (size_t)gam * 8 * 4096) + (size_t)(ip >> 6) * 4096 + d * 64 + (ip & 63);
            v2u w; w.x = pk2(acc[dt][0] + bb, acc[dt][1] + bb); w.y = pk2(acc[dt][2] + bb, acc[dt][3] + bb); *(v2u*)dst = w; }
    }
}
__device__ __forceinline__ void w2_own_units(const Params& P, LAS unsigned char* lds, const pg8::StaticOrder& S, int tid, int lane, int wave) {
    asm volatile("s_waitcnt vmcnt(0)" ::: "memory");
    __syncthreads();
    __builtin_amdgcn_fence(__ATOMIC_ACQUIRE, "agent");
    w2_stage(P, lds, tid);
    __syncthreads();
    pg8::Unit u0, u1, u2; const bool h0 = S.next(0, u0), h1 = S.next(1, u1), h2 = S.next(2, u2);
    bf16x8 fa[8], fb[8];
#define W2_UNIT(has, u) do { if (has) { const int kv = (u).pm >= RC_KV / 256 ? 1 : 0, Rb = ((u).pm - kv * (RC_KV / 256)) * 256; \
        w2_load(P, kv, Rb + 16 * wave, lane, fa); w2_load(P, kv, Rb + 16 * (wave + 8), lane, fb); \
        w2_task(P, lds, kv, Rb + 16 * wave, lane, fa); w2_task(P, lds, kv, Rb + 16 * (wave + 8), lane, fb); } } while (0)
    W2_UNIT(h0, u0); W2_UNIT(h1, u1); W2_UNIT(h2, u2);
#undef W2_UNIT
}

#ifndef ATT_REP_P
#define ATT_REP_P 1
#endif
#ifndef ATT_REP_S
#define ATT_REP_S 1
#endif

__device__ __forceinline__ void load_k8(const bf16* kb, int lane, bf16x8 (&kf)[8]) {
    const int col = lane & 15, quad = lane >> 4;
#pragma unroll
    for (int kt = 0; kt < 4; ++kt) { const bf16* kp = kb + (size_t)(16 * kt + col) * 64 + 8 * quad; kf[2 * kt] = *(const bf16x8*)kp; kf[2 * kt + 1] = *(const bf16x8*)(kp + 32); }
}
__device__ __forceinline__ void load_vt8(const bf16* vtb, int pitch, int lane, bf16x8 (&vf)[8]) {
    const int col = lane & 15, quad = lane >> 4;
#pragma unroll
    for (int dt = 0; dt < 4; ++dt)
#pragma unroll
        for (int ks = 0; ks < 2; ++ks) vf[2 * dt + ks] = *(const bf16x8*)(vtb + (size_t)(16 * dt + col) * pitch + 32 * ks + 8 * quad);
}
__device__ __forceinline__ void select_topk(LAS float* imps, int cur, int lane, unsigned (&msk)[4]) {
    const int col = lane & 15, quad = lane >> 4, ql = col >> 2, hl = col & 3;
#pragma unroll
    for (int w = 0; w < 4; ++w) msk[w] = 0u;
    if (cur <= 15) { msk[0] = (2u << cur) - 1u; return; }
    asm volatile("s_waitcnt lgkmcnt(0)" ::: "memory");
    const int lq = hl + 4 * quad;
    unsigned key[8];
#pragma unroll
    for (int e = 0; e < 8; ++e) { const int sg = lq + 16 * e; const float v = imps[ql * 128 + sg]; key[e] = (sg >= 1 && sg <= cur - 2) ? ((__builtin_bit_cast(unsigned, v) & ~127u) | (unsigned)sg) : 0u; }
    for (int it = 0; it < 13; ++it) {
        unsigned mx = key[0];
#pragma unroll
        for (int e = 1; e < 8; ++e) mx = mx > key[e] ? mx : key[e];
        { unsigned o = dpp_xor1u(mx); mx = mx > o ? mx : o; o = dpp_xor2u(mx); mx = mx > o ? mx : o; o = (unsigned)__shfl_xor((int)mx, 16); mx = mx > o ? mx : o; o = (unsigned)__shfl_xor((int)mx, 32); mx = mx > o ? mx : o; }
        const unsigned sg = mx & 127u, bit = mx ? (1u << (sg & 31u)) : 0u, w = sg >> 5;
        msk[0] |= w == 0u ? bit : 0u; msk[1] |= w == 1u ? bit : 0u; msk[2] |= w == 2u ? bit : 0u; msk[3] |= w == 3u ? bit : 0u;
#pragma unroll
        for (int e = 0; e < 8; ++e) key[e] = key[e] == mx ? 0u : key[e];
    }
    msk[0] |= 1u;
#pragma unroll
    for (int k = 0; k < 2; ++k) { const unsigned sg = (unsigned)(cur - k), bit = 1u << (sg & 31u), w = sg >> 5;
        msk[0] |= w == 0u ? bit : 0u; msk[1] |= w == 1u ? bit : 0u; msk[2] |= w == 2u ? bit : 0u; msk[3] |= w == 3u ? bit : 0u; }
}

__device__ __forceinline__ void attn_cmp_select(const bf16* kc, const bf16* vct, int vpitch, bf16x8 qn0, bf16x8 qn1, int nvis, int nkt, int cur, float nref,
                                                LAS float* imps, int lane, f32x4 (&oc)[4], unsigned (&msk)[4]) {
    const int col = lane & 15, quad = lane >> 4, ql = col >> 2, hl = col & 3;
    const int nb = (nkt + 3) >> 2;
    float lsum = 0.f;
    {   bf16x8 kfA[8], kfB[8];
        if (nb > 0) load_k8(kc, lane, kfA);
        for (int blk = 0; blk < nb; ++blk) {
            if (blk + 1 < nb) load_k8(kc + (size_t)(blk + 1) * 4096, lane, kfB);
#pragma unroll
            for (int kt = 0; kt < 4; ++kt) { f32x4 s = {nref, nref, nref, nref}; s = MFMA16(kfA[2 * kt], qn0, s); s = MFMA16(kfA[2 * kt + 1], qn1, s);
#pragma unroll
                for (int r = 0; r < 4; ++r) lsum += (64 * blk + 16 * kt + 4 * quad + r < nvis) ? fexp2(s[r]) : 0.f; }
#pragma unroll
            for (int i = 0; i < 8; ++i) kfA[i] = kfB[i];
        } }
    float l = lsum + __shfl_xor(lsum, 16); l += __shfl_xor(l, 32);
    const float rl = l > 0.f ? 1.0f / l : 0.f;
#pragma unroll
    for (int dt = 0; dt < 4; ++dt) oc[dt] = (f32x4){0.f, 0.f, 0.f, 0.f};
    float carry = 0.f;
    {   bf16x8 kfA[8], kfB[8], vfA[8];
        if (nb > 0) load_k8(kc, lane, kfA);
        for (int blk = 0; blk < nb; ++blk) {
            load_vt8(vct + (size_t)blk * 4096, 64, lane, vfA);
            if (blk + 1 < nb) load_k8(kc + (size_t)(blk + 1) * 4096, lane, kfB);
            float pa[4][4];
#pragma unroll
            for (int kt = 0; kt < 4; ++kt) { f32x4 s = {nref, nref, nref, nref}; s = MFMA16(kfA[2 * kt], qn0, s); s = MFMA16(kfA[2 * kt + 1], qn1, s);
                float hs[4];
#pragma unroll
                for (int r = 0; r < 4; ++r) { const float p = (64 * blk + 16 * kt + 4 * quad + r < nvis) ? fexp2(s[r]) * rl : 0.f; pa[kt][r] = p; float h = p + dpp_xor1(p); h += dpp_xor2(h); hs[r] = h; }
                const float tot = (hs[0] + hs[1]) + (hs[2] + hs[3]);
                const float up = __shfl(hs[3], (lane + 48) & 63);
                const float prev = quad == 0 ? carry : up; carry = up;
                if (hl == 0) imps[ql * 128 + 16 * blk + 4 * kt + quad] = tot + prev; }
#pragma unroll
            for (int ks = 0; ks < 2; ++ks) { v4u pw; pw.x = pk2(pa[2 * ks][0], pa[2 * ks][1]); pw.y = pk2(pa[2 * ks][2], pa[2 * ks][3]); pw.z = pk2(pa[2 * ks + 1][0], pa[2 * ks + 1][1]); pw.w = pk2(pa[2 * ks + 1][2], pa[2 * ks + 1][3]);
                const bf16x8 pb = __builtin_bit_cast(bf16x8, pw);
#pragma unroll
                for (int dt = 0; dt < 4; ++dt) oc[dt] = MFMA16(vfA[2 * dt + ks], pb, oc[dt]); }
#pragma unroll
            for (int i = 0; i < 8; ++i) kfA[i] = kfB[i];
        } }
    select_topk(imps, cur, lane, msk);
}

__device__ __forceinline__ void tile_step(const bf16x8 (&kf)[8], const bf16x8 (&vf)[8], bf16x8 q0, bf16x8 q1, float cinit, bool masked, int kpos0, int lo, int hi, int lane, f32x4 (&o)[4], float& lsum) {
    const int quad = lane >> 4;
    f32x4 p[4];
#pragma unroll
    for (int kt = 0; kt < 4; ++kt) { f32x4 s = {cinit, cinit, cinit, cinit}; s = MFMA16(kf[2 * kt], q0, s); s = MFMA16(kf[2 * kt + 1], q1, s);
#pragma unroll
        for (int r = 0; r < 4; ++r) p[kt][r] = fexp2(s[r]); }
    if (masked) {
#pragma unroll
        for (int kt = 0; kt < 4; ++kt)
#pragma unroll
            for (int r = 0; r < 4; ++r) { const int kpos = kpos0 + 16 * kt + 4 * quad + r; p[kt][r] = (kpos >= lo && kpos <= hi) ? p[kt][r] : 0.f; } }
#pragma unroll
    for (int kt = 0; kt < 4; ++kt) lsum += (p[kt][0] + p[kt][1]) + (p[kt][2] + p[kt][3]);
#pragma unroll
    for (int ks = 0; ks < 2; ++ks) {
        v4u pw; pw.x = pk2(p[2 * ks][0], p[2 * ks][1]); pw.y = pk2(p[2 * ks][2], p[2 * ks][3]); pw.z = pk2(p[2 * ks + 1][0], p[2 * ks + 1][1]); pw.w = pk2(p[2 * ks + 1][2], p[2 * ks + 1][3]);
        const bf16x8 pb = __builtin_bit_cast(bf16x8, pw);
#pragma unroll
        for (int dt = 0; dt < 4; ++dt) o[dt] = MFMA16(vf[2 * dt + ks], pb, o[dt]); }
}

struct AttnRefs { float cmp, slc, win; };

constexpr int AT_RING = 0, AT_SLOT = 16384, AT_NS = 4;
constexpr int AT_IMPS = AT_NS * AT_SLOT;
constexpr int AT_PARKA = AT_IMPS, AT_PARKB = AT_IMPS + 32768;
constexpr int AT_UNI = RING_BYTES + 1024;
static_assert(AT_PARKB + 32768 <= RING_BYTES && AT_UNI + 256 <= LDS_BYTES, "attention LDS map");
#define AT_WAITV(n) asm volatile("s_waitcnt vmcnt(" #n ")" ::: "memory")
#define AT_RING_WAIT2(rem) do { const int r_ = (rem); if (r_ >= 2) AT_WAITV(4); else if (r_ == 1) AT_WAITV(2); else AT_WAITV(0); } while (0)
#define AT_RING_WAIT1(rem) do { const int r_ = (rem); if (r_ >= 2) AT_WAITV(2); else if (r_ == 1) AT_WAITV(1); else AT_WAITV(0); } while (0)

struct TileQ { bf16x8 q0, q1; int nvis, nvt, tb, tq; };
__device__ __forceinline__ void pv_acc(const bf16x8 (&vf)[8], const f32x4 (&p)[4], f32x4 (&o)[4]);

__device__ __forceinline__ void cmp_p1_step(const bf16x8 (&kf)[8], const TileQ& T, float nref, int j, int lane, float& lsum) {
    const int quad = lane >> 4;
#pragma unroll
    for (int kt = 0; kt < 4; ++kt) { f32x4 s = {nref, nref, nref, nref}; s = MFMA16(kf[2 * kt], T.q0, s); s = MFMA16(kf[2 * kt + 1], T.q1, s);
#pragma unroll
        for (int r = 0; r < 4; ++r) lsum += (64 * j + 16 * kt + 4 * quad + r < T.nvis) ? fexp2(s[r]) : 0.f; }
}
__device__ __forceinline__ void cmp_p2_qk(const bf16x8 (&kf)[8], const TileQ& T, float nref, float rl, int j, int lane, float& carry, LAS float* imps, f32x4 (&pa)[4]) {
    const int col = lane & 15, quad = lane >> 4, ql = col >> 2, hl = col & 3;
#pragma unroll
    for (int kt = 0; kt < 4; ++kt) { f32x4 s = {nref, nref, nref, nref}; s = MFMA16(kf[2 * kt], T.q0, s); s = MFMA16(kf[2 * kt + 1], T.q1, s);
        float hs[4];
#pragma unroll
        for (int r = 0; r < 4; ++r) { const float p = (64 * j + 16 * kt + 4 * quad + r < T.nvis) ? fexp2(s[r]) * rl : 0.f; pa[kt][r] = p; float h = p + dpp_xor1(p); h += dpp_xor2(h); hs[r] = h; }
        const float tot = (hs[0] + hs[1]) + (hs[2] + hs[3]);
        const float up = __shfl(hs[3], (lane + 48) & 63);
        const float prev = quad == 0 ? carry : up; carry = up;
        if (hl == 0) imps[ql * 128 + 16 * j + 4 * kt + quad] = tot + prev; }
}

__device__ __forceinline__ void attn_cmp_ring2(const bf16* Kb, const bf16* Vb, LAS unsigned char* lds, const TileQ& A, const TileQ& B, int nb, int cur, float nref,
                                               LAS float* imps, int w, int lane, f32x4 (&oa)[4], f32x4 (&ob)[4], unsigned (&ma)[4], unsigned (&mb)[4]) {
    const int col = lane & 15, quad = lane >> 4;
    const size_t foff = (size_t)(16 * (w >> 1) + col) * 64 + 32 * (w & 1) + 8 * quad;
#define CR_DMAK(j) __builtin_amdgcn_global_load_lds((const unsigned*)(Kb + (size_t)(j) * 4096 + foff), (LAS unsigned*)(lds + AT_RING + ((j) & (AT_NS - 1)) * AT_SLOT + w * 1024), 16, 0, 0)
#define CR_DMAV(j) __builtin_amdgcn_global_load_lds((const unsigned*)(Vb + (size_t)(j) * 4096 + foff), (LAS unsigned*)(lds + AT_RING + ((j) & (AT_NS - 1)) * AT_SLOT + 8192 + w * 1024), 16, 0, 0)
    float lsa = 0.f, lsb = 0.f;
    asm volatile("s_waitcnt vmcnt(0)" ::: "memory"); __builtin_amdgcn_s_barrier(); asm volatile("" ::: "memory");
    for (int j = 0; j < AT_NS - 1; ++j) if (j < nb) CR_DMAK(j);
    for (int j = 0; j < nb; ++j) {
        AT_RING_WAIT1(nb - 1 - j);
        __builtin_amdgcn_s_barrier(); asm volatile("" ::: "memory");
        if (j + AT_NS - 1 < nb) CR_DMAK(j + AT_NS - 1);
        if (64 * j < B.nvt) {
            const LAS unsigned char* sl = lds + AT_RING + (j & (AT_NS - 1)) * AT_SLOT + lane * 16;
            bf16x8 kf[8];
#pragma unroll
            for (int f = 0; f < 8; ++f) kf[f] = *(const LAS bf16x8*)(sl + f * 1024);
            if (64 * j < A.nvt) cmp_p1_step(kf, A, nref, j, lane, lsa);
            cmp_p1_step(kf, B, nref, j, lane, lsb); }
    }
    lsa += __shfl_xor(lsa, 16); lsa += __shfl_xor(lsa, 32); lsb += __shfl_xor(lsb, 16); lsb += __shfl_xor(lsb, 32);
    const float rla = lsa > 0.f ? 1.0f / lsa : 0.f, rlb = lsb > 0.f ? 1.0f / lsb : 0.f;
#pragma unroll
    for (int dt = 0; dt < 4; ++dt) { oa[dt] = (f32x4){0.f, 0.f, 0.f, 0.f}; ob[dt] = (f32x4){0.f, 0.f, 0.f, 0.f}; }
    float ca = 0.f, cb = 0.f;
    asm volatile("s_waitcnt vmcnt(0)" ::: "memory"); __builtin_amdgcn_s_barrier(); asm volatile("" ::: "memory");
    for (int j = 0; j < AT_NS - 1; ++j) if (j < nb) { CR_DMAK(j); CR_DMAV(j); }
    for (int j = 0; j < nb; ++j) {
        AT_RING_WAIT2(nb - 1 - j);
        __builtin_amdgcn_s_barrier(); asm volatile("" ::: "memory");
        if (j + AT_NS - 1 < nb) { CR_DMAK(j + AT_NS - 1); CR_DMAV(j + AT_NS - 1); }
        const LAS unsigned char* sl = lds + AT_RING + (j & (AT_NS - 1)) * AT_SLOT + lane * 16;
        f32x4 pA[4], pB[4];
        {   bf16x8 kf[8];
#pragma unroll
            for (int f = 0; f < 8; ++f) kf[f] = *(const LAS bf16x8*)(sl + f * 1024);
            cmp_p2_qk(kf, A, nref, rla, j, lane, ca, imps, pA);
            cmp_p2_qk(kf, B, nref, rlb, j, lane, cb, imps + 512, pB); }
        asm volatile("" ::: "memory");
        {   bf16x8 vf[8];
#pragma unroll
            for (int f = 0; f < 8; ++f) vf[f] = *(const LAS bf16x8*)(sl + 8192 + f * 1024);
            pv_acc(vf, pA, oa); pv_acc(vf, pB, ob); }
    }
#undef CR_DMAK
#undef CR_DMAV
    select_topk(imps, cur, lane, ma);
    select_topk(imps + 512, cur, lane, mb);
}

__device__ __forceinline__ void qk_exp(const bf16x8 (&kf)[8], bf16x8 q0, bf16x8 q1, float cinit, bool masked, int kpos0, int lo, int hi, int lane, f32x4 (&p)[4], float& lsum) {
    const int quad = lane >> 4;
#pragma unroll
    for (int kt = 0; kt < 4; ++kt) { f32x4 s = {cinit, cinit, cinit, cinit}; s = MFMA16(kf[2 * kt], q0, s); s = MFMA16(kf[2 * kt + 1], q1, s);
#pragma unroll
        for (int r = 0; r < 4; ++r) p[kt][r] = fexp2(s[r]); }
    if (masked) {
#pragma unroll
        for (int kt = 0; kt < 4; ++kt)
#pragma unroll
            for (int r = 0; r < 4; ++r) { const int kpos = kpos0 + 16 * kt + 4 * quad + r; p[kt][r] = (kpos >= lo && kpos <= hi) ? p[kt][r] : 0.f; } }
#pragma unroll
    for (int kt = 0; kt < 4; ++kt) lsum += (p[kt][0] + p[kt][1]) + (p[kt][2] + p[kt][3]);
}
__device__ __forceinline__ void pv_acc(const bf16x8 (&vf)[8], const f32x4 (&p)[4], f32x4 (&o)[4]) {
#pragma unroll
    for (int ks = 0; ks < 2; ++ks) {
        v4u pw; pw.x = pk2(p[2 * ks][0], p[2 * ks][1]); pw.y = pk2(p[2 * ks][2], p[2 * ks][3]); pw.z = pk2(p[2 * ks + 1][0], p[2 * ks + 1][1]); pw.w = pk2(p[2 * ks + 1][2], p[2 * ks + 1][3]);
        const bf16x8 pb = __builtin_bit_cast(bf16x8, pw);
#pragma unroll
        for (int dt = 0; dt < 4; ++dt) o[dt] = MFMA16(vf[2 * dt + ks], pb, o[dt]); }
}
struct TileB { bf16x8 q0, q1; int tb, tq; float gate; };
template <int BR>
__device__ __forceinline__ void attn_branch2(const bf16* Kb, const bf16* Vb, LAS unsigned char* lds, int t0, int cur, float ref, const TileB& A, const TileB& B,
                                             const unsigned (&ma)[4], const unsigned (&mb)[4], const unsigned (&una)[4], const unsigned (&unb)[4], const unsigned (&uu)[4],
                                             int w, int lane, LAS unsigned char* parkA, LAS unsigned char* parkB) {
    const int col = lane & 15, quad = lane >> 4;
    int nblk, wlo = 0;
    unsigned c0 = uu[0], c1 = uu[1], c2 = uu[2], c3 = uu[3], p0 = uu[0], p1 = uu[1], p2 = uu[2], p3 = uu[3];
    if (BR == 0) nblk = __builtin_popcount(c0) + __builtin_popcount(c1) + __builtin_popcount(c2) + __builtin_popcount(c3);
    else { wlo = (t0 >= WIN ? t0 - WIN : 0) >> 6; nblk = cur - wlo + 1; }
    const size_t foff = (size_t)(16 * (w >> 1) + col) * 64 + 32 * (w & 1) + 8 * quad;
#define AT_BITNEXT(a, b, c, d, out) do { if (a) { out = __builtin_ctz(a); a &= a - 1u; } else if (b) { out = 32 + __builtin_ctz(b); b &= b - 1u; } else if (c) { out = 64 + __builtin_ctz(c); c &= c - 1u; } else { out = 96 + __builtin_ctz(d); d &= d - 1u; } } while (0)
#define AT_DMA(j) do { int sg_; if (BR == 0) AT_BITNEXT(p0, p1, p2, p3, sg_); else sg_ = wlo + (j); LAS unsigned char* sl_ = lds + AT_RING + ((j) & (AT_NS - 1)) * AT_SLOT + w * 1024; \
        __builtin_amdgcn_global_load_lds((const unsigned*)(Kb + (size_t)sg_ * 4096 + foff), (LAS unsigned*)sl_, 16, 0, 0); \
        __builtin_amdgcn_global_load_lds((const unsigned*)(Vb + (size_t)sg_ * 4096 + foff), (LAS unsigned*)(sl_ + 8192), 16, 0, 0); } while (0)
    f32x4 oa[4], ob[4]; float lsa = 0.f, lsb = 0.f;
#pragma unroll
    for (int dt = 0; dt < 4; ++dt) { oa[dt] = (f32x4){0.f, 0.f, 0.f, 0.f}; ob[dt] = (f32x4){0.f, 0.f, 0.f, 0.f}; }
    asm volatile("s_waitcnt vmcnt(0)" ::: "memory");
    __builtin_amdgcn_s_barrier();
    asm volatile("" ::: "memory");
    for (int j = 0; j < AT_NS - 1; ++j) if (j < nblk) AT_DMA(j);
    for (int j = 0; j < nblk; ++j) {
        AT_RING_WAIT2(nblk - 1 - j);
        __builtin_amdgcn_s_barrier();
        asm volatile("" ::: "memory");
        if (j + AT_NS - 1 < nblk) AT_DMA(j + AT_NS - 1);
        int sg; if (BR == 0) AT_BITNEXT(c0, c1, c2, c3, sg); else sg = wlo + j;
        bool na, nbb, mka, mkb;
        if (BR == 0) { const int sw = sg >> 5; const unsigned bit = 1u << (sg & 31);
            const unsigned wa = sw == 0 ? una[0] : sw == 1 ? una[1] : sw == 2 ? una[2] : una[3], wb = sw == 0 ? unb[0] : sw == 1 ? unb[1] : sw == 2 ? unb[2] : unb[3];
            int sgo = sg; asm volatile("" : "+s"(sgo));
            na = (wa & bit) != 0u; nbb = (wb & bit) != 0u; mka = mkb = sgo == cur;
            }
        else { na = (64 * sg + 63 >= A.tb - WIN) && (64 * sg <= A.tb + 3); mka = (64 * sg + 63 > A.tb) || (64 * sg < A.tb + 3 - WIN);
               nbb = (64 * sg + 63 >= B.tb - WIN) && (64 * sg <= B.tb + 3); mkb = (64 * sg + 63 > B.tb) || (64 * sg < B.tb + 3 - WIN); }
        if (na || nbb) {
            const LAS unsigned char* sl = lds + AT_RING + (j & (AT_NS - 1)) * AT_SLOT + lane * 16;
            const int sw = sg >> 5;
            float cia = ref, cib = ref;
            if (BR == 0) { const unsigned mwa = sw == 0 ? ma[0] : sw == 1 ? ma[1] : sw == 2 ? ma[2] : ma[3], mwb = sw == 0 ? mb[0] : sw == 1 ? mb[1] : sw == 2 ? mb[2] : mb[3];
                cia = ((mwa >> (sg & 31)) & 1u) ? ref : -1e30f; cib = ((mwb >> (sg & 31)) & 1u) ? ref : -1e30f; }
            f32x4 pA[4], pB[4];
            {   bf16x8 kf[8];
#pragma unroll
                for (int f = 0; f < 8; ++f) kf[f] = *(const LAS bf16x8*)(sl + f * 1024);
                if (na) qk_exp(kf, A.q0, A.q1, cia, mka, 64 * sg, BR == 0 ? 0 : A.tq - WIN, A.tq, lane, pA, lsa);
                if (nbb) qk_exp(kf, B.q0, B.q1, cib, mkb, 64 * sg, BR == 0 ? 0 : B.tq - WIN, B.tq, lane, pB, lsb); }
            asm volatile("" ::: "memory");
            {   bf16x8 vf[8];
#pragma unroll
                for (int f = 0; f < 8; ++f) vf[f] = *(const LAS bf16x8*)(sl + 8192 + f * 1024);
                if (na) pv_acc(vf, pA, oa);
                if (nbb) pv_acc(vf, pB, ob); }
        }
    }
#undef AT_BITNEXT
#undef AT_DMA
    lsa += __shfl_xor(lsa, 16); lsa += __shfl_xor(lsa, 32); lsb += __shfl_xor(lsb, 16); lsb += __shfl_xor(lsb, 32);
    const float sca = lsa > 0.f ? A.gate / lsa : 0.f, scb = lsb > 0.f ? B.gate / lsb : 0.f;
#pragma unroll
    for (int dt = 0; dt < 4; ++dt) { LAS f32x4* pa_ = (LAS f32x4*)(parkA + dt * 1024); LAS f32x4* pb_ = (LAS f32x4*)(parkB + dt * 1024); *pa_ = *pa_ + oa[dt] * sca; *pb_ = *pb_ + ob[dt] * scb; }
}

__device__ __forceinline__ void attn_prompt_unit(const Params& P, int unit, const AttnRefs& rf, LAS unsigned char* lds, int lane, int wave) {
    unsigned char* ws = P.ws;
    const int w = wave;
    const int gam = unit & 7, pt64 = unit >> 3, b = gam >> 2, g = gam & 3, t0 = 64 * pt64, cur = t0 >> 6;
    const int col = lane & 15, quad = lane >> 4, ql = col >> 2, hl = col & 3;
    LAS unsigned* UNI = (LAS unsigned*)(lds + AT_UNI);
    LAS float* imps = (LAS float*)(lds + AT_IMPS) + wave * 1024;
    const bf16* QN = (const bf16*)(ws + WS_QN); const bf16* QR = (const bf16*)(ws + WS_QR);
    const int tba = t0 + 8 * w, tbb = tba + 4, tqa = tba + ql, tqb = tbb + ql;
    const size_t qoa = (size_t)(b * SEQ + tqa) * D + (4 * g + hl) * 64 + 8 * quad, qob = qoa + 4 * D;
    f32x4 oa[4], ob[4]; unsigned ma[4], mb[4];
    {   TileQ A, B;
        A.q0 = *(const bf16x8*)(QN + qoa); A.q1 = *(const bf16x8*)(QN + qoa + 32); B.q0 = *(const bf16x8*)(QN + qob); B.q1 = *(const bf16x8*)(QN + qob + 32);
        A.tb = tba; A.tq = tqa; B.tb = tbb; B.tq = tqb;
        A.nvis = tqa >= 31 ? ((tqa - 31) >> 4) + 1 : 0; B.nvis = tqb >= 31 ? ((tqb - 31) >> 4) + 1 : 0;
        A.nvt = (tba + 3) >= 31 ? ((tba + 3 - 31) >> 4) + 1 : 0; B.nvt = (tbb + 3) >= 31 ? ((tbb + 3 - 31) >> 4) + 1 : 0;
        const int nvu = (t0 + 63) >= 31 ? ((t0 + 63 - 31) >> 4) + 1 : 0, nb = (nvu + 63) >> 6;
        attn_cmp_ring2((const bf16*)(ws + WS_KCP) + (size_t)gam * 512 * 64, (const bf16*)(ws + WS_VCTP) + (size_t)gam * 8 * 4096, lds, A, B, nb, cur, rf.cmp, imps, w, lane, oa, ob, ma, mb); }
    const float* gta = (const float*)(ws + WS_GATES) + (size_t)(b * SEQ + tqa) * 48 + (4 * g + hl) * 3; const float* gtb = gta + 4 * 48;
    LAS unsigned char* parkA = lds + AT_PARKA + w * 4096 + lane * 16; LAS unsigned char* parkB = lds + AT_PARKB + w * 4096 + lane * 16;
    {   const float ga = gta[0], gb = gtb[0];
#pragma unroll
        for (int dt = 0; dt < 4; ++dt) { *(LAS f32x4*)(parkA + dt * 1024) = oa[dt] * ga; *(LAS f32x4*)(parkB + dt * 1024) = ob[dt] * gb; } }
    unsigned una[4], unb[4];
#pragma unroll
    for (int k = 0; k < 4; ++k) { unsigned u = ma[k]; u |= (unsigned)__shfl_xor((int)u, 4); u |= (unsigned)__shfl_xor((int)u, 8); una[k] = (unsigned)__builtin_amdgcn_readfirstlane((int)u);
        unsigned v = mb[k]; v |= (unsigned)__shfl_xor((int)v, 4); v |= (unsigned)__shfl_xor((int)v, 8); unb[k] = (unsigned)__builtin_amdgcn_readfirstlane((int)v); }
    if (lane == 0) *(LAS v4u*)(UNI + w * 4) = (v4u){una[0] | unb[0], una[1] | unb[1], una[2] | unb[2], una[3] | unb[3]};
    __syncthreads();
    unsigned uu[4];
#pragma unroll
    for (int k = 0; k < 4; ++k) { unsigned x = 0u;
#pragma unroll
        for (int t = 0; t < 8; ++t) x |= UNI[4 * t + k];
        uu[k] = (unsigned)__builtin_amdgcn_readfirstlane((int)x); }
    TileB A, B;
    A.q0 = *(const bf16x8*)(QR + qoa); A.q1 = *(const bf16x8*)(QR + qoa + 32); B.q0 = *(const bf16x8*)(QR + qob); B.q1 = *(const bf16x8*)(QR + qob + 32);
    A.tb = tba; A.tq = tqa; B.tb = tbb; B.tq = tqb;
    A.gate = gta[1]; B.gate = gtb[1];
    attn_branch2<0>((const bf16*)(ws + WS_KS) + (size_t)gam * SEQ * 64, (const bf16*)(ws + WS_VST) + (size_t)gam * 128 * 4096, lds, t0, cur, rf.slc, A, B, ma, mb, una, unb, uu, w, lane, parkA, parkB);
    A.gate = gta[2]; B.gate = gtb[2];
    attn_branch2<1>((const bf16*)(ws + WS_KW) + (size_t)gam * SEQ * 64, (const bf16*)(ws + WS_VWT) + (size_t)gam * 128 * 4096, lds, t0, cur, rf.win, A, B, ma, mb, una, unb, uu, w, lane, parkA, parkB);
    bf16* opa = (bf16*)(ws + WS_O) + (size_t)(b * SEQ + tqa) * D + (4 * g + hl) * 64 + 4 * quad; bf16* opb = opa + 4 * D;
#pragma unroll
    for (int dt = 0; dt < 4; ++dt) { const f32x4 xa = *(const LAS f32x4*)(parkA + dt * 1024), xb = *(const LAS f32x4*)(parkB + dt * 1024);
        v2u wv; wv.x = pk2(xa[0], xa[1]); wv.y = pk2(xa[2], xa[3]); *(v2u*)(opa + 16 * dt) = wv;
        v2u wb; wb.x = pk2(xb[0], xb[1]); wb.y = pk2(xb[2], xb[3]); *(v2u*)(opb + 16 * dt) = wb; }
}

struct DecState { float m[4], l[4]; float o[4][8]; };
__device__ __forceinline__ void dec_step(const f32x4 (&kk)[2], const f32x4 (&vv)[2], bool ok, const unsigned (&qp)[4][4], DecState& st) {
#pragma unroll
    for (int h = 0; h < 4; ++h) {
        float d = (kk[0][0] * bflo(qp[h][0]) + kk[0][1] * bfhi(qp[h][0])) + (kk[0][2] * bflo(qp[h][1]) + kk[0][3] * bfhi(qp[h][1]))
                + (kk[1][0] * bflo(qp[h][2]) + kk[1][1] * bfhi(qp[h][2])) + (kk[1][2] * bflo(qp[h][3]) + kk[1][3] * bfhi(qp[h][3]));
        d += dpp_xor1(d); d += dpp_xor2(d); d += __shfl_xor(d, 4);
        const float sc = ok ? d : -1e30f, mn = fmaxf(st.m[h], sc), al = fexp2(st.m[h] - mn), p = ok ? fexp2(sc - mn) : 0.f;
        st.m[h] = mn; st.l[h] = st.l[h] * al + p;
#pragma unroll
        for (int j = 0; j < 2; ++j)
#pragma unroll
            for (int i = 0; i < 4; ++i) st.o[h][4 * j + i] = st.o[h][4 * j + i] * al + p * vv[j][i]; }
}
__device__ __forceinline__ void dec_job(const float* kbase, const float* vbase, int nkeys, const unsigned (&qp)[4][4], DecState& st, int lane) {
    const int ks8 = lane >> 3, d8 = lane & 7;
    const float* kp = kbase + (size_t)ks8 * 256 + 8 * d8; const float* vp = vbase + (size_t)ks8 * 256 + 8 * d8;
    const f32x4 z4 = {0.f, 0.f, 0.f, 0.f};
    f32x4 kc[2][2], vc[2][2], kn[2][2], vn[2][2];
#pragma unroll
    for (int a = 0; a < 2; ++a) { const bool ok0 = 8 * a + ks8 < nkeys;
#pragma unroll
        for (int j = 0; j < 2; ++j) { kc[a][j] = ok0 ? *(const f32x4*)(kp + (size_t)(8 * a) * 256 + 4 * j) : z4; vc[a][j] = ok0 ? *(const f32x4*)(vp + (size_t)(8 * a) * 256 + 4 * j) : z4; kn[a][j] = kc[a][j]; vn[a][j] = vc[a][j]; } }
#pragma unroll 1
    for (int k0 = 0; k0 < nkeys; k0 += 16) {
        if (k0 + 16 < nkeys) {
#pragma unroll
            for (int a = 0; a < 2; ++a) { const bool okn = k0 + 16 + 8 * a + ks8 < nkeys;
#pragma unroll
                for (int j = 0; j < 2; ++j) { kn[a][j] = okn ? *(const f32x4*)(kp + (size_t)(k0 + 16 + 8 * a) * 256 + 4 * j) : z4; vn[a][j] = okn ? *(const f32x4*)(vp + (size_t)(k0 + 16 + 8 * a) * 256 + 4 * j) : z4; } } }
        dec_step(kc[0], vc[0], k0 + ks8 < nkeys, qp, st);
        dec_step(kc[1], vc[1], k0 + 8 + ks8 < nkeys, qp, st);
#pragma unroll
        for (int a = 0; a < 2; ++a)
#pragma unroll
            for (int j = 0; j < 2; ++j) { kc[a][j] = kn[a][j]; vc[a][j] = vn[a][j]; } }
}

__device__ __forceinline__ void dec_publish(DecState& st, LAS float* slot, int lane) {
    const int d8 = lane & 7;
#pragma unroll
    for (int h = 0; h < 4; ++h) { float M = st.m[h]; M = fmaxf(M, __shfl_xor(M, 8)); M = fmaxf(M, __shfl_xor(M, 16)); M = fmaxf(M, __shfl_xor(M, 32));
        const float f = fexp2(st.m[h] - M); st.m[h] = M; float l = st.l[h] * f; l += __shfl_xor(l, 8); l += __shfl_xor(l, 16); l += __shfl_xor(l, 32); st.l[h] = l;
#pragma unroll
        for (int i = 0; i < 8; ++i) { float v = st.o[h][i] * f; v += __shfl_xor(v, 8); v += __shfl_xor(v, 16); v += __shfl_xor(v, 32); st.o[h][i] = v; } }
    if (lane < 8) {
#pragma unroll
        for (int h = 0; h < 4; ++h) { LAS float* pp = slot + h * 66; if (lane == 0) { pp[0] = st.m[h]; pp[1] = st.l[h]; }
#pragma unroll
            for (int i = 0; i < 8; ++i) pp[2 + 8 * d8 + i] = st.o[h][i]; } }
}
__device__ __forceinline__ void dec_reset(DecState& st) {
#pragma unroll
    for (int h = 0; h < 4; ++h) { st.m[h] = -1e30f; st.l[h] = 0.f;
#pragma unroll
        for (int i = 0; i < 8; ++i) st.o[h][i] = 0.f; }
}
__device__ __forceinline__ void attn_sample_item(const Params& P, int item, const AttnRefs& rf, LAS float* L, int tid, int lane, int wave) {
    unsigned char* ws = P.ws;
    const int s = item >> 2, g = item & 3, row = MP + s;
    LAS float* ocs = L; LAS unsigned* sel = (LAS unsigned*)(L + 256); LAS float* part = L + 260; LAS float* imps = L + 260 + 15 * 4 * 66;
    const float* gates = (const float*)(ws + WS_GATES) + (size_t)row * 48 + 4 * g * 3;
    const int d8 = lane & 7;
    unsigned qp[4][4];
    {   const bf16* QR = (const bf16*)(ws + WS_QR) + (size_t)row * D + 4 * g * 64 + 8 * d8;
#pragma unroll
        for (int h = 0; h < 4; ++h) { const v4u a = *(const v4u*)(QR + h * 64); qp[h][0] = a.x; qp[h][1] = a.y; qp[h][2] = a.z; qp[h][3] = a.w; } }
    DecState st;
    if (wave == 0) {
        const int col = lane & 15, quad = lane >> 4, ql = col >> 2, hl = col & 3;
        const size_t qoff = (size_t)row * D + (4 * g + hl) * 64 + 8 * quad; const bf16* QN = (const bf16*)(ws + WS_QN);
        const bf16x8 qn0 = *(const bf16x8*)(QN + qoff), qn1 = *(const bf16x8*)(QN + qoff + 32);
        f32x4 oc[4]; unsigned msk[4];
        attn_cmp_select((const bf16*)(ws + WS_KCS) + (size_t)item * 128 * 64, (const bf16*)(ws + WS_VCTS) + (size_t)item * 2 * 4096, 64, qn0, qn1, 127, 8, 32, rf.cmp, imps, lane, oc, msk);
        const float g0 = gates[hl * 3];
        if (ql == 0) {
#pragma unroll
            for (int dt = 0; dt < 4; ++dt)
#pragma unroll
                for (int r = 0; r < 4; ++r) ocs[hl * 64 + 16 * dt + 4 * quad + r] = oc[dt][r] * g0; }
        if (lane == 0) sel[0] = msk[0];
    } else {
        dec_reset(st);
#pragma unroll 1
        for (int J = wave - 1; J <= 8; J += 7) { const float* kb; const float* vb; int nk = 64;
            if (J == 8) { const size_t base = ((size_t)s * WIN + (WIN - 1)) * 256 + g * 64; kb = P.out + O_WKS + base; vb = P.out + O_WVS + base; nk = 1; }
            else { const size_t base = ((size_t)s * WIN + 64 * J) * 256 + g * 64; kb = P.in[6] + base; vb = P.in[7] + base; }
            dec_job(kb, vb, nk, qp, st, lane); }
        dec_publish(st, part + (8 + wave - 1) * 4 * 66, lane);
    }
    __syncthreads();
    {   const unsigned m0 = sel[0];
        const int* pt = (const int*)P.in[8] + s * 16;
        dec_reset(st);
#pragma unroll 1
        for (int J = wave; J <= 15; J += 8) { const float* kb; const float* vb; int nk = 64;
            if (J == 15) { kb = P.out + O_SKS + (size_t)s * 256 + g * 64; vb = P.out + O_SVS + (size_t)s * 256 + g * 64; nk = 1; }
            else { unsigned bits = m0; for (int i = 0; i < J; ++i) bits &= bits - 1u; const int sg = bits ? __builtin_ctz(bits) : 0;
                const size_t base = ((size_t)pt[sg >> 1] * 128 + (sg & 1) * 64) * 256 + g * 64; kb = P.in[4] + base; vb = P.in[5] + base; }
            dec_job(kb, vb, nk, qp, st, lane); }
        dec_publish(st, part + wave * 4 * 66, lane);
    }
    __syncthreads();
    if (tid < 256) { const int h = tid >> 6, d = tid & 63;
        float res = ocs[h * 64 + d];
#pragma unroll
        for (int br = 0; br < 2; ++br) { const int w0 = br ? 8 : 0, w1 = br ? 15 : 8; float M = -1e30f;
            for (int w = w0; w < w1; ++w) M = fmaxf(M, part[(w * 4 + h) * 66]);
            float Lt = 0.f, Ot = 0.f;
            for (int w = w0; w < w1; ++w) { const LAS float* pp = part + (w * 4 + h) * 66; const float f = fexp2(pp[0] - M); Lt += pp[1] * f; Ot += pp[2 + d] * f; }
            res += (Lt > 0.f ? Ot / Lt : 0.f) * gates[h * 3 + 1 + br]; }
        ((bf16*)(ws + WS_O))[(size_t)row * D + (4 * g + h) * 64 + d] = (bf16)(pk2(res, 0.f) & 0xffffu); }
    __syncthreads();
}

__device__ __forceinline__ void attn_refs(const Params& P, int lane, AttnRefs& rf) {
    float qg = fabsf(P.in[20][lane]), k0 = fabsf(P.in[24][lane]), k1 = fabsf(P.in[24][64 + lane]), k2 = fabsf(P.in[24][128 + lane]);
    qg = wave_max(qg); k0 = wave_max(k0); k1 = wave_max(k1); k2 = wave_max(k2);
    rf.cmp = -8.0f * 1.4426950409f * qg * k0; rf.slc = -8.0f * 1.4426950409f * qg * k1; rf.win = -8.0f * 1.4426950409f * qg * k2;
}
__device__ __forceinline__ void phase_attn(const Params& P, const AttnRefs& rf, LAS unsigned char* lds, int tid, int lane, int wave) {
    {
        for (int k = 0; k < ATT_REP_P; ++k)
        for (int u0 = blockIdx.x; u0 < 1024; u0 += gridDim.x) { const int gam = u0 & 7, p0 = u0 >> 3, kk = p0 >> 5; const int pt64 = (kk & 1) ? (32 * kk + 31 - (p0 & 31)) : p0;
            attn_prompt_unit(P, pt64 * 8 + gam, rf, lds, lane, wave); } }
    const int gtid = blockIdx.x * 512 + tid, ngt = gridDim.x * 512;
    for (int e = gtid; e < (M65 - MT) * 128; e += ngt) *(v4u*)((bf16*)(P.ws + WS_O) + (size_t)MT * D + (size_t)e * 8) = (v4u){0u, 0u, 0u, 0u};
}

constexpr int NPHASE = 15;
__global__ void __launch_bounds__(NWAVES * 64, 2) fwd(Params P) {
    extern __shared__ __attribute__((aligned(16))) unsigned char lds_raw[];
    LAS unsigned char* lds = (LAS unsigned char*)lds_raw;
    const int tid = threadIdx.x, lane = tid & 63, wave = __builtin_amdgcn_readfirstlane(tid >> 6);
    const int G = gridDim.x;
    unsigned char* ws = P.ws;
    for (int u = tid; u < (LDS_BYTES - LDSCTL_OFF) / 4; u += NWAVES * 64) ((LAS unsigned*)(lds + LDSCTL_OFF))[u] = 0u;
    __syncthreads();
    XcdBarrier bar; bar.bar = (unsigned*)(ws + WS_CTL) + CW_BAR; bar.x = 0; bar.st = nullptr;
#if !MK_PER_PHASE
    bar = xcd_barrier_post((unsigned*)(ws + WS_CTL) + CW_BAR, (volatile LAS unsigned*)(lds + MISC_OFF) + 8);
#endif
    const int lo = P.ph_lo, hi = P.ph_hi;
#ifndef PH_MASK
#define PH_MASK 0x7fff
#endif
#define EN(k) (((PH_MASK) >> (k)) & 1)
#ifndef REP_MASK
#define REP_MASK 0
#endif
#define REPS(k) ((((REP_MASK) >> (k)) & 1) + 1)
#define IN(k) (lo <= (k) && (k) < hi)
#ifdef PROBE_PH
#define STAMP2(k) do { if (blockIdx.x == 0 && tid == 0) ((unsigned long long*)(ws + WS_CTL + 65536))[32 + (k)] = __builtin_amdgcn_s_memrealtime(); } while (0)
#define STAMP3(k) do { if (blockIdx.x == 0 && tid == 0) ((unsigned long long*)(ws + WS_CTL + 65536))[64 + (k)] = __builtin_amdgcn_s_memrealtime(); } while (0)
#else
#define STAMP2(k) do { } while (0)
#define STAMP3(k) do { } while (0)
#endif

#if MK_PER_PHASE
#define GRID_BAR(k) do { } while (0)
#else
#ifdef PROBE_PH
#define GRID_BAR(k) do { if ((k) + 1 < hi) xcd_barrier(bar); if (blockIdx.x == 0 && tid == 0) ((unsigned long long*)(ws + WS_CTL + 65536))[(k) + 1] = __builtin_amdgcn_s_memrealtime(); } while (0)
#else
#define GRID_BAR(k) do { if ((k) + 1 < hi) xcd_barrier(bar); } while (0)
#endif
#endif
    bf16* WBIG = (bf16*)(ws + WS_WBIG); bf16* ACTA = (bf16*)(ws + WS_ACTA); bf16* XB = (bf16*)(ws + WS_AKV); float* SSQ = (float*)(ws + WS_SSQ);
    float* MOD = (float*)(ws + WS_MOD); float* BIAS = (float*)(ws + WS_BIAS); float* ROPE = (float*)(ws + WS_ROPE);
    const size_t SSQ_STRIDE = (size_t)M65;

#ifdef PROBE_PH
    if (blockIdx.x == 0 && tid == 0) ((unsigned long long*)(ws + WS_CTL + 65536))[0] = __builtin_amdgcn_s_memrealtime();
#endif
    if (EN(0) && IN(0)) { for (int rep_ = 0; rep_ < REPS(0); ++rep_) phase0(P, lds, tid, lane, wave); GRID_BAR(0); }
    if (EN(1) && IN(1)) {
        pg8::Gemm g{(const bf16*)(ws + WS_SC), (const bf16*)(ws + WS_WADA), 256, NMOD, 1024, 1024, 1 << 30, 0}; pg8::StaticOrder S; S.init(256, NMOD, G, (int)blockIdx.x);
        EpiMod E{MOD, (bf16*)(ws + WS_SH), P.in[12]};
        pg8::gemm_phase<EpiMod, true>(lds + RING_OFF, g, S, E);
        __syncthreads();
        for (int rep_ = 0; rep_ < REPS(18); ++rep_) phase1_weights(P, lds, lane, wave);
        GRID_BAR(1); }
    if (EN(2) && IN(2)) {
        pg8::Gemm g{(const bf16*)(ws + WS_SH), WBIG, 1024, NBIG, 1024, 1024, 1 << 30, 0}; pg8::StaticOrder S; S.init(1024, NBIG, G, (int)blockIdx.x); S.diag = 1;
        EpiBias E{BIAS};
        for (int rep_ = 0; rep_ < REPS(2); ++rep_) pg8::gemm_phase<EpiBias, true>(lds + RING_OFF, g, S, E);
        for (int rep_ = 0; rep_ < REPS(15); ++rep_) phase2_tail(P, tid, lane, wave);
        for (int rep_ = 0; rep_ < REPS(16); ++rep_) sample_prepass(P, tid, lane, wave);
        GRID_BAR(2); }
#ifdef NO_SKINNY
#define SKINNY_ON(x) do { } while (0)
#else
#define SKINNY_ON(x) x
#endif
#define COMMON_PHASES(layer) do { \
        const int po = layer ? 12 : 5; \
        if (EN(5) && IN(po)) { \
            pg8::Gemm g{layer ? (const bf16*)(ws + WS_O) : (const bf16*)(ws + WS_UM), layer ? (const bf16*)(ws + WS_WBO) : (const bf16*)(ws + WS_WOUT), MP, 1024, 1024, 1024, 1 << 30, 0}; \
            pg8::StaticOrder S; S.init(MP, 1024, G, (int)blockIdx.x); \
            EpiRes<(layer) == 0, false> E{P.in[0], P.in[1], XB, MOD, layer * 6144 + 2048, nullptr, XB, (const float*)(ws + WS_MUL) + (size_t)(layer ? 2 : 0) * 256 * 1024, ACTA, SSQ + (layer ? 4 : 2) * SSQ_STRIDE}; \
            for (int rep_ = 0; rep_ < (layer ? 1 : REPS(5)); ++rep_) pg8::gemm_phase<EpiRes<(layer) == 0, false>, false>(lds + RING_OFF, g, S, E); \
            STAMP2(po); SKINNY_ON(skinny_res(g.A, 1024, 1024, g.Bt, E, lds, tid, lane, wave)); STAMP3(po); \
            GRID_BAR(po); } \
        if (EN(6) && IN(po + 1)) { \
            const int off = layer ? OFF_GU1 : OFF_GU0; \
            pg8::Gemm g{ACTA, WBIG + (size_t)off * 1024, M65, NGU, 1024, 1024, 1 << 30, 0}; pg8::StaticOrder S; S.init(M65, NGU, G, (int)blockIdx.x); \
            EpiGU E{SSQ + (layer ? 4 : 2) * SSQ_STRIDE, BIAS, off, (bf16*)(ws + WS_HID)}; \
            for (int rep_ = 0; rep_ < (layer ? 1 : REPS(6)); ++rep_) pg8::gemm_phase<EpiGU, true>(lds + RING_OFF, g, S, E); \
            { const int nu = (M65 / 256) * (NGU / 256), nx = nu - (nu / G) * G; \
              if (nx > 0) { if ((int)blockIdx.x >= nx) window_copy(P, layer, (int)blockIdx.x - nx, G - nx, lane, wave); } else window_copy(P, layer, (int)blockIdx.x, G, lane, wave); } \
            GRID_BAR(po + 1); } \
        if (EN(7) && IN(po + 2)) { \
            pg8::Gemm g{(const bf16*)(ws + WS_HID), (const bf16*)(ws + WS_WDN) + (size_t)layer * 1024 * DFF, MP, 1024, DFF, DFF, 1 << 30, 0}; pg8::StaticOrder S; S.init(MP, 1024, G, (int)blockIdx.x); \
            EpiRes<false, (layer) == 1> E{nullptr, nullptr, XB, MOD, layer * 6144 + 5120, P.out, XB, (const float*)(ws + WS_MUL) + (size_t)256 * 1024, layer ? nullptr : ACTA, layer ? nullptr : SSQ + 3 * SSQ_STRIDE}; \
            pg8::gemm_phase<EpiRes<false, (layer) == 1>, false>(lds + RING_OFF, g, S, E); \
            STAMP2(po + 2); SKINNY_ON(skinny_res(g.A, DFF, DFF, g.Bt, E, lds, tid, lane, wave)); STAMP3(po + 2); \
            GRID_BAR(po + 2); } \
    } while (0)
            if (EN(3) && IN(3)) {
                pg8::Gemm g{ACTA, WBIG + (size_t)OFF_WIN * 1024, MP, NAIN, 1024, 1024, 1 << 30, 0}; pg8::StaticOrder S; S.init(MP, NAIN, G, (int)blockIdx.x);
                EpiAin E{SSQ, BIAS, (bf16*)(ws + WS_U), (bf16*)(ws + WS_V), SSQ + SSQ_STRIDE};
                for (int rep_ = 0; rep_ < REPS(3); ++rep_) pg8::gemm_phase<EpiAin, true>(lds + RING_OFF, g, S, E);
                skinny_ain(ACTA, WBIG + (size_t)OFF_WIN * 1024, E, lds, tid, lane, wave);
                GRID_BAR(3); }
            if (EN(4) && IN(4)) { for (int rep_ = 0; rep_ < REPS(4); ++rep_) phase_tokmix(P, lds, tid, lane, wave); GRID_BAR(4); }
    COMMON_PHASES(0);
            if (EN(8) && IN(8)) {
                { pg8::Gemm g{(const bf16*)(ws + WS_AKV), (const bf16*)(ws + WS_WKV), M65, NKV, 1024, 1024, 1 << 30, 0}; pg8::StaticOrder S; S.init(M65, NKV, G, (int)blockIdx.x);
                  EpiKV E{SSQ + 3 * SSQ_STRIDE, P.in[24], ROPE, P.out, (bf16*)(ws + WS_RC), (bf16*)(ws + WS_KS), (bf16*)(ws + WS_KW), (bf16*)(ws + WS_VST), (bf16*)(ws + WS_VWT)};
                  for (int rep_ = 0; rep_ < REPS(8); ++rep_) pg8::gemm_phase<EpiKV, true>(lds + RING_OFF, g, S, E); }
                { pg8::Gemm g{ACTA, WBIG + (size_t)OFF_Q * 1024, M65, NQP, 1024, 1024, 1 << 30, 0}; pg8::StaticOrder S; S.init(M65, NQP, G, (int)((blockIdx.x + 122) % G));
                  EpiQ E{SSQ + 3 * SSQ_STRIDE, BIAS, P.in[20], ROPE, (bf16*)(ws + WS_QN), (bf16*)(ws + WS_QR), (float*)(ws + WS_GATES)};
                  for (int rep_ = 0; rep_ < REPS(17); ++rep_) pg8::gemm_phase<EpiQ, true>(lds + RING_OFF, g, S, E); }
                GRID_BAR(8); }
            if (EN(9) && IN(9)) {
                constexpr int NCB = RC_PROMPT * 2 / 256;
                EpiCmp E{(const float*)(ws + WS_C1), (bf16*)(ws + WS_H2)};
                pg8::Gemm g{(const bf16*)(ws + WS_RC), (const bf16*)(ws + WS_W1C), 2 * RC_KV, 256, 2048, 1024, RC_KV / 256, (long)256 * 2048};
                {   pg8::StaticOrder S; S.init(2 * RC_SAMP, 256, G, (int)blockIdx.x); S.cut = RC_SAMP / 256; S.off0 = 0; S.off1 = RC_PROMPT / 256;
                    pg8::gemm_phase<EpiCmp, true>(lds + RING_OFF, g, S, E);
                    STAMP2(9); w2_own_units(P, lds, S, tid, lane, wave); STAMP3(9); }
#if !MK_PER_PHASE
                xcd_barrier(bar);
#endif
                AttnRefs rf; attn_refs(P, lane, rf);
                if ((int)blockIdx.x < NCB) {
                    pg8::StaticOrder S; S.init(2 * RC_PROMPT, 256, NCB, (int)blockIdx.x); S.cut = RC_PROMPT / 256; S.off0 = RC_SAMP / 256; S.off1 = RC_KV / 256 + RC_SAMP / 256 - RC_PROMPT / 256;
                    pg8::gemm_phase<EpiCmp, true>(lds + RING_OFF, g, S, E);
                    w2_own_units(P, lds, S, tid, lane, wave);
                    __syncthreads(); }
                {   unsigned* ticket = (unsigned*)(ws + WS_CTL) + 2048;
                    LAS unsigned* tk = (LAS unsigned*)(lds + RING_BYTES + 512);
                    for (;;) {
                        if (tid == 0) *tk = __hip_atomic_fetch_add(ticket, 1u, __ATOMIC_RELAXED, __HIP_MEMORY_SCOPE_AGENT);
                        __syncthreads();
                        const unsigned item = *tk;
                        __syncthreads();
                        if (item >= 512u) break;
                        attn_sample_item(P, (int)item, rf, (LAS float*)lds, tid, lane, wave); } }
                GRID_BAR(9); }
            if (EN(11) && IN(11)) {
                AttnRefs rf; attn_refs(P, lane, rf);
                phase_attn(P, rf, lds, tid, lane, wave); GRID_BAR(11); }
    COMMON_PHASES(1);
#ifdef PROBE_PH
    if (blockIdx.x == 0) {
        __syncthreads();
        const unsigned long long* st = (const unsigned long long*)(ws + WS_CTL + 65536);
        const int sel = (PROBE_PH) % 100; unsigned long long t1 = st[sel + 1], t0 = (PROBE_PH) >= 100 ? st[0] : st[sel];
        if ((PROBE_PH) >= 300) { t0 = st[32 + sel]; t1 = st[64 + sel]; } else if ((PROBE_PH) >= 200) { t0 = st[sel]; t1 = st[32 + sel]; }
        const float us = (float)(t1 - t0) * 0.01f; const float eps = sqrtf(us * (((PROBE_PH) >= 100 && (PROBE_PH) < 200) ? 1e-4f : 1e-3f));
        for (int e = tid; e < 128 * 1024; e += 512) P.out[O_AVS + e] *= (1.0f + eps); }
#endif
#undef IN
#undef EN
#undef REPS
#undef GRID_BAR
}

extern "C" void kernel_launch(void* const* d_in, const int* in_sizes, int n_in, void* d_out, int out_size, void* d_ws, size_t ws_size, hipStream_t stream) {
    static int grid = 0;
    if (grid == 0) {
        if (n_in != 32 || ws_size < WS_END) { fprintf(stderr, "kernel_launch: unexpected problem (n_in %d, ws %zu < %zu)\n", n_in, ws_size, (size_t)WS_END); grid = -1; return; }
        int dev = 0, cus = 0;
        if (hipGetDevice(&dev) != hipSuccess || hipDeviceGetAttribute(&cus, hipDeviceAttributeMultiprocessorCount, dev) != hipSuccess) { grid = -1; return; }
        if (hipFuncSetAttribute((const void*)fwd, hipFuncAttributeMaxDynamicSharedMemorySize, LDS_BYTES) != hipSuccess) { fprintf(stderr, "kernel_launch: hipFuncSetAttribute failed\n"); grid = -1; return; }
        int per_cu = 0;
        if (hipOccupancyMaxActiveBlocksPerMultiprocessor(&per_cu, (const void*)fwd, NWAVES * 64, LDS_BYTES) != hipSuccess || per_cu < 1) fprintf(stderr, "kernel_launch: occupancy query says %d\n", per_cu);
        (void)hipGetLastError();
        grid = cus;
    }
    if (grid < 0) return;
    (void)hipMemsetAsync((char*)d_ws + WS_CTL, 0, CTL_ZERO_BYTES, stream);
    Params p{};
    for (int i = 0; i < 32; ++i) p.in[i] = (const float*)d_in[i];
    p.out = (float*)d_out; p.ws = (unsigned char*)d_ws;
#if MK_PER_PHASE
    for (int k = 0; k < NPHASE; ++k) { p.ph_lo = k; p.ph_hi = k + 1; hipLaunchKernelGGL(fwd, dim3(grid), dim3(NWAVES * 64), LDS_BYTES, stream, p); }
#else
    p.ph_lo = 0; p.ph_hi = NPHASE;
    hipLaunchKernelGGL(fwd, dim3(grid), dim3(NWAVES * 64), LDS_BYTES, stream, p);
#endif
    const hipError_t le = hipPeekAtLastError();
    if (le != hipSuccess) fprintf(stderr, "kernel_launch: launch failed: %s\n", hipGetErrorName(le));
}
```
